# Optimizing an MI355X kernel written in HIP

```python
import jax, jax.numpy as jnp
from jax import lax
import numpy as np

D_MODEL = 2048
BATCH = 2
SEQ = 4096
DEPTH = 2
DEC_BATCH = 8
DEC_SEQ = 4
PAST_LEN = 16384
PAGE_SIZE = 128

POOL_WIDTH = D_MODEL // 2
POOL_WINDOWS = (2, 4, 8, 16)
POOL_GROUPS = len(POOL_WINDOWS)
POOL_GROUP_DIM = POOL_WIDTH // POOL_GROUPS
POOL_STATE = max(POOL_WINDOWS) - 1
N_HEADS = 16
HEAD_DIM = 64
N_KV_HEADS = 4
GQA = N_HEADS // N_KV_HEADS
ATT_WIDTH = N_HEADS * HEAD_DIM
KV_WIDTH = N_KV_HEADS * HEAD_DIM
N_KV_ROWS = 4
N_KV_PROJ = 6
BLOCK = 64
TOP_N = 16
WINDOW = 512
Q_BLOCK = 64
N_ATT_GATES = 3
SSM_WIDTH = D_MODEL // 2
SSM_GROUP_DIM = 16
SSM_GROUPS = SSM_WIDTH // SSM_GROUP_DIM
SSM_STATE = 64
DT_MIN = 0.001
DT_MAX = 0.1
N_BRANCH = 3
EPS = 1e-6
NEG = -1e30
FORCE = 1e4
IN_SPLITS = (POOL_WIDTH, POOL_WIDTH, ATT_WIDTH, N_KV_PROJ * KV_WIDTH, N_HEADS * N_ATT_GATES,
             ATT_WIDTH, SSM_WIDTH, SSM_WIDTH, N_BRANCH * D_MODEL)
D_IN = sum(IN_SPLITS)
IN_OFFSETS = tuple(int(v) for v in np.cumsum(IN_SPLITS)[:-1])

kernel_name = 'hybrid_pool_nsa_s5_decode_step'


def _rmsnorm(x, g):
    x32 = x.astype(jnp.float32)
    y = x32 * lax.rsqrt(jnp.mean(x32 * x32, axis=-1, keepdims=True) + EPS)
    return (y * g.astype(jnp.float32)).astype(x.dtype)


def _pool_mixer(u, prefix, q0, w_pool, pool_scale):
    b, s, _ = u.shape
    ext = jnp.concatenate([prefix.astype(u.dtype), u], axis=1)
    e32 = ext.astype(jnp.float32)
    cs = jnp.cumsum(e32, axis=1)
    cs = jnp.concatenate([jnp.zeros_like(cs[:, :1]), cs], axis=1)
    pos = q0 + jnp.arange(s, dtype=jnp.int32)
    end = POOL_STATE + 1
    means = []
    for gi, w in enumerate(POOL_WINDOWS):
        lo, hi = gi * POOL_GROUP_DIM, (gi + 1) * POOL_GROUP_DIM
        tot = cs[:, end:end + s, lo:hi] - cs[:, end - w:end - w + s, lo:hi]
        cnt = jnp.minimum(pos + 1, w).astype(jnp.float32)
        means.append(tot / cnt[None, :, None])
    diff = jnp.concatenate(means, axis=-1) - e32[:, POOL_STATE:]
    diff = diff.reshape(b, s, POOL_GROUPS, POOL_GROUP_DIM)
    y = jnp.einsum('bsgc,gcd->bsgd', diff, w_pool.astype(jnp.float32)).reshape(b, s, POOL_WIDTH)
    y = y * pool_scale.astype(jnp.float32)
    return y.astype(u.dtype), ext[:, -POOL_STATE:]


def _block_gather(kb, ix):
    return kb[ix]


_gather_bk = jax.vmap(jax.vmap(_block_gather))


def _nsa_mixer(q, kv_new, gate_logits, kv_past, win_prefix, win_pos0, win_keep, pe_cmp, w_phi):
    b, s, _ = q.shape
    f32 = jnp.float32
    t0 = kv_past.shape[1]
    scale = HEAD_DIM ** -0.5
    q = q.reshape(b, s, N_KV_HEADS, GQA, HEAD_DIM)
    kvn = kv_new.reshape(b, s, N_KV_PROJ, N_KV_HEADS, HEAD_DIM)
    full = jnp.concatenate([kv_past.astype(kvn.dtype), kvn[:, :, :N_KV_ROWS]], axis=1)
    t = t0 + s
    nb = -(-t // BLOCK)
    full = jnp.pad(full, ((0, 0), (0, nb * BLOCK - t), (0, 0), (0, 0), (0, 0)))
    blk = full.reshape(b, nb, BLOCK, N_KV_ROWS, N_KV_HEADS, HEAD_DIM)
    kc = jnp.einsum('bnlkd,lde->bnke', blk[:, :, :, 0] + pe_cmp[0][:, None, :], w_phi[0])
    vc = jnp.einsum('bnlkd,lde->bnke', blk[:, :, :, 1] + pe_cmp[1][:, None, :], w_phi[1])
    pos = t0 + jnp.arange(s, dtype=jnp.int32)
    nidx = jnp.arange(nb, dtype=jnp.int32)
    sc = jnp.einsum('bskgd,bnkd->bkgsn', q, kc).astype(f32) * scale
    cvalid = nidx[None, :] < ((pos + 1) // BLOCK)[:, None]
    pc = jax.nn.softmax(jnp.where(cvalid, sc, NEG), axis=-1) * cvalid
    o_cmp = jnp.einsum('bkgsn,bnkd->bskgd', pc.astype(vc.dtype), vc)
    imp = pc.sum(axis=2)
    cur = (pos // BLOCK)[:, None]
    forced = (nidx[None] == 0) | (nidx[None] == cur) | (nidx[None] == cur - 1)
    score = jnp.where(forced, FORCE, jnp.where(nidx[None] < cur, imp, NEG))
    n_sel = min(TOP_N, nb)
    top_val, top_idx = lax.top_k(score, n_sel)
    sel_ok = top_val > NEG / 2
    ks_b = jnp.moveaxis(blk[:, :, :, 2], 3, 1)
    vs_b = jnp.moveaxis(blk[:, :, :, 3], 3, 1)
    kw_full = jnp.concatenate([win_prefix[:, :, 0].astype(kvn.dtype), kvn[:, :, 4]], axis=1)
    vw_full = jnp.concatenate([win_prefix[:, :, 1].astype(kvn.dtype), kvn[:, :, 5]], axis=1)
    lp = win_prefix.shape[1]
    qb = Q_BLOCK if s % Q_BLOCK == 0 else s
    nq = s // qb
    q_blocks = jnp.moveaxis(q.reshape(b, nq, qb, N_KV_HEADS, GQA, HEAD_DIM), 1, 0)
    idx_blocks = jnp.moveaxis(top_idx.reshape(b, N_KV_HEADS, nq, qb, n_sel), 2, 0)
    ok_blocks = jnp.moveaxis(sel_ok.reshape(b, N_KV_HEADS, nq, qb, n_sel), 2, 0)
    pos_blocks = pos.reshape(nq, qb)
    starts = jnp.arange(nq, dtype=jnp.int32) * qb
    coff = jnp.arange(BLOCK, dtype=jnp.int32)
    woff = jnp.arange(lp + qb, dtype=jnp.int32)

    def sparse_block(args):
        qx, ix, ok, pq, st = args
        kg = _gather_bk(ks_b, ix)
        vg = _gather_bk(vs_b, ix)
        ss = jnp.einsum('bqkgd,bkqjcd->bkgqjc', qx, kg).astype(f32) * scale
        kpos = ix[..., None] * BLOCK + coff
        m = ok[..., None] & (kpos <= pq[None, None, :, None, None])
        ss = jnp.where(m[:, :, None], ss, NEG)
        ps = jax.nn.softmax(ss.reshape(ss.shape[:4] + (-1,)), axis=-1).reshape(ss.shape)
        o_sel = jnp.einsum('bkgqjc,bkqjcd->bqkgd', ps.astype(vg.dtype), vg)
        kw = lax.dynamic_slice_in_dim(kw_full, st, lp + qb, axis=1)
        vw = lax.dynamic_slice_in_dim(vw_full, st, lp + qb, axis=1)
        kp = win_pos0 + st + woff
        sw = jnp.einsum('bqkgd,btkd->bkgqt', qx, kw).astype(f32) * scale
        mw = (kp[None] >= 0) & (kp[None] <= pq[:, None]) & (kp[None] > pq[:, None] - WINDOW)
        pw = jax.nn.softmax(jnp.where(mw, sw, NEG), axis=-1)
        o_win = jnp.einsum('bkgqt,btkd->bqkgd', pw.astype(vw.dtype), vw)
        return o_sel, o_win

    o_sel, o_win = lax.map(sparse_block, (q_blocks, idx_blocks, ok_blocks, pos_blocks, starts))
    o_sel = jnp.moveaxis(o_sel, 0, 1).reshape(b, s, N_KV_HEADS, GQA, HEAD_DIM)
    o_win = jnp.moveaxis(o_win, 0, 1).reshape(b, s, N_KV_HEADS, GQA, HEAD_DIM)
    g = jax.nn.sigmoid(gate_logits.astype(f32)).reshape(b, s, N_KV_HEADS, GQA, N_ATT_GATES)
    o = (g[..., 0:1] * o_cmp.astype(f32) + g[..., 1:2] * o_sel.astype(f32)
         + g[..., 2:3] * o_win.astype(f32))
    win_state = jnp.stack([kw_full[:, -win_keep:], vw_full[:, -win_keep:]], axis=2)
    return o.reshape(b, s, ATT_WIDTH).astype(kvn.dtype), kvn[:, :, :N_KV_ROWS], win_state


def _complex_affine_combine(e1, e2):
    a1r, a1i, b1r, b1i = e1
    a2r, a2i, b2r, b2i = e2
    return (a2r * a1r - a2i * a1i, a2r * a1i + a2i * a1r,
            a2r * b1r - a2i * b1i + b2r, a2r * b1i + a2i * b1r + b2i)


def _ssm_mixer(u, h0, lam_re, lam_im, log_step, b_re, b_im, c_re, c_im, d_skip, w_glu):
    b, s, _ = u.shape
    f32 = jnp.float32
    u32 = u.astype(f32).reshape(b, s, SSM_GROUPS, SSM_GROUP_DIM)
    lr, li = lam_re.astype(f32), lam_im.astype(f32)
    dt = jnp.exp(log_step.astype(f32))[:, None]
    mag = jnp.exp(lr * dt)
    ab_re, ab_im = mag * jnp.cos(li * dt), mag * jnp.sin(li * dt)
    den = lr * lr + li * li
    co_re = ((ab_re - 1.0) * lr + ab_im * li) / den
    co_im = (ab_im * lr - (ab_re - 1.0) * li) / den
    br, bi = b_re.astype(f32), b_im.astype(f32)
    bb_re = co_re[..., None] * br - co_im[..., None] * bi
    bb_im = co_re[..., None] * bi + co_im[..., None] * br
    bu_re = jnp.einsum('bsgc,gnc->bsgn', u32, bb_re)
    bu_im = jnp.einsum('bsgc,gnc->bsgn', u32, bb_im)
    h0r, h0i = h0[:, 0].astype(f32), h0[:, 1].astype(f32)
    bu_re = bu_re.at[:, 0].add(ab_re * h0r - ab_im * h0i)
    bu_im = bu_im.at[:, 0].add(ab_re * h0i + ab_im * h0r)
    a_re = jnp.broadcast_to(ab_re, bu_re.shape)
    a_im = jnp.broadcast_to(ab_im, bu_im.shape)
    _, _, hr, hi = lax.associative_scan(_complex_affine_combine, (a_re, a_im, bu_re, bu_im), axis=1)
    y = (jnp.einsum('gcn,bsgn->bsgc', c_re.astype(f32), hr)
         - jnp.einsum('gcn,bsgn->bsgc', c_im.astype(f32), hi))
    y = y.reshape(b, s, SSM_WIDTH) + d_skip.astype(f32) * u.astype(f32)
    z = jax.nn.gelu(y)
    out = z * jax.nn.sigmoid(z @ w_glu.astype(f32))
    new_state = jnp.stack([hr[:, -1], hi[:, -1]], axis=1)
    return out.astype(u.dtype), new_state.astype(h0.dtype)


def _layer(x, kv_past, win_prefix, win_pos0, win_keep, pool_prefix, ssm_h0, lw):
    (g_pre, g_post, w_in, w_pool, pool_scale, pe_cmp, w_phi, lam_re, lam_im, log_step,
     b_re, b_im, c_re, c_im, d_skip, w_glu, w_br_pool, w_br_nsa, w_br_ssm, w_out) = lw
    b, s, _ = x.shape
    q0 = kv_past.shape[1]
    h = _rmsnorm(x, g_pre)
    proj = h @ w_in
    pu, pz, q, kv, ag, az, su, sz, mg = jnp.split(proj, IN_OFFSETS, axis=-1)
    y_pool, pool_state = _pool_mixer(pu, pool_prefix, q0, w_pool, pool_scale)
    y_att, kv_rows, win_state = _nsa_mixer(q, kv, ag, kv_past, win_prefix, win_pos0, win_keep,
                                           pe_cmp, w_phi)
    y_ssm, ssm_state = _ssm_mixer(su, ssm_h0, lam_re, lam_im, log_step, b_re, b_im, c_re, c_im,
                                  d_skip, w_glu)
    br_pool = (y_pool * jax.nn.silu(pz)) @ w_br_pool
    br_att = (y_att * jax.nn.silu(az)) @ w_br_nsa
    br_ssm = (y_ssm * jax.nn.silu(sz)) @ w_br_ssm
    gm = jax.nn.sigmoid(mg.reshape(b, s, N_BRANCH, D_MODEL))
    merged = gm[:, :, 0] * br_pool + gm[:, :, 1] * br_att + gm[:, :, 2] * br_ssm
    out = merged @ w_out
    return x + _rmsnorm(out, g_post), kv_rows, win_state, pool_state, ssm_state


def setup_inputs(seed: int = 0) -> dict:
    key = jax.random.key(seed)
    ks = jax.random.split(key, 32)
    f32 = jnp.float32
    n_pages = PAST_LEN // PAGE_SIZE
    n_pool = (DEC_BATCH * n_pages * 5 + 3) // 4
    win_buf = min(WINDOW, PAST_LEN)

    def nrm(k, shape, sc):
        return jax.random.normal(k, shape, f32) * sc

    perm = jax.random.permutation(ks[3], n_pool)[:DEC_BATCH * n_pages]
    lam_im = jnp.broadcast_to(jnp.pi * jnp.arange(SSM_STATE, dtype=f32), (DEPTH, SSM_GROUPS, SSM_STATE))
    return {
        'x_prompt': nrm(ks[0], (BATCH, SEQ, D_MODEL), 1.0),
        'x_sample': nrm(ks[1], (DEC_BATCH, DEC_SEQ, D_MODEL), 1.0),
        'cache_kv': nrm(ks[2], (DEPTH, n_pool, PAGE_SIZE, N_KV_ROWS, N_KV_HEADS, HEAD_DIM), 1.0),
        'page_table': perm.reshape(DEC_BATCH, n_pages).astype(jnp.int32),
        'state_win_kv': nrm(ks[4], (DEPTH, DEC_BATCH, win_buf, 2, N_KV_HEADS, HEAD_DIM), 1.0),
        'state_pool': nrm(ks[5], (DEPTH, DEC_BATCH, POOL_STATE, POOL_WIDTH), 1.0),
        'state_ssm': nrm(ks[6], (DEPTH, DEC_BATCH, 2, SSM_GROUPS, SSM_STATE), 0.5),
        'g_pre': 1.0 + nrm(ks[7], (DEPTH, D_MODEL), 0.02),
        'g_post': 1.0 + nrm(ks[8], (DEPTH, D_MODEL), 0.02),
        'w_in': nrm(ks[9], (DEPTH, D_MODEL, D_IN), D_MODEL ** -0.5),
        'w_pool': nrm(ks[10], (DEPTH, POOL_GROUPS, POOL_GROUP_DIM, POOL_GROUP_DIM), POOL_GROUP_DIM ** -0.5),
        'pool_scale': 1.0 + nrm(ks[11], (DEPTH, POOL_WIDTH), 0.1),
        'pe_cmp': nrm(ks[12], (DEPTH, 2, BLOCK, HEAD_DIM), 0.02),
        'w_phi': nrm(ks[13], (DEPTH, 2, BLOCK, HEAD_DIM, HEAD_DIM), (BLOCK * HEAD_DIM) ** -0.5),
        'lam_re': -0.5 + nrm(ks[14], (DEPTH, SSM_GROUPS, SSM_STATE), 0.01),
        'lam_im': lam_im,
        'log_step': jax.random.uniform(ks[15], (DEPTH, SSM_GROUPS), f32,
                                       minval=float(np.log(DT_MIN)), maxval=float(np.log(DT_MAX))),
        'b_re': nrm(ks[16], (DEPTH, SSM_GROUPS, SSM_STATE, SSM_GROUP_DIM), (2 * SSM_GROUP_DIM) ** -0.5),
        'b_im': nrm(ks[17], (DEPTH, SSM_GROUPS, SSM_STATE, SSM_GROUP_DIM), (2 * SSM_GROUP_DIM) ** -0.5),
        'c_re': nrm(ks[18], (DEPTH, SSM_GROUPS, SSM_GROUP_DIM, SSM_STATE), (2 * SSM_STATE) ** -0.5),
        'c_im': nrm(ks[19], (DEPTH, SSM_GROUPS, SSM_GROUP_DIM, SSM_STATE), (2 * SSM_STATE) ** -0.5),
        'd_skip': nrm(ks[20], (DEPTH, SSM_WIDTH), 1.0),
        'w_glu': nrm(ks[21], (DEPTH, SSM_WIDTH, SSM_WIDTH), SSM_WIDTH ** -0.5),
        'w_br_pool': nrm(ks[22], (DEPTH, POOL_WIDTH, D_MODEL), POOL_WIDTH ** -0.5),
        'w_br_nsa': nrm(ks[23], (DEPTH, ATT_WIDTH, D_MODEL), ATT_WIDTH ** -0.5),
        'w_br_ssm': nrm(ks[24], (DEPTH, SSM_WIDTH, D_MODEL), SSM_WIDTH ** -0.5),
        'w_out': nrm(ks[25], (DEPTH, D_MODEL, D_MODEL), D_MODEL ** -0.5),
    }


def reference(x_prompt, x_sample, cache_kv, page_table, state_win_kv, state_pool, state_ssm,
              g_pre, g_post, w_in, w_pool, pool_scale, pe_cmp, w_phi, lam_re, lam_im, log_step,
              b_re, b_im, c_re, c_im, d_skip, w_glu, w_br_pool, w_br_nsa, w_br_ssm, w_out):
    bp, sp, _ = x_prompt.shape
    bd = x_sample.shape[0]
    past_len = page_table.shape[1] * cache_kv.shape[2]
    win_keep = state_win_kv.shape[2]
    dt = x_prompt.dtype
    yp, ys = x_prompt, x_sample
    kvp, kvs, wpr, wsa, ppr, psa, hpr, hsa = [], [], [], [], [], [], [], []
    for l in range(DEPTH):
        lw = (g_pre[l], g_post[l], w_in[l], w_pool[l], pool_scale[l], pe_cmp[l], w_phi[l],
              lam_re[l], lam_im[l], log_step[l], b_re[l], b_im[l], c_re[l], c_im[l],
              d_skip[l], w_glu[l], w_br_pool[l], w_br_nsa[l], w_br_ssm[l], w_out[l])
        yp, r_kv, r_win, r_pool, r_ssm = _layer(
            yp, jnp.zeros((bp, 0, N_KV_ROWS, N_KV_HEADS, HEAD_DIM), dt),
            jnp.zeros((bp, WINDOW, 2, N_KV_HEADS, HEAD_DIM), dt), -WINDOW, min(WINDOW, sp),
            jnp.zeros((bp, POOL_STATE, POOL_WIDTH), dt),
            jnp.zeros((bp, 2, SSM_GROUPS, SSM_STATE), dt), lw)
        past = cache_kv[l][page_table].reshape(bd, past_len, N_KV_ROWS, N_KV_HEADS, HEAD_DIM)
        ys, s_kv, s_win, s_pool, s_ssm = _layer(
            ys, past, state_win_kv[l], past_len - win_keep, win_keep,
            state_pool[l], state_ssm[l], lw)
        kvp.append(r_kv); kvs.append(s_kv); wpr.append(r_win); wsa.append(s_win)
        ppr.append(r_pool); psa.append(s_pool); hpr.append(r_ssm); hsa.append(s_ssm)
    return (yp, ys, jnp.stack(kvp), jnp.stack(kvs), jnp.stack(wpr), jnp.stack(wsa),
            jnp.stack(ppr), jnp.stack(psa), jnp.stack(hpr), jnp.stack(hsa))
```

```cpp
#define MK_PER_PHASE 0
#include <hip/hip_runtime.h>
#include <cstdio>
#include <cstdint>

#ifndef MK_PER_PHASE
#define MK_PER_PHASE 0
#endif

#define LAS __attribute__((address_space(3)))
#define GAS __attribute__((address_space(1)))
typedef unsigned short bf16_t;
typedef short bf16x8 __attribute__((ext_vector_type(8)));
typedef float f32x4 __attribute__((ext_vector_type(4)));
typedef float f32x2 __attribute__((ext_vector_type(2)));
typedef float f32x16 __attribute__((ext_vector_type(16)));
typedef unsigned u32x4 __attribute__((ext_vector_type(4)));
typedef unsigned u32x2 __attribute__((ext_vector_type(2)));
typedef __bf16 bf16x2_t __attribute__((ext_vector_type(2)));

constexpr int DM = 2048, SEQ = 4096, PB = 2, SB = 8, SQ = 4, PAST = 16384;
constexpr int MPT = PB * SEQ;
constexpr int MROWS = MPT + SB * SQ;
constexpr int MPAD = 8448;
constexpr int DIN = 13872, NPROJ = 14080;
constexpr int C_PU = 0, C_PZ = 1024, C_Q = 2048, C_CK = 3072, C_CV = 3328, C_SK = 3584, C_SV = 3840, C_WK = 4096, C_WV = 4352,
              C_AZ = 4608, C_SU = 5632, C_SZ = 6656, C_MG = 7680, C_AG = 13824;
constexpr int NPOOL = 1280;
constexpr int SSM_L = 128, SSM_NCH = SEQ / SSM_L;
constexpr float EPS = 1e-6f;
constexpr float SM_SCALE_L2E = 0.125f * 1.44269504088896f;
constexpr float SM_THR = 8.f;

constexpr size_t O_YP = 0, O_YS = 16777216, O_KVP = 16842752, O_KVS = 33619968, O_WINP = 33685504, O_WINS = 34734080,
                 O_POOLP = 38928384, O_POOLS = 38989824, O_SSMP = 39235584, O_SSMS = 39268352, O_TOTAL = 39399424;

constexpr size_t al1m(size_t x) { return (x + 1048575) & ~(size_t)1048575; }
constexpr size_t SZ_WIN = (size_t)NPROJ * DM * 2, SZ_WPOOL = 4 * 256 * 256 * 2, SZ_WGLU = 1024 * 1024 * 2, SZ_WBR = (size_t)3 * 2048 * 1024 * 2,
                 SZ_WOUT = (size_t)2048 * 2048 * 2, SZ_WPHI = 2 * 64 * 64 * 64 * 2, SZ_PEBP = 2 * 16 * 64 * 4, SZ_SAB = 64 * 64 * 4 * 4,
                 SZ_SBB = 64 * 16 * 2 * 64 * 4, SZ_SCM = 64 * 16 * 128 * 2;
constexpr size_t WS_CTL = 0, CTL_BYTES = 1048576, CTL_ZERO_BYTES = 32768;
constexpr size_t WS_WIN = CTL_BYTES;
constexpr size_t WS_WPOOL = WS_WIN + 2 * al1m(SZ_WIN);
constexpr size_t WS_WGLU = WS_WPOOL + 2 * al1m(SZ_WPOOL);
constexpr size_t WS_WBR = WS_WGLU + 2 * al1m(SZ_WGLU);
constexpr size_t WS_WOUT = WS_WBR + 2 * al1m(SZ_WBR);
constexpr size_t WS_WPHI = WS_WOUT + 2 * al1m(SZ_WOUT);
constexpr size_t WS_PEBP = WS_WPHI + 2 * al1m(SZ_WPHI);
constexpr size_t WS_SAB = WS_PEBP + 2 * al1m(SZ_PEBP);
constexpr size_t WS_SBB = WS_SAB + 2 * al1m(SZ_SAB);
constexpr size_t WS_SCM = WS_SBB + 2 * al1m(SZ_SBB);
constexpr size_t WS_H = WS_SCM + 2 * al1m(SZ_SCM);
constexpr size_t WS_P = WS_H + al1m((size_t)MPAD * DM * 2);
constexpr size_t WS_GATE = WS_P + al1m((size_t)MPAD * NPROJ * 2);
constexpr size_t WS_DIFF = WS_GATE + al1m((size_t)MPAD * 64 * 4);
constexpr size_t WS_ABR = WS_DIFF + al1m((size_t)MPAD * 1024 * 2);
constexpr size_t SZ_ABR1 = (size_t)MPAD * 1024 * 2;
constexpr size_t WS_Z = WS_ABR + al1m(3 * SZ_ABR1);
constexpr size_t WS_KCP = WS_Z + al1m(SZ_ABR1);
constexpr size_t WS_VCTP = WS_KCP + al1m(65536);
constexpr size_t WS_KCS = WS_VCTP + al1m(65536);
constexpr size_t WS_VCTS = WS_KCS + al1m(1048576);
constexpr size_t WS_VTSEL = WS_VCTS + al1m(1048576);
constexpr size_t WS_VTWIN = WS_VTSEL + al1m(4194304);
constexpr size_t WS_SSME = WS_VTWIN + al1m(4194304);
constexpr size_t WS_MERGED = WS_SSME + al1m(2097152);
constexpr size_t WS_OUTB = WS_MERGED + al1m((size_t)MPAD * DM * 2);
constexpr size_t WS_Y0 = WS_OUTB + al1m((size_t)MPAD * DM * 4);
constexpr size_t WS_BRP = WS_Y0 + al1m((size_t)MPAD * DM * 4);
constexpr size_t WS_SOACC = WS_BRP + al1m((size_t)3 * 32 * DM * 4);
constexpr size_t WS_SBB16 = WS_SOACC + al1m(128 * 768 * 4);
constexpr size_t SZ_SBB16 = 64 * 2 * 64 * 16 * 2;
constexpr size_t WS_KTSEL = WS_SBB16 + 2 * al1m(SZ_SBB16);
constexpr size_t WS_KTWIN = WS_KTSEL + al1m(4194304);
constexpr size_t WS_END = WS_KTWIN + al1m(4194304);

constexpr int CW_BAR = 4096;

constexpr int NWAVES = 8, NT = 512;
constexpr int LDS_BYTES = 147456;
constexpr int LDS_MISC = 143360;

__device__ __forceinline__ float bf2f(unsigned b) { return __uint_as_float(b << 16); }
__device__ __forceinline__ unsigned pk2(float lo, float hi) { f32x2 v = {lo, hi}; bf16x2_t b = __builtin_convertvector(v, bf16x2_t); return __builtin_bit_cast(unsigned, b); }
__device__ __forceinline__ unsigned f2bf(float f) { return pk2(f, 0.f) & 0xffffu; }
__device__ __forceinline__ float wave_sum(float v) {
#pragma unroll
    for (int o = 1; o < 64; o <<= 1) v += __shfl_xor(v, o);
    return v;
}
__device__ __forceinline__ float wave_max(float v) {
#pragma unroll
    for (int o = 1; o < 64; o <<= 1) v = fmaxf(v, __shfl_xor(v, o));
    return v;
}
__device__ __forceinline__ float sigmoidf_(float x) { return __builtin_amdgcn_rcpf(1.f + __expf(-x)); }
__device__ __forceinline__ float siluf_(float x) { return x * sigmoidf_(x); }
__device__ __forceinline__ float gelu_tanh(float y) { const float a = 1.5957691216f * (y + 0.044715f * y * y * y); return y * sigmoidf_(a); }
#define LDS_WAIT() asm volatile("s_waitcnt lgkmcnt(0)" ::: "memory")
#define VM_WAIT() asm volatile("s_waitcnt vmcnt(0)" ::: "memory")

#define XB_TMO      128
#define XB_XCNT(j)  (256  + 64 * (j))
#define XB_XSUB(j)  (1280 + 64 * (j))
#define XB_XGEN(j)  (2304 + 64 * (j))
#define XB_TOP      3328
#define XB_TOPGEN   3392
#define XCD_BAR_WORDS 3456
#define XB_SPIN_CAP (1u << 23)
__device__ __forceinline__ unsigned xb_ld(unsigned* p)              { return __hip_atomic_load(p, __ATOMIC_RELAXED, __HIP_MEMORY_SCOPE_AGENT); }
__device__ __forceinline__ unsigned xb_add(unsigned* p, unsigned v) { return __hip_atomic_fetch_add(p, v, __ATOMIC_RELAXED, __HIP_MEMORY_SCOPE_AGENT); }
__device__ __forceinline__ unsigned xb_xcc_id() { return (unsigned)__builtin_amdgcn_s_getreg((3 << 11) | 20) & 0xFu; }
#define XB_SPIN(cond, bar) do { unsigned _sp = 0; while (cond) { __builtin_amdgcn_s_sleep(1); \
    if ((++_sp & 255u) == 0u) { if (xb_ld(&(bar)[XB_TMO])) break; if (_sp > XB_SPIN_CAP) { atomicAdd(&(bar)[XB_TMO], 1u); break; } } } } while (0)
struct XcdBarrier { unsigned* bar; unsigned x; volatile LAS unsigned* st; };
__device__ __forceinline__ XcdBarrier xcd_barrier_post(unsigned* bar, volatile LAS unsigned* st) {
    XcdBarrier b; b.bar = bar; b.x = xb_xcc_id(); b.st = st;
    if (threadIdx.x == 0) (void)xb_add(&bar[XB_XCNT(b.x)], 1u);
    return b;
}
__device__ __forceinline__ void xcd_barrier_complete(unsigned* bar, unsigned x, unsigned& nloc, unsigned& nx) {
    const unsigned G = gridDim.x * gridDim.y * gridDim.z;
    unsigned sum, cnt, mine, sp = 0u;
    for (;;) {
        sum = 0u; cnt = 0u; mine = 0u;
#pragma unroll
        for (unsigned j = 0; j < 16; ++j) { const unsigned c = xb_ld(&bar[XB_XCNT(j)]); sum += c; cnt += (c > 0u) ? 1u : 0u; mine = (j == x) ? c : mine; }
        if (sum == G) break;
        __builtin_amdgcn_s_sleep(1);
        if ((++sp & 255u) == 0u) { if (xb_ld(&bar[XB_TMO])) break; if (sp > XB_SPIN_CAP) { atomicAdd(&bar[XB_TMO], 1u); break; } }
    }
    nloc = mine > 0u ? mine : 1u; nx = cnt > 0u ? cnt : 1u;
}
__device__ __forceinline__ void xcd_barrier(const XcdBarrier& b) {
    asm volatile("s_waitcnt vmcnt(0)" ::: "memory");
    __syncthreads();
    if (threadIdx.x == 0) {
        unsigned* bar = b.bar;
        __builtin_amdgcn_s_waitcnt(0);
        unsigned nloc = b.st[0], nx = b.st[1];
        if (nloc == 0u) { xcd_barrier_complete(bar, b.x, nloc, nx); b.st[0] = nloc; b.st[1] = nx; }
        const unsigned old = xb_add(&bar[XB_XSUB(b.x)], 1u);
        const unsigned gen = old / nloc;
        if (old + 1u == (gen + 1u) * nloc) {
            __builtin_amdgcn_fence(__ATOMIC_RELEASE, "agent");
            asm volatile("s_waitcnt vmcnt(0)" ::: "memory");
            const unsigned og = xb_add(&bar[XB_TOP], 1u);
            const unsigned tg = og / nx;
            if (og + 1u == (tg + 1u) * nx) xb_add(&bar[XB_TOPGEN], 1u);
            else XB_SPIN(xb_ld(&bar[XB_TOPGEN]) == tg, bar);
            __builtin_amdgcn_fence(__ATOMIC_ACQUIRE, "agent");
            xb_add(&bar[XB_XGEN(b.x)], 1u);
            asm volatile("s_waitcnt vmcnt(0)" ::: "memory");
        } else {
            XB_SPIN(xb_ld(&bar[XB_XGEN(b.x)]) == gen, bar);
            __builtin_amdgcn_fence(__ATOMIC_ACQUIRE, "agent");
            asm volatile("s_waitcnt vmcnt(0)" ::: "memory");
        }
    }
    __syncthreads();
}
namespace pg8 {
constexpr int BM = 256, BK = 64, HALF = 128, HTB = HALF * BK * 2, STAGE_BYTES = 8 * HTB, NXCD = 8, WGM = 8;
__host__ __device__ __forceinline__ int lds_byte(int r, int c) { const int st = (r >> 4) * 2 + (c >> 5), rr = r & 15, cc = c & 31, ob = rr * 64 + cc * 2; return st * 1024 + (ob ^ (((ob >> 9) & 1) << 5)); }
__host__ __device__ __forceinline__ void stage_rc(int b, int& R, int& C) { const int st = b / 1024, sb = b % 1024, swz = sb ^ (((sb >> 9) & 1) << 5); R = (st >> 1) * 16 + swz / 64; C = (st & 1) * 32 + (swz % 64) / 2; }
__host__ __device__ __forceinline__ int perm32(int rho) { const int n = rho >> 4, i = rho & 15; return 8 * (i >> 2) + 4 * n + (i & 3); }

struct Unit { int pm, pn, z; };
struct Gemm { const bf16_t* A; const bf16_t* Bt; int lda, ldb, K; size_t zA, zB; };

struct TileOrder {
    int nM, nN, nz, ntile, G, c, zin;
    __device__ void init(int nM_, int nN_, int nz_, int zin_, int G_, int c_) { nM = nM_; nN = nN_; nz = nz_; zin = zin_; ntile = nM * nN; G = G_; c = c_; }
    __device__ bool next(int i, Unit& u) const {
        long L; int z;
        if (zin) { z = i % nz; L = (long)(i / nz) * G + c; if (L >= ntile) return false; }
        else { const long LL = (long)i * G + c; if (LL >= (long)ntile * nz) return false; z = (int)(LL / ntile); L = LL % ntile; }
        int wgid = (int)L; { const int q = ntile / NXCD, r = ntile % NXCD, xcd = wgid % NXCD, off = wgid / NXCD; wgid = (xcd < r ? xcd * (q + 1) : r * (q + 1) + (xcd - r) * q) + off; }
        const int nig = WGM * nN, gid = wgid / nig, fm = gid * WGM, gsz = (nM - fm) < WGM ? (nM - fm) : WGM;
        u.pm = fm + ((wgid % nig) % gsz); u.pn = (wgid % nig) / gsz; u.z = z; return true;
    }
};

template <class Epi, class Sched>
__device__ __forceinline__ void gemm_phase(LAS unsigned char* lds, const Gemm g, const Sched& S, const Epi& E) {
    int tid = threadIdx.x; asm volatile("" : "+v"(tid));
    const int wid = __builtin_amdgcn_readfirstlane(tid >> 6), lane = tid & 63, wr = wid >> 2, wc = wid & 3, fr = lane & 15, fq = lane >> 4;
    const int K = g.K, nt = K / BK;
    unsigned voffA[2], voffB[2];
#pragma unroll
    for (int i = 0; i < 2; ++i) { int R, C; stage_rc(tid * 16 + i * 8192, R, C); const int Rb = (R & ~31) + perm32(R & 31);
        voffA[i] = (unsigned)(R * g.lda + C) * 2u; voffB[i] = (unsigned)(Rb * g.ldb + C) * 2u; }
    const size_t kstep = (size_t)(BK * 2);
    const size_t hstepA = (size_t)HALF * g.lda * 2, hstepB = (size_t)HALF * g.ldb * 2;
    const unsigned ldsw = (unsigned)wid * 1024u;
    const int aoff = lds_byte(wr * 64 + fr, fq * 8), boff = lds_byte(wc * 32 + fr, fq * 8);
#define PG8_SA(b, h) (((b) * 2 + (h)) * HTB)
#define PG8_SB(b, h) ((4 + (b) * 2 + (h)) * HTB)
#define PG8_STAGE(bufoff, gbase, voff) do { _Pragma("unroll") for (int _i = 0; _i < 2; ++_i) \
        __builtin_amdgcn_global_load_lds((const unsigned*)((const char*)(gbase) + (voff)[_i]), (LAS unsigned*)(lds + (bufoff) + ldsw + _i * 8192), 16, 0, 0); } while (0)
#define PG8_LDA(dst, b, h) do { _Pragma("unroll") for (int m = 0; m < 4; ++m) _Pragma("unroll") for (int k = 0; k < 2; ++k) dst[m][k] = *(const LAS bf16x8*)(lds + PG8_SA(b, h) + aoff + m * 2048 + k * 1024); } while (0)
#define PG8_LDB(dst, b, h) do { _Pragma("unroll") for (int n = 0; n < 2; ++n) _Pragma("unroll") for (int k = 0; k < 2; ++k) dst[n][k] = *(const LAS bf16x8*)(lds + PG8_SB(b, h) + boff + n * 2048 + k * 1024); } while (0)
#define PG8_MMA(ai, bj, At, Bt) do { __builtin_amdgcn_s_setprio(1); _Pragma("unroll") for (int m = 0; m < 4; ++m) _Pragma("unroll") for (int n = 0; n < 2; ++n) _Pragma("unroll") for (int k = 0; k < 2; ++k) \
        acc[ai][bj][m][n] = __builtin_amdgcn_mfma_f32_16x16x32_bf16(Bt[n][k], At[m][k], acc[ai][bj][m][n], 0, 0, 0); __builtin_amdgcn_s_setprio(0); } while (0)
#define PG8_WAIT_V(n) asm volatile("s_waitcnt vmcnt(" #n ")" ::: "memory")
#define PG8_WAIT_L(n) asm volatile("s_waitcnt lgkmcnt(" #n ")" ::: "memory")
#define PG8_BAR __builtin_amdgcn_s_barrier()
#define PG8_SCHED __builtin_amdgcn_sched_barrier(0)
#define PG8_UA(u) ((const char*)(g.A + (size_t)(u).z * g.zA) + (size_t)(u).pm * (2 * hstepA))
#define PG8_UB(u) ((const char*)(g.Bt + (size_t)(u).z * g.zB) + (size_t)(u).pn * (2 * hstepB))
    Unit cur, nxt; int ui = 0;
    if (!S.next(0, cur)) return;
    f32x4 acc[2][2][4][2];
#pragma unroll
    for (int a = 0; a < 2; ++a)
#pragma unroll
        for (int b = 0; b < 2; ++b)
#pragma unroll
            for (int m = 0; m < 4; ++m)
#pragma unroll
                for (int n = 0; n < 2; ++n) acc[a][b][m][n] = (f32x4){0.f, 0.f, 0.f, 0.f};
    bf16x8 At[4][2], B0[2][2], B1[2][2];
    const char* cA = PG8_UA(cur); const char* cB = PG8_UB(cur);
    PG8_STAGE(PG8_SB(0, 0), cB, voffB); PG8_STAGE(PG8_SB(0, 1), cB + hstepB, voffB); PG8_STAGE(PG8_SA(0, 0), cA, voffA); PG8_STAGE(PG8_SA(0, 1), cA + hstepA, voffA);
    if (wr == 1) PG8_BAR;
    PG8_WAIT_V(2); PG8_BAR;
    PG8_STAGE(PG8_SB(1, 0), cB + kstep, voffB); PG8_STAGE(PG8_SA(1, 0), cA + kstep, voffA); PG8_STAGE(PG8_SB(1, 1), cB + hstepB + kstep, voffB);
    PG8_WAIT_V(6); PG8_BAR;
    for (;;) {
        const bool has_next = S.next(ui + 1, nxt);
        const char* nA = has_next ? PG8_UA(nxt) : cA; const char* nB = has_next ? PG8_UB(nxt) : cB;
#pragma unroll 1
        for (int t = 0; t < nt; t += 2) {
            const bool last = (t == nt - 2);
            const char* a1 = cA + (size_t)(t + 1) * kstep;
            const char* a2 = last ? nA : cA + (size_t)(t + 2) * kstep; const char* b2 = last ? nB : cB + (size_t)(t + 2) * kstep;
            const char* a3 = a2 + kstep; const char* b3 = b2 + kstep;
            PG8_LDB(B0, 0, 0); PG8_LDB(B1, 0, 1); PG8_SCHED; PG8_LDA(At, 0, 0); PG8_STAGE(PG8_SA(1, 1), a1 + hstepA, voffA);
            PG8_WAIT_V(8); PG8_WAIT_L(0); PG8_BAR; PG8_MMA(0, 0, At, B0); PG8_MMA(0, 1, At, B1); PG8_BAR; PG8_SCHED;
            PG8_LDA(At, 0, 1); PG8_STAGE(PG8_SB(0, 0), b2, voffB); PG8_STAGE(PG8_SB(0, 1), b2 + hstepB, voffB); PG8_STAGE(PG8_SA(0, 0), a2, voffA);
            PG8_WAIT_V(8); PG8_WAIT_L(0); PG8_BAR; PG8_MMA(1, 0, At, B0); PG8_MMA(1, 1, At, B1); PG8_BAR; PG8_SCHED;
            PG8_LDB(B0, 1, 0); PG8_LDB(B1, 1, 1); PG8_SCHED; PG8_LDA(At, 1, 0); PG8_STAGE(PG8_SA(0, 1), a2 + hstepA, voffA);
            PG8_WAIT_V(8); PG8_WAIT_L(0); PG8_BAR; PG8_MMA(0, 0, At, B0); PG8_MMA(0, 1, At, B1); PG8_BAR; PG8_SCHED;
            PG8_LDA(At, 1, 1); PG8_STAGE(PG8_SB(1, 0), b3, voffB); PG8_STAGE(PG8_SB(1, 1), b3 + hstepB, voffB); PG8_STAGE(PG8_SA(1, 0), a3, voffA);
            PG8_WAIT_V(8); PG8_WAIT_L(0); PG8_BAR; PG8_MMA(1, 0, At, B0); PG8_MMA(1, 1, At, B1); PG8_BAR; PG8_SCHED;
        }
        if (wr == 0) PG8_BAR;
        const bool keep = E(acc, cur, wr, wc, fr, fq);
        if (!has_next) break;
        if (!keep) {
#pragma unroll
            for (int a = 0; a < 2; ++a)
#pragma unroll
                for (int b = 0; b < 2; ++b)
#pragma unroll
                    for (int m = 0; m < 4; ++m)
#pragma unroll
                        for (int n = 0; n < 2; ++n) acc[a][b][m][n] = (f32x4){0.f, 0.f, 0.f, 0.f};
        }
        cur = nxt; cA = nA; cB = nB; ++ui;
        if (wr == 1) PG8_BAR;
    }
    PG8_WAIT_V(0);
    PG8_BAR;
#undef PG8_SA
#undef PG8_SB
#undef PG8_STAGE
#undef PG8_LDA
#undef PG8_LDB
#undef PG8_MMA
#undef PG8_WAIT_V
#undef PG8_WAIT_L
#undef PG8_BAR
#undef PG8_SCHED
#undef PG8_UA
#undef PG8_UB
}
}
#define EPI_ARGS f32x4 (&acc)[2][2][4][2], const pg8::Unit& u, int wr, int wc, int fr, int fq
#define EPI_FOR_ROWS _Pragma("unroll") for (int ai = 0; ai < 2; ++ai) _Pragma("unroll") for (int m = 0; m < 4; ++m)
#define EPI_ROW (u.pm * 256 + ai * 128 + wr * 64 + m * 16 + fr)
#define EPI_FOR_COLS _Pragma("unroll") for (int bj = 0; bj < 2; ++bj)
#define EPI_COL (u.pn * 256 + bj * 128 + wc * 32 + 8 * fq)

__device__ __forceinline__ u32x4 pack8(const f32x4& a, const f32x4& b) { u32x4 w; w.x = pk2(a[0], a[1]); w.y = pk2(a[2], a[3]); w.z = pk2(b[0], b[1]); w.w = pk2(b[2], b[3]); return w; }
__device__ __forceinline__ void unpack8(const u32x4& w, float (&f)[8]) {
    f[0] = bf2f(w.x & 0xffffu); f[1] = __uint_as_float(w.x & 0xffff0000u); f[2] = bf2f(w.y & 0xffffu); f[3] = __uint_as_float(w.y & 0xffff0000u);
    f[4] = bf2f(w.z & 0xffffu); f[5] = __uint_as_float(w.z & 0xffff0000u); f[6] = bf2f(w.w & 0xffffu); f[7] = __uint_as_float(w.w & 0xffff0000u);
}

__device__ __forceinline__ u32x2 pack4(const f32x4& v) { u32x2 w; w.x = pk2(v[0], v[1]); w.y = pk2(v[2], v[3]); return w; }
__device__ __forceinline__ f32x4 unpack4(const u32x2& x) { return (f32x4){bf2f(x.x & 0xffffu), __uint_as_float(x.x & 0xffff0000u), bf2f(x.y & 0xffffu), __uint_as_float(x.y & 0xffff0000u)}; }

struct EpiProj {
    bf16_t* P; float* gate; float* out; int layer;
    __device__ __forceinline__ bool operator()(EPI_ARGS) const {
        const int pn = u.pn;
        int mode;
        if (pn < 4) mode = 0; else if (pn < 8) mode = 1; else if (pn < 12) mode = 5; else if (pn < 16) mode = 3; else if (pn < 18) mode = 0;
        else if (pn < 22) mode = 1; else if (pn < 26) mode = 0; else if (pn < 30) mode = 1; else if (pn < 54) mode = 2; else mode = 4;
        if (mode == 0) {
            EPI_FOR_ROWS { bf16_t* rp = P + (size_t)EPI_ROW * NPROJ; EPI_FOR_COLS { *(u32x4*)(rp + EPI_COL) = pack8(acc[ai][bj][m][0], acc[ai][bj][m][1]); } }
        } else if (mode == 5) {
            EPI_FOR_ROWS { bf16_t* rp = P + (size_t)EPI_ROW * NPROJ; EPI_FOR_COLS { *(u32x4*)(rp + EPI_COL) = pack8(acc[ai][bj][m][0] * SM_SCALE_L2E, acc[ai][bj][m][1] * SM_SCALE_L2E); } }
        } else if (mode == 1) {
            EPI_FOR_ROWS { bf16_t* rp = P + (size_t)EPI_ROW * NPROJ; EPI_FOR_COLS { f32x4 a = acc[ai][bj][m][0], b = acc[ai][bj][m][1];
#pragma unroll
                for (int j = 0; j < 4; ++j) { a[j] = siluf_(a[j]); b[j] = siluf_(b[j]); }
                *(u32x4*)(rp + EPI_COL) = pack8(a, b); } }
        } else if (mode == 2) {
            EPI_FOR_ROWS { bf16_t* rp = P + (size_t)EPI_ROW * NPROJ; EPI_FOR_COLS { f32x4 a = acc[ai][bj][m][0], b = acc[ai][bj][m][1];
#pragma unroll
                for (int j = 0; j < 4; ++j) { a[j] = sigmoidf_(a[j]); b[j] = sigmoidf_(b[j]); }
                *(u32x4*)(rp + EPI_COL) = pack8(a, b); } }
        } else if (mode == 3) {
            EPI_FOR_ROWS { const int row = EPI_ROW; bf16_t* rp = P + (size_t)row * NPROJ;
                float* op = nullptr;
                if (row < MPT) op = out + O_KVP + ((size_t)layer * MPT + row) * 1024;
                else if (row < MROWS) op = out + O_KVS + ((size_t)layer * 32 + (row - MPT)) * 1024;
                EPI_FOR_COLS { const int col = EPI_COL; *(u32x4*)(rp + col) = pack8(acc[ai][bj][m][0], acc[ai][bj][m][1]);
                    if (op) { *(f32x4*)(op + col - C_CK) = acc[ai][bj][m][0]; *(f32x4*)(op + col - C_CK + 4) = acc[ai][bj][m][1]; } } }
        } else {
            EPI_FOR_ROWS { float* gp = gate + (size_t)EPI_ROW * 64; EPI_FOR_COLS { const int c = EPI_COL - C_AG; if (c < 48) { f32x4 a = acc[ai][bj][m][0], b = acc[ai][bj][m][1];
#pragma unroll
                for (int j = 0; j < 4; ++j) { a[j] = sigmoidf_(a[j]); b[j] = sigmoidf_(b[j]); }
                *(f32x4*)(gp + c) = a; *(f32x4*)(gp + c + 4) = b; } } }
        }
        return false;
    }
};

struct EpiPool {
    bf16_t* apool; const bf16_t* P; const float* pscale;
    __device__ __forceinline__ bool operator()(EPI_ARGS) const {
        asm volatile("" ::: "memory");
#pragma unroll
        for (int ai = 0; ai < 2; ++ai) {
            u32x4 zw[4][2];
#pragma unroll
            for (int m = 0; m < 4; ++m) EPI_FOR_COLS { const int col = u.z * 256 + bj * 128 + wc * 32 + 8 * fq; zw[m][bj] = *(const u32x4*)(P + (size_t)EPI_ROW * NPROJ + C_PZ + col); }
            __builtin_amdgcn_sched_barrier(0);
#pragma unroll
            for (int m = 0; m < 4; ++m) EPI_FOR_COLS { const int col = u.z * 256 + bj * 128 + wc * 32 + 8 * fq; float zf[8]; unpack8(zw[m][bj], zf);
                const f32x4 s0 = *(const f32x4*)(pscale + col), s1 = *(const f32x4*)(pscale + col + 4);
                f32x4 a = acc[ai][bj][m][0], b = acc[ai][bj][m][1];
#pragma unroll
                for (int j = 0; j < 4; ++j) { a[j] = a[j] * s0[j] * zf[j]; b[j] = b[j] * s1[j] * zf[4 + j]; }
                *(u32x4*)(apool + (size_t)EPI_ROW * 1024 + col) = pack8(a, b); }
            __builtin_amdgcn_sched_barrier(0);
        }
        return false;
    }
};

struct EpiGlu {
    bf16_t* assm; const bf16_t* P; const bf16_t* Z;
    __device__ __forceinline__ bool operator()(EPI_ARGS) const {
#pragma unroll
        for (int ai = 0; ai < 2; ++ai) {
            u32x4 zw[4][2], sw[4][2];
#pragma unroll
            for (int m = 0; m < 4; ++m) EPI_FOR_COLS { const int row = EPI_ROW, col = EPI_COL; zw[m][bj] = *(const u32x4*)(Z + (size_t)row * 1024 + col); sw[m][bj] = *(const u32x4*)(P + (size_t)row * NPROJ + C_SZ + col); }
            __builtin_amdgcn_sched_barrier(0);
#pragma unroll
            for (int m = 0; m < 4; ++m) EPI_FOR_COLS { float zf[8], sf[8]; unpack8(zw[m][bj], zf); unpack8(sw[m][bj], sf);
                f32x4 a = acc[ai][bj][m][0], b = acc[ai][bj][m][1];
#pragma unroll
                for (int j = 0; j < 4; ++j) { a[j] = zf[j] * sigmoidf_(a[j]) * sf[j]; b[j] = zf[4 + j] * sigmoidf_(b[j]) * sf[4 + j]; }
                *(u32x4*)(assm + (size_t)EPI_ROW * 1024 + EPI_COL) = pack8(a, b); }
            __builtin_amdgcn_sched_barrier(0);
        }
        return false;
    }
};

struct EpiBranch {
    bf16_t* merged; const bf16_t* P;
    __device__ __forceinline__ bool operator()(EPI_ARGS) const {
        const int z = u.z;
#pragma unroll
        for (int ai = 0; ai < 2; ++ai) {
            u32x4 gzw[4][2], gnw[4][2];
#pragma unroll
            for (int m = 0; m < 4; ++m) EPI_FOR_COLS { const bf16_t* gp = P + (size_t)EPI_ROW * NPROJ + C_MG + EPI_COL; gzw[m][bj] = *(const u32x4*)(gp + z * 2048); gnw[m][bj] = *(const u32x4*)(gp + (z < 2 ? z + 1 : 2) * 2048); }
            __builtin_amdgcn_sched_barrier(0);
#pragma unroll
            for (int m = 0; m < 4; ++m) EPI_FOR_COLS { float gz[8], gn[8]; unpack8(gzw[m][bj], gz); unpack8(gnw[m][bj], gn);
                f32x4& a = acc[ai][bj][m][0]; f32x4& b = acc[ai][bj][m][1];
                if (z < 2) {
#pragma unroll
                    for (int j = 0; j < 4; ++j) { a[j] *= fmaxf(gz[j], 1e-30f) * __builtin_amdgcn_rcpf(fmaxf(gn[j], 1e-30f)); b[j] *= fmaxf(gz[4 + j], 1e-30f) * __builtin_amdgcn_rcpf(fmaxf(gn[4 + j], 1e-30f)); }
                } else {
                    f32x4 a2, b2;
#pragma unroll
                    for (int j = 0; j < 4; ++j) { a2[j] = a[j] * fmaxf(gz[j], 1e-30f); b2[j] = b[j] * fmaxf(gz[4 + j], 1e-30f); }
                    *(u32x4*)(merged + (size_t)EPI_ROW * DM + EPI_COL) = pack8(a2, b2);
                } }
            __builtin_amdgcn_sched_barrier(0);
        }
        return z < 2;
    }
};

struct EpiOut {
    bf16_t* outb;
    __device__ __forceinline__ bool operator()(EPI_ARGS) const {
        EPI_FOR_ROWS { bf16_t* rp = outb + (size_t)EPI_ROW * DM; EPI_FOR_COLS { *(u32x4*)(rp + EPI_COL) = pack8(acc[ai][bj][m][0], acc[ai][bj][m][1]); } }
        return false;
    }
};
struct Frame {
    LAS unsigned char* lds;
    int tid, lane, wave, G, bid, gw, ngw;
    float* out; unsigned char* ws;
};
#define FIN(i) ((const float*)(const GAS float*)(((const float* const __attribute__((address_space(4)))*)__builtin_amdgcn_kernarg_segment_ptr())[i]))
#define IN_XP 0
#define IN_XS 1
#define IN_CACHE 2
#define IN_PT 3
#define IN_SWIN 4
#define IN_SPOOL 5
#define IN_SSSM 6
#define IN_GPRE 7
#define IN_GPOST 8
#define IN_WIN 9
#define IN_WPOOL 10
#define IN_PSCALE 11
#define IN_PE 12
#define IN_WPHI 13
#define IN_LRE 14
#define IN_LIM 15
#define IN_LSTEP 16
#define IN_BRE 17
#define IN_BIM 18
#define IN_CRE 19
#define IN_CIM 20
#define IN_DSKIP 21
#define IN_WGLU 22
#define IN_WBRP 23
#define IN_WBRN 24
#define IN_WBRS 25
#define IN_WOUT 26

template <class MAP>
__device__ __forceinline__ void transpose_item(const float* W, int ldw, int K, bf16_t* WT, int k0, int nd0, LAS float* scr, int lane, const MAP& map) {
    const int nq = 4 * (lane & 15), ns = map(nd0 + nq), kr = lane >> 4;
    f32x4 v[16];
#pragma unroll
    for (int i = 0; i < 16; ++i) v[i] = ns >= 0 ? *(const f32x4*)(W + (size_t)(k0 + 4 * i + kr) * ldw + ns) : (f32x4){0.f, 0.f, 0.f, 0.f};
#pragma unroll
    for (int i = 0; i < 16; ++i) { LAS float* d = scr + (4 * i + kr) * 65 + nq; d[0] = v[i].x; d[1] = v[i].y; d[2] = v[i].z; d[3] = v[i].w; }
    LDS_WAIT(); asm volatile("" ::: "memory");
    const int c = lane & 7;
#pragma unroll
    for (int j = 0; j < 8; ++j) { const int n = (lane >> 3) + 8 * j; const LAS float* s = scr + (8 * c) * 65 + n;
        u32x4 o; o.x = pk2(s[0 * 65], s[1 * 65]); o.y = pk2(s[2 * 65], s[3 * 65]); o.z = pk2(s[4 * 65], s[5 * 65]); o.w = pk2(s[6 * 65], s[7 * 65]);
        *(u32x4*)(WT + (size_t)(nd0 + n) * K + k0 + 8 * c) = o; }
    LDS_WAIT(); asm volatile("" ::: "memory");
}
struct MapId { __device__ __forceinline__ int operator()(int n) const { return n; } };
struct MapWin { __device__ __forceinline__ int operator()(int n) const { return n < C_AZ ? n : (n < C_AG ? n + 48 : (n < C_AG + 48 ? n - C_AG + 4608 : -1)); } };

__device__ __forceinline__ double exp_d(double x) {
    const double r = x * (1.0 / 64.0); double t = 1.0, s = 1.0;
#pragma unroll
    for (int k = 1; k <= 14; ++k) { t *= r / (double)k; s += t; }
#pragma unroll
    for (int k = 0; k < 6; ++k) s *= s;
    return s;
}
__device__ __forceinline__ void sincos_d(double x, double& sn, double& cs) {
    const double k = rint(x * 0.63661977236758134308);
    double r = fma(-k, 1.57079632679489655800e+00, x); r = fma(-k, 6.12323399573676603587e-17, r);
    const double r2 = r * r;
    double sp = 1.0, cp = 1.0, ts = 1.0, tc = 1.0;
#pragma unroll
    for (int i = 1; i <= 9; ++i) { ts *= -r2 / (double)((2 * i) * (2 * i + 1)); sp += ts; tc *= -r2 / (double)((2 * i - 1) * (2 * i)); cp += tc; }
    sp *= r;
    const int q = ((int)k) & 3;
    sn = (q == 0) ? sp : (q == 1) ? cp : (q == 2) ? -sp : -cp;
    cs = (q == 0) ? cp : (q == 1) ? -sp : (q == 2) ? -cp : sp;
}

__device__ __forceinline__ void rms_row_to_bf16(const float* xrow, const float* g, bf16_t* orow, int lane) {
    const f32x4* xr = (const f32x4*)xrow + lane; const f32x4* gr = (const f32x4*)g + lane;
    f32x4 v[8]; float s = 0.f;
#pragma unroll
    for (int j = 0; j < 8; ++j) { v[j] = xr[64 * j]; s += (v[j].x * v[j].x + v[j].y * v[j].y) + (v[j].z * v[j].z + v[j].w * v[j].w); }
    const float rstd = 1.f / sqrtf(wave_sum(s) * (1.f / DM) + EPS);
    u32x2* o8 = (u32x2*)orow + lane;
#pragma unroll
    for (int j = 0; j < 8; ++j) { const f32x4 gg = gr[64 * j]; u32x2 w; w.x = pk2(v[j].x * rstd * gg.x, v[j].y * rstd * gg.y); w.y = pk2(v[j].z * rstd * gg.z, v[j].w * rstd * gg.w); o8[64 * j] = w; }
}
__device__ __forceinline__ const float* x_row_l0(const Frame& F, int m) {
    const GAS float* s0 = (const GAS float*)FIN(IN_XP); const GAS float* s1 = (const GAS float*)FIN(IN_XS);
    asm volatile("" : "+s"(s0), "+s"(s1));
    return (const float*)(m < MPT ? s0 + (size_t)m * DM : s1 + (size_t)(m - MPT) * DM); }

__device__ __forceinline__ void phase_prologue(Frame& F) {
    LAS float* scr = (LAS float*)(F.lds + F.wave * 16640);
    const int lane = F.lane;
    constexpr int I_WIN = 32 * (NPROJ / 64), I_GLU = 16 * 16, I_BR = 16 * 32, I_OUT = 32 * 32, I_POOL = 4 * 4, I_PHI = 1;
    constexpr int PER_L = I_WIN + I_GLU + 3 * I_BR + I_OUT + 4 * I_POOL + 128 * I_PHI;
    for (int it = F.gw; it < 2 * PER_L; it += F.ngw) {
        const int l = it / PER_L; int r = it % PER_L;
        if (r < I_WIN) { const int kb = r / (NPROJ / 64), nb = r % (NPROJ / 64);
            transpose_item(FIN(IN_WIN) + (size_t)l * DM * DIN, DIN, DM, (bf16_t*)(F.ws + WS_WIN + l * al1m(SZ_WIN)), 64 * kb, 64 * nb, scr, lane, MapWin()); continue; } r -= I_WIN;
        if (r < I_GLU) { const int kb = r / 16, nb = r % 16;
            transpose_item(FIN(IN_WGLU) + (size_t)l * 1024 * 1024, 1024, 1024, (bf16_t*)(F.ws + WS_WGLU + l * al1m(SZ_WGLU)), 64 * kb, 64 * nb, scr, lane, MapId()); continue; } r -= I_GLU;
        if (r < 3 * I_BR) { const int z = r / I_BR, rr = r % I_BR, kb = rr / 32, nb = rr % 32;
            const float* src = FIN(IN_WBRP + z) + (size_t)l * 1024 * 2048;
            transpose_item(src, 2048, 1024, (bf16_t*)(F.ws + WS_WBR + l * al1m(SZ_WBR)) + (size_t)z * 2048 * 1024, 64 * kb, 64 * nb, scr, lane, MapId()); continue; } r -= 3 * I_BR;
        if (r < I_OUT) { const int kb = r / 32, nb = r % 32;
            transpose_item(FIN(IN_WOUT) + (size_t)l * 2048 * 2048, 2048, 2048, (bf16_t*)(F.ws + WS_WOUT + l * al1m(SZ_WOUT)), 64 * kb, 64 * nb, scr, lane, MapId()); continue; } r -= I_OUT;
        if (r < 4 * I_POOL) { const int z = r / I_POOL, rr = r % I_POOL, kb = rr / 4, nb = rr % 4;
            transpose_item(FIN(IN_WPOOL) + ((size_t)l * 4 + z) * 65536, 256, 256, (bf16_t*)(F.ws + WS_WPOOL + l * al1m(SZ_WPOOL)) + (size_t)z * 65536, 64 * kb, 64 * nb, scr, lane, MapId()); continue; } r -= 4 * I_POOL;
        {
            transpose_item(FIN(IN_WPHI) + ((size_t)l * 128 + r) * 4096, 64, 64, (bf16_t*)(F.ws + WS_WPHI + l * al1m(SZ_WPHI)) + (size_t)r * 4096, 0, 0, scr, lane, MapId()); }
    }
    for (int it = F.gw; it < 64; it += F.ngw) {
        const int l = it >> 5, j = (it >> 4) & 1, part = it & 15;
        const float* pe = FIN(IN_PE) + ((size_t)(l * 2 + j) * 64 + part * 4) * 64;
        const float* wp = FIN(IN_WPHI) + ((size_t)(l * 2 + j) * 64 + part * 4) * 4096;
        float s = 0.f;
#pragma unroll 16
        for (int i = 0; i < 256; ++i) s += pe[i] * wp[(size_t)i * 64 + lane];
        ((float*)(F.ws + WS_PEBP + l * al1m(SZ_PEBP)))[(j * 16 + part) * 64 + lane] = s;
    }
    for (int it = F.gw * 64 + lane; it < 2 * 4096; it += F.ngw * 64) {
        const int l = it >> 12, g = (it >> 6) & 63, n = it & 63;
        const double dt = exp_d((double)FIN(IN_LSTEP)[l * 64 + g]);
        const double lr = (double)FIN(IN_LRE)[(l * 64 + g) * 64 + n], li = (double)FIN(IN_LIM)[(l * 64 + g) * 64 + n];
        const double mag = exp_d(lr * dt); double sn, cs; sincos_d(li * dt, sn, cs);
        const double ar = mag * cs, ai = mag * sn, den = lr * lr + li * li;
        const double cr = ((ar - 1.0) * lr + ai * li) / den, ci = (ai * lr - (ar - 1.0) * li) / den;
        double pr = ar, pi = ai;
#pragma unroll
        for (int k = 0; k < 7; ++k) { const double t = pr * pr - pi * pi; pi = 2.0 * pr * pi; pr = t; }
        float* ab = (float*)(F.ws + WS_SAB + l * al1m(SZ_SAB)) + (g * 64 + n) * 4;
        ab[0] = (float)ar; ab[1] = (float)ai; ab[2] = (float)pr; ab[3] = (float)pi;
        float* bb = (float*)(F.ws + WS_SBB + l * al1m(SZ_SBB)) + (size_t)g * 16 * 128;
        const float* bre = FIN(IN_BRE) + ((size_t)(l * 64 + g) * 64 + n) * 16; const float* bim = FIN(IN_BIM) + ((size_t)(l * 64 + g) * 64 + n) * 16;
        unsigned* bb16 = (unsigned*)(F.ws + WS_SBB16 + l * al1m(SZ_SBB16));
        for (int c = 0; c < 16; c += 2) { const double br0 = bre[c], bi0 = bim[c], br1 = bre[c + 1], bi1 = bim[c + 1];
            const float r0 = (float)(cr * br0 - ci * bi0), i0 = (float)(cr * bi0 + ci * br0), r1 = (float)(cr * br1 - ci * bi1), i1 = (float)(cr * bi1 + ci * br1);
            bb[c * 128 + n] = r0; bb[c * 128 + 64 + n] = i0; bb[(c + 1) * 128 + n] = r1; bb[(c + 1) * 128 + 64 + n] = i1;
            bb16[(((g * 2 + 0) * 64 + n) * 16 + c) >> 1] = pk2(r0, r1); bb16[(((g * 2 + 1) * 64 + n) * 16 + c) >> 1] = pk2(i0, i1); }
        bf16_t* cm = (bf16_t*)(F.ws + WS_SCM + l * al1m(SZ_SCM)) + (size_t)g * 16 * 128;
        const float* cre = FIN(IN_CRE) + (size_t)(l * 64 + g) * 16 * 64; const float* cim = FIN(IN_CIM) + (size_t)(l * 64 + g) * 16 * 64;
        for (int c = 0; c < 16; ++c) *(unsigned*)(cm + c * 128 + 2 * n) = pk2(cre[c * 64 + n], -cim[c * 64 + n]);
    }
    bf16_t* H = (bf16_t*)(F.ws + WS_H);
    for (int m = F.gw; m < MROWS; m += F.ngw) rms_row_to_bf16(x_row_l0(F, m), FIN(IN_GPRE), H + (size_t)m * DM, lane);
}

__device__ __forceinline__ void phase_norm(Frame& F, int l) {
    const int lane = F.lane;
    const bf16_t* outb = (const bf16_t*)(F.ws + WS_OUTB);
    float* y0 = (float*)(F.ws + WS_Y0);
    bf16_t* H = (bf16_t*)(F.ws + WS_H);
    for (int r = F.bid; r < MROWS - MPT; r += F.G) {
        const int m = MPT + r, c0 = F.wave * 256 + 4 * lane;
        LAS float* red = (LAS float*)F.lds;
        const float* xrow = l == 0 ? FIN(IN_XS) + (size_t)r * DM : y0 + (size_t)m * DM;
        float* yrow = l == 0 ? y0 + (size_t)m * DM : F.out + O_YS + (size_t)r * DM;
        const f32x4 o = unpack4(*(const u32x2*)(outb + (size_t)m * DM + c0)), x = *(const f32x4*)(xrow + c0), g = *(const f32x4*)(FIN(IN_GPOST) + l * DM + c0);
        float s = wave_sum(o.x * o.x + o.y * o.y + o.z * o.z + o.w * o.w);
        __syncthreads();
        if (lane == 0) red[F.wave] = s;
        __syncthreads();
        s = 0.f;
#pragma unroll
        for (int w2 = 0; w2 < NWAVES; ++w2) s += red[w2];
        const float rstd = 1.f / sqrtf(s * (1.f / DM) + EPS);
        const f32x4 y = x + o * rstd * g;
        *(f32x4*)(yrow + c0) = y;
        if (l == 0) {
            float s2 = wave_sum(y.x * y.x + y.y * y.y + y.z * y.z + y.w * y.w);
            if (lane == 0) red[8 + F.wave] = s2;
            __syncthreads();
            s2 = 0.f;
#pragma unroll
            for (int w2 = 0; w2 < NWAVES; ++w2) s2 += red[8 + w2];
            const float rstd2 = 1.f / sqrtf(s2 * (1.f / DM) + EPS);
            const f32x4 g2 = *(const f32x4*)(FIN(IN_GPRE) + DM + c0);
            *(u32x2*)(H + (size_t)m * DM + c0) = pack4(y * rstd2 * g2);
        }
    }
    for (int m = F.gw; m < MPT; m += F.ngw) {
        const float* xrow = l == 0 ? x_row_l0(F, m) : y0 + (size_t)m * DM;
        float* yrow = l == 0 ? y0 + (size_t)m * DM : (m < MPT ? F.out + O_YP + (size_t)m * DM : F.out + O_YS + (size_t)(m - MPT) * DM);
        const float* gp = FIN(IN_GPOST) + l * DM;
        float v[4][8]; float s = 0.f;
#pragma unroll
        for (int j = 0; j < 4; ++j) { const u32x4 w = *(const u32x4*)(outb + (size_t)m * DM + 8 * (lane + 64 * j)); unpack8(w, v[j]);
#pragma unroll
            for (int e = 0; e < 8; ++e) s += v[j][e] * v[j][e]; }
        const float rstd = 1.f / sqrtf(wave_sum(s) * (1.f / DM) + EPS);
        float s2 = 0.f;
#pragma unroll
        for (int j = 0; j < 4; ++j) { const int c0 = 8 * (lane + 64 * j);
            const f32x4 g0 = *(const f32x4*)(gp + c0), g1 = *(const f32x4*)(gp + c0 + 4), x0 = *(const f32x4*)(xrow + c0), x1 = *(const f32x4*)(xrow + c0 + 4);
            f32x4 y0v, y1v;
#pragma unroll
            for (int e = 0; e < 4; ++e) { y0v[e] = x0[e] + v[j][e] * rstd * g0[e]; y1v[e] = x1[e] + v[j][4 + e] * rstd * g1[e]; v[j][e] = y0v[e]; v[j][4 + e] = y1v[e]; s2 += y0v[e] * y0v[e] + y1v[e] * y1v[e]; }
            *(f32x4*)(yrow + c0) = y0v; *(f32x4*)(yrow + c0 + 4) = y1v; }
        if (l == 0) {
            const float rstd2 = 1.f / sqrtf(wave_sum(s2) * (1.f / DM) + EPS);
            const float* g2 = FIN(IN_GPRE) + DM;
#pragma unroll
            for (int j = 0; j < 4; ++j) { const int c0 = 8 * (lane + 64 * j); const f32x4 g0 = *(const f32x4*)(g2 + c0), g1 = *(const f32x4*)(g2 + c0 + 4);
                f32x4 a, bq;
#pragma unroll
                for (int e = 0; e < 4; ++e) { a[e] = v[j][e] * rstd2 * g0[e]; bq[e] = v[j][4 + e] * rstd2 * g1[e]; }
                *(u32x4*)(H + (size_t)m * DM + c0) = pack8(a, bq); }
        }
    }
}
template <int KP>
__device__ __forceinline__ void skinny_stage(LAS unsigned char* lds, const bf16_t* A, int lda, int tid) {
    constexpr int CH = KP / 8;
#pragma unroll 8
    for (int i = tid; i < 32 * CH; i += NT) { const int r = i / CH, c = i % CH; *(LAS u32x4*)(lds + r * (KP * 2 + 16) + c * 16) = *(const u32x4*)(A + (size_t)r * lda + 8 * c); }
    __syncthreads();
}
template <int KP>
__device__ __forceinline__ void skinny_tile(const LAS unsigned char* lds, const bf16_t* Bt, int ldb, int n0, int kbeg, int klen, int lane, f32x4& d0, f32x4& d1) {
    const int rw = lane & 15, q = lane >> 4;
    const bf16_t* wrow = Bt + (size_t)(n0 + rw) * ldb + 32 * q;
    const LAS unsigned char* a0 = lds + rw * (KP * 2 + 16) + (kbeg + 32 * q) * 2;
    const LAS unsigned char* a1 = a0 + 16 * (KP * 2 + 16);
    d0 = (f32x4){0.f, 0.f, 0.f, 0.f}; d1 = d0;
#pragma unroll 4
    for (int k0 = 0; k0 < klen; k0 += 128) {
        bf16x8 w[4];
#pragma unroll
        for (int s = 0; s < 4; ++s) w[s] = *(const bf16x8*)(wrow + k0 + 8 * s);
#pragma unroll
        for (int s = 0; s < 4; ++s) { const bf16x8 b0 = *(const LAS bf16x8*)(a0 + k0 * 2 + 16 * s), b1 = *(const LAS bf16x8*)(a1 + k0 * 2 + 16 * s);
            d0 = __builtin_amdgcn_mfma_f32_16x16x32_bf16(w[s], b0, d0, 0, 0, 0); d1 = __builtin_amdgcn_mfma_f32_16x16x32_bf16(w[s], b1, d1, 0, 0, 0); }
    }
}

__device__ __forceinline__ void skinny_proj(Frame& F, int l) {
    constexpr int NTASK = NPROJ / 128;
    bf16_t* P = (bf16_t*)(F.ws + WS_P); float* gate = (float*)(F.ws + WS_GATE);
    const bf16_t* W = (const bf16_t*)(F.ws + WS_WIN + l * al1m(SZ_WIN));
    bool staged = false;
    const int ntile = (MPT / 256) * (NPROJ / 256), nlight = (ntile % F.G) ? F.G - (ntile % F.G) : F.G, first = F.G - nlight;
    for (int it = 0; it < 2; ++it) { int task;
        if (F.bid >= first) task = (F.bid - first) + it * nlight; else { if (it) break; task = 2 * nlight + (first - 1 - F.bid); }
        if (task >= NTASK) break;
        if (!staged) { skinny_stage<DM>(F.lds, (const bf16_t*)(F.ws + WS_H) + (size_t)MPT * DM, DM, F.tid); staged = true; }
        const int n0 = task * 128 + F.wave * 16; f32x4 d[2];
        skinny_tile<DM>(F.lds, W, DM, n0, 0, DM, F.lane, d[0], d[1]);
        const int n = n0 + 4 * (F.lane >> 4), pn = n >> 8;
        int mode; if (pn < 4) mode = 0; else if (pn < 8) mode = 1; else if (pn < 12) mode = 5; else if (pn < 16) mode = 3; else if (pn < 18) mode = 0;
        else if (pn < 22) mode = 1; else if (pn < 26) mode = 0; else if (pn < 30) mode = 1; else if (pn < 54) mode = 2; else mode = 4;
#pragma unroll
        for (int tt = 0; tt < 2; ++tt) { const int t = 16 * tt + (F.lane & 15), row = MPT + t; f32x4 v = d[tt];
            if (mode == 4) { const int c = n - C_AG; if (c < 48) {
#pragma unroll
                for (int j = 0; j < 4; ++j) v[j] = sigmoidf_(v[j]);
                *(f32x4*)(gate + (size_t)row * 64 + c) = v; } }
            else {
                if (mode == 3) *(f32x4*)(F.out + O_KVS + ((size_t)l * 32 + t) * 1024 + n - C_CK) = v;
                if (mode == 5) v = v * SM_SCALE_L2E;
                if (mode == 1) {
#pragma unroll
                    for (int j = 0; j < 4; ++j) v[j] = siluf_(v[j]); }
                if (mode == 2) {
#pragma unroll
                    for (int j = 0; j < 4; ++j) v[j] = sigmoidf_(v[j]); }
                *(u32x2*)(P + (size_t)row * NPROJ + n) = pack4(v);
            } }
    }
    __syncthreads();
}
__device__ __forceinline__ void skinny_pool(Frame& F, int l) {
    const bf16_t* P = (const bf16_t*)(F.ws + WS_P); bf16_t* apool = (bf16_t*)(F.ws + WS_ABR);
    const bf16_t* W = (const bf16_t*)(F.ws + WS_WPOOL + l * al1m(SZ_WPOOL)); const float* pscale = FIN(IN_PSCALE) + l * 1024;
    bool staged = false;
    for (int task = F.G - 1 - F.bid; task < 8; task += F.G) {
        if (!staged) { skinny_stage<1024>(F.lds, (const bf16_t*)(F.ws + WS_DIFF) + (size_t)MPT * 1024, 1024, F.tid); staged = true; }
        const int z = task >> 1, n0 = (task & 1) * 128 + F.wave * 16; f32x4 d[2];
        skinny_tile<1024>(F.lds, W + (size_t)z * 65536, 256, n0, z * 256, 256, F.lane, d[0], d[1]);
        const int col = z * 256 + n0 + 4 * (F.lane >> 4);
        const f32x4 ps = *(const f32x4*)(pscale + col);
#pragma unroll
        for (int tt = 0; tt < 2; ++tt) { const int row = MPT + 16 * tt + (F.lane & 15);
            const f32x4 zf = unpack4(*(const u32x2*)(P + (size_t)row * NPROJ + C_PZ + col));
            *(u32x2*)(apool + (size_t)row * 1024 + col) = pack4(d[tt] * ps * zf); }
    }
    __syncthreads();
}
__device__ __forceinline__ void skinny_glu(Frame& F, int l) {
    const bf16_t* P = (const bf16_t*)(F.ws + WS_P); const bf16_t* Z = (const bf16_t*)(F.ws + WS_Z); bf16_t* assm = (bf16_t*)(F.ws + WS_ABR + 2 * SZ_ABR1);
    const bf16_t* W = (const bf16_t*)(F.ws + WS_WGLU + l * al1m(SZ_WGLU));
    bool staged = false;
    for (int task = F.G - 1 - F.bid; task < 8; task += F.G) {
        if (!staged) { skinny_stage<1024>(F.lds, Z + (size_t)MPT * 1024, 1024, F.tid); staged = true; }
        const int n0 = task * 128 + F.wave * 16; f32x4 d[2];
        skinny_tile<1024>(F.lds, W, 1024, n0, 0, 1024, F.lane, d[0], d[1]);
        const int col = n0 + 4 * (F.lane >> 4);
#pragma unroll
        for (int tt = 0; tt < 2; ++tt) { const int row = MPT + 16 * tt + (F.lane & 15);
            const f32x4 zf = unpack4(*(const u32x2*)(Z + (size_t)row * 1024 + col)), sf = unpack4(*(const u32x2*)(P + (size_t)row * NPROJ + C_SZ + col));
            f32x4 v = d[tt];
#pragma unroll
            for (int j = 0; j < 4; ++j) v[j] = zf[j] * sigmoidf_(v[j]) * sf[j];
            *(u32x2*)(assm + (size_t)row * 1024 + col) = pack4(v); }
    }
    __syncthreads();
}
__device__ __forceinline__ void skinny_branch(Frame& F, int l) {
    const bf16_t* P = (const bf16_t*)(F.ws + WS_P); float* brp = (float*)(F.ws + WS_BRP);
    const bf16_t* W = (const bf16_t*)(F.ws + WS_WBR + l * al1m(SZ_WBR));
    for (int task = F.G - 1 - F.bid; task < 48; task += F.G) {
        const int z = task >> 4, n0 = (task & 15) * 128 + F.wave * 16; f32x4 d[2];
        __syncthreads();
        skinny_stage<1024>(F.lds, (const bf16_t*)(F.ws + WS_ABR) + (size_t)z * MPAD * 1024 + (size_t)MPT * 1024, 1024, F.tid);
        skinny_tile<1024>(F.lds, W + (size_t)z * 2048 * 1024, 1024, n0, 0, 1024, F.lane, d[0], d[1]);
        const int col = n0 + 4 * (F.lane >> 4);
#pragma unroll
        for (int tt = 0; tt < 2; ++tt) { const int t = 16 * tt + (F.lane & 15), row = MPT + t;
            const f32x4 gm = unpack4(*(const u32x2*)(P + (size_t)row * NPROJ + C_MG + z * 2048 + col));
            *(f32x4*)(brp + ((size_t)z * 32 + t) * DM + col) = d[tt] * gm; }
    }
    __syncthreads();
}
__device__ __forceinline__ void skinny_out(Frame& F, int l) {
    const float* brp = (const float*)(F.ws + WS_BRP); bf16_t* outb = (bf16_t*)(F.ws + WS_OUTB);
    const bf16_t* W = (const bf16_t*)(F.ws + WS_WOUT + l * al1m(SZ_WOUT));
    bool staged = false;
    for (int task = F.G - 1 - F.bid; task < 64; task += F.G) {
        if (!staged) {
#pragma unroll 4
            for (int i = F.tid; i < 32 * (DM / 4); i += NT) { const int r = i / (DM / 4), c = i % (DM / 4);
                const f32x4 s = *(const f32x4*)(brp + (size_t)r * DM + 4 * c) + *(const f32x4*)(brp + (size_t)(32 + r) * DM + 4 * c) + *(const f32x4*)(brp + (size_t)(64 + r) * DM + 4 * c);
                *(LAS u32x2*)(F.lds + r * (DM * 2 + 16) + c * 8) = pack4(s); }
            __syncthreads(); staged = true; }
        const int tile = F.wave & 1, kq = F.wave >> 1, n0 = task * 32 + tile * 16; f32x4 d[2];
        skinny_tile<DM>(F.lds, W + kq * 512, DM, n0, kq * 512, 512, F.lane, d[0], d[1]);
        __syncthreads();
        LAS f32x4* red = (LAS f32x4*)F.lds;
        red[(F.wave * 2 + 0) * 64 + F.lane] = d[0]; red[(F.wave * 2 + 1) * 64 + F.lane] = d[1];
        staged = false;
        __syncthreads();
        if (kq == 0) {
#pragma unroll
            for (int tt = 0; tt < 2; ++tt) { f32x4 a = d[tt];
#pragma unroll
                for (int k2 = 1; k2 < 4; ++k2) a += red[((2 * k2 + tile) * 2 + tt) * 64 + F.lane];
                *(u32x2*)(outb + (size_t)(MPT + 16 * tt + (F.lane & 15)) * DM + n0 + 4 * (F.lane >> 4)) = pack4(a); } }
        __syncthreads();
    }
    __syncthreads();
}
__device__ __forceinline__ int keypos(int key) { return (key & ~12) | ((key & 4) << 1) | ((key & 8) >> 1); }

template <int W>
__device__ __forceinline__ void pool_diff_load(const bf16_t* P, const float* spool, int m, int c0, f32x4 (&v)[W]) {
    if (m < MPT) {
        const int s = m & (SEQ - 1);
#pragma unroll
        for (int j = 0; j < W; ++j) v[j] = (j <= s) ? unpack4(*(const u32x2*)(P + (size_t)(m - j) * NPROJ + C_PU + c0)) : (f32x4){0.f, 0.f, 0.f, 0.f};
    } else {
        const int b = (m - MPT) >> 2, i = (m - MPT) & 3;
#pragma unroll
        for (int j = 0; j < W; ++j) { const int idx = 15 + i - j;
            v[j] = (idx >= 15) ? unpack4(*(const u32x2*)(P + (size_t)(MPT + b * 4 + idx - 15) * NPROJ + C_PU + c0)) : *(const f32x4*)(spool + ((size_t)b * 15 + idx) * 1024 + c0); }
    }
}
template <int W>
__device__ __forceinline__ void pool_diff_store(bf16_t* D, int m, int c0, const f32x4 (&v)[W]) {
    int cnt = W; if (m < MPT) { const int s = m & (SEQ - 1); cnt = (s + 1 < W) ? s + 1 : W; }
    f32x4 sum = v[0];
#pragma unroll
    for (int j = 1; j < W; ++j) sum += v[j];
    *(u32x2*)(D + (size_t)m * 1024 + c0) = pack4(sum * (1.f / (float)cnt) - v[0]);
}
__device__ __forceinline__ void s2_pool_diff(Frame& F, int l) {
    const bf16_t* P = (const bf16_t*)(F.ws + WS_P); bf16_t* D = (bf16_t*)(F.ws + WS_DIFF);
    const float* spool = FIN(IN_SPOOL) + (size_t)l * SB * 15 * 1024;
    const int c0 = 4 * F.lane;
    for (int m = F.gw; m < MROWS; m += F.ngw) {
        f32x4 v2[2], v4[4], v8[8], v16[16];
        pool_diff_load<2>(P, spool, m, c0, v2); pool_diff_load<4>(P, spool, m, 256 + c0, v4); pool_diff_load<8>(P, spool, m, 512 + c0, v8); pool_diff_load<16>(P, spool, m, 768 + c0, v16);
        pool_diff_store<2>(D, m, c0, v2); pool_diff_store<4>(D, m, 256 + c0, v4); pool_diff_store<8>(D, m, 512 + c0, v8); pool_diff_store<16>(D, m, 768 + c0, v16);
    }
}

__device__ __forceinline__ void store8f(float* dst, const u32x4& x) { float f[8]; unpack8(x, f); *(f32x4*)dst = (f32x4){f[0], f[1], f[2], f[3]}; *(f32x4*)(dst + 4) = (f32x4){f[4], f[5], f[6], f[7]}; }

__device__ __forceinline__ void s2_state_outputs(Frame& F, int l) {
    const bf16_t* P = (const bf16_t*)(F.ws + WS_P);
    const int gt = F.gw * 64 + F.lane, ngt = F.ngw * 64;
    for (int it = gt; it < PB * 15 * 128; it += ngt) { const int c0 = (it & 127) * 8, r = (it >> 7) % 15, b = (it >> 7) / 15;
        store8f(F.out + O_POOLP + (((size_t)l * PB + b) * 15 + r) * 1024 + c0, *(const u32x4*)(P + (size_t)(b * SEQ + SEQ - 15 + r) * NPROJ + C_PU + c0)); }
    for (int it = gt; it < SB * 15 * 128; it += ngt) { const int c0 = (it & 127) * 8, r = (it >> 7) % 15, b = (it >> 7) / 15, e = 4 + r;
        float* dst = F.out + O_POOLS + (((size_t)l * SB + b) * 15 + r) * 1024 + c0;
        if (e < 15) { const float* sp = FIN(IN_SPOOL) + (((size_t)l * SB + b) * 15 + e) * 1024 + c0; *(f32x4*)dst = *(const f32x4*)sp; *(f32x4*)(dst + 4) = *(const f32x4*)(sp + 4); }
        else store8f(dst, *(const u32x4*)(P + (size_t)(MPT + b * 4 + e - 15) * NPROJ + C_PU + c0)); }
    for (int it = gt; it < PB * 512 * 64; it += ngt) { const int c0 = (it & 63) * 8, r = (it >> 6) & 511, b = it >> 15;
        store8f(F.out + O_WINP + (((size_t)l * PB + b) * 512 + r) * 512 + c0, *(const u32x4*)(P + (size_t)(b * SEQ + SEQ - 512 + r) * NPROJ + C_WK + c0)); }
    for (int it = gt; it < SB * 512 * 64; it += ngt) { const int c0 = (it & 63) * 8, r = (it >> 6) & 511, b = it >> 15;
        float* dst = F.out + O_WINS + (((size_t)l * SB + b) * 512 + r) * 512 + c0;
        if (r < 508) { const float* sp = FIN(IN_SWIN) + (((size_t)l * SB + b) * 512 + r + 4) * 512 + c0; *(f32x4*)dst = *(const f32x4*)sp; *(f32x4*)(dst + 4) = *(const f32x4*)(sp + 4); }
        else store8f(dst, *(const u32x4*)(P + (size_t)(MPT + b * 4 + r - 508) * NPROJ + C_WK + c0)); }
}

__device__ __forceinline__ void s2_vt_images(Frame& F) {
    const bf16_t* P = (const bf16_t*)(F.ws + WS_P);
    for (int it = F.gw; it < 2 * PB * 4 * 64; it += F.ngw) {
        const int which = it >> 9, b = (it >> 8) & 1, kvh = (it >> 6) & 3, blk = it & 63;
        const bf16_t* src = P + (size_t)(b * SEQ + blk * 64 + F.lane) * NPROJ + (which ? C_WK : C_SK) + kvh * 64;
        bf16_t* img = (bf16_t*)(F.ws + (which ? WS_KTWIN : WS_KTSEL)) + (size_t)((b * 4 + kvh) * 64 + blk) * 4096 + F.lane * 8;
        u32x4 v[8];
#pragma unroll
        for (int j = 0; j < 8; ++j) v[j] = *(const u32x4*)(src + 8 * j);
#pragma unroll
        for (int j = 0; j < 8; ++j) *(u32x4*)(img + j * 512) = v[j];
    }
    for (int it = F.gw; it < 2 * PB * 4 * 64; it += F.ngw) {
        const int which = it >> 9, b = (it >> 8) & 1, kvh = (it >> 6) & 3, blk = it & 63;
        const bf16_t* src = P + (size_t)(b * SEQ + blk * 64 + F.lane) * NPROJ + (which ? C_WV : C_SV) + kvh * 64;
        const int pos = keypos(F.lane);
        bf16_t* img = (bf16_t*)(F.ws + (which ? WS_VTWIN : WS_VTSEL)) + (size_t)((b * 4 + kvh) * 64 + blk) * 4096 + (pos >> 3) * 512 + (pos & 7);
        u32x4 v[8];
#pragma unroll
        for (int j = 0; j < 8; ++j) v[j] = *(const u32x4*)(src + 8 * j);
#pragma unroll
        for (int j = 0; j < 8; ++j) {
            img[(8 * j + 0) * 8] = (bf16_t)(v[j].x & 0xffffu); img[(8 * j + 1) * 8] = (bf16_t)(v[j].x >> 16);
            img[(8 * j + 2) * 8] = (bf16_t)(v[j].y & 0xffffu); img[(8 * j + 3) * 8] = (bf16_t)(v[j].y >> 16);
            img[(8 * j + 4) * 8] = (bf16_t)(v[j].z & 0xffffu); img[(8 * j + 5) * 8] = (bf16_t)(v[j].z >> 16);
            img[(8 * j + 6) * 8] = (bf16_t)(v[j].w & 0xffffu); img[(8 * j + 7) * 8] = (bf16_t)(v[j].w >> 16); }
    }
}

template <bool SAMPLE>
__device__ __forceinline__ void compress_unit(Frame& F, int l, int unit) {
    const int lane = F.lane, w = F.wave, col = lane & 15, q = lane >> 4, nl = col >> 2, k = col & 3;
    const int b = SAMPLE ? unit >> 5 : unit >> 3, n0 = SAMPLE ? (unit & 31) * 8 : (unit & 7) * 8;
    const bf16_t* wphi = (const bf16_t*)(F.ws + WS_WPHI + l * al1m(SZ_WPHI));
    const bf16_t* P = (const bf16_t*)(F.ws + WS_P);
    const float* cache = FIN(IN_CACHE); const int* pt = (const int*)FIN(IN_PT);
    f32x4 acc[2][2][4];
#pragma unroll
    for (int j = 0; j < 2; ++j)
#pragma unroll
        for (int nt = 0; nt < 2; ++nt)
#pragma unroll
            for (int et = 0; et < 4; ++et) acc[j][nt][et] = (f32x4){0.f, 0.f, 0.f, 0.f};
    size_t xoff[2];
#pragma unroll
    for (int nt = 0; nt < 2; ++nt) { const int blk = n0 + 4 * nt + nl;
        if (SAMPLE) { const int page = pt[b * 128 + (blk >> 1)]; xoff[nt] = ((((size_t)l * NPOOL + page) * 128 + (blk & 1) * 64) * 4) * 256 + k * 64 + 8 * q; }
        else xoff[nt] = (size_t)(b * SEQ + blk * 64) * NPROJ + C_CK + k * 64 + 8 * q; }
    bf16x8 ra[2][2][4];
    f32x4 rx[2][2][2][2];
#define CMP_LOAD(J, LPOS) do { _Pragma("unroll") for (int dc = 0; dc < 2; ++dc) { \
        _Pragma("unroll") for (int et = 0; et < 4; ++et) ra[J][dc][et] = *(const bf16x8*)(wphi + ((size_t)((J) * 64 + (LPOS)) * 64 + 16 * et + col) * 64 + 32 * dc + 8 * q); \
        _Pragma("unroll") for (int nt = 0; nt < 2; ++nt) { \
            if (SAMPLE) { const float* s_ = cache + xoff[nt] + ((size_t)(LPOS) * 4 + (J)) * 256 + 32 * dc; rx[J][dc][nt][0] = __builtin_nontemporal_load((const f32x4*)s_); rx[J][dc][nt][1] = __builtin_nontemporal_load((const f32x4*)(s_ + 4)); } \
            else rx[J][dc][nt][0] = __builtin_bit_cast(f32x4, *(const bf16x8*)(P + xoff[nt] + (size_t)(LPOS) * NPROJ + (J) * 256 + 32 * dc)); } } } while (0)
#define CMP_MMA(J) do { _Pragma("unroll") for (int dc = 0; dc < 2; ++dc) _Pragma("unroll") for (int nt = 0; nt < 2; ++nt) { \
        const bf16x8 bx_ = SAMPLE ? __builtin_bit_cast(bf16x8, pack8(rx[J][dc][nt][0], rx[J][dc][nt][1])) : __builtin_bit_cast(bf16x8, rx[J][dc][nt][0]); \
        _Pragma("unroll") for (int et = 0; et < 4; ++et) acc[J][nt][et] = __builtin_amdgcn_mfma_f32_16x16x32_bf16(ra[J][dc][et], bx_, acc[J][nt][et], 0, 0, 0); } } while (0)
    CMP_LOAD(0, w * 8);
#pragma unroll 1
    for (int li = 0; li < 8; ++li) { const int lpos = w * 8 + li;
        CMP_LOAD(1, lpos); __builtin_amdgcn_sched_barrier(0);
        CMP_MMA(0); __builtin_amdgcn_sched_barrier(0);
        if (li < 7) CMP_LOAD(0, lpos + 1);
        __builtin_amdgcn_sched_barrier(0);
        CMP_MMA(1); __builtin_amdgcn_sched_barrier(0);
    }
#undef CMP_LOAD
#undef CMP_MMA
    LAS float* red = (LAS float*)F.lds;
#pragma unroll
    for (int j = 0; j < 2; ++j)
#pragma unroll
        for (int nt = 0; nt < 2; ++nt)
#pragma unroll
            for (int et = 0; et < 4; ++et)
#pragma unroll
                for (int i = 0; i < 4; ++i) red[(w * 64 + ((j * 2 + nt) * 4 + et) * 4 + i) * 64 + lane] = acc[j][nt][et][i];
    __syncthreads();
    const LAS float* pb = (const LAS float*)(F.lds + 131072);
    bf16_t* kc = (bf16_t*)(F.ws + (SAMPLE ? WS_KCS : WS_KCP)); bf16_t* vct = (bf16_t*)(F.ws + (SAMPLE ? WS_VCTS : WS_VCTP));
    constexpr int NBLK = SAMPLE ? 256 : 64;
    for (int o = F.tid; o < 4096; o += NT) { const int r = o >> 6, ln = o & 63;
        float s = 0.f;
#pragma unroll
        for (int ww = 0; ww < 8; ++ww) s += red[(ww * 64 + r) * 64 + ln];
        const int j = r >> 5, nt = (r >> 4) & 1, et = (r >> 2) & 3, i = r & 3, e = 16 * et + 4 * (ln >> 4) + i, cc = ln & 15, blk = n0 + 4 * nt + (cc >> 2), kk = cc & 3;
        s += pb[j * 64 + e];
        if (j == 0) kc[((size_t)(b * 4 + kk) * NBLK + blk) * 64 + e] = (bf16_t)f2bf(s);
        else vct[(((size_t)(b * 4 + kk) * (NBLK / 64) + (blk >> 6)) * 64 + e) * 64 + keypos(blk & 63)] = (bf16_t)f2bf(s);
    }
    __syncthreads();
}

__device__ __forceinline__ void compress_prompt_piece(Frame& F, int l, int piece) {
    const int lane = F.lane, w = F.wave, col = lane & 15, q = lane >> 4, nl = col >> 2, k = col & 3;
    const int ntile = piece >> 3, j = (piece >> 2) & 1, et = piece & 3, b = ntile >> 4, n0 = (ntile & 15) * 4;
    const bf16_t* wphi = (const bf16_t*)(F.ws + WS_WPHI + l * al1m(SZ_WPHI)) + ((size_t)(j * 64) * 64 + 16 * et + col) * 64 + 8 * q;
    const bf16_t* xp = (const bf16_t*)(F.ws + WS_P) + (size_t)(b * SEQ + (n0 + nl) * 64) * NPROJ + C_CK + j * 256 + k * 64 + 8 * q;
    bf16x8 a[16], x[16];
#pragma unroll
    for (int li = 0; li < 8; ++li)
#pragma unroll
        for (int dc = 0; dc < 2; ++dc) { const int lpos = w * 8 + li;
            a[li * 2 + dc] = *(const bf16x8*)(wphi + (size_t)lpos * 4096 + 32 * dc); x[li * 2 + dc] = *(const bf16x8*)(xp + (size_t)lpos * NPROJ + 32 * dc); }
    f32x4 acc = {0.f, 0.f, 0.f, 0.f};
#pragma unroll
    for (int i = 0; i < 16; ++i) acc = __builtin_amdgcn_mfma_f32_16x16x32_bf16(a[i], x[i], acc, 0, 0, 0);
    LAS float* red = (LAS float*)F.lds;
    __syncthreads();
#pragma unroll
    for (int i = 0; i < 4; ++i) red[(w * 4 + i) * 64 + lane] = acc[i];
    __syncthreads();
    if (F.tid < 256) { const int i = F.tid >> 6, ln = F.tid & 63; float s = 0.f;
#pragma unroll
        for (int ww = 0; ww < 8; ++ww) s += red[(ww * 4 + i) * 64 + ln];
        const int e = 16 * et + 4 * (ln >> 4) + i, cc = ln & 15, blk = n0 + (cc >> 2), kk = cc & 3;
        s += ((const LAS float*)(F.lds + 131072))[j * 64 + e];
        if (j == 0) ((bf16_t*)(F.ws + WS_KCP))[(size_t)(b * 4 + kk) * 4096 + (e >> 3) * 512 + blk * 8 + (e & 7)] = (bf16_t)f2bf(s);
        else { const int pos = keypos(blk); ((bf16_t*)(F.ws + WS_VCTP))[(size_t)(b * 4 + kk) * 4096 + (pos >> 3) * 512 + e * 8 + (pos & 7)] = (bf16_t)f2bf(s); } }
    __syncthreads();
}

__device__ __forceinline__ void s2_compress(Frame& F, int l) {
    if (F.tid < 128) { const float* pp = (const float*)(F.ws + WS_PEBP + l * al1m(SZ_PEBP)); float s = 0.f;
#pragma unroll
        for (int p = 0; p < 16; ++p) s += pp[((F.tid >> 6) * 16 + p) * 64 + (F.tid & 63)];
        ((LAS float*)(F.lds + 131072))[F.tid] = s; }
    __syncthreads();
    for (int u = F.bid; u < 256; u += F.G) compress_unit<true>(F, l, u);
    for (int u = F.bid; u < 256; u += F.G) compress_prompt_piece(F, l, u);
}

#ifndef NSA_SGB
#define NSA_SGB 1
#endif
#define MFMA32(a, b, c) __builtin_amdgcn_mfma_f32_32x32x16_bf16((a), (b), (c), 0, 0, 0)
constexpr float NEG_BIG = -1e30f;
constexpr int AL_K = 0, AL_V = 8192, AL_SLOT = 16384  , AL_MASK = 4 * AL_SLOT  , AL_UNION = AL_MASK + 512,
              AL_TOT = 66560  , AL_IMP = AL_TOT  ;
__device__ __forceinline__ void dma16(const void* src, LAS unsigned char* dst) { __builtin_amdgcn_global_load_lds((const unsigned*)src, (LAS unsigned*)dst, 16, 0, 0); }
__device__ __forceinline__ void tile_dma(const bf16_t* kimg, const bf16_t* vimg, LAS unsigned char* slot, int w, int lane) {
    dma16(kimg + (unsigned)w * 512u + 8u * (unsigned)lane, slot + AL_K + w * 1024);
    dma16(vimg + (unsigned)w * 512u + 8u * (unsigned)lane, slot + AL_V + w * 1024);
}

struct FlashState { f32x16 o[2]; float m, l; };
__device__ __forceinline__ void flash_reset(FlashState& S) {
#pragma unroll
    for (int i = 0; i < 16; ++i) { S.o[0][i] = 0.f; S.o[1][i] = 0.f; }
    S.m = 0.f; S.l = 0.f;
}
__device__ __forceinline__ void flash_scores(const LAS unsigned char* kbuf, const bf16x8 (&qf)[4], int r, int h, float init, f32x16& s0, f32x16& s1) {
    bf16x8 kf[8];
#pragma unroll
    for (int ks = 0; ks < 4; ++ks) { kf[2 * ks] = *(const LAS bf16x8*)(kbuf + (2 * ks + h) * 1024 + r * 16); kf[2 * ks + 1] = *(const LAS bf16x8*)(kbuf + (2 * ks + h) * 1024 + (32 + r) * 16); }
    __builtin_amdgcn_sched_barrier(0);
#pragma unroll
    for (int i = 0; i < 16; ++i) { s0[i] = init; s1[i] = init; }
#pragma unroll
    for (int ks = 0; ks < 4; ++ks) { s0 = MFMA32(kf[2 * ks], qf[ks], s0); s1 = MFMA32(kf[2 * ks + 1], qf[ks], s1); }
}
__device__ __forceinline__ bf16x8 pack_p(const f32x16& p, int s) {
    u32x4 w; w.x = pk2(p[8 * s], p[8 * s + 1]); w.y = pk2(p[8 * s + 2], p[8 * s + 3]); w.z = pk2(p[8 * s + 4], p[8 * s + 5]); w.w = pk2(p[8 * s + 6], p[8 * s + 7]);
    return __builtin_bit_cast(bf16x8, w);
}
__device__ __forceinline__ void flash_vload(const LAS unsigned char* vbuf, int r, int h, bf16x8 (&vf)[8]) {
#pragma unroll
    for (int sub = 0; sub < 2; ++sub)
#pragma unroll
        for (int s = 0; s < 2; ++s)
#pragma unroll
            for (int dt = 0; dt < 2; ++dt) vf[(sub * 2 + s) * 2 + dt] = *(const LAS bf16x8*)(vbuf + (4 * sub + 2 * s + h) * 1024 + (32 * dt + r) * 16);
    __builtin_amdgcn_sched_barrier(0);
}
__device__ __forceinline__ void flash_pv(const bf16x8 (&vf)[8], const f32x16& p0, const f32x16& p1, f32x16 (&o)[2]) {
#pragma unroll
    for (int sub = 0; sub < 2; ++sub)
#pragma unroll
        for (int s = 0; s < 2; ++s) {
            const bf16x8 pb = pack_p(sub ? p1 : p0, s);
#pragma unroll
            for (int dt = 0; dt < 2; ++dt) o[dt] = MFMA32(vf[(sub * 2 + s) * 2 + dt], pb, o[dt]);
        }
}
__device__ __forceinline__ float xhalf_max(float x) {
    const auto r = __builtin_amdgcn_permlane32_swap(__float_as_uint(x), __float_as_uint(x), false, false);
    return fmaxf(__uint_as_float(r[0]), __uint_as_float(r[1]));
}
__device__ __forceinline__ void flash_mask(f32x16& s0, f32x16& s1, int lo, int hi, int h) {
#pragma unroll
    for (int i = 0; i < 16; ++i) { const int key = (i & 3) + 8 * (i >> 2) + 4 * h;
        s0[i] = (key >= lo && key <= hi) ? s0[i] : -INFINITY; s1[i] = (key + 32 >= lo && key + 32 <= hi) ? s1[i] : -INFINITY; }
}
__device__ __forceinline__ float flash_rowmax(const f32x16& s0, const f32x16& s1) {
    float mx = -INFINITY;
#pragma unroll
    for (int i = 0; i < 16; ++i) asm("v_max3_f32 %0, %1, %2, %3" : "=v"(mx) : "v"(mx), "v"(s0[i]), "v"(s1[i]));
    return xhalf_max(mx);
}
__device__ __forceinline__ void flash_first(FlashState& S, f32x16& s0, f32x16& s1, int lo, int hi, int h, bool masked) {
    if (masked) flash_mask(s0, s1, lo, hi, h);
    S.m = fmaxf(flash_rowmax(s0, s1), NEG_BIG);
    float ls = 0.f;
#pragma unroll
    for (int i = 0; i < 16; ++i) { s0[i] = __builtin_amdgcn_exp2f(s0[i] - S.m); s1[i] = __builtin_amdgcn_exp2f(s1[i] - S.m); ls += s0[i] + s1[i]; }
    S.l = ls;
}
__device__ __forceinline__ void flash_next(FlashState& S, f32x16& s0, f32x16& s1, float mused, int lo, int hi, int h, bool masked, bool first) {
    if (masked) flash_mask(s0, s1, lo, hi, h);
    const float corr = S.m - mused;
    if (__ballot(corr != 0.f) != 0ull) {
#pragma unroll
        for (int i = 0; i < 16; ++i) { s0[i] -= corr; s1[i] -= corr; } }
    const float mx = flash_rowmax(s0, s1);
    if (__ballot(mx > SM_THR || (first && mx < -SM_THR)) != 0ull) {
        const float d = (mx > NEG_BIG) ? (first ? mx : fmaxf(mx, 0.f)) : 0.f, alpha = __builtin_amdgcn_exp2f(-d);
        S.m += d; S.l *= alpha;
#pragma unroll
        for (int i = 0; i < 16; ++i) { S.o[0][i] *= alpha; S.o[1][i] *= alpha; s0[i] -= d; s1[i] -= d; }
    }
    float ls = 0.f;
#pragma unroll
    for (int i = 0; i < 16; ++i) { s0[i] = __builtin_amdgcn_exp2f(s0[i]); s1[i] = __builtin_amdgcn_exp2f(s1[i]); ls += s0[i] + s1[i]; }
    S.l += ls;
}

__device__ __forceinline__ void flash_kload(const LAS unsigned char* kbuf, int r, int h, bf16x8 (&kf)[8]) {
#pragma unroll
    for (int ks = 0; ks < 4; ++ks) { kf[2 * ks] = *(const LAS bf16x8*)(kbuf + (2 * ks + h) * 1024 + r * 16); kf[2 * ks + 1] = *(const LAS bf16x8*)(kbuf + (2 * ks + h) * 1024 + (32 + r) * 16); }
    __builtin_amdgcn_sched_barrier(0);
}
struct TileCtl { bool en, masked; int lo, hi; };
__device__ __forceinline__ void flash_pair(FlashState& S, const LAS unsigned char* ka, const LAS unsigned char* va, const LAS unsigned char* kb2, const LAS unsigned char* vb2,
                                           const bf16x8 (&qf)[4], const TileCtl& A, const TileCtl& B, bool first, int r, int h) {
    bf16x8 kf[8]; f32x16 a0, a1, b0, b1;
    flash_kload(ka, r, h, kf);
    { const float init = A.en ? -S.m : -INFINITY;
#pragma unroll
        for (int i = 0; i < 16; ++i) { a0[i] = init; a1[i] = init; }
#pragma unroll
        for (int ks = 0; ks < 4; ++ks) { a0 = MFMA32(kf[2 * ks], qf[ks], a0); a1 = MFMA32(kf[2 * ks + 1], qf[ks], a1); } }
    if (A.masked) flash_mask(a0, a1, A.lo, A.hi, h);
    { const float mx = flash_rowmax(a0, a1);
        if (__ballot(mx > SM_THR || (first && mx < -SM_THR)) != 0ull) { const float d = (mx > NEG_BIG) ? (first ? mx : fmaxf(mx, 0.f)) : 0.f, alpha = __builtin_amdgcn_exp2f(-d); S.m += d; S.l *= alpha;
#pragma unroll
            for (int i = 0; i < 16; ++i) { S.o[0][i] *= alpha; S.o[1][i] *= alpha; a0[i] -= d; a1[i] -= d; } } }
    flash_kload(kb2, r, h, kf);
    { const float init = B.en ? -S.m : -INFINITY;
#pragma unroll
        for (int i = 0; i < 16; ++i) { b0[i] = init; b1[i] = init; } }
    __builtin_amdgcn_sched_barrier(0);
#pragma unroll
    for (int k = 0; k < 8; ++k) {
        if (k & 1) b1 = MFMA32(kf[k], qf[k >> 1], b1); else b0 = MFMA32(kf[k], qf[k >> 1], b0);
#pragma unroll
        for (int e = 0; e < 4; ++e) { const int idx = 4 * k + e;
            if (idx < 16) { float t = __builtin_amdgcn_exp2f(a0[idx]); asm volatile("" : "+v"(t)); a0[idx] = t; }
            else { float t = __builtin_amdgcn_exp2f(a1[idx - 16]); asm volatile("" : "+v"(t)); a1[idx - 16] = t; } }
        __builtin_amdgcn_sched_barrier(0);
    }
    bf16x8 pa[4]; float ls = 0.f;
#pragma unroll
    for (int i = 0; i < 16; ++i) ls += a0[i] + a1[i];
    pa[0] = pack_p(a0, 0); pa[1] = pack_p(a0, 1); pa[2] = pack_p(a1, 0); pa[3] = pack_p(a1, 1);
    S.l += ls;
    __builtin_amdgcn_sched_barrier(0);
    if (B.masked) flash_mask(b0, b1, B.lo, B.hi, h);
    float alphaB = 1.f;
    { const float mx = flash_rowmax(b0, b1);
        if (__ballot(mx > SM_THR) != 0ull) { const float d = (mx > NEG_BIG) ? fmaxf(mx, 0.f) : 0.f; alphaB = __builtin_amdgcn_exp2f(-d); S.m += d; S.l *= alphaB;
#pragma unroll
            for (int i = 0; i < 16; ++i) { b0[i] -= d; b1[i] -= d; } } }
    { bf16x8 vf[8]; flash_vload(va, r, h, vf);
#pragma unroll
        for (int k = 0; k < 8; ++k) {
            S.o[k & 1] = MFMA32(vf[k], pa[k >> 1], S.o[k & 1]);
#pragma unroll
            for (int e = 0; e < 4; ++e) { const int idx = 4 * k + e;
                if (idx < 16) { float t = __builtin_amdgcn_exp2f(b0[idx]); asm volatile("" : "+v"(t)); b0[idx] = t; }
                else { float t = __builtin_amdgcn_exp2f(b1[idx - 16]); asm volatile("" : "+v"(t)); b1[idx - 16] = t; } }
            __builtin_amdgcn_sched_barrier(0);
        }
    }
    __builtin_amdgcn_sched_barrier(0);
    if (__ballot(alphaB != 1.f) != 0ull) {
#pragma unroll
        for (int i = 0; i < 16; ++i) { S.o[0][i] *= alphaB; S.o[1][i] *= alphaB; } }
    { bf16x8 vf[8]; flash_vload(vb2, r, h, vf);
        bf16x8 pb[4]; pb[0] = pack_p(b0, 0); pb[1] = pack_p(b0, 1); pb[2] = pack_p(b1, 0); pb[3] = pack_p(b1, 1);
        float l0 = 0.f, l1 = 0.f;
        __builtin_amdgcn_sched_barrier(0);
#pragma unroll
        for (int k = 0; k < 8; ++k) {
            S.o[k & 1] = MFMA32(vf[k], pb[k >> 1], S.o[k & 1]);
#pragma unroll
            for (int e = 0; e < 2; ++e) { const int idx = 2 * k + e; l0 += b0[idx]; l1 += b1[idx]; }
            asm volatile("" : "+v"(l0), "+v"(l1));
            __builtin_amdgcn_sched_barrier(0);
        }
        S.l += l0 + l1; }
}

__device__ __forceinline__ void nsa_prompt_unit(Frame& F, int l, int b, int kvh, int c) {
    int tid = threadIdx.x; asm volatile("" : "+v"(tid));
    const int lane = tid & 63, w = F.wave, r = lane & 31, h = lane >> 5, qi = r >> 2, g = r & 3, qloc = 8 * w + qi;
    const int tok = b * SEQ + 64 * c + qloc, head = kvh * 4 + g;
    const bf16_t* P = (const bf16_t*)(F.ws + WS_P);
    LAS unsigned char* kbuf = F.lds + AL_K; LAS unsigned char* vbuf = F.lds + AL_V;
    LAS float* imp = (LAS float*)(F.lds + AL_IMP); LAS unsigned* msk = (LAS unsigned*)(F.lds + AL_MASK); LAS unsigned* uni = (LAS unsigned*)(F.lds + AL_UNION);
    bf16x8 qf[4];
#pragma unroll
    for (int ks = 0; ks < 4; ++ks) qf[ks] = *(const bf16x8*)(P + (size_t)tok * NPROJ + C_Q + head * 64 + 16 * ks + 8 * h);
    const float* gt = (const float*)(F.ws + WS_GATE) + (size_t)tok * 64 + head * 3;
    const float g_cmp = gt[0], g_sel = gt[1], g_win = gt[2];
    LAS f32x4* ltot = (LAS f32x4*)(F.lds + AL_TOT) + tid;
    FlashState S;
    {
        __syncthreads();
        tile_dma((const bf16_t*)(F.ws + WS_KCP) + (size_t)(b * 4 + kvh) * 4096, (const bf16_t*)(F.ws + WS_VCTP) + (size_t)(b * 4 + kvh) * 4096, F.lds, w, lane);
        if (tid < 128) msk[tid] = 0u; if (tid < 2) uni[tid] = 0u;
        __syncthreads();
        flash_reset(S);
        f32x16 s0, s1; flash_scores(kbuf, qf, r, h, 0.f, s0, s1);
        const int nvalid = c + (qloc == 63 ? 1 : 0);
        bf16x8 vf[8]; flash_vload(vbuf, r, h, vf);
        flash_first(S, s0, s1, 0, nvalid - 1, h, true);
        const float lt = S.l + __shfl_xor(S.l, 32), inv = lt > 0.f ? 1.f / lt : 0.f;
#pragma unroll
        for (int i = 0; i < 16; ++i) { s0[i] *= inv; s1[i] *= inv; }
#pragma unroll
        for (int i = 0; i < 16; ++i) { float a = s0[i]; a += __shfl_xor(a, 1); a += __shfl_xor(a, 2); float bq = s1[i]; bq += __shfl_xor(bq, 1); bq += __shfl_xor(bq, 2);
            if (g == 0) { const int key = (i & 3) + 8 * (i >> 2) + 4 * h; imp[qloc * 65 + key] = a; imp[qloc * 65 + key + 32] = bq; } }
        flash_pv(vf, s0, s1, S.o);
    }
    __syncthreads();
    {
        const int n = lane; const bool cand = (n >= 1) && (n <= c - 2);
        const unsigned long long forced = 1ull | (1ull << c) | (c >= 1 ? (1ull << (c - 1)) : 0ull);
        unsigned long long um = 0ull;
#pragma unroll 1
        for (int qq = 0; qq < 8; ++qq) { const int q = w * 8 + qq;
            const unsigned kb_ = cand ? __float_as_uint(imp[q * 65 + n]) : 0u;
            int rank = 0;
            for (int j = 1; j <= c - 2; ++j) { const unsigned sj = __builtin_amdgcn_readlane(kb_, j); rank += (sj > kb_ || (sj == kb_ && j < n)) ? 1 : 0; }
            const unsigned long long m = __ballot(cand && rank < 13) | forced;
            if (lane == 0) { msk[q * 2] = (unsigned)m; msk[q * 2 + 1] = (unsigned)(m >> 32); }
            um |= m; }
        if (lane == 0) { atomicOr((unsigned*)uni, (unsigned)um); atomicOr((unsigned*)(uni + 1), (unsigned)(um >> 32)); }
    }
    __syncthreads();
    const unsigned mlo = msk[qloc * 2], mhi = msk[qloc * 2 + 1], ulo = uni[0], uhi = uni[1];
#pragma unroll
    for (int i4 = 0; i4 < 8; ++i4) { const f32x16& o = S.o[i4 >> 2]; const int i = 4 * (i4 & 3); ltot[i4 * 512] = (f32x4){g_cmp * o[i], g_cmp * o[i + 1], g_cmp * o[i + 2], g_cmp * o[i + 3]}; }
#define NSA_POP(REM_) ((REM_) ? (t_ = sel ? __builtin_ctzll(REM_) : 63 - __builtin_clzll(REM_), (REM_) &= ~(1ull << t_), t_) : -1)
#define NSA_EN(N_) (sel ? ((((N_) < 32 ? mlo >> (N_) : mhi >> ((N_) - 32)) & 1u) != 0u) : true)
#define NSA_LOHI(N_) const int n_ = (N_), lo_ = (!sel && n_ == c - 8) ? qloc + 1 : 0, hi_ = (n_ == c) ? qloc : 63; const bool mk_ = (n_ == c) || (!sel && n_ == c - 8)
#define NSA_PV(SLOT_, S0_, S1_) do { bf16x8 vf[8]; flash_vload(vbuf + (SLOT_), r, h, vf); flash_pv(vf, S0_, S1_, S.o); } while (0)
#pragma unroll 1
    for (int pass = 0; pass < 2; ++pass) {
        const bool sel = pass == 0;
        flash_reset(S);
        const bf16_t* kb = (const bf16_t*)(F.ws + (sel ? WS_KTSEL : WS_KTWIN)) + (size_t)(b * 4 + kvh) * 64 * 4096;
        const bf16_t* vt = (const bf16_t*)(F.ws + (sel ? WS_VTSEL : WS_VTWIN)) + (size_t)(b * 4 + kvh) * 64 * 4096;
        unsigned long long rem;
        if (sel) rem = ((unsigned long long)uhi << 32) | ulo;
        else { const int lo = c >= 8 ? c - 8 : 0; rem = (c == 63 ? ~0ull : ((1ull << (c + 1)) - 1ull)) & ~((1ull << lo) - 1ull); }
        int t_;
        int tA = NSA_POP(rem), tB = NSA_POP(rem);
        int pr = 0; bool first = true;
        __syncthreads();
        tile_dma(kb + (size_t)tA * 4096, vt + (size_t)tA * 4096, F.lds, w, lane);
        if (tB >= 0) tile_dma(kb + (size_t)tB * 4096, vt + (size_t)tB * 4096, F.lds + AL_SLOT, w, lane);
        for (;;) {
            const int sa = pr, sb = pr + AL_SLOT;
            __syncthreads();
            const int nA = NSA_POP(rem), nB = NSA_POP(rem);
            if (nA >= 0) tile_dma(kb + (size_t)nA * 4096, vt + (size_t)nA * 4096, F.lds + (pr ^ (2 * AL_SLOT)), w, lane);
            if (nB >= 0) tile_dma(kb + (size_t)nB * 4096, vt + (size_t)nB * 4096, F.lds + (pr ^ (2 * AL_SLOT)) + AL_SLOT, w, lane);
            const bool enA = first || NSA_EN(tA), enB = tB >= 0 ? NSA_EN(tB) : false;
            if (__ballot(enA || enB) != 0ull) {
                TileCtl A, B;
                A.en = enA; A.masked = (tA == c) || (!sel && tA == c - 8); A.lo = (!sel && tA == c - 8) ? qloc + 1 : 0; A.hi = (tA == c) ? qloc : 63;
                B.en = enB; B.masked = (tB == c) || (!sel && tB == c - 8); B.lo = (!sel && tB == c - 8) ? qloc + 1 : 0; B.hi = (tB == c) ? qloc : 63;
                const int sbb = tB >= 0 ? sb : sa;
                flash_pair(S, kbuf + sa, vbuf + sa, kbuf + sbb, vbuf + sbb, qf, A, B, first, r, h);
            }
            first = false;
            if (nA < 0) break;
            tA = nA; tB = nB; pr ^= 2 * AL_SLOT;
        }
        const float lt = S.l + __shfl_xor(S.l, 32), sc = (sel ? g_sel : g_win) / lt;
#pragma unroll
        for (int i4 = 0; i4 < 8; ++i4) { const f32x16& o = S.o[i4 >> 2]; const int i = 4 * (i4 & 3); ltot[i4 * 512] += (f32x4){sc * o[i], sc * o[i + 1], sc * o[i + 2], sc * o[i + 3]}; }
    }
#undef NSA_PV
#undef NSA_LOHI
#undef NSA_EN
#undef NSA_POP
    bf16_t* ao = (bf16_t*)(F.ws + WS_ABR + SZ_ABR1) + (size_t)tok * 1024 + head * 64;
    const bf16_t* az = P + (size_t)tok * NPROJ + C_AZ + head * 64;
#pragma unroll
    for (int i4 = 0; i4 < 8; ++i4) { const int d = 32 * (i4 >> 2) + 8 * (i4 & 3) + 4 * h;
        const f32x4 t = ltot[i4 * 512]; const f32x4 zz = unpack4(*(const u32x2*)(az + d));
        *(u32x2*)(ao + d) = pack4(t * zz); }
}

constexpr int SL_Q = 0  , SL_SC = 1024  , SL_IMP = SL_SC + 4 * 1040 * 4  , SL_RED = SL_IMP + 264 * 4  ,
              SL_LIST = SL_RED + 128  , SL_KOFF = SL_LIST + 64  , SL_PART = SL_KOFF + 1040 * 4  , SL_OACC = SL_PART + 32768  ;
constexpr int KOFF_INVALID = -2147483647;

__device__ __forceinline__ void block_softmax4(LAS float* sc, int count, LAS float* red, int tid) {
    const int gh = tid >> 7, t = tid & 127, wv = tid >> 6;
    LAS float* row = sc + gh * 1040;
    float mx = -INFINITY;
    for (int i = t; i < count; i += 128) mx = fmaxf(mx, row[i]);
    mx = wave_max(mx);
    if ((tid & 63) == 0) red[wv] = mx;
    __syncthreads();
    mx = fmaxf(red[2 * gh], red[2 * gh + 1]);
    float sm = 0.f;
    for (int i = t; i < count; i += 128) { const float p = __expf(row[i] - mx); row[i] = p; sm += p; }
    sm = wave_sum(sm);
    if ((tid & 63) == 0) red[8 + wv] = sm;
    __syncthreads();
    const float inv = 1.f / (red[8 + 2 * gh] + red[8 + 2 * gh + 1]);
    for (int i = t; i < count; i += 128) row[i] *= inv;
    __syncthreads();
}
__device__ __forceinline__ void sample_scores(const float* base, const bf16_t* Pnew, int pcol, int count, const LAS int* koff, const LAS float* qv, LAS float* sc, int tid) {
#pragma unroll 1
    for (int idx = tid; idx < count; idx += NT) {
        const int ko = koff[idx];
        float d0 = -INFINITY, d1 = -INFINITY, d2 = -INFINITY, d3 = -INFINITY;
        if (ko != KOFF_INVALID) {
            f32x4 kx[16];
            if (ko >= 0) {
#pragma unroll
                for (int j = 0; j < 16; ++j) kx[j] = *(const f32x4*)(base + (size_t)ko + 4 * j); }
            else {
#pragma unroll
                for (int j = 0; j < 16; ++j) kx[j] = unpack4(*(const u32x2*)(Pnew + (size_t)(-1 - ko) * NPROJ + pcol + 4 * j)); }
            d0 = d1 = d2 = d3 = 0.f;
#pragma unroll
            for (int j4 = 0; j4 < 4; ++j4) {
#pragma unroll
                for (int jj = 0; jj < 4; ++jj) { const int j = 4 * j4 + jj; const f32x4 kq = kx[j];
                    const f32x4 q0 = *(const LAS f32x4*)(qv + 4 * j), q1 = *(const LAS f32x4*)(qv + 64 + 4 * j), q2 = *(const LAS f32x4*)(qv + 128 + 4 * j), q3 = *(const LAS f32x4*)(qv + 192 + 4 * j);
                    d0 += kq.x * q0.x + kq.y * q0.y + kq.z * q0.z + kq.w * q0.w; d1 += kq.x * q1.x + kq.y * q1.y + kq.z * q1.z + kq.w * q1.w;
                    d2 += kq.x * q2.x + kq.y * q2.y + kq.z * q2.z + kq.w * q2.w; d3 += kq.x * q3.x + kq.y * q3.y + kq.z * q3.z + kq.w * q3.w; }
                __builtin_amdgcn_sched_barrier(0);
            }
            d0 *= 0.125f; d1 *= 0.125f; d2 *= 0.125f; d3 *= 0.125f;
        }
        sc[idx] = d0; sc[1040 + idx] = d1; sc[2080 + idx] = d2; sc[3120 + idx] = d3;
    }
}
__device__ __forceinline__ void sample_pv(const float* base, const bf16_t* Pnew, int pcol, int count, const LAS int* koff, const LAS float* sc, LAS float* part, LAS float* oacc, int tid) {
    const int dq = tid & 15, ks = tid >> 4, per = (count + 31) >> 5, i0 = ks * per, i1 = (i0 + per < count) ? i0 + per : count;
    f32x4 a0 = {0.f, 0.f, 0.f, 0.f}, a1 = a0, a2 = a0, a3 = a0;
#pragma unroll 8
    for (int idx = i0; idx < i1; ++idx) { const int ko = koff[idx];
        f32x4 v = {0.f, 0.f, 0.f, 0.f};
        if (ko >= 0) v = *(const f32x4*)(base + (size_t)ko + 256 + 4 * dq);
        else if (ko != KOFF_INVALID) { const u32x2 x = *(const u32x2*)(Pnew + (size_t)(-1 - ko) * NPROJ + pcol + 256 + 4 * dq); v = (f32x4){bf2f(x.x & 0xffffu), __uint_as_float(x.x & 0xffff0000u), bf2f(x.y & 0xffffu), __uint_as_float(x.y & 0xffff0000u)}; }
        a0 += sc[idx] * v; a1 += sc[1040 + idx] * v; a2 += sc[2080 + idx] * v; a3 += sc[3120 + idx] * v; }
    *(LAS f32x4*)(part + ks * 256 + 4 * dq) = a0; *(LAS f32x4*)(part + ks * 256 + 64 + 4 * dq) = a1; *(LAS f32x4*)(part + ks * 256 + 128 + 4 * dq) = a2; *(LAS f32x4*)(part + ks * 256 + 192 + 4 * dq) = a3;
    __syncthreads();
    if (tid < 256) { float t = 0.f;
#pragma unroll 8
        for (int k = 0; k < 32; ++k) t += part[k * 256 + tid];
        oacc[tid] = t; }
    __syncthreads();
}

__device__ __forceinline__ void nsa_sample_unit(Frame& F, int l, int unit, int part_id) {
    const int tid = F.tid, qi = unit & 3, kvh = (unit >> 2) & 3, b = unit >> 4, row = MPT + b * 4 + qi;
    const bf16_t* P = (const bf16_t*)(F.ws + WS_P); const int* pt = (const int*)FIN(IN_PT);
    LAS float* qv = (LAS float*)(F.lds + SL_Q); LAS float* sc = (LAS float*)(F.lds + SL_SC); LAS float* imp = (LAS float*)(F.lds + SL_IMP); LAS float* red = (LAS float*)(F.lds + SL_RED);
    LAS int* list = (LAS int*)(F.lds + SL_LIST); LAS int* koff = (LAS int*)(F.lds + SL_KOFF); LAS float* part = (LAS float*)(F.lds + SL_PART); LAS float* oacc = (LAS float*)(F.lds + SL_OACC);
    __syncthreads();
    if (tid < 256) qv[tid] = bf2f(P[(size_t)row * NPROJ + C_Q + kvh * 256 + tid]) * (1.f / SM_SCALE_L2E);
    __syncthreads();
    float* soacc = (float*)(F.ws + WS_SOACC) + (size_t)unit * 768;
    if (part_id == 0) {
    {
        const int n = tid & 255, gp = tid >> 8;
        const bf16_t* kr = (const bf16_t*)(F.ws + WS_KCS) + ((size_t)(b * 4 + kvh) * 256 + n) * 64;
        float d0 = 0.f, d1 = 0.f;
#pragma unroll
        for (int j = 0; j < 8; ++j) { const u32x4 x = *(const u32x4*)(kr + 8 * j); float kf[8]; unpack8(x, kf);
#pragma unroll
            for (int e = 0; e < 8; ++e) { d0 += kf[e] * qv[(2 * gp) * 64 + 8 * j + e]; d1 += kf[e] * qv[(2 * gp + 1) * 64 + 8 * j + e]; } }
        sc[(2 * gp) * 1040 + n] = d0 * 0.125f; sc[(2 * gp + 1) * 1040 + n] = d1 * 0.125f;
    }
    __syncthreads();
    block_softmax4(sc, 256, red, tid);
    if (tid < 257) { float v; if (tid == 0 || tid >= 255) v = 1e4f; else v = sc[tid] + sc[1040 + tid] + sc[2080 + tid] + sc[3120 + tid]; imp[tid] = v; }
    {
        const int half = tid >> 8, gd = tid & 255, gh = gd >> 6, d = gd & 63;
        const bf16_t* vt = (const bf16_t*)(F.ws + WS_VCTS) + (size_t)(b * 4 + kvh) * 4 * 4096;
        float a = 0.f;
        for (int tl = 2 * half; tl < 2 * half + 2; ++tl) {
            const bf16_t* vr = vt + (size_t)tl * 4096 + d * 64;
#pragma unroll
            for (int j = 0; j < 8; ++j) { const u32x4 x = *(const u32x4*)(vr + 8 * j); float vf[8]; unpack8(x, vf);
#pragma unroll
                for (int e = 0; e < 8; ++e) a += sc[gh * 1040 + tl * 64 + keypos(8 * j + e)] * vf[e]; } }
        part[half * 256 + gd] = a;
    }
    __syncthreads();
    if (tid < 256) oacc[tid] = part[tid] + part[256 + tid];
    if (tid < 257) { const float si = imp[tid]; int rk = 0;
        for (int j = 0; j < 257; ++j) { const float sj = imp[j]; rk += (sj > si || (sj == si && j < tid)) ? 1 : 0; }
        if (rk < 16) list[rk] = tid; }
    __syncthreads();
    for (int idx = tid; idx < 1024; idx += NT) { const int blk = list[idx >> 6], kk = idx & 63; int ko;
        if (blk < 256) { const int page = pt[b * 128 + (blk >> 1)]; ko = (int)(((((size_t)l * NPOOL + page) * 128 + (blk & 1) * 64 + kk) * 4 + 2) * 256 + kvh * 64); }
        else ko = (kk <= qi) ? -1 - (MPT + b * 4 + kk) : KOFF_INVALID;
        koff[idx] = ko; }
    __syncthreads();
    sample_scores(FIN(IN_CACHE), P, C_SK + kvh * 64, 1024, koff, qv, sc, tid);
    __syncthreads();
    block_softmax4(sc, 1024, red, tid);
    sample_pv(FIN(IN_CACHE), P, C_SK + kvh * 64, 1024, koff, sc, part, oacc + 256, tid);
    soacc[tid] = oacc[tid];
    } else {
    for (int idx = tid; idx < 516; idx += NT) { int ko;
        if (idx < 512) ko = (idx > qi) ? (int)((((size_t)(l * SB + b) * 512 + idx) * 2) * 256 + kvh * 64) : KOFF_INVALID;
        else ko = (idx - 512 <= qi) ? -1 - (MPT + b * 4 + idx - 512) : KOFF_INVALID;
        koff[idx] = ko; }
    __syncthreads();
    sample_scores(FIN(IN_SWIN), P, C_WK + kvh * 64, 516, koff, qv, sc, tid);
    __syncthreads();
    block_softmax4(sc, 516, red, tid);
    sample_pv(FIN(IN_SWIN), P, C_WK + kvh * 64, 516, koff, sc, part, oacc + 512, tid);
    if (tid < 256) soacc[512 + tid] = oacc[512 + tid];
    }
    __syncthreads();
}
__device__ __forceinline__ void sample_combine(Frame& F) {
    const bf16_t* P = (const bf16_t*)(F.ws + WS_P); const float* so = (const float*)(F.ws + WS_SOACC);
    for (int it = F.gw * 64 + F.lane; it < 128 * 256; it += F.ngw * 64) {
        const int unit = it >> 8, t = it & 255, qi = unit & 3, kvh = (unit >> 2) & 3, b = unit >> 4, row = MPT + b * 4 + qi, head = kvh * 4 + (t >> 6), d = t & 63;
        const float* gt = (const float*)(F.ws + WS_GATE) + (size_t)row * 64 + head * 3;
        const float o = gt[0] * so[(size_t)unit * 768 + t] + gt[1] * so[(size_t)unit * 768 + 256 + t] + gt[2] * so[(size_t)unit * 768 + 512 + t];
        ((bf16_t*)(F.ws + WS_ABR + SZ_ABR1))[(size_t)row * 1024 + head * 64 + d] = (bf16_t)f2bf(o * bf2f(P[(size_t)row * NPROJ + C_AZ + head * 64 + d])); }
}

struct SsmPow { float r[4], i[4]; };
__device__ __forceinline__ void ssm_pows(float ar, float ai, SsmPow& p) {
    p.r[0] = ar; p.i[0] = ai;
    p.r[1] = ar * ar - ai * ai; p.i[1] = 2.f * ar * ai;
    p.r[2] = p.r[1] * ar - p.i[1] * ai; p.i[2] = p.r[1] * ai + p.i[1] * ar;
    p.r[3] = p.r[1] * p.r[1] - p.i[1] * p.i[1]; p.i[3] = 2.f * p.r[1] * p.i[1];
}
struct SsmUnit { SsmPow pw[2]; bf16x8 bfr[4]; float alr[2], ali[2]; };
__device__ __forceinline__ void ssm_unit_load(const Frame& F, int l, int g, int lane, SsmUnit& U) {
    const int n32 = lane & 31, h = lane >> 5;
    const float* sab = (const float*)(F.ws + WS_SAB + l * al1m(SZ_SAB)) + (size_t)g * 64 * 4;
    const bf16_t* bb16 = (const bf16_t*)(F.ws + WS_SBB16 + l * al1m(SZ_SBB16)) + (size_t)g * 2 * 64 * 16;
#pragma unroll
    for (int s = 0; s < 2; ++s) { const f32x4 ab = *(const f32x4*)(sab + (n32 + 32 * s) * 4); ssm_pows(ab.x, ab.y, U.pw[s]); U.alr[s] = ab.z; U.ali[s] = ab.w;
        U.bfr[2 * s] = *(const bf16x8*)(bb16 + (size_t)(n32 + 32 * s) * 16 + 8 * h); U.bfr[2 * s + 1] = *(const bf16x8*)(bb16 + (size_t)(64 + n32 + 32 * s) * 16 + 8 * h); }
}
template <bool FIX>
__device__ __forceinline__ void ssm_block32(const bf16x8& au, const SsmUnit& U, float (&Hr)[2], float (&Hi)[2], float (&H1r)[2], float (&H1i)[2], f32x16 (&Dr)[2], f32x16 (&Di)[2], int h) {
    f32x16 z;
#pragma unroll
    for (int i = 0; i < 16; ++i) z[i] = 0.f;
#pragma unroll
    for (int s = 0; s < 2; ++s) { Dr[s] = MFMA32(au, U.bfr[2 * s], z); Di[s] = MFMA32(au, U.bfr[2 * s + 1], z); }
#pragma unroll
    for (int s = 0; s < 2; ++s) {
        const float ar = U.pw[s].r[0], ai = U.pw[s].i[0], a4r = U.pw[s].r[3], a4i = U.pw[s].i[3];
#pragma unroll
        for (int j = 0; j < 4; ++j)
#pragma unroll
            for (int e = 1; e < 4; ++e) { const int i = 4 * j + e;
                const float nr = ar * Dr[s][i - 1] - ai * Di[s][i - 1] + Dr[s][i], ni = ar * Di[s][i - 1] + ai * Dr[s][i - 1] + Di[s][i]; Dr[s][i] = nr; Di[s][i] = ni; }
        float hr = Hr[s], hi = Hi[s];
#pragma unroll
        for (int j = 0; j < 4; ++j) {
            const float ownr = Dr[s][4 * j + 3], owni = Di[s][4 * j + 3], othr = __shfl_xor(ownr, 32), othi = __shfl_xor(owni, 32);
            const float evr = h ? othr : ownr, evi = h ? othi : owni, odr = h ? ownr : othr, odi = h ? owni : othi;
            const float inr0 = hr, ini0 = hi;
            float t = a4r * hr - a4i * hi + evr; hi = a4r * hi + a4i * hr + evi; hr = t;
            if (j == 0) { H1r[s] = hr; H1i[s] = hi; }
            const float inr1 = hr, ini1 = hi;
            t = a4r * hr - a4i * hi + odr; hi = a4r * hi + a4i * hr + odi; hr = t;
            if (FIX) { const float inr = h ? inr1 : inr0, ini = h ? ini1 : ini0;
#pragma unroll
                for (int e = 0; e < 4; ++e) { const int i = 4 * j + e; Dr[s][i] += U.pw[s].r[e] * inr - U.pw[s].i[e] * ini; Di[s][i] += U.pw[s].r[e] * ini + U.pw[s].i[e] * inr; } }
        }
        Hr[s] = hr; Hi[s] = hi;
    }
}
__device__ __forceinline__ bf16x8 ssm_load_au(const bf16_t* P, int m0, int ntok, int g, int lane) {
    const int t = lane & 31, h = lane >> 5;
    if (t < ntok) return *(const bf16x8*)(P + (size_t)(m0 + t) * NPROJ + C_SU + g * 16 + 8 * h);
    return (bf16x8){0, 0, 0, 0, 0, 0, 0, 0};
}
__device__ __forceinline__ void s2_ssm_pass1(Frame& F, int l) {
    const bf16_t* P = (const bf16_t*)(F.ws + WS_P); f32x2* E = (f32x2*)(F.ws + WS_SSME);
    const int lane = F.lane, n32 = lane & 31, h = lane >> 5;
    for (int u = F.gw; u < PB * 64 * SSM_NCH; u += F.ngw) {
        const int b = u >> 11, g = (u >> 5) & 63, ch = u & 31, m0 = b * SEQ + ch * SSM_L;
        SsmUnit U; ssm_unit_load(F, l, g, lane, U);
        float Hr[2] = {0.f, 0.f}, Hi[2] = {0.f, 0.f}, H1r[2], H1i[2];
        bf16x8 au = ssm_load_au(P, m0, 32, g, lane);
#pragma unroll 1
        for (int blk = 0; blk < SSM_L / 32; ++blk) {
            const bf16x8 an = ssm_load_au(P, m0 + 32 * ((blk + 1) & 3), 32, g, lane);
            f32x16 Dr[2], Di[2];
            ssm_block32<false>(au, U, Hr, Hi, H1r, H1i, Dr, Di, h);
            au = an;
        }
        if (h == 0) { f32x2* e = E + ((size_t)(b * 64 + g) * SSM_NCH + ch) * 64; e[n32] = (f32x2){Hr[0], Hi[0]}; e[32 + n32] = (f32x2){Hr[1], Hi[1]}; }
    }
}
__device__ __forceinline__ void s3_ssm_pass2(Frame& F, int l) {
    const bf16_t* P = (const bf16_t*)(F.ws + WS_P); const f32x2* E = (const f32x2*)(F.ws + WS_SSME); bf16_t* Z = (bf16_t*)(F.ws + WS_Z);
    LAS unsigned char* himg = F.lds + 65536 + F.wave * 8960;
    const int lane = F.lane, n32 = lane & 31, h = lane >> 5, tk = lane & 15, cq = lane >> 4;
    for (int u = F.gw; u < PB * 64 * SSM_NCH + SB * 64; u += F.ngw) {
        const bool smp = u >= PB * 64 * SSM_NCH;
        int b, g, ch, m0, nblk, ntok;
        if (!smp) { b = u >> 11; g = (u >> 5) & 63; ch = u & 31; m0 = b * SEQ + ch * SSM_L; nblk = SSM_L / 32; ntok = 32; }
        else { const int su = u - PB * 64 * SSM_NCH; b = su >> 6; g = su & 63; ch = 0; m0 = MPT + b * 4; nblk = 1; ntok = 4; }
        SsmUnit U; ssm_unit_load(F, l, g, lane, U);
        bf16x8 cmf[4];
        { const bf16_t* cm = (const bf16_t*)(F.ws + WS_SCM + l * al1m(SZ_SCM)) + (size_t)(g * 16 + tk) * 128 + 8 * cq;
#pragma unroll
            for (int ks = 0; ks < 4; ++ks) cmf[ks] = *(const bf16x8*)(cm + 32 * ks); }
        const f32x4 ds = *(const f32x4*)(FIN(IN_DSKIP) + l * 1024 + g * 16 + 4 * cq);
        float Hr[2] = {0.f, 0.f}, Hi[2] = {0.f, 0.f}, H1r[2] = {0.f, 0.f}, H1i[2] = {0.f, 0.f};
        if (!smp) { const f32x2* e = E + (size_t)(b * 64 + g) * SSM_NCH * 64;
            for (int j0 = 0; j0 < ch; j0 += 8) {
                f32x2 ev[8][2];
#pragma unroll
                for (int jj = 0; jj < 8; ++jj)
#pragma unroll
                    for (int s = 0; s < 2; ++s) ev[jj][s] = (j0 + jj < ch) ? e[(size_t)(j0 + jj) * 64 + n32 + 32 * s] : (f32x2){0.f, 0.f};
#pragma unroll
                for (int jj = 0; jj < 8; ++jj) if (j0 + jj < ch) {
#pragma unroll
                    for (int s = 0; s < 2; ++s) { const float nr = U.alr[s] * Hr[s] - U.ali[s] * Hi[s] + ev[jj][s].x, ni = U.alr[s] * Hi[s] + U.ali[s] * Hr[s] + ev[jj][s].y; Hr[s] = nr; Hi[s] = ni; } } } }
        else { const float* h0 = FIN(IN_SSSM) + ((size_t)(l * SB + b) * 2 * 64 + g) * 64 + n32;
#pragma unroll
            for (int s = 0; s < 2; ++s) { Hr[s] = h0[32 * s]; Hi[s] = h0[64 * 64 + 32 * s]; } }
        bf16x8 au = ssm_load_au(P, m0, ntok, g, lane);
#pragma unroll 1
        for (int blk = 0; blk < nblk; ++blk) {
            const bf16x8 an = ssm_load_au(P, m0 + 32 * ((blk + 1) & 3), ntok, g, lane);
            u32x2 uw[2];
#pragma unroll
            for (int tt = 0; tt < 2; ++tt) uw[tt] = (16 * tt + tk < ntok) ? *(const u32x2*)(P + (size_t)(m0 + 32 * blk + 16 * tt + tk) * NPROJ + C_SU + g * 16 + 4 * cq) : (u32x2){0u, 0u};
            f32x16 Dr[2], Di[2];
            ssm_block32<true>(au, U, Hr, Hi, H1r, H1i, Dr, Di, h);
            au = an;
#pragma unroll
            for (int i = 0; i < 16; ++i) { const int tl = (i & 3) + 8 * (i >> 2) + 4 * h;
                *(LAS unsigned*)(himg + tl * 272 + 4 * n32) = pk2(Dr[0][i], Di[0][i]); *(LAS unsigned*)(himg + tl * 272 + 4 * (32 + n32)) = pk2(Dr[1][i], Di[1][i]); }
            LDS_WAIT(); asm volatile("" ::: "memory");
#pragma unroll
            for (int tt = 0; tt < 2; ++tt) {
                f32x4 y = {0.f, 0.f, 0.f, 0.f};
#pragma unroll
                for (int ks = 0; ks < 4; ++ks) { const bf16x8 hf = *(const LAS bf16x8*)(himg + (16 * tt + tk) * 272 + (32 * ks + 8 * cq) * 2); y = __builtin_amdgcn_mfma_f32_16x16x32_bf16(cmf[ks], hf, y, 0, 0, 0); }
                const int t = 32 * blk + 16 * tt + tk;
                if (16 * tt + tk < ntok) { const f32x4 uu = unpack4(uw[tt]);
                    u32x2 o; o.x = pk2(gelu_tanh(y.x + ds.x * uu.x), gelu_tanh(y.y + ds.y * uu.y)); o.y = pk2(gelu_tanh(y.z + ds.z * uu.z), gelu_tanh(y.w + ds.w * uu.w));
                    *(u32x2*)(Z + (size_t)(m0 + t) * 1024 + g * 16 + 4 * cq) = o; }
            }
            LDS_WAIT(); asm volatile("" ::: "memory");
        }
        if (h == 0) {
            if (smp) { float* o = F.out + O_SSMS + ((size_t)(l * SB + b) * 2 * 64 + g) * 64 + n32;
#pragma unroll
                for (int s = 0; s < 2; ++s) { o[32 * s] = H1r[s]; o[64 * 64 + 32 * s] = H1i[s]; } }
            else if (ch == SSM_NCH - 1) { float* o = F.out + O_SSMP + ((size_t)(l * PB + b) * 2 * 64 + g) * 64 + n32;
#pragma unroll
                for (int s = 0; s < 2; ++s) { o[32 * s] = Hr[s]; o[64 * 64 + 32 * s] = Hi[s]; } }
        }
    }
}
struct Args { const float* in[27]; float* out; unsigned char* ws; int ph_lo, ph_hi; };
constexpr int N_PHASES = 15;

__global__ void __launch_bounds__(NT, 2) fwd_kernel(Args args) {
    extern __shared__ __attribute__((aligned(16))) unsigned char lds_raw[];
    Frame F;
    F.lds = (LAS unsigned char*)lds_raw;
    F.tid = threadIdx.x; F.lane = F.tid & 63; F.wave = __builtin_amdgcn_readfirstlane(F.tid >> 6);
    F.G = gridDim.x; F.bid = blockIdx.x; F.gw = F.bid * NWAVES + F.wave; F.ngw = F.G * NWAVES;
    F.out = args.out; F.ws = args.ws;
    volatile LAS unsigned* misc = (volatile LAS unsigned*)(F.lds + LDS_MISC);
    if (F.tid < 64) misc[F.tid] = 0u;
    __syncthreads();
    const int lo = args.ph_lo, hi = args.ph_hi;
#if MK_PER_PHASE
#define GRID_BAR() do { } while (0)
#else
    XcdBarrier bar = xcd_barrier_post((unsigned*)(F.ws + WS_CTL) + CW_BAR, misc + 8);
#define GRID_BAR() xcd_barrier(bar)
#endif
#ifdef ONLYPH
#define IN(k) ((((k)==0?0:(((k)-1)%7)+1))==ONLYPH && lo <= (k) && (k) < hi)
#else
#define IN(k) (lo <= (k) && (k) < hi)
#endif
#define BOTH(k) (IN(k) && IN((k) + 1))
#ifndef PROBE_PH
#define PROBE_PH -1
#endif
#define REPS(k) _Pragma("unroll 1") for (int rep_ = 0; rep_ < ((PROBE_PH) == (k) ? 2 : 1); ++rep_)
#define PHASE_BEGIN() do { int t_ = threadIdx.x; asm volatile("" : "+v"(t_)); F.tid = t_; F.lane = t_ & 63; F.wave = __builtin_amdgcn_readfirstlane(t_ >> 6); \
    F.gw = F.bid * NWAVES + F.wave; GAS unsigned char* w_ = (GAS unsigned char*)args.ws; asm volatile("" : "+s"(w_)); F.ws = (unsigned char*)w_; \
    GAS float* o_ = (GAS float*)args.out; asm volatile("" : "+s"(o_)); F.out = (float*)o_; } while (0)
    if (IN(0)) { PHASE_BEGIN(); REPS(0) phase_prologue(F); if (BOTH(0)) GRID_BAR(); }
    for (int l = 0; l < 2; ++l) {
        const int p0 = 1 + 7 * l;
        if (IN(p0)) {
            PHASE_BEGIN();
            pg8::Gemm g{(const bf16_t*)(F.ws + WS_H), (const bf16_t*)(F.ws + WS_WIN + l * al1m(SZ_WIN)), DM, DM, DM, 0, 0};
            pg8::TileOrder S; S.init(MPT / 256, NPROJ / 256, 1, 0, F.G, F.bid);
            EpiProj E{(bf16_t*)(F.ws + WS_P), (float*)(F.ws + WS_GATE), F.out, l};
            REPS(1) pg8::gemm_phase(F.lds, g, S, E);
            skinny_proj(F, l);
            if (BOTH(p0)) GRID_BAR();
        }
        if (IN(p0 + 1)) {
            PHASE_BEGIN();
            REPS(2) {
#ifndef SK_A
            REPS(21) s2_compress(F, l);
#endif
            __syncthreads();
#ifndef SK_B
            PHASE_BEGIN();
            REPS(22) s2_ssm_pass1(F, l);
#endif
#ifndef SK_C
            PHASE_BEGIN();
            REPS(23) s2_pool_diff(F, l);
#endif
#ifndef SK_D
            PHASE_BEGIN();
            REPS(24) s2_state_outputs(F, l);
#endif
#ifndef SK_E
            PHASE_BEGIN();
            REPS(25) s2_vt_images(F);
#endif
            }
            if (BOTH(p0 + 1)) GRID_BAR();
        }
        if (IN(p0 + 2)) {
            PHASE_BEGIN();
            REPS(3) {
#ifndef SK_F
            REPS(31) for (int p = F.bid; p < 256; p += F.G) { const int bk = p >> 5, j = p & 31;
#pragma unroll 1
                for (int k2 = 0; k2 < 2; ++k2) nsa_prompt_unit(F, l, bk >> 2, bk & 3, k2 ? j : 63 - j); }
#endif
#ifndef SK_G
            PHASE_BEGIN();
            REPS(32) for (int u = F.bid; u < 256; u += F.G) nsa_sample_unit(F, l, u >> 1, u & 1);
#endif
            __syncthreads();
#ifndef SK_H
            PHASE_BEGIN();
            REPS(33) s3_ssm_pass2(F, l);
#endif
            __syncthreads();
            }
            if (BOTH(p0 + 2)) GRID_BAR();
        }
        if (IN(p0 + 3)) {
            PHASE_BEGIN();
            sample_combine(F);
            REPS(4) {
            const int hg = F.G >> 1;
            if (F.bid < hg) {
                pg8::Gemm g{(const bf16_t*)(F.ws + WS_Z), (const bf16_t*)(F.ws + WS_WGLU + l * al1m(SZ_WGLU)), 1024, 1024, 1024, 0, 0};
                pg8::TileOrder S; S.init(MPT / 256, 4, 1, 0, hg, F.bid);
                EpiGlu E{(bf16_t*)(F.ws + WS_ABR + 2 * SZ_ABR1), (const bf16_t*)(F.ws + WS_P), (const bf16_t*)(F.ws + WS_Z)};
                pg8::gemm_phase(F.lds, g, S, E);
            } else {
                pg8::Gemm g{(const bf16_t*)(F.ws + WS_DIFF), (const bf16_t*)(F.ws + WS_WPOOL + l * al1m(SZ_WPOOL)), 1024, 256, 256, 256, 65536};
                pg8::TileOrder S; S.init(MPT / 256, 1, 4, 0, F.G - hg, F.bid - hg);
                EpiPool E{(bf16_t*)(F.ws + WS_ABR), (const bf16_t*)(F.ws + WS_P), FIN(IN_PSCALE) + l * 1024};
                pg8::gemm_phase(F.lds, g, S, E);
            }
            skinny_glu(F, l); skinny_pool(F, l);
            }
            if (BOTH(p0 + 3)) GRID_BAR();
        }
        if (IN(p0 + 4)) {
            PHASE_BEGIN();
            pg8::Gemm g{(const bf16_t*)(F.ws + WS_ABR), (const bf16_t*)(F.ws + WS_WBR + l * al1m(SZ_WBR)), 1024, 1024, 1024, (size_t)MPAD * 1024, (size_t)2048 * 1024};
            pg8::TileOrder S; S.init(MPT / 256, 8, 3, 1, F.G, F.bid);
            EpiBranch E{(bf16_t*)(F.ws + WS_MERGED), (const bf16_t*)(F.ws + WS_P)};
            REPS(5) { pg8::gemm_phase(F.lds, g, S, E); skinny_branch(F, l); }
            if (BOTH(p0 + 4)) GRID_BAR();
        }
        if (IN(p0 + 5)) {
            PHASE_BEGIN();
            pg8::Gemm g{(const bf16_t*)(F.ws + WS_MERGED), (const bf16_t*)(F.ws + WS_WOUT + l * al1m(SZ_WOUT)), DM, DM, DM, 0, 0};
            pg8::TileOrder S; S.init(MPT / 256, 8, 1, 0, F.G, F.bid);
            EpiOut E{(bf16_t*)(F.ws + WS_OUTB)};
            REPS(6) { pg8::gemm_phase(F.lds, g, S, E); skinny_out(F, l); }
            if (BOTH(p0 + 5)) GRID_BAR();
        }
        if (IN(p0 + 6)) {
            PHASE_BEGIN();
            REPS(7) phase_norm(F, l);
            if (BOTH(p0 + 6)) GRID_BAR();
        }
    }
#undef IN
#undef BOTH
}

extern "C" void kernel_launch(void* const* d_in, const int* in_sizes, int n_in, void* d_out, int out_size, void* d_ws, size_t ws_size, hipStream_t stream) {
    static int grid = 0;
    if (grid == 0) {
        if (n_in != 27 || out_size != (int)O_TOTAL || ws_size < WS_END) { fprintf(stderr, "kernel_launch: unexpected problem shape (n_in %d, out %d, ws %zu < %zu)\n", n_in, out_size, ws_size, (size_t)WS_END); grid = -1; return; }
        int dev = 0, cus = 0, per_cu = 0;
        if (hipGetDevice(&dev) != hipSuccess || hipDeviceGetAttribute(&cus, hipDeviceAttributeMultiprocessorCount, dev) != hipSuccess) { grid = -1; return; }
        if (hipFuncSetAttribute((const void*)fwd_kernel, hipFuncAttributeMaxDynamicSharedMemorySize, LDS_BYTES) != hipSuccess) { fprintf(stderr, "kernel_launch: hipFuncSetAttribute failed\n"); grid = -1; return; }
        if (hipOccupancyMaxActiveBlocksPerMultiprocessor(&per_cu, (const void*)fwd_kernel, NT, LDS_BYTES) != hipSuccess || per_cu < 1)
            fprintf(stderr, "kernel_launch: note: occupancy query reports %d workgroups per CU\n", per_cu);
        (void)hipGetLastError();
        grid = cus;
    }
    if (grid < 0) return;
    if (hipMemsetAsync((char*)d_ws + WS_CTL, 0, CTL_ZERO_BYTES, stream) != hipSuccess) return;
    Args a{};
    for (int i = 0; i < 27; ++i) a.in[i] = (const float*)d_in[i];
    a.out = (float*)d_out; a.ws = (unsigned char*)d_ws;
#if MK_PER_PHASE
    for (int k = 0; k < N_PHASES; ++k) { a.ph_lo = k; a.ph_hi = k + 1; hipLaunchKernelGGL(fwd_kernel, dim3(grid), dim3(NT), LDS_BYTES, stream, a); }
#else
    a.ph_lo = 0; a.ph_hi = N_PHASES;
    hipLaunchKernelGGL(fwd_kernel, dim3(grid), dim3(NT), LDS_BYTES, stream, a);
#endif
    const hipError_t le = hipPeekAtLastError();
    if (le != hipSuccess) fprintf(stderr, "kernel_launch: launch failed: %s\n", hipGetErrorName(le));
}
```

```cpp
#define MK_PER_PHASE 0
#include <hip/hip_runtime.h>
#include <cstdio>
#include <cstdint>

#ifndef MK_PER_PHASE
#define MK_PER_PHASE 0
#endif

#define LAS __attribute__((address_space(3)))
#define GAS __attribute__((address_space(1)))
typedef unsigned short bf16_t;
typedef short bf16x8 __attribute__((ext_vector_type(8)));
typedef float f32x4 __attribute__((ext_vector_type(4)));
typedef float f32x2 __attribute__((ext_vector_type(2)));
typedef float f32x16 __attribute__((ext_vector_type(16)));
typedef unsigned u32x4 __attribute__((ext_vector_type(4)));
typedef unsigned u32x2 __attribute__((ext_vector_type(2)));
typedef __bf16 bf16x2_t __attribute__((ext_vector_type(2)));

constexpr int DM = 2048, SEQ = 4096, PB = 2, SB = 8, SQ = 4, PAST = 16384;
constexpr int MPT = PB * SEQ;
constexpr int MROWS = MPT + SB * SQ;
constexpr int MPAD = 8448;
constexpr int DIN = 13872, NPROJ = 14080;
constexpr int C_PU = 0, C_PZ = 1024, C_Q = 2048, C_CK = 3072, C_CV = 3328, C_SK = 3584, C_SV = 3840, C_WK = 4096, C_WV = 4352,
              C_AZ = 4608, C_SU = 5632, C_SZ = 6656, C_MG = 7680, C_AG = 13824;
constexpr int NPOOL = 1280;
constexpr int SSM_L = 128, SSM_NCH = SEQ / SSM_L;
constexpr float EPS = 1e-6f;
constexpr float SM_SCALE_L2E = 0.125f * 1.44269504088896f;
constexpr float SM_THR = 8.f;

constexpr size_t O_YP = 0, O_YS = 16777216, O_KVP = 16842752, O_KVS = 33619968, O_WINP = 33685504, O_WINS = 34734080,
                 O_POOLP = 38928384, O_POOLS = 38989824, O_SSMP = 39235584, O_SSMS = 39268352, O_TOTAL = 39399424;

constexpr size_t al1m(size_t x) { return (x + 1048575) & ~(size_t)1048575; }
constexpr size_t SZ_WIN = (size_t)NPROJ * DM * 2, SZ_WPOOL = 4 * 256 * 256 * 2, SZ_WGLU = 1024 * 1024 * 2, SZ_WBR = (size_t)3 * 2048 * 1024 * 2,
                 SZ_WOUT = (size_t)2048 * 2048 * 2, SZ_WPHI = 2 * 64 * 64 * 64 * 2, SZ_PEBP = 2 * 16 * 64 * 4, SZ_SAB = 64 * 64 * 4 * 4,
                 SZ_SBB = 64 * 16 * 2 * 64 * 4, SZ_SCM = 64 * 16 * 128 * 2;
constexpr size_t WS_CTL = 0, CTL_BYTES = 1048576, CTL_ZERO_BYTES = 32768;
constexpr size_t WS_WIN = CTL_BYTES;
constexpr size_t WS_WPOOL = WS_WIN + 2 * al1m(SZ_WIN);
constexpr size_t WS_WGLU = WS_WPOOL + 2 * al1m(SZ_WPOOL);
constexpr size_t WS_WBR = WS_WGLU + 2 * al1m(SZ_WGLU);
constexpr size_t WS_WOUT = WS_WBR + 2 * al1m(SZ_WBR);
constexpr size_t WS_WPHI = WS_WOUT + 2 * al1m(SZ_WOUT);
constexpr size_t WS_PEBP = WS_WPHI + 2 * al1m(SZ_WPHI);
constexpr size_t WS_SAB = WS_PEBP + 2 * al1m(SZ_PEBP);
constexpr size_t WS_SBB = WS_SAB + 2 * al1m(SZ_SAB);
constexpr size_t WS_SCM = WS_SBB + 2 * al1m(SZ_SBB);
constexpr size_t WS_H = WS_SCM + 2 * al1m(SZ_SCM);
constexpr size_t WS_P = WS_H + al1m((size_t)MPAD * DM * 2);
constexpr size_t WS_GATE = WS_P + al1m((size_t)MPAD * NPROJ * 2);
constexpr size_t WS_DIFF = WS_GATE + al1m((size_t)MPAD * 64 * 4);
constexpr size_t WS_ABR = WS_DIFF + al1m((size_t)MPAD * 1024 * 2);
constexpr size_t SZ_ABR1 = (size_t)MPAD * 1024 * 2;
constexpr size_t WS_Z = WS_ABR + al1m(3 * SZ_ABR1);
constexpr size_t WS_KCP = WS_Z + al1m(SZ_ABR1);
constexpr size_t WS_VCTP = WS_KCP + al1m(65536);
constexpr size_t WS_KCS = WS_VCTP + al1m(65536);
constexpr size_t WS_VCTS = WS_KCS + al1m(1048576);
constexpr size_t WS_VTSEL = WS_VCTS + al1m(1048576);
constexpr size_t WS_VTWIN = WS_VTSEL + al1m(4194304);
constexpr size_t WS_SSME = WS_VTWIN + al1m(4194304);
constexpr size_t WS_MERGED = WS_SSME + al1m(2097152);
constexpr size_t WS_OUTB = WS_MERGED + al1m((size_t)MPAD * DM * 2);
constexpr size_t WS_Y0 = WS_OUTB + al1m((size_t)MPAD * DM * 4);
constexpr size_t WS_BRP = WS_Y0 + al1m((size_t)MPAD * DM * 4);
constexpr size_t WS_SOACC = WS_BRP + al1m((size_t)3 * 32 * DM * 4);
constexpr size_t WS_SBB16 = WS_SOACC + al1m(128 * 768 * 4);
constexpr size_t SZ_SBB16 = 64 * 2 * 64 * 16 * 2;
constexpr size_t WS_KTSEL = WS_SBB16 + 2 * al1m(SZ_SBB16);
constexpr size_t WS_KTWIN = WS_KTSEL + al1m(4194304);
constexpr size_t WS_END = WS_KTWIN + al1m(4194304);

constexpr int CW_BAR = 4096;

constexpr int NWAVES = 8, NT = 512;
constexpr int LDS_BYTES = 147456;
constexpr int LDS_MISC = 143360;

__device__ __forceinline__ float bf2f(unsigned b) { return __uint_as_float(b << 16); }
__device__ __forceinline__ unsigned pk2(float lo, float hi) { f32x2 v = {lo, hi}; bf16x2_t b = __builtin_convertvector(v, bf16x2_t); return __builtin_bit_cast(unsigned, b); }
__device__ __forceinline__ unsigned f2bf(float f) { return pk2(f, 0.f) & 0xffffu; }
__device__ __forceinline__ float wave_sum(float v) {
#pragma unroll
    for (int o = 1; o < 64; o <<= 1) v += __shfl_xor(v, o);
    return v;
}
__device__ __forceinline__ float wave_max(float v) {
#pragma unroll
    for (int o = 1; o < 64; o <<= 1) v = fmaxf(v, __shfl_xor(v, o));
    return v;
}
__device__ __forceinline__ float sigmoidf_(float x) { return __builtin_amdgcn_rcpf(1.f + __expf(-x)); }
__device__ __forceinline__ float siluf_(float x) { return x * sigmoidf_(x); }
__device__ __forceinline__ float gelu_tanh(float y) { const float a = 1.5957691216f * (y + 0.044715f * y * y * y); return y * sigmoidf_(a); }
#define LDS_WAIT() asm volatile("s_waitcnt lgkmcnt(0)" ::: "memory")
#define VM_WAIT() asm volatile("s_waitcnt vmcnt(0)" ::: "memory")

#define XB_TMO      128
#define XB_XCNT(j)  (256  + 64 * (j))
#define XB_XSUB(j)  (1280 + 64 * (j))
#define XB_XGEN(j)  (2304 + 64 * (j))
#define XB_TOP      3328
#define XB_TOPGEN   3392
#define XCD_BAR_WORDS 3456
#define XB_SPIN_CAP (1u << 23)
__device__ __forceinline__ unsigned xb_ld(unsigned* p)              { return __hip_atomic_load(p, __ATOMIC_RELAXED, __HIP_MEMORY_SCOPE_AGENT); }
__device__ __forceinline__ unsigned xb_add(unsigned* p, unsigned v) { return __hip_atomic_fetch_add(p, v, __ATOMIC_RELAXED, __HIP_MEMORY_SCOPE_AGENT); }
__device__ __forceinline__ unsigned xb_xcc_id() { return (unsigned)__builtin_amdgcn_s_getreg((3 << 11) | 20) & 0xFu; }
#define XB_SPIN(cond, bar) do { unsigned _sp = 0; while (cond) { __builtin_amdgcn_s_sleep(1); \
    if ((++_sp & 255u) == 0u) { if (xb_ld(&(bar)[XB_TMO])) break; if (_sp > XB_SPIN_CAP) { atomicAdd(&(bar)[XB_TMO], 1u); break; } } } } while (0)
struct XcdBarrier { unsigned* bar; unsigned x; volatile LAS unsigned* st; };
__device__ __forceinline__ XcdBarrier xcd_barrier_post(unsigned* bar, volatile LAS unsigned* st) {
    XcdBarrier b; b.bar = bar; b.x = xb_xcc_id(); b.st = st;
    if (threadIdx.x == 0) (void)xb_add(&bar[XB_XCNT(b.x)], 1u);
    return b;
}
__device__ __forceinline__ void xcd_barrier_complete(unsigned* bar, unsigned x, unsigned& nloc, unsigned& nx) {
    const unsigned G = gridDim.x * gridDim.y * gridDim.z;
    unsigned sum, cnt, mine, sp = 0u;
    for (;;) {
        sum = 0u; cnt = 0u; mine = 0u;
#pragma unroll
        for (unsigned j = 0; j < 16; ++j) { const unsigned c = xb_ld(&bar[XB_XCNT(j)]); sum += c; cnt += (c > 0u) ? 1u : 0u; mine = (j == x) ? c : mine; }
        if (sum == G) break;
        __builtin_amdgcn_s_sleep(1);
        if ((++sp & 255u) == 0u) { if (xb_ld(&bar[XB_TMO])) break; if (sp > XB_SPIN_CAP) { atomicAdd(&bar[XB_TMO], 1u); break; } }
    }
    nloc = mine > 0u ? mine : 1u; nx = cnt > 0u ? cnt : 1u;
}
__device__ __forceinline__ void xcd_barrier(const XcdBarrier& b) {
    asm volatile("s_waitcnt vmcnt(0)" ::: "memory");
    __syncthreads();
    if (threadIdx.x == 0) {
        unsigned* bar = b.bar;
        __builtin_amdgcn_s_waitcnt(0);
        unsigned nloc = b.st[0], nx = b.st[1];
        if (nloc == 0u) { xcd_barrier_complete(bar, b.x, nloc, nx); b.st[0] = nloc; b.st[1] = nx; }
        const unsigned old = xb_add(&bar[XB_XSUB(b.x)], 1u);
        const unsigned gen = old / nloc;
        if (old + 1u == (gen + 1u) * nloc) {
            __builtin_amdgcn_fence(__ATOMIC_RELEASE, "agent");
            asm volatile("s_waitcnt vmcnt(0)" ::: "memory");
            const unsigned og = xb_add(&bar[XB_TOP], 1u);
            const unsigned tg = og / nx;
            if (og + 1u == (tg + 1u) * nx) xb_add(&bar[XB_TOPGEN], 1u);
            else XB_SPIN(xb_ld(&bar[XB_TOPGEN]) == tg, bar);
            __builtin_amdgcn_fence(__ATOMIC_ACQUIRE, "agent");
            xb_add(&bar[XB_XGEN(b.x)], 1u);
            asm volatile("s_waitcnt vmcnt(0)" ::: "memory");
        } else {
            XB_SPIN(xb_ld(&bar[XB_XGEN(b.x)]) == gen, bar);
            __builtin_amdgcn_fence(__ATOMIC_ACQUIRE, "agent");
            asm volatile("s_waitcnt vmcnt(0)" ::: "memory");
        }
    }
    __syncthreads();
}
namespace pg8 {
constexpr int BM = 256, BK = 64, HALF = 128, HTB = HALF * BK * 2, STAGE_BYTES = 8 * HTB, NXCD = 8, WGM = 8;
__host__ __device__ __forceinline__ int lds_byte(int r, int c) { const int st = (r >> 4) * 2 + (c >> 5), rr = r & 15, cc = c & 31, ob = rr * 64 + cc * 2; return st * 1024 + (ob ^ (((ob >> 9) & 1) << 5)); }
__host__ __device__ __forceinline__ void stage_rc(int b, int& R, int& C) { const int st = b / 1024, sb = b % 1024, swz = sb ^ (((sb >> 9) & 1) << 5); R = (st >> 1) * 16 + swz / 64; C = (st & 1) * 32 + (swz % 64) / 2; }
__host__ __device__ __forceinline__ int perm32(int rho) { const int n = rho >> 4, i = rho & 15; return 8 * (i >> 2) + 4 * n + (i & 3); }

struct Unit { int pm, pn, z; };
struct Gemm { const bf16_t* A; const bf16_t* Bt; int lda, ldb, K; size_t zA, zB; };

struct TileOrder {
    int nM, nN, nz, ntile, G, c, zin;
    __device__ void init(int nM_, int nN_, int nz_, int zin_, int G_, int c_) { nM = nM_; nN = nN_; nz = nz_; zin = zin_; ntile = nM * nN; G = G_; c = c_; }
    __device__ bool next(int i, Unit& u) const {
        long L; int z;
        if (zin) { z = i % nz; L = (long)(i / nz) * G + c; if (L >= ntile) return false; }
        else { const long LL = (long)i * G + c; if (LL >= (long)ntile * nz) return false; z = (int)(LL / ntile); L = LL % ntile; }
        int wgid = (int)L; { const int q = ntile / NXCD, r = ntile % NXCD, xcd = wgid % NXCD, off = wgid / NXCD; wgid = (xcd < r ? xcd * (q + 1) : r * (q + 1) + (xcd - r) * q) + off; }
        const int nig = WGM * nN, gid = wgid / nig, fm = gid * WGM, gsz = (nM - fm) < WGM ? (nM - fm) : WGM;
        u.pm = fm + ((wgid % nig) % gsz); u.pn = (wgid % nig) / gsz; u.z = z; return true;
    }
};

template <class Epi, class Sched>
__device__ __forceinline__ void gemm_phase(LAS unsigned char* lds, const Gemm g, const Sched& S, const Epi& E) {
    int tid = threadIdx.x; asm volatile("" : "+v"(tid));
    const int wid = __builtin_amdgcn_readfirstlane(tid >> 6), lane = tid & 63, wr = wid >> 2, wc = wid & 3, fr = lane & 15, fq = lane >> 4;
    const int K = g.K, nt = K / BK;
    unsigned voffA[2], voffB[2];
#pragma unroll
    for (int i = 0; i < 2; ++i) { int R, C; stage_rc(tid * 16 + i * 8192, R, C); const int Rb = (R & ~31) + perm32(R & 31);
        voffA[i] = (unsigned)(R * g.lda + C) * 2u; voffB[i] = (unsigned)(Rb * g.ldb + C) * 2u; }
    const size_t kstep = (size_t)(BK * 2);
    const size_t hstepA = (size_t)HALF * g.lda * 2, hstepB = (size_t)HALF * g.ldb * 2;
    const unsigned ldsw = (unsigned)wid * 1024u;
    const int aoff = lds_byte(wr * 64 + fr, fq * 8), boff = lds_byte(wc * 32 + fr, fq * 8);
#define PG8_SA(b, h) (((b) * 2 + (h)) * HTB)
#define PG8_SB(b, h) ((4 + (b) * 2 + (h)) * HTB)
#define PG8_STAGE(bufoff, gbase, voff) do { _Pragma("unroll") for (int _i = 0; _i < 2; ++_i) \
        __builtin_amdgcn_global_load_lds((const unsigned*)((const char*)(gbase) + (voff)[_i]), (LAS unsigned*)(lds + (bufoff) + ldsw + _i * 8192), 16, 0, 0); } while (0)
#define PG8_LDA(dst, b, h) do { _Pragma("unroll") for (int m = 0; m < 4; ++m) _Pragma("unroll") for (int k = 0; k < 2; ++k) dst[m][k] = *(const LAS bf16x8*)(lds + PG8_SA(b, h) + aoff + m * 2048 + k * 1024); } while (0)
#define PG8_LDB(dst, b, h) do { _Pragma("unroll") for (int n = 0; n < 2; ++n) _Pragma("unroll") for (int k = 0; k < 2; ++k) dst[n][k] = *(const LAS bf16x8*)(lds + PG8_SB(b, h) + boff + n * 2048 + k * 1024); } while (0)
#define PG8_MMA(ai, bj, At, Bt) do { __builtin_amdgcn_s_setprio(1); _Pragma("unroll") for (int m = 0; m < 4; ++m) _Pragma("unroll") for (int n = 0; n < 2; ++n) _Pragma("unroll") for (int k = 0; k < 2; ++k) \
        acc[ai][bj][m][n] = __builtin_amdgcn_mfma_f32_16x16x32_bf16(Bt[n][k], At[m][k], acc[ai][bj][m][n], 0, 0, 0); __builtin_amdgcn_s_setprio(0); } while (0)
#define PG8_WAIT_V(n) asm volatile("s_waitcnt vmcnt(" #n ")" ::: "memory")
#define PG8_WAIT_L(n) asm volatile("s_waitcnt lgkmcnt(" #n ")" ::: "memory")
#define PG8_BAR __builtin_amdgcn_s_barrier()
#define PG8_SCHED __builtin_amdgcn_sched_barrier(0)
#define PG8_UA(u) ((const char*)(g.A + (size_t)(u).z * g.zA) + (size_t)(u).pm * (2 * hstepA))
#define PG8_UB(u) ((const char*)(g.Bt + (size_t)(u).z * g.zB) + (size_t)(u).pn * (2 * hstepB))
    Unit cur, nxt; int ui = 0;
    if (!S.next(0, cur)) return;
    f32x4 acc[2][2][4][2];
#pragma unroll
    for (int a = 0; a < 2; ++a)
#pragma unroll
        for (int b = 0; b < 2; ++b)
#pragma unroll
            for (int m = 0; m < 4; ++m)
#pragma unroll
                for (int n = 0; n < 2; ++n) acc[a][b][m][n] = (f32x4){0.f, 0.f, 0.f, 0.f};
    bf16x8 At[4][2], B0[2][2], B1[2][2];
    const char* cA = PG8_UA(cur); const char* cB = PG8_UB(cur);
    PG8_STAGE(PG8_SB(0, 0), cB, voffB); PG8_STAGE(PG8_SB(0, 1), cB + hstepB, voffB); PG8_STAGE(PG8_SA(0, 0), cA, voffA); PG8_STAGE(PG8_SA(0, 1), cA + hstepA, voffA);
    if (wr == 1) PG8_BAR;
    PG8_WAIT_V(2); PG8_BAR;
    PG8_STAGE(PG8_SB(1, 0), cB + kstep, voffB); PG8_STAGE(PG8_SA(1, 0), cA + kstep, voffA); PG8_STAGE(PG8_SB(1, 1), cB + hstepB + kstep, voffB);
    PG8_WAIT_V(6); PG8_BAR;
    for (;;) {
        const bool has_next = S.next(ui + 1, nxt);
        const char* nA = has_next ? PG8_UA(nxt) : cA; const char* nB = has_next ? PG8_UB(nxt) : cB;
#pragma unroll 1
        for (int t = 0; t < nt; t += 2) {
            const bool last = (t == nt - 2);
            const char* a1 = cA + (size_t)(t + 1) * kstep;
            const char* a2 = last ? nA : cA + (size_t)(t + 2) * kstep; const char* b2 = last ? nB : cB + (size_t)(t + 2) * kstep;
            const char* a3 = a2 + kstep; const char* b3 = b2 + kstep;
            PG8_LDB(B0, 0, 0); PG8_LDB(B1, 0, 1); PG8_SCHED; PG8_LDA(At, 0, 0); PG8_STAGE(PG8_SA(1, 1), a1 + hstepA, voffA);
            PG8_WAIT_V(8); PG8_WAIT_L(0); PG8_BAR; PG8_MMA(0, 0, At, B0); PG8_MMA(0, 1, At, B1); PG8_BAR; PG8_SCHED;
            PG8_LDA(At, 0, 1); PG8_STAGE(PG8_SB(0, 0), b2, voffB); PG8_STAGE(PG8_SB(0, 1), b2 + hstepB, voffB); PG8_STAGE(PG8_SA(0, 0), a2, voffA);
            PG8_WAIT_V(8); PG8_WAIT_L(0); PG8_BAR; PG8_MMA(1, 0, At, B0); PG8_MMA(1, 1, At, B1); PG8_BAR; PG8_SCHED;
            PG8_LDB(B0, 1, 0); PG8_LDB(B1, 1, 1); PG8_SCHED; PG8_LDA(At, 1, 0); PG8_STAGE(PG8_SA(0, 1), a2 + hstepA, voffA);
            PG8_WAIT_V(8); PG8_WAIT_L(0); PG8_BAR; PG8_MMA(0, 0, At, B0); PG8_MMA(0, 1, At, B1); PG8_BAR; PG8_SCHED;
            PG8_LDA(At, 1, 1); PG8_STAGE(PG8_SB(1, 0), b3, voffB); PG8_STAGE(PG8_SB(1, 1), b3 + hstepB, voffB); PG8_STAGE(PG8_SA(1, 0), a3, voffA);
            PG8_WAIT_V(8); PG8_WAIT_L(0); PG8_BAR; PG8_MMA(1, 0, At, B0); PG8_MMA(1, 1, At, B1); PG8_BAR; PG8_SCHED;
        }
        if (wr == 0) PG8_BAR;
        const bool keep = E(acc, cur, wr, wc, fr, fq);
        if (!has_next) break;
        if (!keep) {
#pragma unroll
            for (int a = 0; a < 2; ++a)
#pragma unroll
                for (int b = 0; b < 2; ++b)
#pragma unroll
                    for (int m = 0; m < 4; ++m)
#pragma unroll
                        for (int n = 0; n < 2; ++n) acc[a][b][m][n] = (f32x4){0.f, 0.f, 0.f, 0.f};
        }
        cur = nxt; cA = nA; cB = nB; ++ui;
        if (wr == 1) PG8_BAR;
    }
    PG8_WAIT_V(0);
    PG8_BAR;
#undef PG8_SA
#undef PG8_SB
#undef PG8_STAGE
#undef PG8_LDA
#undef PG8_LDB
#undef PG8_MMA
#undef PG8_WAIT_V
#undef PG8_WAIT_L
#undef PG8_BAR
#undef PG8_SCHED
#undef PG8_UA
#undef PG8_UB
}
}
#define EPI_ARGS f32x4 (&acc)[2][2][4][2], const pg8::Unit& u, int wr, int wc, int fr, int fq
#define EPI_FOR_ROWS _Pragma("unroll") for (int ai = 0; ai < 2; ++ai) _Pragma("unroll") for (int m = 0; m < 4; ++m)
#define EPI_ROW (u.pm * 256 + ai * 128 + wr * 64 + m * 16 + fr)
#define EPI_FOR_COLS _Pragma("unroll") for (int bj = 0; bj < 2; ++bj)
#define EPI_COL (u.pn * 256 + bj * 128 + wc * 32 + 8 * fq)

__device__ __forceinline__ u32x4 pack8(const f32x4& a, const f32x4& b) { u32x4 w; w.x = pk2(a[0], a[1]); w.y = pk2(a[2], a[3]); w.z = pk2(b[0], b[1]); w.w = pk2(b[2], b[3]); return w; }
__device__ __forceinline__ void unpack8(const u32x4& w, float (&f)[8]) {
    f[0] = bf2f(w.x & 0xffffu); f[1] = __uint_as_float(w.x & 0xffff0000u); f[2] = bf2f(w.y & 0xffffu); f[3] = __uint_as_float(w.y & 0xffff0000u);
    f[4] = bf2f(w.z & 0xffffu); f[5] = __uint_as_float(w.z & 0xffff0000u); f[6] = bf2f(w.w & 0xffffu); f[7] = __uint_as_float(w.w & 0xffff0000u);
}

__device__ __forceinline__ u32x2 pack4(const f32x4& v) { u32x2 w; w.x = pk2(v[0], v[1]); w.y = pk2(v[2], v[3]); return w; }
__device__ __forceinline__ f32x4 unpack4(const u32x2& x) { return (f32x4){bf2f(x.x & 0xffffu), __uint_as_float(x.x & 0xffff0000u), bf2f(x.y & 0xffffu), __uint_as_float(x.y & 0xffff0000u)}; }

struct EpiProj {
    bf16_t* P; float* gate; float* out; int layer;
    __device__ __forceinline__ bool operator()(EPI_ARGS) const {
        const int pn = u.pn;
        int mode;
        if (pn < 4) mode = 0; else if (pn < 8) mode = 1; else if (pn < 12) mode = 5; else if (pn < 16) mode = 3; else if (pn < 18) mode = 0;
        else if (pn < 22) mode = 1; else if (pn < 26) mode = 0; else if (pn < 30) mode = 1; else if (pn < 54) mode = 2; else mode = 4;
        if (mode == 0) {
            EPI_FOR_ROWS { bf16_t* rp = P + (size_t)EPI_ROW * NPROJ; EPI_FOR_COLS { *(u32x4*)(rp + EPI_COL) = pack8(acc[ai][bj][m][0], acc[ai][bj][m][1]); } }
        } else if (mode == 5) {
            EPI_FOR_ROWS { bf16_t* rp = P + (size_t)EPI_ROW * NPROJ; EPI_FOR_COLS { *(u32x4*)(rp + EPI_COL) = pack8(acc[ai][bj][m][0] * SM_SCALE_L2E, acc[ai][bj][m][1] * SM_SCALE_L2E); } }
        } else if (mode == 1) {
            EPI_FOR_ROWS { bf16_t* rp = P + (size_t)EPI_ROW * NPROJ; EPI_FOR_COLS { f32x4 a = acc[ai][bj][m][0], b = acc[ai][bj][m][1];
#pragma unroll
                for (int j = 0; j < 4; ++j) { a[j] = siluf_(a[j]); b[j] = siluf_(b[j]); }
                *(u32x4*)(rp + EPI_COL) = pack8(a, b); } }
        } else if (mode == 2) {
            EPI_FOR_ROWS { bf16_t* rp = P + (size_t)EPI_ROW * NPROJ; EPI_FOR_COLS { f32x4 a = acc[ai][bj][m][0], b = acc[ai][bj][m][1];
#pragma unroll
                for (int j = 0; j < 4; ++j) { a[j] = sigmoidf_(a[j]); b[j] = sigmoidf_(b[j]); }
                *(u32x4*)(rp + EPI_COL) = pack8(a, b); } }
        } else if (mode == 3) {
            EPI_FOR_ROWS { const int row = EPI_ROW; bf16_t* rp = P + (size_t)row * NPROJ;
                float* op = nullptr;
                if (row < MPT) op = out + O_KVP + ((size_t)layer * MPT + row) * 1024;
                else if (row < MROWS) op = out + O_KVS + ((size_t)layer * 32 + (row - MPT)) * 1024;
                EPI_FOR_COLS { const int col = EPI_COL; *(u32x4*)(rp + col) = pack8(acc[ai][bj][m][0], acc[ai][bj][m][1]);
                    if (op) { *(f32x4*)(op + col - C_CK) = acc[ai][bj][m][0]; *(f32x4*)(op + col - C_CK + 4) = acc[ai][bj][m][1]; } } }
        } else {
            EPI_FOR_ROWS { float* gp = gate + (size_t)EPI_ROW * 64; EPI_FOR_COLS { const int c = EPI_COL - C_AG; if (c < 48) { f32x4 a = acc[ai][bj][m][0], b = acc[ai][bj][m][1];
#pragma unroll
                for (int j = 0; j < 4; ++j) { a[j] = sigmoidf_(a[j]); b[j] = sigmoidf_(b[j]); }
                *(f32x4*)(gp + c) = a; *(f32x4*)(gp + c + 4) = b; } } }
        }
        return false;
    }
};

struct EpiPool {
    bf16_t* apool; const bf16_t* P; const float* pscale;
    __device__ __forceinline__ bool operator()(EPI_ARGS) const {
        asm volatile("" ::: "memory");
#pragma unroll
        for (int ai = 0; ai < 2; ++ai) {
            u32x4 zw[4][2];
#pragma unroll
            for (int m = 0; m < 4; ++m) EPI_FOR_COLS { const int col = u.z * 256 + bj * 128 + wc * 32 + 8 * fq; zw[m][bj] = *(const u32x4*)(P + (size_t)EPI_ROW * NPROJ + C_PZ + col); }
            __builtin_amdgcn_sched_barrier(0);
#pragma unroll
            for (int m = 0; m < 4; ++m) EPI_FOR_COLS { const int col = u.z * 256 + bj * 128 + wc * 32 + 8 * fq; float zf[8]; unpack8(zw[m][bj], zf);
                const f32x4 s0 = *(const f32x4*)(pscale + col), s1 = *(const f32x4*)(pscale + col + 4);
                f32x4 a = acc[ai][bj][m][0], b = acc[ai][bj][m][1];
#pragma unroll
                for (int j = 0; j < 4; ++j) { a[j] = a[j] * s0[j] * zf[j]; b[j] = b[j] * s1[j] * zf[4 + j]; }
                *(u32x4*)(apool + (size_t)EPI_ROW * 1024 + col) = pack8(a, b); }
            __builtin_amdgcn_sched_barrier(0);
        }
        return false;
    }
};

struct EpiGlu {
    bf16_t* assm; const bf16_t* P; const bf16_t* Z;
    __device__ __forceinline__ bool operator()(EPI_ARGS) const {
#pragma unroll
        for (int ai = 0; ai < 2; ++ai) {
            u32x4 zw[4][2], sw[4][2];
#pragma unroll
            for (int m = 0; m < 4; ++m) EPI_FOR_COLS { const int row = EPI_ROW, col = EPI_COL; zw[m][bj] = *(const u32x4*)(Z + (size_t)row * 1024 + col); sw[m][bj] = *(const u32x4*)(P + (size_t)row * NPROJ + C_SZ + col); }
            __builtin_amdgcn_sched_barrier(0);
#pragma unroll
            for (int m = 0; m < 4; ++m) EPI_FOR_COLS { float zf[8], sf[8]; unpack8(zw[m][bj], zf); unpack8(sw[m][bj], sf);
                f32x4 a = acc[ai][bj][m][0], b = acc[ai][bj][m][1];
#pragma unroll
                for (int j = 0; j < 4; ++j) { a[j] = zf[j] * sigmoidf_(a[j]) * sf[j]; b[j] = zf[4 + j] * sigmoidf_(b[j]) * sf[4 + j]; }
                *(u32x4*)(assm + (size_t)EPI_ROW * 1024 + EPI_COL) = pack8(a, b); }
            __builtin_amdgcn_sched_barrier(0);
        }
        return false;
    }
};

struct EpiBranch {
    bf16_t* merged; const bf16_t* P;
    __device__ __forceinline__ bool operator()(EPI_ARGS) const {
        const int z = u.z;
#pragma unroll
        for (int ai = 0; ai < 2; ++ai) {
            u32x4 gzw[4][2], gnw[4][2];
#pragma unroll
            for (int m = 0; m < 4; ++m) EPI_FOR_COLS { const bf16_t* gp = P + (size_t)EPI_ROW * NPROJ + C_MG + EPI_COL; gzw[m][bj] = *(const u32x4*)(gp + z * 2048); gnw[m][bj] = *(const u32x4*)(gp + (z < 2 ? z + 1 : 2) * 2048); }
            __builtin_amdgcn_sched_barrier(0);
#pragma unroll
            for (int m = 0; m < 4; ++m) EPI_FOR_COLS { float gz[8], gn[8]; unpack8(gzw[m][bj], gz); unpack8(gnw[m][bj], gn);
                f32x4& a = acc[ai][bj][m][0]; f32x4& b = acc[ai][bj][m][1];
                if (z < 2) {
#pragma unroll
                    for (int j = 0; j < 4; ++j) { a[j] *= fmaxf(gz[j], 1e-30f) * __builtin_amdgcn_rcpf(fmaxf(gn[j], 1e-30f)); b[j] *= fmaxf(gz[4 + j], 1e-30f) * __builtin_amdgcn_rcpf(fmaxf(gn[4 + j], 1e-30f)); }
                } else {
                    f32x4 a2, b2;
#pragma unroll
                    for (int j = 0; j < 4; ++j) { a2[j] = a[j] * fmaxf(gz[j], 1e-30f); b2[j] = b[j] * fmaxf(gz[4 + j], 1e-30f); }
                    *(u32x4*)(merged + (size_t)EPI_ROW * DM + EPI_COL) = pack8(a2, b2);
                } }
            __builtin_amdgcn_sched_barrier(0);
        }
        return z < 2;
    }
};

struct EpiOut {
    bf16_t* outb;
    __device__ __forceinline__ bool operator()(EPI_ARGS) const {
        EPI_FOR_ROWS { bf16_t* rp = outb + (size_t)EPI_ROW * DM; EPI_FOR_COLS { *(u32x4*)(rp + EPI_COL) = pack8(acc[ai][bj][m][0], acc[ai][bj][m][1]); } }
        return false;
    }
};
struct Frame {
    LAS unsigned char* lds;
    int tid, lane, wave, G, bid, gw, ngw;
    float* out; unsigned char* ws;
};
#define FIN(i) ((const float*)(const GAS float*)(((const float* const __attribute__((address_space(4)))*)__builtin_amdgcn_kernarg_segment_ptr())[i]))
#define IN_XP 0
#define IN_XS 1
#define IN_CACHE 2
#define IN_PT 3
#define IN_SWIN 4
#define IN_SPOOL 5
#define IN_SSSM 6
#define IN_GPRE 7
#define IN_GPOST 8
#define IN_WIN 9
#define IN_WPOOL 10
#define IN_PSCALE 11
#define IN_PE 12
#define IN_WPHI 13
#define IN_LRE 14
#define IN_LIM 15
#define IN_LSTEP 16
#define IN_BRE 17
#define IN_BIM 18
#define IN_CRE 19
#define IN_CIM 20
#define IN_DSKIP 21
#define IN_WGLU 22
#define IN_WBRP 23
#define IN_WBRN 24
#define IN_WBRS 25
#define IN_WOUT 26

template <class MAP>
__device__ __forceinline__ void transpose_item(const float* W, int ldw, int K, bf16_t* WT, int k0, int nd0, LAS float* scr, int lane, const MAP& map) {
    const int nq = 4 * (lane & 15), ns = map(nd0 + nq), kr = lane >> 4;
    f32x4 v[16];
#pragma unroll
    for (int i = 0; i < 16; ++i) v[i] = ns >= 0 ? *(const f32x4*)(W + (size_t)(k0 + 4 * i + kr) * ldw + ns) : (f32x4){0.f, 0.f, 0.f, 0.f};
#pragma unroll
    for (int i = 0; i < 16; ++i) { LAS float* d = scr + (4 * i + kr) * 65 + nq; d[0] = v[i].x; d[1] = v[i].y; d[2] = v[i].z; d[3] = v[i].w; }
    LDS_WAIT(); asm volatile("" ::: "memory");
    const int c = lane & 7;
#pragma unroll
    for (int j = 0; j < 8; ++j) { const int n = (lane >> 3) + 8 * j; const LAS float* s = scr + (8 * c) * 65 + n;
        u32x4 o; o.x = pk2(s[0 * 65], s[1 * 65]); o.y = pk2(s[2 * 65], s[3 * 65]); o.z = pk2(s[4 * 65], s[5 * 65]); o.w = pk2(s[6 * 65], s[7 * 65]);
        *(u32x4*)(WT + (size_t)(nd0 + n) * K + k0 + 8 * c) = o; }
    LDS_WAIT(); asm volatile("" ::: "memory");
}
struct MapId { __device__ __forceinline__ int operator()(int n) const { return n; } };
struct MapWin { __device__ __forceinline__ int operator()(int n) const { return n < C_AZ ? n : (n < C_AG ? n + 48 : (n < C_AG + 48 ? n - C_AG + 4608 : -1)); } };

__device__ __forceinline__ double exp_d(double x) {
    const double r = x * (1.0 / 64.0); double t = 1.0, s = 1.0;
#pragma unroll
    for (int k = 1; k <= 14; ++k) { t *= r / (double)k; s += t; }
#pragma unroll
    for (int k = 0; k < 6; ++k) s *= s;
    return s;
}
__device__ __forceinline__ void sincos_d(double x, double& sn, double& cs) {
    const double k = rint(x * 0.63661977236758134308);
    double r = fma(-k, 1.57079632679489655800e+00, x); r = fma(-k, 6.12323399573676603587e-17, r);
    const double r2 = r * r;
    double sp = 1.0, cp = 1.0, ts = 1.0, tc = 1.0;
#pragma unroll
    for (int i = 1; i <= 9; ++i) { ts *= -r2 / (double)((2 * i) * (2 * i + 1)); sp += ts; tc *= -r2 / (double)((2 * i - 1) * (2 * i)); cp += tc; }
    sp *= r;
    const int q = ((int)k) & 3;
    sn = (q == 0) ? sp : (q == 1) ? cp : (q == 2) ? -sp : -cp;
    cs = (q == 0) ? cp : (q == 1) ? -sp : (q == 2) ? -cp : sp;
}

__device__ __forceinline__ void rms_row_to_bf16(const float* xrow, const float* g, bf16_t* orow, int lane) {
    const f32x4* xr = (const f32x4*)xrow + lane; const f32x4* gr = (const f32x4*)g + lane;
    f32x4 v[8]; float s = 0.f;
#pragma unroll
    for (int j = 0; j < 8; ++j) { v[j] = xr[64 * j]; s += (v[j].x * v[j].x + v[j].y * v[j].y) + (v[j].z * v[j].z + v[j].w * v[j].w); }
    const float rstd = 1.f / sqrtf(wave_sum(s) * (1.f / DM) + EPS);
    u32x2* o8 = (u32x2*)orow + lane;
#pragma unroll
    for (int j = 0; j < 8; ++j) { const f32x4 gg = gr[64 * j]; u32x2 w; w.x = pk2(v[j].x * rstd * gg.x, v[j].y * rstd * gg.y); w.y = pk2(v[j].z * rstd * gg.z, v[j].w * rstd * gg.w); o8[64 * j] = w; }
}
__device__ __forceinline__ const float* x_row_l0(const Frame& F, int m) {
    const GAS float* s0 = (const GAS float*)FIN(IN_XP); const GAS float* s1 = (const GAS float*)FIN(IN_XS);
    asm volatile("" : "+s"(s0), "+s"(s1));
    return (const float*)(m < MPT ? s0 + (size_t)m * DM : s1 + (size_t)(m - MPT) * DM); }

__device__ __forceinline__ void phase_prologue(Frame& F) {
    LAS float* scr = (LAS float*)(F.lds + F.wave * 16640);
    const int lane = F.lane;
    constexpr int I_WIN = 32 * (NPROJ / 64), I_GLU = 16 * 16, I_BR = 16 * 32, I_OUT = 32 * 32, I_POOL = 4 * 4, I_PHI = 1;
    constexpr int PER_L = I_WIN + I_GLU + 3 * I_BR + I_OUT + 4 * I_POOL + 128 * I_PHI;
    for (int it = F.gw; it < 2 * PER_L; it += F.ngw) {
        const int l = it / PER_L; int r = it % PER_L;
        if (r < I_WIN) { const int kb = r / (NPROJ / 64), nb = r % (NPROJ / 64);
            transpose_item(FIN(IN_WIN) + (size_t)l * DM * DIN, DIN, DM, (bf16_t*)(F.ws + WS_WIN + l * al1m(SZ_WIN)), 64 * kb, 64 * nb, scr, lane, MapWin()); continue; } r -= I_WIN;
        if (r < I_GLU) { const int kb = r / 16, nb = r % 16;
            transpose_item(FIN(IN_WGLU) + (size_t)l * 1024 * 1024, 1024, 1024, (bf16_t*)(F.ws + WS_WGLU + l * al1m(SZ_WGLU)), 64 * kb, 64 * nb, scr, lane, MapId()); continue; } r -= I_GLU;
        if (r < 3 * I_BR) { const int z = r / I_BR, rr = r % I_BR, kb = rr / 32, nb = rr % 32;
            const float* src = FIN(IN_WBRP + z) + (size_t)l * 1024 * 2048;
            transpose_item(src, 2048, 1024, (bf16_t*)(F.ws + WS_WBR + l * al1m(SZ_WBR)) + (size_t)z * 2048 * 1024, 64 * kb, 64 * nb, scr, lane, MapId()); continue; } r -= 3 * I_BR;
        if (r < I_OUT) { const int kb = r / 32, nb = r % 32;
            transpose_item(FIN(IN_WOUT) + (size_t)l * 2048 * 2048, 2048, 2048, (bf16_t*)(F.ws + WS_WOUT + l * al1m(SZ_WOUT)), 64 * kb, 64 * nb, scr, lane, MapId()); continue; } r -= I_OUT;
        if (r < 4 * I_POOL) { const int z = r / I_POOL, rr = r % I_POOL, kb = rr / 4, nb = rr % 4;
            transpose_item(FIN(IN_WPOOL) + ((size_t)l * 4 + z) * 65536, 256, 256, (bf16_t*)(F.ws + WS_WPOOL + l * al1m(SZ_WPOOL)) + (size_t)z * 65536, 64 * kb, 64 * nb, scr, lane, MapId()); continue; } r -= 4 * I_POOL;
        {
            transpose_item(FIN(IN_WPHI) + ((size_t)l * 128 + r) * 4096, 64, 64, (bf16_t*)(F.ws + WS_WPHI + l * al1m(SZ_WPHI)) + (size_t)r * 4096, 0, 0, scr, lane, MapId()); }
    }
    for (int it = F.gw; it < 64; it += F.ngw) {
        const int l = it >> 5, j = (it >> 4) & 1, part = it & 15;
        const float* pe = FIN(IN_PE) + ((size_t)(l * 2 + j) * 64 + part * 4) * 64;
        const float* wp = FIN(IN_WPHI) + ((size_t)(l * 2 + j) * 64 + part * 4) * 4096;
        float s = 0.f;
#pragma unroll 16
        for (int i = 0; i < 256; ++i) s += pe[i] * wp[(size_t)i * 64 + lane];
        ((float*)(F.ws + WS_PEBP + l * al1m(SZ_PEBP)))[(j * 16 + part) * 64 + lane] = s;
    }
    for (int it = F.gw * 64 + lane; it < 2 * 4096; it += F.ngw * 64) {
        const int l = it >> 12, g = (it >> 6) & 63, n = it & 63;
        const double dt = exp_d((double)FIN(IN_LSTEP)[l * 64 + g]);
        const double lr = (double)FIN(IN_LRE)[(l * 64 + g) * 64 + n], li = (double)FIN(IN_LIM)[(l * 64 + g) * 64 + n];
        const double mag = exp_d(lr * dt); double sn, cs; sincos_d(li * dt, sn, cs);
        const double ar = mag * cs, ai = mag * sn, den = lr * lr + li * li;
        const double cr = ((ar - 1.0) * lr + ai * li) / den, ci = (ai * lr - (ar - 1.0) * li) / den;
        double pr = ar, pi = ai;
#pragma unroll
        for (int k = 0; k < 7; ++k) { const double t = pr * pr - pi * pi; pi = 2.0 * pr * pi; pr = t; }
        float* ab = (float*)(F.ws + WS_SAB + l * al1m(SZ_SAB)) + (g * 64 + n) * 4;
        ab[0] = (float)ar; ab[1] = (float)ai; ab[2] = (float)pr; ab[3] = (float)pi;
        float* bb = (float*)(F.ws + WS_SBB + l * al1m(SZ_SBB)) + (size_t)g * 16 * 128;
        const float* bre = FIN(IN_BRE) + ((size_t)(l * 64 + g) * 64 + n) * 16; const float* bim = FIN(IN_BIM) + ((size_t)(l * 64 + g) * 64 + n) * 16;
        unsigned* bb16 = (unsigned*)(F.ws + WS_SBB16 + l * al1m(SZ_SBB16));
        for (int c = 0; c < 16; c += 2) { const double br0 = bre[c], bi0 = bim[c], br1 = bre[c + 1], bi1 = bim[c + 1];
            const float r0 = (float)(cr * br0 - ci * bi0), i0 = (float)(cr * bi0 + ci * br0), r1 = (float)(cr * br1 - ci * bi1), i1 = (float)(cr * bi1 + ci * br1);
            bb[c * 128 + n] = r0; bb[c * 128 + 64 + n] = i0; bb[(c + 1) * 128 + n] = r1; bb[(c + 1) * 128 + 64 + n] = i1;
            bb16[(((g * 2 + 0) * 64 + n) * 16 + c) >> 1] = pk2(r0, r1); bb16[(((g * 2 + 1) * 64 + n) * 16 + c) >> 1] = pk2(i0, i1); }
        bf16_t* cm = (bf16_t*)(F.ws + WS_SCM + l * al1m(SZ_SCM)) + (size_t)g * 16 * 128;
        const float* cre = FIN(IN_CRE) + (size_t)(l * 64 + g) * 16 * 64; const float* cim = FIN(IN_CIM) + (size_t)(l * 64 + g) * 16 * 64;
        for (int c = 0; c < 16; ++c) *(unsigned*)(cm + c * 128 + 2 * n) = pk2(cre[c * 64 + n], -cim[c * 64 + n]);
    }
    bf16_t* H = (bf16_t*)(F.ws + WS_H);
    for (int m = F.gw; m < MROWS; m += F.ngw) rms_row_to_bf16(x_row_l0(F, m), FIN(IN_GPRE), H + (size_t)m * DM, lane);
}

__device__ __forceinline__ void phase_norm(Frame& F, int l) {
    const int lane = F.lane;
    const bf16_t* outb = (const bf16_t*)(F.ws + WS_OUTB);
    float* y0 = (float*)(F.ws + WS_Y0);
    bf16_t* H = (bf16_t*)(F.ws + WS_H);
    for (int r = F.bid; r < MROWS - MPT; r += F.G) {
        const int m = MPT + r, c0 = F.wave * 256 + 4 * lane;
        LAS float* red = (LAS float*)F.lds;
        const float* xrow = l == 0 ? FIN(IN_XS) + (size_t)r * DM : y0 + (size_t)m * DM;
        float* yrow = l == 0 ? y0 + (size_t)m * DM : F.out + O_YS + (size_t)r * DM;
        const f32x4 o = unpack4(*(const u32x2*)(outb + (size_t)m * DM + c0)), x = *(const f32x4*)(xrow + c0), g = *(const f32x4*)(FIN(IN_GPOST) + l * DM + c0);
        float s = wave_sum(o.x * o.x + o.y * o.y + o.z * o.z + o.w * o.w);
        __syncthreads();
        if (lane == 0) red[F.wave] = s;
        __syncthreads();
        s = 0.f;
#pragma unroll
        for (int w2 = 0; w2 < NWAVES; ++w2) s += red[w2];
        const float rstd = 1.f / sqrtf(s * (1.f / DM) + EPS);
        const f32x4 y = x + o * rstd * g;
        *(f32x4*)(yrow + c0) = y;
        if (l == 0) {
            float s2 = wave_sum(y.x * y.x + y.y * y.y + y.z * y.z + y.w * y.w);
            if (lane == 0) red[8 + F.wave] = s2;
            __syncthreads();
            s2 = 0.f;
#pragma unroll
            for (int w2 = 0; w2 < NWAVES; ++w2) s2 += red[8 + w2];
            const float rstd2 = 1.f / sqrtf(s2 * (1.f / DM) + EPS);
            const f32x4 g2 = *(const f32x4*)(FIN(IN_GPRE) + DM + c0);
            *(u32x2*)(H + (size_t)m * DM + c0) = pack4(y * rstd2 * g2);
        }
    }
    for (int m = F.gw; m < MPT; m += F.ngw) {
        const float* xrow = l == 0 ? x_row_l0(F, m) : y0 + (size_t)m * DM;
        float* yrow = l == 0 ? y0 + (size_t)m * DM : (m < MPT ? F.out + O_YP + (size_t)m * DM : F.out + O_YS + (size_t)(m - MPT) * DM);
        const float* gp = FIN(IN_GPOST) + l * DM;
        float v[4][8]; float s = 0.f;
#pragma unroll
        for (int j = 0; j < 4; ++j) { const u32x4 w = *(const u32x4*)(outb + (size_t)m * DM + 8 * (lane + 64 * j)); unpack8(w, v[j]);
#pragma unroll
            for (int e = 0; e < 8; ++e) s += v[j][e] * v[j][e]; }
        const float rstd = 1.f / sqrtf(wave_sum(s) * (1.f / DM) + EPS);
        float s2 = 0.f;
#pragma unroll
        for (int j = 0; j < 4; ++j) { const int c0 = 8 * (lane + 64 * j);
            const f32x4 g0 = *(const f32x4*)(gp + c0), g1 = *(const f32x4*)(gp + c0 + 4), x0 = *(const f32x4*)(xrow + c0), x1 = *(const f32x4*)(xrow + c0 + 4);
            f32x4 y0v, y1v;
#pragma unroll
            for (int e = 0; e < 4; ++e) { y0v[e] = x0[e] + v[j][e] * rstd * g0[e]; y1v[e] = x1[e] + v[j][4 + e] * rstd * g1[e]; v[j][e] = y0v[e]; v[j][4 + e] = y1v[e]; s2 += y0v[e] * y0v[e] + y1v[e] * y1v[e]; }
            *(f32x4*)(yrow + c0) = y0v; *(f32x4*)(yrow + c0 + 4) = y1v; }
        if (l == 0) {
            const float rstd2 = 1.f / sqrtf(wave_sum(s2) * (1.f / DM) + EPS);
            const float* g2 = FIN(IN_GPRE) + DM;
#pragma unroll
            for (int j = 0; j < 4; ++j) { const int c0 = 8 * (lane + 64 * j); const f32x4 g0 = *(const f32x4*)(g2 + c0), g1 = *(const f32x4*)(g2 + c0 + 4);
                f32x4 a, bq;
#pragma unroll
                for (int e = 0; e < 4; ++e) { a[e] = v[j][e] * rstd2 * g0[e]; bq[e] = v[j][4 + e] * rstd2 * g1[e]; }
                *(u32x4*)(H + (size_t)m * DM + c0) = pack8(a, bq); }
        }
    }
}
template <int KP>
__device__ __forceinline__ void skinny_stage(LAS unsigned char* lds, const bf16_t* A, int lda, int tid) {
    constexpr int CH = KP / 8;
#pragma unroll 8
    for (int i = tid; i < 32 * CH; i += NT) { const int r = i / CH, c = i % CH; *(LAS u32x4*)(lds + r * (KP * 2 + 16) + c * 16) = *(const u32x4*)(A + (size_t)r * lda + 8 * c); }
    __syncthreads();
}
template <int KP>
__device__ __forceinline__ void skinny_tile(const LAS unsigned char* lds, const bf16_t* Bt, int ldb, int n0, int kbeg, int klen, int lane, f32x4& d0, f32x4& d1) {
    const int rw = lane & 15, q = lane >> 4;
    const bf16_t* wrow = Bt + (size_t)(n0 + rw) * ldb + 32 * q;
    const LAS unsigned char* a0 = lds + rw * (KP * 2 + 16) + (kbeg + 32 * q) * 2;
    const LAS unsigned char* a1 = a0 + 16 * (KP * 2 + 16);
    d0 = (f32x4){0.f, 0.f, 0.f, 0.f}; d1 = d0;
#pragma unroll 4
    for (int k0 = 0; k0 < klen; k0 += 128) {
        bf16x8 w[4];
#pragma unroll
        for (int s = 0; s < 4; ++s) w[s] = *(const bf16x8*)(wrow + k0 + 8 * s);
#pragma unroll
        for (int s = 0; s < 4; ++s) { const bf16x8 b0 = *(const LAS bf16x8*)(a0 + k0 * 2 + 16 * s), b1 = *(const LAS bf16x8*)(a1 + k0 * 2 + 16 * s);
            d0 = __builtin_amdgcn_mfma_f32_16x16x32_bf16(w[s], b0, d0, 0, 0, 0); d1 = __builtin_amdgcn_mfma_f32_16x16x32_bf16(w[s], b1, d1, 0, 0, 0); }
    }
}

__device__ __forceinline__ void skinny_proj(Frame& F, int l) {
    constexpr int NTASK = NPROJ / 128;
    bf16_t* P = (bf16_t*)(F.ws + WS_P); float* gate = (float*)(F.ws + WS_GATE);
    const bf16_t* W = (const bf16_t*)(F.ws + WS_WIN + l * al1m(SZ_WIN));
    bool staged = false;
    const int ntile = (MPT / 256) * (NPROJ / 256), nlight = (ntile % F.G) ? F.G - (ntile % F.G) : F.G, first = F.G - nlight;
    for (int it = 0; it < 2; ++it) { int task;
        if (F.bid >= first) task = (F.bid - first) + it * nlight; else { if (it) break; task = 2 * nlight + (first - 1 - F.bid); }
        if (task >= NTASK) break;
        if (!staged) { skinny_stage<DM>(F.lds, (const bf16_t*)(F.ws + WS_H) + (size_t)MPT * DM, DM, F.tid); staged = true; }
        const int n0 = task * 128 + F.wave * 16; f32x4 d[2];
        skinny_tile<DM>(F.lds, W, DM, n0, 0, DM, F.lane, d[0], d[1]);
        const int n = n0 + 4 * (F.lane >> 4), pn = n >> 8;
        int mode; if (pn < 4) mode = 0; else if (pn < 8) mode = 1; else if (pn < 12) mode = 5; else if (pn < 16) mode = 3; else if (pn < 18) mode = 0;
        else if (pn < 22) mode = 1; else if (pn < 26) mode = 0; else if (pn < 30) mode = 1; else if (pn < 54) mode = 2; else mode = 4;
#pragma unroll
        for (int tt = 0; tt < 2; ++tt) { const int t = 16 * tt + (F.lane & 15), row = MPT + t; f32x4 v = d[tt];
            if (mode == 4) { const int c = n - C_AG; if (c < 48) {
#pragma unroll
                for (int j = 0; j < 4; ++j) v[j] = sigmoidf_(v[j]);
                *(f32x4*)(gate + (size_t)row * 64 + c) = v; } }
            else {
                if (mode == 3) *(f32x4*)(F.out + O_KVS + ((size_t)l * 32 + t) * 1024 + n - C_CK) = v;
                if (mode == 5) v = v * SM_SCALE_L2E;
                if (mode == 1) {
#pragma unroll
                    for (int j = 0; j < 4; ++j) v[j] = siluf_(v[j]); }
                if (mode == 2) {
#pragma unroll
                    for (int j = 0; j < 4; ++j) v[j] = sigmoidf_(v[j]); }
                *(u32x2*)(P + (size_t)row * NPROJ + n) = pack4(v);
            } }
    }
    __syncthreads();
}
__device__ __forceinline__ void skinny_pool(Frame& F, int l) {
    const bf16_t* P = (const bf16_t*)(F.ws + WS_P); bf16_t* apool = (bf16_t*)(F.ws + WS_ABR);
    const bf16_t* W = (const bf16_t*)(F.ws + WS_WPOOL + l * al1m(SZ_WPOOL)); const float* pscale = FIN(IN_PSCALE) + l * 1024;
    bool staged = false;
    for (int task = F.G - 1 - F.bid; task < 8; task += F.G) {
        if (!staged) { skinny_stage<1024>(F.lds, (const bf16_t*)(F.ws + WS_DIFF) + (size_t)MPT * 1024, 1024, F.tid); staged = true; }
        const int z = task >> 1, n0 = (task & 1) * 128 + F.wave * 16; f32x4 d[2];
        skinny_tile<1024>(F.lds, W + (size_t)z * 65536, 256, n0, z * 256, 256, F.lane, d[0], d[1]);
        const int col = z * 256 + n0 + 4 * (F.lane >> 4);
        const f32x4 ps = *(const f32x4*)(pscale + col);
#pragma unroll
        for (int tt = 0; tt < 2; ++tt) { const int row = MPT + 16 * tt + (F.lane & 15);
            const f32x4 zf = unpack4(*(const u32x2*)(P + (size_t)row * NPROJ + C_PZ + col));
            *(u32x2*)(apool + (size_t)row * 1024 + col) = pack4(d[tt] * ps * zf); }
    }
    __syncthreads();
}
__device__ __forceinline__ void skinny_glu(Frame& F, int l) {
    const bf16_t* P = (const bf16_t*)(F.ws + WS_P); const bf16_t* Z = (const bf16_t*)(F.ws + WS_Z); bf16_t* assm = (bf16_t*)(F.ws + WS_ABR + 2 * SZ_ABR1);
    const bf16_t* W = (const bf16_t*)(F.ws + WS_WGLU + l * al1m(SZ_WGLU));
    bool staged = false;
    for (int task = F.G - 1 - F.bid; task < 8; task += F.G) {
        if (!staged) { skinny_stage<1024>(F.lds, Z + (size_t)MPT * 1024, 1024, F.tid); staged = true; }
        const int n0 = task * 128 + F.wave * 16; f32x4 d[2];
        skinny_tile<1024>(F.lds, W, 1024, n0, 0, 1024, F.lane, d[0], d[1]);
        const int col = n0 + 4 * (F.lane >> 4);
#pragma unroll
        for (int tt = 0; tt < 2; ++tt) { const int row = MPT + 16 * tt + (F.lane & 15);
            const f32x4 zf = unpack4(*(const u32x2*)(Z + (size_t)row * 1024 + col)), sf = unpack4(*(const u32x2*)(P + (size_t)row * NPROJ + C_SZ + col));
            f32x4 v = d[tt];
#pragma unroll
            for (int j = 0; j < 4; ++j) v[j] = zf[j] * sigmoidf_(v[j]) * sf[j];
            *(u32x2*)(assm + (size_t)row * 1024 + col) = pack4(v); }
    }
    __syncthreads();
}
__device__ __forceinline__ void skinny_branch(Frame& F, int l) {
    const bf16_t* P = (const bf16_t*)(F.ws + WS_P); float* brp = (float*)(F.ws + WS_BRP);
    const bf16_t* W = (const bf16_t*)(F.ws + WS_WBR + l * al1m(SZ_WBR));
    for (int task = F.G - 1 - F.bid; task < 48; task += F.G) {
        const int z = task >> 4, n0 = (task & 15) * 128 + F.wave * 16; f32x4 d[2];
        __syncthreads();
        skinny_stage<1024>(F.lds, (const bf16_t*)(F.ws + WS_ABR) + (size_t)z * MPAD * 1024 + (size_t)MPT * 1024, 1024, F.tid);
        skinny_tile<1024>(F.lds, W + (size_t)z * 2048 * 1024, 1024, n0, 0, 1024, F.lane, d[0], d[1]);
        const int col = n0 + 4 * (F.lane >> 4);
#pragma unroll
        for (int tt = 0; tt < 2; ++tt) { const int t = 16 * tt + (F.lane & 15), row = MPT + t;
            const f32x4 gm = unpack4(*(const u32x2*)(P + (size_t)row * NPROJ + C_MG + z * 2048 + col));
            *(f32x4*)(brp + ((size_t)z * 32 + t) * DM + col) = d[tt] * gm; }
    }
    __syncthreads();
}
__device__ __forceinline__ void skinny_out(Frame& F, int l) {
    const float* brp = (const float*)(F.ws + WS_BRP); bf16_t* outb = (bf16_t*)(F.ws + WS_OUTB);
    const bf16_t* W = (const bf16_t*)(F.ws + WS_WOUT + l * al1m(SZ_WOUT));
    bool staged = false;
    for (int task = F.G - 1 - F.bid; task < 64; task += F.G) {
        if (!staged) {
#pragma unroll 4
            for (int i = F.tid; i < 32 * (DM / 4); i += NT) { const int r = i / (DM / 4), c = i % (DM / 4);
                const f32x4 s = *(const f32x4*)(brp + (size_t)r * DM + 4 * c) + *(const f32x4*)(brp + (size_t)(32 + r) * DM + 4 * c) + *(const f32x4*)(brp + (size_t)(64 + r) * DM + 4 * c);
                *(LAS u32x2*)(F.lds + r * (DM * 2 + 16) + c * 8) = pack4(s); }
            __syncthreads(); staged = true; }
        const int tile = F.wave & 1, kq = F.wave >> 1, n0 = task * 32 + tile * 16; f32x4 d[2];
        skinny_tile<DM>(F.lds, W + kq * 512, DM, n0, kq * 512, 512, F.lane, d[0], d[1]);
        __syncthreads();
        LAS f32x4* red = (LAS f32x4*)F.lds;
        red[(F.wave * 2 + 0) * 64 + F.lane] = d[0]; red[(F.wave * 2 + 1) * 64 + F.lane] = d[1];
        staged = false;
        __syncthreads();
        if (kq == 0) {
#pragma unroll
            for (int tt = 0; tt < 2; ++tt) { f32x4 a = d[tt];
#pragma unroll
                for (int k2 = 1; k2 < 4; ++k2) a += red[((2 * k2 + tile) * 2 + tt) * 64 + F.lane];
                *(u32x2*)(outb + (size_t)(MPT + 16 * tt + (F.lane & 15)) * DM + n0 + 4 * (F.lane >> 4)) = pack4(a); } }
        __syncthreads();
    }
    __syncthreads();
}
__device__ __forceinline__ int keypos(int key) { return (key & ~12) | ((key & 4) << 1) | ((key & 8) >> 1); }

template <int W>
__device__ __forceinline__ void pool_diff_load(const bf16_t* P, const float* spool, int m, int c0, f32x4 (&v)[W]) {
    if (m < MPT) {
        const int s = m & (SEQ - 1);
#pragma unroll
        for (int j = 0; j < W; ++j) v[j] = (j <= s) ? unpack4(*(const u32x2*)(P + (size_t)(m - j) * NPROJ + C_PU + c0)) : (f32x4){0.f, 0.f, 0.f, 0.f};
    } else {
        const int b = (m - MPT) >> 2, i = (m - MPT) & 3;
#pragma unroll
        for (int j = 0; j < W; ++j) { const int idx = 15 + i - j;
            v[j] = (idx >= 15) ? unpack4(*(const u32x2*)(P + (size_t)(MPT + b * 4 + idx - 15) * NPROJ + C_PU + c0)) : *(const f32x4*)(spool + ((size_t)b * 15 + idx) * 1024 + c0); }
    }
}
template <int W>
__device__ __forceinline__ void pool_diff_store(bf16_t* D, int m, int c0, const f32x4 (&v)[W]) {
    int cnt = W; if (m < MPT) { const int s = m & (SEQ - 1); cnt = (s + 1 < W) ? s + 1 : W; }
    f32x4 sum = v[0];
#pragma unroll
    for (int j = 1; j < W; ++j) sum += v[j];
    *(u32x2*)(D + (size_t)m * 1024 + c0) = pack4(sum * (1.f / (float)cnt) - v[0]);
}
__device__ __forceinline__ void s2_pool_diff(Frame& F, int l) {
    const bf16_t* P = (const bf16_t*)(F.ws + WS_P); bf16_t* D = (bf16_t*)(F.ws + WS_DIFF);
    const float* spool = FIN(IN_SPOOL) + (size_t)l * SB * 15 * 1024;
    const int c0 = 4 * F.lane;
    for (int m = F.gw; m < MROWS; m += F.ngw) {
        f32x4 v2[2], v4[4], v8[8], v16[16];
        pool_diff_load<2>(P, spool, m, c0, v2); pool_diff_load<4>(P, spool, m, 256 + c0, v4); pool_diff_load<8>(P, spool, m, 512 + c0, v8); pool_diff_load<16>(P, spool, m, 768 + c0, v16);
        pool_diff_store<2>(D, m, c0, v2); pool_diff_store<4>(D, m, 256 + c0, v4); pool_diff_store<8>(D, m, 512 + c0, v8); pool_diff_store<16>(D, m, 768 + c0, v16);
    }
}

__device__ __forceinline__ void store8f(float* dst, const u32x4& x) { float f[8]; unpack8(x, f); *(f32x4*)dst = (f32x4){f[0], f[1], f[2], f[3]}; *(f32x4*)(dst + 4) = (f32x4){f[4], f[5], f[6], f[7]}; }

__device__ __forceinline__ void s2_state_outputs(Frame& F, int l) {
    const bf16_t* P = (const bf16_t*)(F.ws + WS_P);
    const int gt = F.gw * 64 + F.lane, ngt = F.ngw * 64;
    for (int it = gt; it < PB * 15 * 128; it += ngt) { const int c0 = (it & 127) * 8, r = (it >> 7) % 15, b = (it >> 7) / 15;
        store8f(F.out + O_POOLP + (((size_t)l * PB + b) * 15 + r) * 1024 + c0, *(const u32x4*)(P + (size_t)(b * SEQ + SEQ - 15 + r) * NPROJ + C_PU + c0)); }
    for (int it = gt; it < SB * 15 * 128; it += ngt) { const int c0 = (it & 127) * 8, r = (it >> 7) % 15, b = (it >> 7) / 15, e = 4 + r;
        float* dst = F.out + O_POOLS + (((size_t)l * SB + b) * 15 + r) * 1024 + c0;
        if (e < 15) { const float* sp = FIN(IN_SPOOL) + (((size_t)l * SB + b) * 15 + e) * 1024 + c0; *(f32x4*)dst = *(const f32x4*)sp; *(f32x4*)(dst + 4) = *(const f32x4*)(sp + 4); }
        else store8f(dst, *(const u32x4*)(P + (size_t)(MPT + b * 4 + e - 15) * NPROJ + C_PU + c0)); }
    for (int it = gt; it < PB * 512 * 64; it += ngt) { const int c0 = (it & 63) * 8, r = (it >> 6) & 511, b = it >> 15;
        store8f(F.out + O_WINP + (((size_t)l * PB + b) * 512 + r) * 512 + c0, *(const u32x4*)(P + (size_t)(b * SEQ + SEQ - 512 + r) * NPROJ + C_WK + c0)); }
    for (int it = gt; it < SB * 512 * 64; it += ngt) { const int c0 = (it & 63) * 8, r = (it >> 6) & 511, b = it >> 15;
        float* dst = F.out + O_WINS + (((size_t)l * SB + b) * 512 + r) * 512 + c0;
        if (r < 508) { const float* sp = FIN(IN_SWIN) + (((size_t)l * SB + b) * 512 + r + 4) * 512 + c0; *(f32x4*)dst = *(const f32x4*)sp; *(f32x4*)(dst + 4) = *(const f32x4*)(sp + 4); }
        else store8f(dst, *(const u32x4*)(P + (size_t)(MPT + b * 4 + r - 508) * NPROJ + C_WK + c0)); }
}

__device__ __forceinline__ void s2_vt_images(Frame& F) {
    const bf16_t* P = (const bf16_t*)(F.ws + WS_P);
    for (int it = F.gw; it < 2 * PB * 4 * 64; it += F.ngw) {
        const int which = it >> 9, b = (it >> 8) & 1, kvh = (it >> 6) & 3, blk = it & 63;
        const bf16_t* src = P + (size_t)(b * SEQ + blk * 64 + F.lane) * NPROJ + (which ? C_WK : C_SK) + kvh * 64;
        bf16_t* img = (bf16_t*)(F.ws + (which ? WS_KTWIN : WS_KTSEL)) + (size_t)((b * 4 + kvh) * 64 + blk) * 4096 + F.lane * 8;
        u32x4 v[8];
#pragma unroll
        for (int j = 0; j < 8; ++j) v[j] = *(const u32x4*)(src + 8 * j);
#pragma unroll
        for (int j = 0; j < 8; ++j) *(u32x4*)(img + j * 512) = v[j];
    }
    for (int it = F.gw; it < 2 * PB * 4 * 64; it += F.ngw) {
        const int which = it >> 9, b = (it >> 8) & 1, kvh = (it >> 6) & 3, blk = it & 63;
        const bf16_t* src = P + (size_t)(b * SEQ + blk * 64 + F.lane) * NPROJ + (which ? C_WV : C_SV) + kvh * 64;
        const int pos = keypos(F.lane);
        bf16_t* img = (bf16_t*)(F.ws + (which ? WS_VTWIN : WS_VTSEL)) + (size_t)((b * 4 + kvh) * 64 + blk) * 4096 + (pos >> 3) * 512 + (pos & 7);
        u32x4 v[8];
#pragma unroll
        for (int j = 0; j < 8; ++j) v[j] = *(const u32x4*)(src + 8 * j);
#pragma unroll
        for (int j = 0; j < 8; ++j) {
            img[(8 * j + 0) * 8] = (bf16_t)(v[j].x & 0xffffu); img[(8 * j + 1) * 8] = (bf16_t)(v[j].x >> 16);
            img[(8 * j + 2) * 8] = (bf16_t)(v[j].y & 0xffffu); img[(8 * j + 3) * 8] = (bf16_t)(v[j].y >> 16);
            img[(8 * j + 4) * 8] = (bf16_t)(v[j].z & 0xffffu); img[(8 * j + 5) * 8] = (bf16_t)(v[j].z >> 16);
            img[(8 * j + 6) * 8] = (bf16_t)(v[j].w & 0xffffu); img[(8 * j + 7) * 8] = (bf16_t)(v[j].w >> 16); }
    }
}

template <bool SAMPLE>
__device__ __forceinline__ void compress_unit(Frame& F, int l, int unit) {
    const int lane = F.lane, w = F.wave, col = lane & 15, q = lane >> 4, nl = col >> 2, k = col & 3;
    const int b = SAMPLE ? unit >> 5 : unit >> 3, n0 = SAMPLE ? (unit & 31) * 8 : (unit & 7) * 8;
    const bf16_t* wphi = (const bf16_t*)(F.ws + WS_WPHI + l * al1m(SZ_WPHI));
    const bf16_t* P = (const bf16_t*)(F.ws + WS_P);
    const float* cache = FIN(IN_CACHE); const int* pt = (const int*)FIN(IN_PT);
    f32x4 acc[2][2][4];
#pragma unroll
    for (int j = 0; j < 2; ++j)
#pragma unroll
        for (int nt = 0; nt < 2; ++nt)
#pragma unroll
            for (int et = 0; et < 4; ++et) acc[j][nt][et] = (f32x4){0.f, 0.f, 0.f, 0.f};
    size_t xoff[2];
#pragma unroll
    for (int nt = 0; nt < 2; ++nt) { const int blk = n0 + 4 * nt + nl;
        if (SAMPLE) { const int page = pt[b * 128 + (blk >> 1)]; xoff[nt] = ((((size_t)l * NPOOL + page) * 128 + (blk & 1) * 64) * 4) * 256 + k * 64 + 8 * q; }
        else xoff[nt] = (size_t)(b * SEQ + blk * 64) * NPROJ + C_CK + k * 64 + 8 * q; }
    bf16x8 ra[2][2][4];
    f32x4 rx[2][2][2][2];
#define CMP_LOAD(J, LPOS) do { _Pragma("unroll") for (int dc = 0; dc < 2; ++dc) { \
        _Pragma("unroll") for (int et = 0; et < 4; ++et) ra[J][dc][et] = *(const bf16x8*)(wphi + ((size_t)((J) * 64 + (LPOS)) * 64 + 16 * et + col) * 64 + 32 * dc + 8 * q); \
        _Pragma("unroll") for (int nt = 0; nt < 2; ++nt) { \
            if (SAMPLE) { const float* s_ = cache + xoff[nt] + ((size_t)(LPOS) * 4 + (J)) * 256 + 32 * dc; rx[J][dc][nt][0] = __builtin_nontemporal_load((const f32x4*)s_); rx[J][dc][nt][1] = __builtin_nontemporal_load((const f32x4*)(s_ + 4)); } \
            else rx[J][dc][nt][0] = __builtin_bit_cast(f32x4, *(const bf16x8*)(P + xoff[nt] + (size_t)(LPOS) * NPROJ + (J) * 256 + 32 * dc)); } } } while (0)
#define CMP_MMA(J) do { _Pragma("unroll") for (int dc = 0; dc < 2; ++dc) _Pragma("unroll") for (int nt = 0; nt < 2; ++nt) { \
        const bf16x8 bx_ = SAMPLE ? __builtin_bit_cast(bf16x8, pack8(rx[J][dc][nt][0], rx[J][dc][nt][1])) : __builtin_bit_cast(bf16x8, rx[J][dc][nt][0]); \
        _Pragma("unroll") for (int et = 0; et < 4; ++et) acc[J][nt][et] = __builtin_amdgcn_mfma_f32_16x16x32_bf16(ra[J][dc][et], bx_, acc[J][nt][et], 0, 0, 0); } } while (0)
    CMP_LOAD(0, w * 8);
#pragma unroll 1
    for (int li = 0; li < 8; ++li) { const int lpos = w * 8 + li;
        CMP_LOAD(1, lpos); __builtin_amdgcn_sched_barrier(0);
        CMP_MMA(0); __builtin_amdgcn_sched_barrier(0);
        if (li < 7) CMP_LOAD(0, lpos + 1);
        __builtin_amdgcn_sched_barrier(0);
        CMP_MMA(1); __builtin_amdgcn_sched_barrier(0);
    }
#undef CMP_LOAD
#undef CMP_MMA
    LAS float* red = (LAS float*)F.lds;
#pragma unroll
    for (int j = 0; j < 2; ++j)
#pragma unroll
        for (int nt = 0; nt < 2; ++nt)
#pragma unroll
            for (int et = 0; et < 4; ++et)
#pragma unroll
                for (int i = 0; i < 4; ++i) red[(w * 64 + ((j * 2 + nt) * 4 + et) * 4 + i) * 64 + lane] = acc[j][nt][et][i];
    __syncthreads();
    const LAS float* pb = (const LAS float*)(F.lds + 131072);
    bf16_t* kc = (bf16_t*)(F.ws + (SAMPLE ? WS_KCS : WS_KCP)); bf16_t* vct = (bf16_t*)(F.ws + (SAMPLE ? WS_VCTS : WS_VCTP));
    constexpr int NBLK = SAMPLE ? 256 : 64;
    for (int o = F.tid; o < 4096; o += NT) { const int r = o >> 6, ln = o & 63;
        float s = 0.f;
#pragma unroll
        for (int ww = 0; ww < 8; ++ww) s += red[(ww * 64 + r) * 64 + ln];
        const int j = r >> 5, nt = (r >> 4) & 1, et = (r >> 2) & 3, i = r & 3, e = 16 * et + 4 * (ln >> 4) + i, cc = ln & 15, blk = n0 + 4 * nt + (cc >> 2), kk = cc & 3;
        s += pb[j * 64 + e];
        if (j == 0) kc[((size_t)(b * 4 + kk) * NBLK + blk) * 64 + e] = (bf16_t)f2bf(s);
        else vct[(((size_t)(b * 4 + kk) * (NBLK / 64) + (blk >> 6)) * 64 + e) * 64 + keypos(blk & 63)] = (bf16_t)f2bf(s);
    }
    __syncthreads();
}

__device__ __forceinline__ void compress_prompt_piece(Frame& F, int l, int piece) {
    const int lane = F.lane, w = F.wave, col = lane & 15, q = lane >> 4, nl = col >> 2, k = col & 3;
    const int ntile = piece >> 3, j = (piece >> 2) & 1, et = piece & 3, b = ntile >> 4, n0 = (ntile & 15) * 4;
    const bf16_t* wphi = (const bf16_t*)(F.ws + WS_WPHI + l * al1m(SZ_WPHI)) + ((size_t)(j * 64) * 64 + 16 * et + col) * 64 + 8 * q;
    const bf16_t* xp = (const bf16_t*)(F.ws + WS_P) + (size_t)(b * SEQ + (n0 + nl) * 64) * NPROJ + C_CK + j * 256 + k * 64 + 8 * q;
    bf16x8 a[16], x[16];
#pragma unroll
    for (int li = 0; li < 8; ++li)
#pragma unroll
        for (int dc = 0; dc < 2; ++dc) { const int lpos = w * 8 + li;
            a[li * 2 + dc] = *(const bf16x8*)(wphi + (size_t)lpos * 4096 + 32 * dc); x[li * 2 + dc] = *(const bf16x8*)(xp + (size_t)lpos * NPROJ + 32 * dc); }
    f32x4 acc = {0.f, 0.f, 0.f, 0.f};
#pragma unroll
    for (int i = 0; i < 16; ++i) acc = __builtin_amdgcn_mfma_f32_16x16x32_bf16(a[i], x[i], acc, 0, 0, 0);
    LAS float* red = (LAS float*)F.lds;
    __syncthreads();
#pragma unroll
    for (int i = 0; i < 4; ++i) red[(w * 4 + i) * 64 + lane] = acc[i];
    __syncthreads();
    if (F.tid < 256) { const int i = F.tid >> 6, ln = F.tid & 63; float s = 0.f;
#pragma unroll
        for (int ww = 0; ww < 8; ++ww) s += red[(ww * 4 + i) * 64 + ln];
        const int e = 16 * et + 4 * (ln >> 4) + i, cc = ln & 15, blk = n0 + (cc >> 2), kk = cc & 3;
        s += ((const LAS float*)(F.lds + 131072))[j * 64 + e];
        if (j == 0) ((bf16_t*)(F.ws + WS_KCP))[(size_t)(b * 4 + kk) * 4096 + (e >> 3) * 512 + blk * 8 + (e & 7)] = (bf16_t)f2bf(s);
        else { const int pos = keypos(blk); ((bf16_t*)(F.ws + WS_VCTP))[(size_t)(b * 4 + kk) * 4096 + (pos >> 3) * 512 + e * 8 + (pos & 7)] = (bf16_t)f2bf(s); } }
    __syncthreads();
}

__device__ __forceinline__ void s2_compress(Frame& F, int l) {
    if (F.tid < 128) { const float* pp = (const float*)(F.ws + WS_PEBP + l * al1m(SZ_PEBP)); float s = 0.f;
#pragma unroll
        for (int p = 0; p < 16; ++p) s += pp[((F.tid >> 6) * 16 + p) * 64 + (F.tid & 63)];
        ((LAS float*)(F.lds + 131072))[F.tid] = s; }
    __syncthreads();
    for (int u = F.bid; u < 256; u += F.G) compress_unit<true>(F, l, u);
    for (int u = F.bid; u < 256; u += F.G) compress_prompt_piece(F, l, u);
}

#ifndef NSA_SGB
#define NSA_SGB 1
#endif
#define MFMA32(a, b, c) __builtin_amdgcn_mfma_f32_32x32x16_bf16((a), (b), (c), 0, 0, 0)
constexpr float NEG_BIG = -1e30f;
constexpr int AL_K = 0, AL_V = 8192, AL_SLOT = 16384  , AL_MASK = 4 * AL_SLOT  , AL_UNION = AL_MASK + 512,
              AL_TOT = 66560  , AL_IMP = AL_TOT  ;
__device__ __forceinline__ void dma16(const void* src, LAS unsigned char* dst) { __builtin_amdgcn_global_load_lds((const unsigned*)src, (LAS unsigned*)dst, 16, 0, 0); }
__device__ __forceinline__ void tile_dma(const bf16_t* kimg, const bf16_t* vimg, LAS unsigned char* slot, int w, int lane) {
    dma16(kimg + (unsigned)w * 512u + 8u * (unsigned)lane, slot + AL_K + w * 1024);
    dma16(vimg + (unsigned)w * 512u + 8u * (unsigned)lane, slot + AL_V + w * 1024);
}

template <int CTRL> __device__ __forceinline__ float quad_xor(float x) { return __int_as_float(__builtin_amdgcn_update_dpp(0, __float_as_int(x), CTRL, 0xF, 0xF, false)); }
struct FlashState { f32x16 o[2]; float m, l; };
__device__ __forceinline__ void flash_reset(FlashState& S) {
#pragma unroll
    for (int i = 0; i < 16; ++i) { S.o[0][i] = 0.f; S.o[1][i] = 0.f; }
    S.m = 0.f; S.l = 0.f;
}
__device__ __forceinline__ void flash_scores(const LAS unsigned char* kbuf, const bf16x8 (&qf)[4], int r, int h, float init, f32x16& s0, f32x16& s1) {
    bf16x8 kf[8];
#pragma unroll
    for (int ks = 0; ks < 4; ++ks) { kf[2 * ks] = *(const LAS bf16x8*)(kbuf + (2 * ks + h) * 1024 + r * 16); kf[2 * ks + 1] = *(const LAS bf16x8*)(kbuf + (2 * ks + h) * 1024 + (32 + r) * 16); }
    __builtin_amdgcn_sched_barrier(0);
#pragma unroll
    for (int i = 0; i < 16; ++i) { s0[i] = init; s1[i] = init; }
#pragma unroll
    for (int ks = 0; ks < 4; ++ks) { s0 = MFMA32(kf[2 * ks], qf[ks], s0); s1 = MFMA32(kf[2 * ks + 1], qf[ks], s1); }
}
__device__ __forceinline__ bf16x8 pack_p(const f32x16& p, int s) {
    u32x4 w; w.x = pk2(p[8 * s], p[8 * s + 1]); w.y = pk2(p[8 * s + 2], p[8 * s + 3]); w.z = pk2(p[8 * s + 4], p[8 * s + 5]); w.w = pk2(p[8 * s + 6], p[8 * s + 7]);
    return __builtin_bit_cast(bf16x8, w);
}
__device__ __forceinline__ void flash_vload(const LAS unsigned char* vbuf, int r, int h, bf16x8 (&vf)[8]) {
#pragma unroll
    for (int sub = 0; sub < 2; ++sub)
#pragma unroll
        for (int s = 0; s < 2; ++s)
#pragma unroll
            for (int dt = 0; dt < 2; ++dt) vf[(sub * 2 + s) * 2 + dt] = *(const LAS bf16x8*)(vbuf + (4 * sub + 2 * s + h) * 1024 + (32 * dt + r) * 16);
    __builtin_amdgcn_sched_barrier(0);
}
__device__ __forceinline__ void flash_pv(const bf16x8 (&vf)[8], const f32x16& p0, const f32x16& p1, f32x16 (&o)[2]) {
#pragma unroll
    for (int sub = 0; sub < 2; ++sub)
#pragma unroll
        for (int s = 0; s < 2; ++s) {
            const bf16x8 pb = pack_p(sub ? p1 : p0, s);
#pragma unroll
            for (int dt = 0; dt < 2; ++dt) o[dt] = MFMA32(vf[(sub * 2 + s) * 2 + dt], pb, o[dt]);
        }
}
__device__ __forceinline__ float xhalf_max(float x) {
    const auto r = __builtin_amdgcn_permlane32_swap(__float_as_uint(x), __float_as_uint(x), false, false);
    return fmaxf(__uint_as_float(r[0]), __uint_as_float(r[1]));
}
__device__ __forceinline__ void flash_mask(f32x16& s0, f32x16& s1, int lo, int hi, int h) {
#pragma unroll
    for (int i = 0; i < 16; ++i) { const int key = (i & 3) + 8 * (i >> 2) + 4 * h;
        s0[i] = (key >= lo && key <= hi) ? s0[i] : -INFINITY; s1[i] = (key + 32 >= lo && key + 32 <= hi) ? s1[i] : -INFINITY; }
}
__device__ __forceinline__ float flash_rowmax(const f32x16& s0, const f32x16& s1) {
    float mx = -INFINITY;
#pragma unroll
    for (int i = 0; i < 16; ++i) asm("v_max3_f32 %0, %1, %2, %3" : "=v"(mx) : "v"(mx), "v"(s0[i]), "v"(s1[i]));
    return xhalf_max(mx);
}
__device__ __forceinline__ void flash_first(FlashState& S, f32x16& s0, f32x16& s1, int lo, int hi, int h, bool masked) {
    if (masked) flash_mask(s0, s1, lo, hi, h);
    S.m = fmaxf(flash_rowmax(s0, s1), NEG_BIG);
    float ls = 0.f;
#pragma unroll
    for (int i = 0; i < 16; ++i) { s0[i] = __builtin_amdgcn_exp2f(s0[i] - S.m); s1[i] = __builtin_amdgcn_exp2f(s1[i] - S.m); ls += s0[i] + s1[i]; }
    S.l = ls;
}
__device__ __forceinline__ void flash_next(FlashState& S, f32x16& s0, f32x16& s1, float mused, int lo, int hi, int h, bool masked, bool first) {
    if (masked) flash_mask(s0, s1, lo, hi, h);
    const float corr = S.m - mused;
    if (__ballot(corr != 0.f) != 0ull) {
#pragma unroll
        for (int i = 0; i < 16; ++i) { s0[i] -= corr; s1[i] -= corr; } }
    const float mx = flash_rowmax(s0, s1);
    if (__ballot(mx > SM_THR || (first && mx < -SM_THR)) != 0ull) {
        const float d = (mx > NEG_BIG) ? (first ? mx : fmaxf(mx, 0.f)) : 0.f, alpha = __builtin_amdgcn_exp2f(-d);
        S.m += d; S.l *= alpha;
#pragma unroll
        for (int i = 0; i < 16; ++i) { S.o[0][i] *= alpha; S.o[1][i] *= alpha; s0[i] -= d; s1[i] -= d; }
    }
    float ls = 0.f;
#pragma unroll
    for (int i = 0; i < 16; ++i) { s0[i] = __builtin_amdgcn_exp2f(s0[i]); s1[i] = __builtin_amdgcn_exp2f(s1[i]); ls += s0[i] + s1[i]; }
    S.l += ls;
}

__device__ __forceinline__ void flash_kload(const LAS unsigned char* kbuf, int r, int h, bf16x8 (&kf)[8]) {
#pragma unroll
    for (int ks = 0; ks < 4; ++ks) { kf[2 * ks] = *(const LAS bf16x8*)(kbuf + (2 * ks + h) * 1024 + r * 16); kf[2 * ks + 1] = *(const LAS bf16x8*)(kbuf + (2 * ks + h) * 1024 + (32 + r) * 16); }
    __builtin_amdgcn_sched_barrier(0);
}
struct TileCtl { bool en, masked; int lo, hi; };
__device__ __forceinline__ void flash_pair(FlashState& S, const LAS unsigned char* ka, const LAS unsigned char* va, const LAS unsigned char* kb2, const LAS unsigned char* vb2,
                                           const bf16x8 (&qf)[4], const TileCtl& A, const TileCtl& B, bool first, int r, int h) {
    bf16x8 kf[8]; f32x16 a0, a1, b0, b1;
    flash_kload(ka, r, h, kf);
    { const float init = A.en ? -S.m : -INFINITY;
#pragma unroll
        for (int i = 0; i < 16; ++i) { a0[i] = init; a1[i] = init; }
#pragma unroll
        for (int ks = 0; ks < 4; ++ks) { a0 = MFMA32(kf[2 * ks], qf[ks], a0); a1 = MFMA32(kf[2 * ks + 1], qf[ks], a1); } }
    if (A.masked) flash_mask(a0, a1, A.lo, A.hi, h);
    { const float mx = flash_rowmax(a0, a1);
        if (__ballot(mx > SM_THR || (first && mx < -SM_THR)) != 0ull) { const float d = (mx > NEG_BIG) ? (first ? mx : fmaxf(mx, 0.f)) : 0.f, alpha = __builtin_amdgcn_exp2f(-d); S.m += d; S.l *= alpha;
#pragma unroll
            for (int i = 0; i < 16; ++i) { S.o[0][i] *= alpha; S.o[1][i] *= alpha; a0[i] -= d; a1[i] -= d; } } }
    flash_kload(kb2, r, h, kf);
    { const float init = B.en ? -S.m : -INFINITY;
#pragma unroll
        for (int i = 0; i < 16; ++i) { b0[i] = init; b1[i] = init; } }
    __builtin_amdgcn_sched_barrier(0);
#pragma unroll
    for (int k = 0; k < 8; ++k) {
        if (k & 1) b1 = MFMA32(kf[k], qf[k >> 1], b1); else b0 = MFMA32(kf[k], qf[k >> 1], b0);
#pragma unroll
        for (int e = 0; e < 4; ++e) { const int idx = 4 * k + e;
            if (idx < 16) { float t = __builtin_amdgcn_exp2f(a0[idx]); asm volatile("" : "+v"(t)); a0[idx] = t; }
            else { float t = __builtin_amdgcn_exp2f(a1[idx - 16]); asm volatile("" : "+v"(t)); a1[idx - 16] = t; } }
        __builtin_amdgcn_sched_barrier(0);
    }
    bf16x8 pa[4]; float ls = 0.f;
#pragma unroll
    for (int i = 0; i < 16; ++i) ls += a0[i] + a1[i];
    pa[0] = pack_p(a0, 0); pa[1] = pack_p(a0, 1); pa[2] = pack_p(a1, 0); pa[3] = pack_p(a1, 1);
    S.l += ls;
    __builtin_amdgcn_sched_barrier(0);
    if (B.masked) flash_mask(b0, b1, B.lo, B.hi, h);
    float alphaB = 1.f;
    { const float mx = flash_rowmax(b0, b1);
        if (__ballot(mx > SM_THR) != 0ull) { const float d = (mx > NEG_BIG) ? fmaxf(mx, 0.f) : 0.f; alphaB = __builtin_amdgcn_exp2f(-d); S.m += d; S.l *= alphaB;
#pragma unroll
            for (int i = 0; i < 16; ++i) { b0[i] -= d; b1[i] -= d; } } }
    { bf16x8 vf[8]; flash_vload(va, r, h, vf);
#pragma unroll
        for (int k = 0; k < 8; ++k) {
            S.o[k & 1] = MFMA32(vf[k], pa[k >> 1], S.o[k & 1]);
#pragma unroll
            for (int e = 0; e < 4; ++e) { const int idx = 4 * k + e;
                if (idx < 16) { float t = __builtin_amdgcn_exp2f(b0[idx]); asm volatile("" : "+v"(t)); b0[idx] = t; }
                else { float t = __builtin_amdgcn_exp2f(b1[idx - 16]); asm volatile("" : "+v"(t)); b1[idx - 16] = t; } }
            __builtin_amdgcn_sched_barrier(0);
        }
    }
    __builtin_amdgcn_sched_barrier(0);
    if (__ballot(alphaB != 1.f) != 0ull) {
#pragma unroll
        for (int i = 0; i < 16; ++i) { S.o[0][i] *= alphaB; S.o[1][i] *= alphaB; } }
    { bf16x8 vf[8]; flash_vload(vb2, r, h, vf);
        bf16x8 pb[4]; pb[0] = pack_p(b0, 0); pb[1] = pack_p(b0, 1); pb[2] = pack_p(b1, 0); pb[3] = pack_p(b1, 1);
        float l0 = 0.f, l1 = 0.f;
        __builtin_amdgcn_sched_barrier(0);
#pragma unroll
        for (int k = 0; k < 8; ++k) {
            S.o[k & 1] = MFMA32(vf[k], pb[k >> 1], S.o[k & 1]);
#pragma unroll
            for (int e = 0; e < 2; ++e) { const int idx = 2 * k + e; l0 += b0[idx]; l1 += b1[idx]; }
            asm volatile("" : "+v"(l0), "+v"(l1));
            __builtin_amdgcn_sched_barrier(0);
        }
        S.l += l0 + l1; }
}

__device__ __forceinline__ void nsa_prompt_unit(Frame& F, int l, int b, int kvh, int c) {
    int tid = threadIdx.x; asm volatile("" : "+v"(tid));
    const int lane = tid & 63, w = F.wave, r = lane & 31, h = lane >> 5, qi = r >> 2, g = r & 3, qloc = 8 * w + qi;
    const int tok = b * SEQ + 64 * c + qloc, head = kvh * 4 + g;
    const bf16_t* P = (const bf16_t*)(F.ws + WS_P);
    LAS unsigned char* kbuf = F.lds + AL_K; LAS unsigned char* vbuf = F.lds + AL_V;
    LAS float* imp = (LAS float*)(F.lds + AL_IMP); LAS unsigned* msk = (LAS unsigned*)(F.lds + AL_MASK); LAS unsigned* uni = (LAS unsigned*)(F.lds + AL_UNION);
    __syncthreads();
    tile_dma((const bf16_t*)(F.ws + WS_KCP) + (size_t)(b * 4 + kvh) * 4096, (const bf16_t*)(F.ws + WS_VCTP) + (size_t)(b * 4 + kvh) * 4096, F.lds, w, lane);
    bf16x8 qf[4];
#pragma unroll
    for (int ks = 0; ks < 4; ++ks) qf[ks] = *(const bf16x8*)(P + (size_t)tok * NPROJ + C_Q + head * 64 + 16 * ks + 8 * h);
    const float* gt = (const float*)(F.ws + WS_GATE) + (size_t)tok * 64 + head * 3;
    const float g_cmp = gt[0], g_sel = gt[1], g_win = gt[2];
    LAS f32x4* ltot = (LAS f32x4*)(F.lds + AL_TOT) + tid;
    FlashState S;
    {
        if (tid < 128) msk[tid] = 0u; if (tid < 2) uni[tid] = 0u;
        __syncthreads();
        flash_reset(S);
        f32x16 s0, s1; flash_scores(kbuf, qf, r, h, 0.f, s0, s1);
        const int nvalid = c + (qloc == 63 ? 1 : 0);
        bf16x8 vf[8]; flash_vload(vbuf, r, h, vf);
        flash_first(S, s0, s1, 0, nvalid - 1, h, true);
        const float lt = S.l + __shfl_xor(S.l, 32), inv = lt > 0.f ? 1.f / lt : 0.f;
#pragma unroll
        for (int i = 0; i < 16; ++i) { s0[i] *= inv; s1[i] *= inv; }
#pragma unroll
        for (int i = 0; i < 16; ++i) { float a = s0[i]; a += quad_xor<0xB1>(a); a += quad_xor<0x4E>(a); float bq = s1[i]; bq += quad_xor<0xB1>(bq); bq += quad_xor<0x4E>(bq);
            if (g == 0) { const int key = (i & 3) + 8 * (i >> 2) + 4 * h; imp[qloc * 65 + key] = a; imp[qloc * 65 + key + 32] = bq; } }
        flash_pv(vf, s0, s1, S.o);
    }
    __syncthreads();
    {
        const int n = lane; const bool cand = (n >= 1) && (n <= c - 2);
        const unsigned long long forced = 1ull | (1ull << c) | (c >= 1 ? (1ull << (c - 1)) : 0ull);
        unsigned long long um = 0ull;
#pragma unroll 1
        for (int qq = 0; qq < 8; ++qq) { const int q = w * 8 + qq;
            const unsigned kb_ = cand ? ((__float_as_uint(imp[q * 65 + n]) & ~63u) | (unsigned)(63 - n)) : 0u;
            int rank = 0;
            for (int j = 1; j <= c - 2; ++j) { const unsigned sj = __builtin_amdgcn_readlane(kb_, j); rank += (sj > kb_) ? 1 : 0; }
            const unsigned long long m = __ballot(cand && rank < 13) | forced;
            if (lane == 0) { msk[q * 2] = (unsigned)m; msk[q * 2 + 1] = (unsigned)(m >> 32); }
            um |= m; }
        if (lane == 0) { atomicOr((unsigned*)uni, (unsigned)um); atomicOr((unsigned*)(uni + 1), (unsigned)(um >> 32)); }
    }
    __syncthreads();
    const unsigned mlo = msk[qloc * 2], mhi = msk[qloc * 2 + 1], ulo = uni[0], uhi = uni[1];
#pragma unroll
    for (int i4 = 0; i4 < 8; ++i4) { const f32x16& o = S.o[i4 >> 2]; const int i = 4 * (i4 & 3); ltot[i4 * 512] = (f32x4){g_cmp * o[i], g_cmp * o[i + 1], g_cmp * o[i + 2], g_cmp * o[i + 3]}; }
#define NSA_POP(REM_) ((REM_) ? (t_ = sel ? __builtin_ctzll(REM_) : 63 - __builtin_clzll(REM_), (REM_) &= ~(1ull << t_), t_) : -1)
#define NSA_EN(N_) (sel ? ((((N_) < 32 ? mlo >> (N_) : mhi >> ((N_) - 32)) & 1u) != 0u) : true)
#define NSA_LOHI(N_) const int n_ = (N_), lo_ = (!sel && n_ == c - 8) ? qloc + 1 : 0, hi_ = (n_ == c) ? qloc : 63; const bool mk_ = (n_ == c) || (!sel && n_ == c - 8)
#define NSA_PV(SLOT_, S0_, S1_) do { bf16x8 vf[8]; flash_vload(vbuf + (SLOT_), r, h, vf); flash_pv(vf, S0_, S1_, S.o); } while (0)
#pragma unroll 1
    for (int pass = 0; pass < 2; ++pass) {
        const bool sel = pass == 0;
        flash_reset(S);
        const bf16_t* kb = (const bf16_t*)(F.ws + (sel ? WS_KTSEL : WS_KTWIN)) + (size_t)(b * 4 + kvh) * 64 * 4096;
        const bf16_t* vt = (const bf16_t*)(F.ws + (sel ? WS_VTSEL : WS_VTWIN)) + (size_t)(b * 4 + kvh) * 64 * 4096;
        unsigned long long rem;
        if (sel) rem = ((unsigned long long)uhi << 32) | ulo;
        else { const int lo = c >= 8 ? c - 8 : 0; rem = (c == 63 ? ~0ull : ((1ull << (c + 1)) - 1ull)) & ~((1ull << lo) - 1ull); }
        int t_;
        int tA = NSA_POP(rem), tB = NSA_POP(rem);
        int pr = 0; bool first = true;
        __syncthreads();
        tile_dma(kb + (size_t)tA * 4096, vt + (size_t)tA * 4096, F.lds, w, lane);
        if (tB >= 0) tile_dma(kb + (size_t)tB * 4096, vt + (size_t)tB * 4096, F.lds + AL_SLOT, w, lane);
        for (;;) {
            const int sa = pr, sb = pr + AL_SLOT;
            __syncthreads();
            const int nA = NSA_POP(rem), nB = NSA_POP(rem);
            if (nA >= 0) tile_dma(kb + (size_t)nA * 4096, vt + (size_t)nA * 4096, F.lds + (pr ^ (2 * AL_SLOT)), w, lane);
            if (nB >= 0) tile_dma(kb + (size_t)nB * 4096, vt + (size_t)nB * 4096, F.lds + (pr ^ (2 * AL_SLOT)) + AL_SLOT, w, lane);
            const bool enA = first || NSA_EN(tA), enB = tB >= 0 ? NSA_EN(tB) : false;
            if (__ballot(enA || enB) != 0ull) {
                TileCtl A, B;
                A.en = enA; A.masked = (tA == c) || (!sel && tA == c - 8); A.lo = (!sel && tA == c - 8) ? qloc + 1 : 0; A.hi = (tA == c) ? qloc : 63;
                B.en = enB; B.masked = (tB == c) || (!sel && tB == c - 8); B.lo = (!sel && tB == c - 8) ? qloc + 1 : 0; B.hi = (tB == c) ? qloc : 63;
                const int sbb = tB >= 0 ? sb : sa;
                flash_pair(S, kbuf + sa, vbuf + sa, kbuf + sbb, vbuf + sbb, qf, A, B, first, r, h);
            }
            first = false;
            if (nA < 0) break;
            tA = nA; tB = nB; pr ^= 2 * AL_SLOT;
        }
        const float lt = S.l + __shfl_xor(S.l, 32), sc = (sel ? g_sel : g_win) / lt;
#pragma unroll
        for (int i4 = 0; i4 < 8; ++i4) { const f32x16& o = S.o[i4 >> 2]; const int i = 4 * (i4 & 3); ltot[i4 * 512] += (f32x4){sc * o[i], sc * o[i + 1], sc * o[i + 2], sc * o[i + 3]}; }
    }
#undef NSA_PV
#undef NSA_LOHI
#undef NSA_EN
#undef NSA_POP
    bf16_t* ao = (bf16_t*)(F.ws + WS_ABR + SZ_ABR1) + (size_t)tok * 1024 + head * 64;
    const bf16_t* az = P + (size_t)tok * NPROJ + C_AZ + head * 64;
#pragma unroll
    for (int i4 = 0; i4 < 8; ++i4) { const int d = 32 * (i4 >> 2) + 8 * (i4 & 3) + 4 * h;
        const f32x4 t = ltot[i4 * 512]; const f32x4 zz = unpack4(*(const u32x2*)(az + d));
        *(u32x2*)(ao + d) = pack4(t * zz); }
}

constexpr int SL_Q = 0  , SL_SC = 1024  , SL_IMP = SL_SC + 4 * 1040 * 4  , SL_RED = SL_IMP + 264 * 4  ,
              SL_LIST = SL_RED + 128  , SL_KOFF = SL_LIST + 64  , SL_PART = SL_KOFF + 1040 * 4  , SL_OACC = SL_PART + 32768  ;
constexpr int KOFF_INVALID = -2147483647;

__device__ __forceinline__ void block_softmax4(LAS float* sc, int count, LAS float* red, int tid) {
    const int gh = tid >> 7, t = tid & 127, wv = tid >> 6;
    LAS float* row = sc + gh * 1040;
    float mx = -INFINITY;
    for (int i = t; i < count; i += 128) mx = fmaxf(mx, row[i]);
    mx = wave_max(mx);
    if ((tid & 63) == 0) red[wv] = mx;
    __syncthreads();
    mx = fmaxf(red[2 * gh], red[2 * gh + 1]);
    float sm = 0.f;
    for (int i = t; i < count; i += 128) { const float p = __expf(row[i] - mx); row[i] = p; sm += p; }
    sm = wave_sum(sm);
    if ((tid & 63) == 0) red[8 + wv] = sm;
    __syncthreads();
    const float inv = 1.f / (red[8 + 2 * gh] + red[8 + 2 * gh + 1]);
    for (int i = t; i < count; i += 128) row[i] *= inv;
    __syncthreads();
}
__device__ __forceinline__ void sample_scores(const float* base, const bf16_t* Pnew, int pcol, int count, const LAS int* koff, const LAS float* qv, LAS float* sc, int tid) {
#pragma unroll 1
    for (int idx = tid; idx < count; idx += NT) {
        const int ko = koff[idx];
        float d0 = -INFINITY, d1 = -INFINITY, d2 = -INFINITY, d3 = -INFINITY;
        if (ko != KOFF_INVALID) {
            f32x4 kx[16];
            if (ko >= 0) {
#pragma unroll
                for (int j = 0; j < 16; ++j) kx[j] = *(const f32x4*)(base + (size_t)ko + 4 * j); }
            else {
#pragma unroll
                for (int j = 0; j < 16; ++j) kx[j] = unpack4(*(const u32x2*)(Pnew + (size_t)(-1 - ko) * NPROJ + pcol + 4 * j)); }
            d0 = d1 = d2 = d3 = 0.f;
#pragma unroll
            for (int j4 = 0; j4 < 4; ++j4) {
#pragma unroll
                for (int jj = 0; jj < 4; ++jj) { const int j = 4 * j4 + jj; const f32x4 kq = kx[j];
                    const f32x4 q0 = *(const LAS f32x4*)(qv + 4 * j), q1 = *(const LAS f32x4*)(qv + 64 + 4 * j), q2 = *(const LAS f32x4*)(qv + 128 + 4 * j), q3 = *(const LAS f32x4*)(qv + 192 + 4 * j);
                    d0 += kq.x * q0.x + kq.y * q0.y + kq.z * q0.z + kq.w * q0.w; d1 += kq.x * q1.x + kq.y * q1.y + kq.z * q1.z + kq.w * q1.w;
                    d2 += kq.x * q2.x + kq.y * q2.y + kq.z * q2.z + kq.w * q2.w; d3 += kq.x * q3.x + kq.y * q3.y + kq.z * q3.z + kq.w * q3.w; }
                __builtin_amdgcn_sched_barrier(0);
            }
            d0 *= 0.125f; d1 *= 0.125f; d2 *= 0.125f; d3 *= 0.125f;
        }
        sc[idx] = d0; sc[1040 + idx] = d1; sc[2080 + idx] = d2; sc[3120 + idx] = d3;
    }
}
__device__ __forceinline__ void sample_pv(const float* base, const bf16_t* Pnew, int pcol, int count, const LAS int* koff, const LAS float* sc, LAS float* part, LAS float* oacc, int tid) {
    const int dq = tid & 15, ks = tid >> 4, per = (count + 31) >> 5, i0 = ks * per, i1 = (i0 + per < count) ? i0 + per : count;
    f32x4 a0 = {0.f, 0.f, 0.f, 0.f}, a1 = a0, a2 = a0, a3 = a0;
#pragma unroll 8
    for (int idx = i0; idx < i1; ++idx) { const int ko = koff[idx];
        f32x4 v = {0.f, 0.f, 0.f, 0.f};
        if (ko >= 0) v = *(const f32x4*)(base + (size_t)ko + 256 + 4 * dq);
        else if (ko != KOFF_INVALID) { const u32x2 x = *(const u32x2*)(Pnew + (size_t)(-1 - ko) * NPROJ + pcol + 256 + 4 * dq); v = (f32x4){bf2f(x.x & 0xffffu), __uint_as_float(x.x & 0xffff0000u), bf2f(x.y & 0xffffu), __uint_as_float(x.y & 0xffff0000u)}; }
        a0 += sc[idx] * v; a1 += sc[1040 + idx] * v; a2 += sc[2080 + idx] * v; a3 += sc[3120 + idx] * v; }
    *(LAS f32x4*)(part + ks * 256 + 4 * dq) = a0; *(LAS f32x4*)(part + ks * 256 + 64 + 4 * dq) = a1; *(LAS f32x4*)(part + ks * 256 + 128 + 4 * dq) = a2; *(LAS f32x4*)(part + ks * 256 + 192 + 4 * dq) = a3;
    __syncthreads();
    if (tid < 256) { float t = 0.f;
#pragma unroll 8
        for (int k = 0; k < 32; ++k) t += part[k * 256 + tid];
        oacc[tid] = t; }
    __syncthreads();
}

__device__ __forceinline__ void nsa_sample_unit(Frame& F, int l, int unit, int part_id) {
    const int tid = F.tid, qi = unit & 3, kvh = (unit >> 2) & 3, b = unit >> 4, row = MPT + b * 4 + qi;
    const bf16_t* P = (const bf16_t*)(F.ws + WS_P); const int* pt = (const int*)FIN(IN_PT);
    LAS float* qv = (LAS float*)(F.lds + SL_Q); LAS float* sc = (LAS float*)(F.lds + SL_SC); LAS float* imp = (LAS float*)(F.lds + SL_IMP); LAS float* red = (LAS float*)(F.lds + SL_RED);
    LAS int* list = (LAS int*)(F.lds + SL_LIST); LAS int* koff = (LAS int*)(F.lds + SL_KOFF); LAS float* part = (LAS float*)(F.lds + SL_PART); LAS float* oacc = (LAS float*)(F.lds + SL_OACC);
    __syncthreads();
    if (tid < 256) qv[tid] = bf2f(P[(size_t)row * NPROJ + C_Q + kvh * 256 + tid]) * (1.f / SM_SCALE_L2E);
    __syncthreads();
    float* soacc = (float*)(F.ws + WS_SOACC) + (size_t)unit * 768;
    if (part_id == 0) {
    {
        const int n = tid & 255, gp = tid >> 8;
        const bf16_t* kr = (const bf16_t*)(F.ws + WS_KCS) + ((size_t)(b * 4 + kvh) * 256 + n) * 64;
        float d0 = 0.f, d1 = 0.f;
#pragma unroll
        for (int j = 0; j < 8; ++j) { const u32x4 x = *(const u32x4*)(kr + 8 * j); float kf[8]; unpack8(x, kf);
#pragma unroll
            for (int e = 0; e < 8; ++e) { d0 += kf[e] * qv[(2 * gp) * 64 + 8 * j + e]; d1 += kf[e] * qv[(2 * gp + 1) * 64 + 8 * j + e]; } }
        sc[(2 * gp) * 1040 + n] = d0 * 0.125f; sc[(2 * gp + 1) * 1040 + n] = d1 * 0.125f;
    }
    __syncthreads();
    block_softmax4(sc, 256, red, tid);
    if (tid < 257) { float v; if (tid == 0 || tid >= 255) v = 1e4f; else v = sc[tid] + sc[1040 + tid] + sc[2080 + tid] + sc[3120 + tid]; imp[tid] = v; }
    {
        const int half = tid >> 8, gd = tid & 255, gh = gd >> 6, d = gd & 63;
        const bf16_t* vt = (const bf16_t*)(F.ws + WS_VCTS) + (size_t)(b * 4 + kvh) * 4 * 4096;
        float a = 0.f;
        for (int tl = 2 * half; tl < 2 * half + 2; ++tl) {
            const bf16_t* vr = vt + (size_t)tl * 4096 + d * 64;
#pragma unroll
            for (int j = 0; j < 8; ++j) { const u32x4 x = *(const u32x4*)(vr + 8 * j); float vf[8]; unpack8(x, vf);
#pragma unroll
                for (int e = 0; e < 8; ++e) a += sc[gh * 1040 + tl * 64 + keypos(8 * j + e)] * vf[e]; } }
        part[half * 256 + gd] = a;
    }
    __syncthreads();
    if (tid < 256) oacc[tid] = part[tid] + part[256 + tid];
    if (tid < 257) { const float si = imp[tid]; int rk = 0;
        for (int j = 0; j < 257; ++j) { const float sj = imp[j]; rk += (sj > si || (sj == si && j < tid)) ? 1 : 0; }
        if (rk < 16) list[rk] = tid; }
    __syncthreads();
    for (int idx = tid; idx < 1024; idx += NT) { const int blk = list[idx >> 6], kk = idx & 63; int ko;
        if (blk < 256) { const int page = pt[b * 128 + (blk >> 1)]; ko = (int)(((((size_t)l * NPOOL + page) * 128 + (blk & 1) * 64 + kk) * 4 + 2) * 256 + kvh * 64); }
        else ko = (kk <= qi) ? -1 - (MPT + b * 4 + kk) : KOFF_INVALID;
        koff[idx] = ko; }
    __syncthreads();
    sample_scores(FIN(IN_CACHE), P, C_SK + kvh * 64, 1024, koff, qv, sc, tid);
    __syncthreads();
    block_softmax4(sc, 1024, red, tid);
    sample_pv(FIN(IN_CACHE), P, C_SK + kvh * 64, 1024, koff, sc, part, oacc + 256, tid);
    soacc[tid] = oacc[tid];
    } else {
    for (int idx = tid; idx < 516; idx += NT) { int ko;
        if (idx < 512) ko = (idx > qi) ? (int)((((size_t)(l * SB + b) * 512 + idx) * 2) * 256 + kvh * 64) : KOFF_INVALID;
        else ko = (idx - 512 <= qi) ? -1 - (MPT + b * 4 + idx - 512) : KOFF_INVALID;
        koff[idx] = ko; }
    __syncthreads();
    sample_scores(FIN(IN_SWIN), P, C_WK + kvh * 64, 516, koff, qv, sc, tid);
    __syncthreads();
    block_softmax4(sc, 516, red, tid);
    sample_pv(FIN(IN_SWIN), P, C_WK + kvh * 64, 516, koff, sc, part, oacc + 512, tid);
    if (tid < 256) soacc[512 + tid] = oacc[512 + tid];
    }
    __syncthreads();
}
__device__ __forceinline__ void sample_combine(Frame& F) {
    const bf16_t* P = (const bf16_t*)(F.ws + WS_P); const float* so = (const float*)(F.ws + WS_SOACC);
    for (int it = F.gw * 64 + F.lane; it < 128 * 256; it += F.ngw * 64) {
        const int unit = it >> 8, t = it & 255, qi = unit & 3, kvh = (unit >> 2) & 3, b = unit >> 4, row = MPT + b * 4 + qi, head = kvh * 4 + (t >> 6), d = t & 63;
        const float* gt = (const float*)(F.ws + WS_GATE) + (size_t)row * 64 + head * 3;
        const float o = gt[0] * so[(size_t)unit * 768 + t] + gt[1] * so[(size_t)unit * 768 + 256 + t] + gt[2] * so[(size_t)unit * 768 + 512 + t];
        ((bf16_t*)(F.ws + WS_ABR + SZ_ABR1))[(size_t)row * 1024 + head * 64 + d] = (bf16_t)f2bf(o * bf2f(P[(size_t)row * NPROJ + C_AZ + head * 64 + d])); }
}

struct SsmPow { float r[4], i[4]; };
__device__ __forceinline__ void ssm_pows(float ar, float ai, SsmPow& p) {
    p.r[0] = ar; p.i[0] = ai;
    p.r[1] = ar * ar - ai * ai; p.i[1] = 2.f * ar * ai;
    p.r[2] = p.r[1] * ar - p.i[1] * ai; p.i[2] = p.r[1] * ai + p.i[1] * ar;
    p.r[3] = p.r[1] * p.r[1] - p.i[1] * p.i[1]; p.i[3] = 2.f * p.r[1] * p.i[1];
}
struct SsmUnit { SsmPow pw[2]; bf16x8 bfr[4]; float alr[2], ali[2]; };
__device__ __forceinline__ void ssm_unit_load(const Frame& F, int l, int g, int lane, SsmUnit& U) {
    const int n32 = lane & 31, h = lane >> 5;
    const float* sab = (const float*)(F.ws + WS_SAB + l * al1m(SZ_SAB)) + (size_t)g * 64 * 4;
    const bf16_t* bb16 = (const bf16_t*)(F.ws + WS_SBB16 + l * al1m(SZ_SBB16)) + (size_t)g * 2 * 64 * 16;
#pragma unroll
    for (int s = 0; s < 2; ++s) { const f32x4 ab = *(const f32x4*)(sab + (n32 + 32 * s) * 4); ssm_pows(ab.x, ab.y, U.pw[s]); U.alr[s] = ab.z; U.ali[s] = ab.w;
        U.bfr[2 * s] = *(const bf16x8*)(bb16 + (size_t)(n32 + 32 * s) * 16 + 8 * h); U.bfr[2 * s + 1] = *(const bf16x8*)(bb16 + (size_t)(64 + n32 + 32 * s) * 16 + 8 * h); }
}
template <bool FIX>
__device__ __forceinline__ void ssm_block32(const bf16x8& au, const SsmUnit& U, float (&Hr)[2], float (&Hi)[2], float (&H1r)[2], float (&H1i)[2], f32x16 (&Dr)[2], f32x16 (&Di)[2], int h) {
    f32x16 z;
#pragma unroll
    for (int i = 0; i < 16; ++i) z[i] = 0.f;
#pragma unroll
    for (int s = 0; s < 2; ++s) { Dr[s] = MFMA32(au, U.bfr[2 * s], z); Di[s] = MFMA32(au, U.bfr[2 * s + 1], z); }
#pragma unroll
    for (int s = 0; s < 2; ++s) {
        const float ar = U.pw[s].r[0], ai = U.pw[s].i[0], a4r = U.pw[s].r[3], a4i = U.pw[s].i[3];
#pragma unroll
        for (int j = 0; j < 4; ++j)
#pragma unroll
            for (int e = 1; e < 4; ++e) { const int i = 4 * j + e;
                const float nr = ar * Dr[s][i - 1] - ai * Di[s][i - 1] + Dr[s][i], ni = ar * Di[s][i - 1] + ai * Dr[s][i - 1] + Di[s][i]; Dr[s][i] = nr; Di[s][i] = ni; }
        float hr = Hr[s], hi = Hi[s];
#pragma unroll
        for (int j = 0; j < 4; ++j) {
            const float ownr = Dr[s][4 * j + 3], owni = Di[s][4 * j + 3], othr = __shfl_xor(ownr, 32), othi = __shfl_xor(owni, 32);
            const float evr = h ? othr : ownr, evi = h ? othi : owni, odr = h ? ownr : othr, odi = h ? owni : othi;
            const float inr0 = hr, ini0 = hi;
            float t = a4r * hr - a4i * hi + evr; hi = a4r * hi + a4i * hr + evi; hr = t;
            if (j == 0) { H1r[s] = hr; H1i[s] = hi; }
            const float inr1 = hr, ini1 = hi;
            t = a4r * hr - a4i * hi + odr; hi = a4r * hi + a4i * hr + odi; hr = t;
            if (FIX) { const float inr = h ? inr1 : inr0, ini = h ? ini1 : ini0;
#pragma unroll
                for (int e = 0; e < 4; ++e) { const int i = 4 * j + e; Dr[s][i] += U.pw[s].r[e] * inr - U.pw[s].i[e] * ini; Di[s][i] += U.pw[s].r[e] * ini + U.pw[s].i[e] * inr; } }
        }
        Hr[s] = hr; Hi[s] = hi;
    }
}
__device__ __forceinline__ bf16x8 ssm_load_au(const bf16_t* P, int m0, int ntok, int g, int lane) {
    const int t = lane & 31, h = lane >> 5;
    if (t < ntok) return *(const bf16x8*)(P + (size_t)(m0 + t) * NPROJ + C_SU + g * 16 + 8 * h);
    return (bf16x8){0, 0, 0, 0, 0, 0, 0, 0};
}
__device__ __forceinline__ void s2_ssm_pass1(Frame& F, int l) {
    const bf16_t* P = (const bf16_t*)(F.ws + WS_P); f32x2* E = (f32x2*)(F.ws + WS_SSME);
    const int lane = F.lane, n32 = lane & 31, h = lane >> 5;
    for (int u = F.gw; u < PB * 64 * SSM_NCH; u += F.ngw) {
        const int b = u >> 11, g = (u >> 5) & 63, ch = u & 31, m0 = b * SEQ + ch * SSM_L;
        SsmUnit U; ssm_unit_load(F, l, g, lane, U);
        float Hr[2] = {0.f, 0.f}, Hi[2] = {0.f, 0.f}, H1r[2], H1i[2];
        bf16x8 au = ssm_load_au(P, m0, 32, g, lane);
#pragma unroll 1
        for (int blk = 0; blk < SSM_L / 32; ++blk) {
            const bf16x8 an = ssm_load_au(P, m0 + 32 * ((blk + 1) & 3), 32, g, lane);
            f32x16 Dr[2], Di[2];
            ssm_block32<false>(au, U, Hr, Hi, H1r, H1i, Dr, Di, h);
            au = an;
        }
        if (h == 0) { f32x2* e = E + ((size_t)(b * 64 + g) * SSM_NCH + ch) * 64; e[n32] = (f32x2){Hr[0], Hi[0]}; e[32 + n32] = (f32x2){Hr[1], Hi[1]}; }
    }
}
__device__ __forceinline__ void s3_ssm_pass2(Frame& F, int l) {
    const bf16_t* P = (const bf16_t*)(F.ws + WS_P); const f32x2* E = (const f32x2*)(F.ws + WS_SSME); bf16_t* Z = (bf16_t*)(F.ws + WS_Z);
    LAS unsigned char* himg = F.lds + 65536 + F.wave * 8960;
    const int lane = F.lane, n32 = lane & 31, h = lane >> 5, tk = lane & 15, cq = lane >> 4;
    for (int u = F.gw; u < PB * 64 * SSM_NCH + SB * 64; u += F.ngw) {
        const bool smp = u >= PB * 64 * SSM_NCH;
        int b, g, ch, m0, nblk, ntok;
        if (!smp) { b = u >> 11; g = (u >> 5) & 63; ch = u & 31; m0 = b * SEQ + ch * SSM_L; nblk = SSM_L / 32; ntok = 32; }
        else { const int su = u - PB * 64 * SSM_NCH; b = su >> 6; g = su & 63; ch = 0; m0 = MPT + b * 4; nblk = 1; ntok = 4; }
        SsmUnit U; ssm_unit_load(F, l, g, lane, U);
        bf16x8 cmf[4];
        { const bf16_t* cm = (const bf16_t*)(F.ws + WS_SCM + l * al1m(SZ_SCM)) + (size_t)(g * 16 + tk) * 128 + 8 * cq;
#pragma unroll
            for (int ks = 0; ks < 4; ++ks) cmf[ks] = *(const bf16x8*)(cm + 32 * ks); }
        const f32x4 ds = *(const f32x4*)(FIN(IN_DSKIP) + l * 1024 + g * 16 + 4 * cq);
        float Hr[2] = {0.f, 0.f}, Hi[2] = {0.f, 0.f}, H1r[2] = {0.f, 0.f}, H1i[2] = {0.f, 0.f};
        if (!smp) { const f32x2* e = E + (size_t)(b * 64 + g) * SSM_NCH * 64;
            for (int j0 = 0; j0 < ch; j0 += 8) {
                f32x2 ev[8][2];
#pragma unroll
                for (int jj = 0; jj < 8; ++jj)
#pragma unroll
                    for (int s = 0; s < 2; ++s) ev[jj][s] = (j0 + jj < ch) ? e[(size_t)(j0 + jj) * 64 + n32 + 32 * s] : (f32x2){0.f, 0.f};
#pragma unroll
                for (int jj = 0; jj < 8; ++jj) if (j0 + jj < ch) {
#pragma unroll
                    for (int s = 0; s < 2; ++s) { const float nr = U.alr[s] * Hr[s] - U.ali[s] * Hi[s] + ev[jj][s].x, ni = U.alr[s] * Hi[s] + U.ali[s] * Hr[s] + ev[jj][s].y; Hr[s] = nr; Hi[s] = ni; } } } }
        else { const float* h0 = FIN(IN_SSSM) + ((size_t)(l * SB + b) * 2 * 64 + g) * 64 + n32;
#pragma unroll
            for (int s = 0; s < 2; ++s) { Hr[s] = h0[32 * s]; Hi[s] = h0[64 * 64 + 32 * s]; } }
        bf16x8 au = ssm_load_au(P, m0, ntok, g, lane);
#pragma unroll 1
        for (int blk = 0; blk < nblk; ++blk) {
            const bf16x8 an = ssm_load_au(P, m0 + 32 * ((blk + 1) & 3), ntok, g, lane);
            u32x2 uw[2];
#pragma unroll
            for (int tt = 0; tt < 2; ++tt) uw[tt] = (16 * tt + tk < ntok) ? *(const u32x2*)(P + (size_t)(m0 + 32 * blk + 16 * tt + tk) * NPROJ + C_SU + g * 16 + 4 * cq) : (u32x2){0u, 0u};
            f32x16 Dr[2], Di[2];
            ssm_block32<true>(au, U, Hr, Hi, H1r, H1i, Dr, Di, h);
            au = an;
#pragma unroll
            for (int i = 0; i < 16; ++i) { const int tl = (i & 3) + 8 * (i >> 2) + 4 * h;
                *(LAS unsigned*)(himg + tl * 272 + 4 * n32) = pk2(Dr[0][i], Di[0][i]); *(LAS unsigned*)(himg + tl * 272 + 4 * (32 + n32)) = pk2(Dr[1][i], Di[1][i]); }
            LDS_WAIT(); asm volatile("" ::: "memory");
#pragma unroll
            for (int tt = 0; tt < 2; ++tt) {
                f32x4 y = {0.f, 0.f, 0.f, 0.f};
#pragma unroll
                for (int ks = 0; ks < 4; ++ks) { const bf16x8 hf = *(const LAS bf16x8*)(himg + (16 * tt + tk) * 272 + (32 * ks + 8 * cq) * 2); y = __builtin_amdgcn_mfma_f32_16x16x32_bf16(cmf[ks], hf, y, 0, 0, 0); }
                const int t = 32 * blk + 16 * tt + tk;
                if (16 * tt + tk < ntok) { const f32x4 uu = unpack4(uw[tt]);
                    u32x2 o; o.x = pk2(gelu_tanh(y.x + ds.x * uu.x), gelu_tanh(y.y + ds.y * uu.y)); o.y = pk2(gelu_tanh(y.z + ds.z * uu.z), gelu_tanh(y.w + ds.w * uu.w));
                    *(u32x2*)(Z + (size_t)(m0 + t) * 1024 + g * 16 + 4 * cq) = o; }
            }
            LDS_WAIT(); asm volatile("" ::: "memory");
        }
        if (h == 0) {
            if (smp) { float* o = F.out + O_SSMS + ((size_t)(l * SB + b) * 2 * 64 + g) * 64 + n32;
#pragma unroll
                for (int s = 0; s < 2; ++s) { o[32 * s] = H1r[s]; o[64 * 64 + 32 * s] = H1i[s]; } }
            else if (ch == SSM_NCH - 1) { float* o = F.out + O_SSMP + ((size_t)(l * PB + b) * 2 * 64 + g) * 64 + n32;
#pragma unroll
                for (int s = 0; s < 2; ++s) { o[32 * s] = Hr[s]; o[64 * 64 + 32 * s] = Hi[s]; } }
        }
    }
}
struct Args { const float* in[27]; float* out; unsigned char* ws; int ph_lo, ph_hi; };
constexpr int N_PHASES = 15;

__global__ void __launch_bounds__(NT, 2) fwd_kernel(Args args) {
    extern __shared__ __attribute__((aligned(16))) unsigned char lds_raw[];
    Frame F;
    F.lds = (LAS unsigned char*)lds_raw;
    F.tid = threadIdx.x; F.lane = F.tid & 63; F.wave = __builtin_amdgcn_readfirstlane(F.tid >> 6);
    F.G = gridDim.x; F.bid = blockIdx.x; F.gw = F.bid * NWAVES + F.wave; F.ngw = F.G * NWAVES;
    F.out = args.out; F.ws = args.ws;
    volatile LAS unsigned* misc = (volatile LAS unsigned*)(F.lds + LDS_MISC);
    if (F.tid < 64) misc[F.tid] = 0u;
    __syncthreads();
    const int lo = args.ph_lo, hi = args.ph_hi;
#if MK_PER_PHASE
#define GRID_BAR() do { } while (0)
#else
    XcdBarrier bar = xcd_barrier_post((unsigned*)(F.ws + WS_CTL) + CW_BAR, misc + 8);
#define GRID_BAR() xcd_barrier(bar)
#endif
#ifdef ONLYPH
#define IN(k) ((((k)==0?0:(((k)-1)%7)+1))==ONLYPH && lo <= (k) && (k) < hi)
#else
#define IN(k) (lo <= (k) && (k) < hi)
#endif
#define BOTH(k) (IN(k) && IN((k) + 1))
#ifndef PROBE_PH
#define PROBE_PH -1
#endif
#define REPS(k) _Pragma("unroll 1") for (int rep_ = 0; rep_ < ((PROBE_PH) == (k) ? 2 : 1); ++rep_)
#define PHASE_BEGIN() do { int t_ = threadIdx.x; asm volatile("" : "+v"(t_)); F.tid = t_; F.lane = t_ & 63; F.wave = __builtin_amdgcn_readfirstlane(t_ >> 6); \
    F.gw = F.bid * NWAVES + F.wave; GAS unsigned char* w_ = (GAS unsigned char*)args.ws; asm volatile("" : "+s"(w_)); F.ws = (unsigned char*)w_; \
    GAS float* o_ = (GAS float*)args.out; asm volatile("" : "+s"(o_)); F.out = (float*)o_; } while (0)
    if (IN(0)) { PHASE_BEGIN(); REPS(0) phase_prologue(F); if (BOTH(0)) GRID_BAR(); }
    for (int l = 0; l < 2; ++l) {
        const int p0 = 1 + 7 * l;
        if (IN(p0)) {
            PHASE_BEGIN();
            pg8::Gemm g{(const bf16_t*)(F.ws + WS_H), (const bf16_t*)(F.ws + WS_WIN + l * al1m(SZ_WIN)), DM, DM, DM, 0, 0};
            pg8::TileOrder S; S.init(MPT / 256, NPROJ / 256, 1, 0, F.G, F.bid);
            EpiProj E{(bf16_t*)(F.ws + WS_P), (float*)(F.ws + WS_GATE), F.out, l};
            REPS(1) pg8::gemm_phase(F.lds, g, S, E);
            skinny_proj(F, l);
            if (BOTH(p0)) GRID_BAR();
        }
        if (IN(p0 + 1)) {
            PHASE_BEGIN();
            REPS(2) {
#ifndef SK_A
            REPS(21) s2_compress(F, l);
#endif
            __syncthreads();
#ifndef SK_B
            PHASE_BEGIN();
            REPS(22) s2_ssm_pass1(F, l);
#endif
#ifndef SK_C
            PHASE_BEGIN();
            REPS(23) s2_pool_diff(F, l);
#endif
#ifndef SK_D
            PHASE_BEGIN();
            REPS(24) s2_state_outputs(F, l);
#endif
#ifndef SK_E
            PHASE_BEGIN();
            REPS(25) s2_vt_images(F);
#endif
            }
            if (BOTH(p0 + 1)) GRID_BAR();
        }
        if (IN(p0 + 2)) {
            PHASE_BEGIN();
            REPS(3) {
#ifndef SK_F
            REPS(31) for (int p = F.bid; p < 256; p += F.G) { const int bk = p >> 5, j = p & 31;
#pragma unroll 1
                for (int k2 = 0; k2 < 2; ++k2) nsa_prompt_unit(F, l, bk >> 2, bk & 3, k2 ? j : 63 - j); }
#endif
#ifndef SK_G
            PHASE_BEGIN();
            REPS(32) for (int u = F.bid; u < 256; u += F.G) nsa_sample_unit(F, l, u >> 1, u & 1);
#endif
            __syncthreads();
#ifndef SK_H
            PHASE_BEGIN();
            REPS(33) s3_ssm_pass2(F, l);
#endif
            __syncthreads();
            }
            if (BOTH(p0 + 2)) GRID_BAR();
        }
        if (IN(p0 + 3)) {
            PHASE_BEGIN();
            sample_combine(F);
            REPS(4) {
            const int hg = F.G >> 1;
            if (F.bid < hg) {
                pg8::Gemm g{(const bf16_t*)(F.ws + WS_Z), (const bf16_t*)(F.ws + WS_WGLU + l * al1m(SZ_WGLU)), 1024, 1024, 1024, 0, 0};
                pg8::TileOrder S; S.init(MPT / 256, 4, 1, 0, hg, F.bid);
                EpiGlu E{(bf16_t*)(F.ws + WS_ABR + 2 * SZ_ABR1), (const bf16_t*)(F.ws + WS_P), (const bf16_t*)(F.ws + WS_Z)};
                pg8::gemm_phase(F.lds, g, S, E);
            } else {
                pg8::Gemm g{(const bf16_t*)(F.ws + WS_DIFF), (const bf16_t*)(F.ws + WS_WPOOL + l * al1m(SZ_WPOOL)), 1024, 256, 256, 256, 65536};
                pg8::TileOrder S; S.init(MPT / 256, 1, 4, 0, F.G - hg, F.bid - hg);
                EpiPool E{(bf16_t*)(F.ws + WS_ABR), (const bf16_t*)(F.ws + WS_P), FIN(IN_PSCALE) + l * 1024};
                pg8::gemm_phase(F.lds, g, S, E);
            }
            skinny_glu(F, l); skinny_pool(F, l);
            }
            if (BOTH(p0 + 3)) GRID_BAR();
        }
        if (IN(p0 + 4)) {
            PHASE_BEGIN();
            pg8::Gemm g{(const bf16_t*)(F.ws + WS_ABR), (const bf16_t*)(F.ws + WS_WBR + l * al1m(SZ_WBR)), 1024, 1024, 1024, (size_t)MPAD * 1024, (size_t)2048 * 1024};
            pg8::TileOrder S; S.init(MPT / 256, 8, 3, 1, F.G, F.bid);
            EpiBranch E{(bf16_t*)(F.ws + WS_MERGED), (const bf16_t*)(F.ws + WS_P)};
            REPS(5) { pg8::gemm_phase(F.lds, g, S, E); skinny_branch(F, l); }
            if (BOTH(p0 + 4)) GRID_BAR();
        }
        if (IN(p0 + 5)) {
            PHASE_BEGIN();
            pg8::Gemm g{(const bf16_t*)(F.ws + WS_MERGED), (const bf16_t*)(F.ws + WS_WOUT + l * al1m(SZ_WOUT)), DM, DM, DM, 0, 0};
            pg8::TileOrder S; S.init(MPT / 256, 8, 1, 0, F.G, F.bid);
            EpiOut E{(bf16_t*)(F.ws + WS_OUTB)};
            REPS(6) { pg8::gemm_phase(F.lds, g, S, E); skinny_out(F, l); }
            if (BOTH(p0 + 5)) GRID_BAR();
        }
        if (IN(p0 + 6)) {
            PHASE_BEGIN();
            REPS(7) phase_norm(F, l);
            if (BOTH(p0 + 6)) GRID_BAR();
        }
    }
#undef IN
#undef BOTH
}

extern "C" void kernel_launch(void* const* d_in, const int* in_sizes, int n_in, void* d_out, int out_size, void* d_ws, size_t ws_size, hipStream_t stream) {
    static int grid = 0;
    if (grid == 0) {
        if (n_in != 27 || out_size != (int)O_TOTAL || ws_size < WS_END) { fprintf(stderr, "kernel_launch: unexpected problem shape (n_in %d, out %d, ws %zu < %zu)\n", n_in, out_size, ws_size, (size_t)WS_END); grid = -1; return; }
        int dev = 0, cus = 0, per_cu = 0;
        if (hipGetDevice(&dev) != hipSuccess || hipDeviceGetAttribute(&cus, hipDeviceAttributeMultiprocessorCount, dev) != hipSuccess) { grid = -1; return; }
        if (hipFuncSetAttribute((const void*)fwd_kernel, hipFuncAttributeMaxDynamicSharedMemorySize, LDS_BYTES) != hipSuccess) { fprintf(stderr, "kernel_launch: hipFuncSetAttribute failed\n"); grid = -1; return; }
        if (hipOccupancyMaxActiveBlocksPerMultiprocessor(&per_cu, (const void*)fwd_kernel, NT, LDS_BYTES) != hipSuccess || per_cu < 1)
            fprintf(stderr, "kernel_launch: note: occupancy query reports %d workgroups per CU\n", per_cu);
        (void)hipGetLastError();
        grid = cus;
    }
    if (grid < 0) return;
    if (hipMemsetAsync((char*)d_ws + WS_CTL, 0, CTL_ZERO_BYTES, stream) != hipSuccess) return;
    Args a{};
    for (int i = 0; i < 27; ++i) a.in[i] = (const float*)d_in[i];
    a.out = (float*)d_out; a.ws = (unsigned char*)d_ws;
#if MK_PER_PHASE
    for (int k = 0; k < N_PHASES; ++k) { a.ph_lo = k; a.ph_hi = k + 1; hipLaunchKernelGGL(fwd_kernel, dim3(grid), dim3(NT), LDS_BYTES, stream, a); }
#else
    a.ph_lo = 0; a.ph_hi = N_PHASES;
    hipLaunchKernelGGL(fwd_kernel, dim3(grid), dim3(NT), LDS_BYTES, stream, a);
#endif
    const hipError_t le = hipPeekAtLastError();
    if (le != hipSuccess) fprintf(stderr, "kernel_launch: launch failed: %s\n", hipGetErrorName(le));
}
```

```cpp
#define MK_PER_PHASE 0
#include <hip/hip_runtime.h>
#include <cstdio>
#include <cstdint>

#ifndef MK_PER_PHASE
#define MK_PER_PHASE 0
#endif

#define LAS __attribute__((address_space(3)))
#define GAS __attribute__((address_space(1)))
typedef unsigned short bf16_t;
typedef short bf16x8 __attribute__((ext_vector_type(8)));
typedef float f32x4 __attribute__((ext_vector_type(4)));
typedef float f32x2 __attribute__((ext_vector_type(2)));
typedef float f32x16 __attribute__((ext_vector_type(16)));
typedef unsigned u32x4 __attribute__((ext_vector_type(4)));
typedef unsigned u32x2 __attribute__((ext_vector_type(2)));
typedef __bf16 bf16x2_t __attribute__((ext_vector_type(2)));

constexpr int DM = 2048, SEQ = 4096, PB = 2, SB = 8, SQ = 4, PAST = 16384;
constexpr int MPT = PB * SEQ;
constexpr int MROWS = MPT + SB * SQ;
constexpr int MPAD = 8448;
constexpr int DIN = 13872, NPROJ = 14080;
constexpr int C_PU = 0, C_PZ = 1024, C_Q = 2048, C_CK = 3072, C_CV = 3328, C_SK = 3584, C_SV = 3840, C_WK = 4096, C_WV = 4352,
              C_AZ = 4608, C_SU = 5632, C_SZ = 6656, C_MG = 7680, C_AG = 13824;
constexpr int NPOOL = 1280;
constexpr int SSM_L = 128, SSM_NCH = SEQ / SSM_L;
constexpr float EPS = 1e-6f;
constexpr float SM_SCALE_L2E = 0.125f * 1.44269504088896f;
constexpr float SM_THR = 8.f;

constexpr size_t O_YP = 0, O_YS = 16777216, O_KVP = 16842752, O_KVS = 33619968, O_WINP = 33685504, O_WINS = 34734080,
                 O_POOLP = 38928384, O_POOLS = 38989824, O_SSMP = 39235584, O_SSMS = 39268352, O_TOTAL = 39399424;

constexpr size_t al1m(size_t x) { return (x + 1048575) & ~(size_t)1048575; }
constexpr size_t SZ_WIN = (size_t)NPROJ * DM * 2, SZ_WPOOL = 4 * 256 * 256 * 2, SZ_WGLU = 1024 * 1024 * 2, SZ_WBR = (size_t)3 * 2048 * 1024 * 2,
                 SZ_WOUT = (size_t)2048 * 2048 * 2, SZ_WPHI = 2 * 64 * 64 * 64 * 2, SZ_PEBP = 2 * 16 * 64 * 4, SZ_SAB = 64 * 64 * 4 * 4,
                 SZ_SBB = 64 * 16 * 2 * 64 * 4, SZ_SCM = 64 * 16 * 128 * 2;
constexpr size_t WS_CTL = 0, CTL_BYTES = 1048576, CTL_ZERO_BYTES = 32768;
constexpr size_t WS_WIN = CTL_BYTES;
constexpr size_t WS_WPOOL = WS_WIN + 2 * al1m(SZ_WIN);
constexpr size_t WS_WGLU = WS_WPOOL + 2 * al1m(SZ_WPOOL);
constexpr size_t WS_WBR = WS_WGLU + 2 * al1m(SZ_WGLU);
constexpr size_t WS_WOUT = WS_WBR + 2 * al1m(SZ_WBR);
constexpr size_t WS_WPHI = WS_WOUT + 2 * al1m(SZ_WOUT);
constexpr size_t WS_PEBP = WS_WPHI + 2 * al1m(SZ_WPHI);
constexpr size_t WS_SAB = WS_PEBP + 2 * al1m(SZ_PEBP);
constexpr size_t WS_SBB = WS_SAB + 2 * al1m(SZ_SAB);
constexpr size_t WS_SCM = WS_SBB + 2 * al1m(SZ_SBB);
constexpr size_t WS_H = WS_SCM + 2 * al1m(SZ_SCM);
constexpr size_t WS_P = WS_H + al1m((size_t)MPAD * DM * 2);
constexpr size_t WS_GATE = WS_P + al1m((size_t)MPAD * NPROJ * 2);
constexpr size_t WS_DIFF = WS_GATE + al1m((size_t)MPAD * 64 * 4);
constexpr size_t WS_ABR = WS_DIFF + al1m((size_t)MPAD * 1024 * 2);
constexpr size_t SZ_ABR1 = (size_t)MPAD * 1024 * 2;
constexpr size_t WS_Z = WS_ABR + al1m(3 * SZ_ABR1);
constexpr size_t WS_KCP = WS_Z + al1m(SZ_ABR1);
constexpr size_t WS_VCTP = WS_KCP + al1m(65536);
constexpr size_t WS_KCS = WS_VCTP + al1m(65536);
constexpr size_t WS_VCTS = WS_KCS + al1m(1048576);
constexpr size_t WS_VTSEL = WS_VCTS + al1m(1048576);
constexpr size_t WS_VTWIN = WS_VTSEL + al1m(4194304);
constexpr size_t WS_SSME = WS_VTWIN + al1m(4194304);
constexpr size_t WS_MERGED = WS_SSME + al1m(2097152);
constexpr size_t WS_OUTB = WS_MERGED + al1m((size_t)MPAD * DM * 2);
constexpr size_t WS_Y0 = WS_OUTB + al1m((size_t)MPAD * DM * 4);
constexpr size_t WS_BRP = WS_Y0 + al1m((size_t)MPAD * DM * 4);
constexpr size_t WS_SOACC = WS_BRP + al1m((size_t)3 * 32 * DM * 4);
constexpr size_t WS_SBB16 = WS_SOACC + al1m(128 * 768 * 4);
constexpr size_t SZ_SBB16 = 64 * 2 * 64 * 16 * 2;
constexpr size_t WS_KTSEL = WS_SBB16 + 2 * al1m(SZ_SBB16);
constexpr size_t WS_KTWIN = WS_KTSEL + al1m(4194304);
constexpr size_t WS_END = WS_KTWIN + al1m(4194304);

constexpr int CW_BAR = 4096;

constexpr int NWAVES = 8, NT = 512;
constexpr int LDS_BYTES = 147456;
constexpr int LDS_MISC = 143360;

__device__ __forceinline__ float bf2f(unsigned b) { return __uint_as_float(b << 16); }
__device__ __forceinline__ unsigned pk2(float lo, float hi) { f32x2 v = {lo, hi}; bf16x2_t b = __builtin_convertvector(v, bf16x2_t); return __builtin_bit_cast(unsigned, b); }
__device__ __forceinline__ unsigned f2bf(float f) { return pk2(f, 0.f) & 0xffffu; }
__device__ __forceinline__ float wave_sum(float v) {
#pragma unroll
    for (int o = 1; o < 64; o <<= 1) v += __shfl_xor(v, o);
    return v;
}
__device__ __forceinline__ float wave_max(float v) {
#pragma unroll
    for (int o = 1; o < 64; o <<= 1) v = fmaxf(v, __shfl_xor(v, o));
    return v;
}
__device__ __forceinline__ float sigmoidf_(float x) { return __builtin_amdgcn_rcpf(1.f + __expf(-x)); }
__device__ __forceinline__ float siluf_(float x) { return x * sigmoidf_(x); }
__device__ __forceinline__ float gelu_tanh(float y) { const float a = 1.5957691216f * (y + 0.044715f * y * y * y); return y * sigmoidf_(a); }
#define LDS_WAIT() asm volatile("s_waitcnt lgkmcnt(0)" ::: "memory")
#define VM_WAIT() asm volatile("s_waitcnt vmcnt(0)" ::: "memory")

#define XB_TMO      128
#define XB_XCNT(j)  (256  + 64 * (j))
#define XB_XSUB(j)  (1280 + 64 * (j))
#define XB_XGEN(j)  (2304 + 64 * (j))
#define XB_TOP      3328
#define XB_TOPGEN   3392
#define XCD_BAR_WORDS 3456
#define XB_SPIN_CAP (1u << 23)
__device__ __forceinline__ unsigned xb_ld(unsigned* p)              { return __hip_atomic_load(p, __ATOMIC_RELAXED, __HIP_MEMORY_SCOPE_AGENT); }
__device__ __forceinline__ unsigned xb_add(unsigned* p, unsigned v) { return __hip_atomic_fetch_add(p, v, __ATOMIC_RELAXED, __HIP_MEMORY_SCOPE_AGENT); }
__device__ __forceinline__ unsigned xb_xcc_id() { return (unsigned)__builtin_amdgcn_s_getreg((3 << 11) | 20) & 0xFu; }
#define XB_SPIN(cond, bar) do { unsigned _sp = 0; while (cond) { __builtin_amdgcn_s_sleep(1); \
    if ((++_sp & 255u) == 0u) { if (xb_ld(&(bar)[XB_TMO])) break; if (_sp > XB_SPIN_CAP) { atomicAdd(&(bar)[XB_TMO], 1u); break; } } } } while (0)
struct XcdBarrier { unsigned* bar; unsigned x; volatile LAS unsigned* st; };
__device__ __forceinline__ XcdBarrier xcd_barrier_post(unsigned* bar, volatile LAS unsigned* st) {
    XcdBarrier b; b.bar = bar; b.x = xb_xcc_id(); b.st = st;
    if (threadIdx.x == 0) (void)xb_add(&bar[XB_XCNT(b.x)], 1u);
    return b;
}
__device__ __forceinline__ void xcd_barrier_complete(unsigned* bar, unsigned x, unsigned& nloc, unsigned& nx) {
    const unsigned G = gridDim.x * gridDim.y * gridDim.z;
    unsigned sum, cnt, mine, sp = 0u;
    for (;;) {
        sum = 0u; cnt = 0u; mine = 0u;
#pragma unroll
        for (unsigned j = 0; j < 16; ++j) { const unsigned c = xb_ld(&bar[XB_XCNT(j)]); sum += c; cnt += (c > 0u) ? 1u : 0u; mine = (j == x) ? c : mine; }
        if (sum == G) break;
        __builtin_amdgcn_s_sleep(1);
        if ((++sp & 255u) == 0u) { if (xb_ld(&bar[XB_TMO])) break; if (sp > XB_SPIN_CAP) { atomicAdd(&bar[XB_TMO], 1u); break; } }
    }
    nloc = mine > 0u ? mine : 1u; nx = cnt > 0u ? cnt : 1u;
}
__device__ __forceinline__ void xcd_barrier(const XcdBarrier& b) {
    asm volatile("s_waitcnt vmcnt(0)" ::: "memory");
    __syncthreads();
    if (threadIdx.x == 0) {
        unsigned* bar = b.bar;
        __builtin_amdgcn_s_waitcnt(0);
        unsigned nloc = b.st[0], nx = b.st[1];
        if (nloc == 0u) { xcd_barrier_complete(bar, b.x, nloc, nx); b.st[0] = nloc; b.st[1] = nx; }
        const unsigned old = xb_add(&bar[XB_XSUB(b.x)], 1u);
        const unsigned gen = old / nloc;
        if (old + 1u == (gen + 1u) * nloc) {
            __builtin_amdgcn_fence(__ATOMIC_RELEASE, "agent");
            asm volatile("s_waitcnt vmcnt(0)" ::: "memory");
            const unsigned og = xb_add(&bar[XB_TOP], 1u);
            const unsigned tg = og / nx;
            if (og + 1u == (tg + 1u) * nx) xb_add(&bar[XB_TOPGEN], 1u);
            else XB_SPIN(xb_ld(&bar[XB_TOPGEN]) == tg, bar);
            __builtin_amdgcn_fence(__ATOMIC_ACQUIRE, "agent");
            xb_add(&bar[XB_XGEN(b.x)], 1u);
            asm volatile("s_waitcnt vmcnt(0)" ::: "memory");
        } else {
            XB_SPIN(xb_ld(&bar[XB_XGEN(b.x)]) == gen, bar);
            __builtin_amdgcn_fence(__ATOMIC_ACQUIRE, "agent");
            asm volatile("s_waitcnt vmcnt(0)" ::: "memory");
        }
    }
    __syncthreads();
}
namespace pg8 {
constexpr int BM = 256, BK = 64, HALF = 128, HTB = HALF * BK * 2, STAGE_BYTES = 8 * HTB, NXCD = 8, WGM = 8;
__host__ __device__ __forceinline__ int lds_byte(int r, int c) { const int st = (r >> 4) * 2 + (c >> 5), rr = r & 15, cc = c & 31, ob = rr * 64 + cc * 2; return st * 1024 + (ob ^ (((ob >> 9) & 1) << 5)); }
__host__ __device__ __forceinline__ void stage_rc(int b, int& R, int& C) { const int st = b / 1024, sb = b % 1024, swz = sb ^ (((sb >> 9) & 1) << 5); R = (st >> 1) * 16 + swz / 64; C = (st & 1) * 32 + (swz % 64) / 2; }
__host__ __device__ __forceinline__ int perm32(int rho) { const int n = rho >> 4, i = rho & 15; return 8 * (i >> 2) + 4 * n + (i & 3); }

struct Unit { int pm, pn, z; };
struct Gemm { const bf16_t* A; const bf16_t* Bt; int lda, ldb, K; size_t zA, zB; };

struct TileOrder {
    int nM, nN, nz, ntile, G, c, zin;
    __device__ void init(int nM_, int nN_, int nz_, int zin_, int G_, int c_) { nM = nM_; nN = nN_; nz = nz_; zin = zin_; ntile = nM * nN; G = G_; c = c_; }
    __device__ bool next(int i, Unit& u) const {
        long L; int z;
        if (zin) { z = i % nz; L = (long)(i / nz) * G + c; if (L >= ntile) return false; }
        else { const long LL = (long)i * G + c; if (LL >= (long)ntile * nz) return false; z = (int)(LL / ntile); L = LL % ntile; }
        int wgid = (int)L; { const int q = ntile / NXCD, r = ntile % NXCD, xcd = wgid % NXCD, off = wgid / NXCD; wgid = (xcd < r ? xcd * (q + 1) : r * (q + 1) + (xcd - r) * q) + off; }
        const int nig = WGM * nN, gid = wgid / nig, fm = gid * WGM, gsz = (nM - fm) < WGM ? (nM - fm) : WGM;
        u.pm = fm + ((wgid % nig) % gsz); u.pn = (wgid % nig) / gsz; u.z = z; return true;
    }
};

template <class Epi, class Sched>
__device__ __forceinline__ void gemm_phase(LAS unsigned char* lds, const Gemm g, const Sched& S, const Epi& E) {
    int tid = threadIdx.x; asm volatile("" : "+v"(tid));
    const int wid = __builtin_amdgcn_readfirstlane(tid >> 6), lane = tid & 63, wr = wid >> 2, wc = wid & 3, fr = lane & 15, fq = lane >> 4;
    const int K = g.K, nt = K / BK;
    unsigned voffA[2], voffB[2];
#pragma unroll
    for (int i = 0; i < 2; ++i) { int R, C; stage_rc(tid * 16 + i * 8192, R, C); const int Rb = (R & ~31) + perm32(R & 31);
        voffA[i] = (unsigned)(R * g.lda + C) * 2u; voffB[i] = (unsigned)(Rb * g.ldb + C) * 2u; }
    const size_t kstep = (size_t)(BK * 2);
    const size_t hstepA = (size_t)HALF * g.lda * 2, hstepB = (size_t)HALF * g.ldb * 2;
    const unsigned ldsw = (unsigned)wid * 1024u;
    const int aoff = lds_byte(wr * 64 + fr, fq * 8), boff = lds_byte(wc * 32 + fr, fq * 8);
#define PG8_SA(b, h) (((b) * 2 + (h)) * HTB)
#define PG8_SB(b, h) ((4 + (b) * 2 + (h)) * HTB)
#define PG8_STAGE(bufoff, gbase, voff) do { _Pragma("unroll") for (int _i = 0; _i < 2; ++_i) \
        __builtin_amdgcn_global_load_lds((const unsigned*)((const char*)(gbase) + (voff)[_i]), (LAS unsigned*)(lds + (bufoff) + ldsw + _i * 8192), 16, 0, 0); } while (0)
#define PG8_LDA(dst, b, h) do { _Pragma("unroll") for (int m = 0; m < 4; ++m) _Pragma("unroll") for (int k = 0; k < 2; ++k) dst[m][k] = *(const LAS bf16x8*)(lds + PG8_SA(b, h) + aoff + m * 2048 + k * 1024); } while (0)
#define PG8_LDB(dst, b, h) do { _Pragma("unroll") for (int n = 0; n < 2; ++n) _Pragma("unroll") for (int k = 0; k < 2; ++k) dst[n][k] = *(const LAS bf16x8*)(lds + PG8_SB(b, h) + boff + n * 2048 + k * 1024); } while (0)
#define PG8_MMA(ai, bj, At, Bt) do { __builtin_amdgcn_s_setprio(1); _Pragma("unroll") for (int m = 0; m < 4; ++m) _Pragma("unroll") for (int n = 0; n < 2; ++n) _Pragma("unroll") for (int k = 0; k < 2; ++k) \
        acc[ai][bj][m][n] = __builtin_amdgcn_mfma_f32_16x16x32_bf16(Bt[n][k], At[m][k], acc[ai][bj][m][n], 0, 0, 0); __builtin_amdgcn_s_setprio(0); } while (0)
#define PG8_WAIT_V(n) asm volatile("s_waitcnt vmcnt(" #n ")" ::: "memory")
#define PG8_WAIT_L(n) asm volatile("s_waitcnt lgkmcnt(" #n ")" ::: "memory")
#define PG8_BAR __builtin_amdgcn_s_barrier()
#define PG8_SCHED __builtin_amdgcn_sched_barrier(0)
#define PG8_UA(u) ((const char*)(g.A + (size_t)(u).z * g.zA) + (size_t)(u).pm * (2 * hstepA))
#define PG8_UB(u) ((const char*)(g.Bt + (size_t)(u).z * g.zB) + (size_t)(u).pn * (2 * hstepB))
    Unit cur, nxt; int ui = 0;
    if (!S.next(0, cur)) return;
    f32x4 acc[2][2][4][2];
#pragma unroll
    for (int a = 0; a < 2; ++a)
#pragma unroll
        for (int b = 0; b < 2; ++b)
#pragma unroll
            for (int m = 0; m < 4; ++m)
#pragma unroll
                for (int n = 0; n < 2; ++n) acc[a][b][m][n] = (f32x4){0.f, 0.f, 0.f, 0.f};
    bf16x8 At[4][2], B0[2][2], B1[2][2];
    const char* cA = PG8_UA(cur); const char* cB = PG8_UB(cur);
    PG8_STAGE(PG8_SB(0, 0), cB, voffB); PG8_STAGE(PG8_SB(0, 1), cB + hstepB, voffB); PG8_STAGE(PG8_SA(0, 0), cA, voffA); PG8_STAGE(PG8_SA(0, 1), cA + hstepA, voffA);
    if (wr == 1) PG8_BAR;
    PG8_WAIT_V(2); PG8_BAR;
    PG8_STAGE(PG8_SB(1, 0), cB + kstep, voffB); PG8_STAGE(PG8_SA(1, 0), cA + kstep, voffA); PG8_STAGE(PG8_SB(1, 1), cB + hstepB + kstep, voffB);
    PG8_WAIT_V(6); PG8_BAR;
    for (;;) {
        const bool has_next = S.next(ui + 1, nxt);
        const char* nA = has_next ? PG8_UA(nxt) : cA; const char* nB = has_next ? PG8_UB(nxt) : cB;
#pragma unroll 1
        for (int t = 0; t < nt; t += 2) {
            const bool last = (t == nt - 2);
            const char* a1 = cA + (size_t)(t + 1) * kstep;
            const char* a2 = last ? nA : cA + (size_t)(t + 2) * kstep; const char* b2 = last ? nB : cB + (size_t)(t + 2) * kstep;
            const char* a3 = a2 + kstep; const char* b3 = b2 + kstep;
            PG8_LDB(B0, 0, 0); PG8_LDB(B1, 0, 1); PG8_SCHED; PG8_LDA(At, 0, 0); PG8_STAGE(PG8_SA(1, 1), a1 + hstepA, voffA);
            PG8_WAIT_V(8); PG8_WAIT_L(0); PG8_BAR; PG8_MMA(0, 0, At, B0); PG8_MMA(0, 1, At, B1); PG8_BAR; PG8_SCHED;
            PG8_LDA(At, 0, 1); PG8_STAGE(PG8_SB(0, 0), b2, voffB); PG8_STAGE(PG8_SB(0, 1), b2 + hstepB, voffB); PG8_STAGE(PG8_SA(0, 0), a2, voffA);
            PG8_WAIT_V(8); PG8_WAIT_L(0); PG8_BAR; PG8_MMA(1, 0, At, B0); PG8_MMA(1, 1, At, B1); PG8_BAR; PG8_SCHED;
            PG8_LDB(B0, 1, 0); PG8_LDB(B1, 1, 1); PG8_SCHED; PG8_LDA(At, 1, 0); PG8_STAGE(PG8_SA(0, 1), a2 + hstepA, voffA);
            PG8_WAIT_V(8); PG8_WAIT_L(0); PG8_BAR; PG8_MMA(0, 0, At, B0); PG8_MMA(0, 1, At, B1); PG8_BAR; PG8_SCHED;
            PG8_LDA(At, 1, 1); PG8_STAGE(PG8_SB(1, 0), b3, voffB); PG8_STAGE(PG8_SB(1, 1), b3 + hstepB, voffB); PG8_STAGE(PG8_SA(1, 0), a3, voffA);
            PG8_WAIT_V(8); PG8_WAIT_L(0); PG8_BAR; PG8_MMA(1, 0, At, B0); PG8_MMA(1, 1, At, B1); PG8_BAR; PG8_SCHED;
        }
        if (wr == 0) PG8_BAR;
        const bool keep = E(acc, cur, wr, wc, fr, fq);
        if (!has_next) break;
        if (!keep) {
#pragma unroll
            for (int a = 0; a < 2; ++a)
#pragma unroll
                for (int b = 0; b < 2; ++b)
#pragma unroll
                    for (int m = 0; m < 4; ++m)
#pragma unroll
                        for (int n = 0; n < 2; ++n) acc[a][b][m][n] = (f32x4){0.f, 0.f, 0.f, 0.f};
        }
        cur = nxt; cA = nA; cB = nB; ++ui;
        if (wr == 1) PG8_BAR;
    }
    PG8_WAIT_V(0);
    PG8_BAR;
#undef PG8_SA
#undef PG8_SB
#undef PG8_STAGE
#undef PG8_LDA
#undef PG8_LDB
#undef PG8_MMA
#undef PG8_WAIT_V
#undef PG8_WAIT_L
#undef PG8_BAR
#undef PG8_SCHED
#undef PG8_UA
#undef PG8_UB
}
}
#define EPI_ARGS f32x4 (&acc)[2][2][4][2], const pg8::Unit& u, int wr, int wc, int fr, int fq
#define EPI_FOR_ROWS _Pragma("unroll") for (int ai = 0; ai < 2; ++ai) _Pragma("unroll") for (int m = 0; m < 4; ++m)
#define EPI_ROW (u.pm * 256 + ai * 128 + wr * 64 + m * 16 + fr)
#define EPI_FOR_COLS _Pragma("unroll") for (int bj = 0; bj < 2; ++bj)
#define EPI_COL (u.pn * 256 + bj * 128 + wc * 32 + 8 * fq)

__device__ __forceinline__ u32x4 pack8(const f32x4& a, const f32x4& b) { u32x4 w; w.x = pk2(a[0], a[1]); w.y = pk2(a[2], a[3]); w.z = pk2(b[0], b[1]); w.w = pk2(b[2], b[3]); return w; }
__device__ __forceinline__ void unpack8(const u32x4& w, float (&f)[8]) {
    f[0] = bf2f(w.x & 0xffffu); f[1] = __uint_as_float(w.x & 0xffff0000u); f[2] = bf2f(w.y & 0xffffu); f[3] = __uint_as_float(w.y & 0xffff0000u);
    f[4] = bf2f(w.z & 0xffffu); f[5] = __uint_as_float(w.z & 0xffff0000u); f[6] = bf2f(w.w & 0xffffu); f[7] = __uint_as_float(w.w & 0xffff0000u);
}

__device__ __forceinline__ u32x2 pack4(const f32x4& v) { u32x2 w; w.x = pk2(v[0], v[1]); w.y = pk2(v[2], v[3]); return w; }
__device__ __forceinline__ f32x4 unpack4(const u32x2& x) { return (f32x4){bf2f(x.x & 0xffffu), __uint_as_float(x.x & 0xffff0000u), bf2f(x.y & 0xffffu), __uint_as_float(x.y & 0xffff0000u)}; }

struct EpiProj {
    bf16_t* P; float* gate; float* out; int layer;
    __device__ __forceinline__ bool operator()(EPI_ARGS) const {
        const int pn = u.pn;
        int mode;
        if (pn < 4) mode = 0; else if (pn < 8) mode = 1; else if (pn < 12) mode = 5; else if (pn < 16) mode = 3; else if (pn < 18) mode = 0;
        else if (pn < 22) mode = 1; else if (pn < 26) mode = 0; else if (pn < 30) mode = 1; else if (pn < 54) mode = 2; else mode = 4;
        if (mode == 0) {
            EPI_FOR_ROWS { bf16_t* rp = P + (size_t)EPI_ROW * NPROJ; EPI_FOR_COLS { *(u32x4*)(rp + EPI_COL) = pack8(acc[ai][bj][m][0], acc[ai][bj][m][1]); } }
        } else if (mode == 5) {
            EPI_FOR_ROWS { bf16_t* rp = P + (size_t)EPI_ROW * NPROJ; EPI_FOR_COLS { *(u32x4*)(rp + EPI_COL) = pack8(acc[ai][bj][m][0] * SM_SCALE_L2E, acc[ai][bj][m][1] * SM_SCALE_L2E); } }
        } else if (mode == 1) {
            EPI_FOR_ROWS { bf16_t* rp = P + (size_t)EPI_ROW * NPROJ; EPI_FOR_COLS { f32x4 a = acc[ai][bj][m][0], b = acc[ai][bj][m][1];
#pragma unroll
                for (int j = 0; j < 4; ++j) { a[j] = siluf_(a[j]); b[j] = siluf_(b[j]); }
                *(u32x4*)(rp + EPI_COL) = pack8(a, b); } }
        } else if (mode == 2) {
            EPI_FOR_ROWS { bf16_t* rp = P + (size_t)EPI_ROW * NPROJ; EPI_FOR_COLS { f32x4 a = acc[ai][bj][m][0], b = acc[ai][bj][m][1];
#pragma unroll
                for (int j = 0; j < 4; ++j) { a[j] = sigmoidf_(a[j]); b[j] = sigmoidf_(b[j]); }
                *(u32x4*)(rp + EPI_COL) = pack8(a, b); } }
        } else if (mode == 3) {
            EPI_FOR_ROWS { const int row = EPI_ROW; bf16_t* rp = P + (size_t)row * NPROJ;
                float* op = nullptr;
                if (row < MPT) op = out + O_KVP + ((size_t)layer * MPT + row) * 1024;
                else if (row < MROWS) op = out + O_KVS + ((size_t)layer * 32 + (row - MPT)) * 1024;
                EPI_FOR_COLS { const int col = EPI_COL; *(u32x4*)(rp + col) = pack8(acc[ai][bj][m][0], acc[ai][bj][m][1]);
                    if (op) { *(f32x4*)(op + col - C_CK) = acc[ai][bj][m][0]; *(f32x4*)(op + col - C_CK + 4) = acc[ai][bj][m][1]; } } }
        } else {
            EPI_FOR_ROWS { float* gp = gate + (size_t)EPI_ROW * 64; EPI_FOR_COLS { const int c = EPI_COL - C_AG; if (c < 48) { f32x4 a = acc[ai][bj][m][0], b = acc[ai][bj][m][1];
#pragma unroll
                for (int j = 0; j < 4; ++j) { a[j] = sigmoidf_(a[j]); b[j] = sigmoidf_(b[j]); }
                *(f32x4*)(gp + c) = a; *(f32x4*)(gp + c + 4) = b; } } }
        }
        return false;
    }
};

struct EpiPool {
    bf16_t* apool; const bf16_t* P; const float* pscale;
    __device__ __forceinline__ bool operator()(EPI_ARGS) const {
        asm volatile("" ::: "memory");
#pragma unroll
        for (int ai = 0; ai < 2; ++ai) {
            u32x4 zw[4][2];
#pragma unroll
            for (int m = 0; m < 4; ++m) EPI_FOR_COLS { const int col = u.z * 256 + bj * 128 + wc * 32 + 8 * fq; zw[m][bj] = *(const u32x4*)(P + (size_t)EPI_ROW * NPROJ + C_PZ + col); }
            __builtin_amdgcn_sched_barrier(0);
#pragma unroll
            for (int m = 0; m < 4; ++m) EPI_FOR_COLS { const int col = u.z * 256 + bj * 128 + wc * 32 + 8 * fq; float zf[8]; unpack8(zw[m][bj], zf);
                const f32x4 s0 = *(const f32x4*)(pscale + col), s1 = *(const f32x4*)(pscale + col + 4);
                f32x4 a = acc[ai][bj][m][0], b = acc[ai][bj][m][1];
#pragma unroll
                for (int j = 0; j < 4; ++j) { a[j] = a[j] * s0[j] * zf[j]; b[j] = b[j] * s1[j] * zf[4 + j]; }
                *(u32x4*)(apool + (size_t)EPI_ROW * 1024 + col) = pack8(a, b); }
            __builtin_amdgcn_sched_barrier(0);
        }
        return false;
    }
};

struct EpiGlu {
    bf16_t* assm; const bf16_t* P; const bf16_t* Z;
    __device__ __forceinline__ bool operator()(EPI_ARGS) const {
#pragma unroll
        for (int ai = 0; ai < 2; ++ai) {
            u32x4 zw[4][2], sw[4][2];
#pragma unroll
            for (int m = 0; m < 4; ++m) EPI_FOR_COLS { const int row = EPI_ROW, col = EPI_COL; zw[m][bj] = *(const u32x4*)(Z + (size_t)row * 1024 + col); sw[m][bj] = *(const u32x4*)(P + (size_t)row * NPROJ + C_SZ + col); }
            __builtin_amdgcn_sched_barrier(0);
#pragma unroll
            for (int m = 0; m < 4; ++m) EPI_FOR_COLS { float zf[8], sf[8]; unpack8(zw[m][bj], zf); unpack8(sw[m][bj], sf);
                f32x4 a = acc[ai][bj][m][0], b = acc[ai][bj][m][1];
#pragma unroll
                for (int j = 0; j < 4; ++j) { a[j] = zf[j] * sigmoidf_(a[j]) * sf[j]; b[j] = zf[4 + j] * sigmoidf_(b[j]) * sf[4 + j]; }
                *(u32x4*)(assm + (size_t)EPI_ROW * 1024 + EPI_COL) = pack8(a, b); }
            __builtin_amdgcn_sched_barrier(0);
        }
        return false;
    }
};

struct EpiBranch {
    bf16_t* merged; const bf16_t* P;
    __device__ __forceinline__ bool operator()(EPI_ARGS) const {
        const int z = u.z;
#pragma unroll
        for (int ai = 0; ai < 2; ++ai) {
            u32x4 gzw[4][2], gnw[4][2];
#pragma unroll
            for (int m = 0; m < 4; ++m) EPI_FOR_COLS { const bf16_t* gp = P + (size_t)EPI_ROW * NPROJ + C_MG + EPI_COL; gzw[m][bj] = *(const u32x4*)(gp + z * 2048); gnw[m][bj] = *(const u32x4*)(gp + (z < 2 ? z + 1 : 2) * 2048); }
            __builtin_amdgcn_sched_barrier(0);
#pragma unroll
            for (int m = 0; m < 4; ++m) EPI_FOR_COLS { float gz[8], gn[8]; unpack8(gzw[m][bj], gz); unpack8(gnw[m][bj], gn);
                f32x4& a = acc[ai][bj][m][0]; f32x4& b = acc[ai][bj][m][1];
                if (z < 2) {
#pragma unroll
                    for (int j = 0; j < 4; ++j) { a[j] *= fmaxf(gz[j], 1e-30f) * __builtin_amdgcn_rcpf(fmaxf(gn[j], 1e-30f)); b[j] *= fmaxf(gz[4 + j], 1e-30f) * __builtin_amdgcn_rcpf(fmaxf(gn[4 + j], 1e-30f)); }
                } else {
                    f32x4 a2, b2;
#pragma unroll
                    for (int j = 0; j < 4; ++j) { a2[j] = a[j] * fmaxf(gz[j], 1e-30f); b2[j] = b[j] * fmaxf(gz[4 + j], 1e-30f); }
                    *(u32x4*)(merged + (size_t)EPI_ROW * DM + EPI_COL) = pack8(a2, b2);
                } }
            __builtin_amdgcn_sched_barrier(0);
        }
        return z < 2;
    }
};

struct EpiOut {
    bf16_t* outb;
    __device__ __forceinline__ bool operator()(EPI_ARGS) const {
        EPI_FOR_ROWS { bf16_t* rp = outb + (size_t)EPI_ROW * DM; EPI_FOR_COLS { *(u32x4*)(rp + EPI_COL) = pack8(acc[ai][bj][m][0], acc[ai][bj][m][1]); } }
        return false;
    }
};
struct Frame {
    LAS unsigned char* lds;
    int tid, lane, wave, G, bid, gw, ngw;
    float* out; unsigned char* ws;
};
#define FIN(i) ((const float*)(const GAS float*)(((const float* const __attribute__((address_space(4)))*)__builtin_amdgcn_kernarg_segment_ptr())[i]))
#define IN_XP 0
#define IN_XS 1
#define IN_CACHE 2
#define IN_PT 3
#define IN_SWIN 4
#define IN_SPOOL 5
#define IN_SSSM 6
#define IN_GPRE 7
#define IN_GPOST 8
#define IN_WIN 9
#define IN_WPOOL 10
#define IN_PSCALE 11
#define IN_PE 12
#define IN_WPHI 13
#define IN_LRE 14
#define IN_LIM 15
#define IN_LSTEP 16
#define IN_BRE 17
#define IN_BIM 18
#define IN_CRE 19
#define IN_CIM 20
#define IN_DSKIP 21
#define IN_WGLU 22
#define IN_WBRP 23
#define IN_WBRN 24
#define IN_WBRS 25
#define IN_WOUT 26

template <class MAP>
__device__ __forceinline__ void transpose_item(const float* W, int ldw, int K, bf16_t* WT, int k0, int nd0, LAS float* scr, int lane, const MAP& map) {
    const int nq = 4 * (lane & 15), ns = map(nd0 + nq), kr = lane >> 4;
    f32x4 v[16];
#pragma unroll
    for (int i = 0; i < 16; ++i) v[i] = ns >= 0 ? *(const f32x4*)(W + (size_t)(k0 + 4 * i + kr) * ldw + ns) : (f32x4){0.f, 0.f, 0.f, 0.f};
#pragma unroll
    for (int i = 0; i < 16; ++i) { LAS float* d = scr + (4 * i + kr) * 65 + nq; d[0] = v[i].x; d[1] = v[i].y; d[2] = v[i].z; d[3] = v[i].w; }
    LDS_WAIT(); asm volatile("" ::: "memory");
    const int c = lane & 7;
#pragma unroll
    for (int j = 0; j < 8; ++j) { const int n = (lane >> 3) + 8 * j; const LAS float* s = scr + (8 * c) * 65 + n;
        u32x4 o; o.x = pk2(s[0 * 65], s[1 * 65]); o.y = pk2(s[2 * 65], s[3 * 65]); o.z = pk2(s[4 * 65], s[5 * 65]); o.w = pk2(s[6 * 65], s[7 * 65]);
        *(u32x4*)(WT + (size_t)(nd0 + n) * K + k0 + 8 * c) = o; }
    LDS_WAIT(); asm volatile("" ::: "memory");
}
struct MapId { __device__ __forceinline__ int operator()(int n) const { return n; } };
struct MapWin { __device__ __forceinline__ int operator()(int n) const { return n < C_AZ ? n : (n < C_AG ? n + 48 : (n < C_AG + 48 ? n - C_AG + 4608 : -1)); } };

__device__ __forceinline__ double exp_d(double x) {
    const double r = x * (1.0 / 64.0); double t = 1.0, s = 1.0;
#pragma unroll
    for (int k = 1; k <= 14; ++k) { t *= r / (double)k; s += t; }
#pragma unroll
    for (int k = 0; k < 6; ++k) s *= s;
    return s;
}
__device__ __forceinline__ void sincos_d(double x, double& sn, double& cs) {
    const double k = rint(x * 0.63661977236758134308);
    double r = fma(-k, 1.57079632679489655800e+00, x); r = fma(-k, 6.12323399573676603587e-17, r);
    const double r2 = r * r;
    double sp = 1.0, cp = 1.0, ts = 1.0, tc = 1.0;
#pragma unroll
    for (int i = 1; i <= 9; ++i) { ts *= -r2 / (double)((2 * i) * (2 * i + 1)); sp += ts; tc *= -r2 / (double)((2 * i - 1) * (2 * i)); cp += tc; }
    sp *= r;
    const int q = ((int)k) & 3;
    sn = (q == 0) ? sp : (q == 1) ? cp : (q == 2) ? -sp : -cp;
    cs = (q == 0) ? cp : (q == 1) ? -sp : (q == 2) ? -cp : sp;
}

__device__ __forceinline__ void rms_row_to_bf16(const float* xrow, const float* g, bf16_t* orow, int lane) {
    const f32x4* xr = (const f32x4*)xrow + lane; const f32x4* gr = (const f32x4*)g + lane;
    f32x4 v[8]; float s = 0.f;
#pragma unroll
    for (int j = 0; j < 8; ++j) { v[j] = xr[64 * j]; s += (v[j].x * v[j].x + v[j].y * v[j].y) + (v[j].z * v[j].z + v[j].w * v[j].w); }
    const float rstd = 1.f / sqrtf(wave_sum(s) * (1.f / DM) + EPS);
    u32x2* o8 = (u32x2*)orow + lane;
#pragma unroll
    for (int j = 0; j < 8; ++j) { const f32x4 gg = gr[64 * j]; u32x2 w; w.x = pk2(v[j].x * rstd * gg.x, v[j].y * rstd * gg.y); w.y = pk2(v[j].z * rstd * gg.z, v[j].w * rstd * gg.w); o8[64 * j] = w; }
}
__device__ __forceinline__ const float* x_row_l0(const Frame& F, int m) {
    const GAS float* s0 = (const GAS float*)FIN(IN_XP); const GAS float* s1 = (const GAS float*)FIN(IN_XS);
    asm volatile("" : "+s"(s0), "+s"(s1));
    return (const float*)(m < MPT ? s0 + (size_t)m * DM : s1 + (size_t)(m - MPT) * DM); }

__device__ __forceinline__ void phase_prologue(Frame& F) {
    LAS float* scr = (LAS float*)(F.lds + F.wave * 16640);
    const int lane = F.lane;
    constexpr int I_WIN = 32 * (NPROJ / 64), I_GLU = 16 * 16, I_BR = 16 * 32, I_OUT = 32 * 32, I_POOL = 4 * 4, I_PHI = 1;
    constexpr int PER_L = I_WIN + I_GLU + 3 * I_BR + I_OUT + 4 * I_POOL + 128 * I_PHI;
    for (int it = F.gw; it < 2 * PER_L; it += F.ngw) {
        const int l = it / PER_L; int r = it % PER_L;
        if (r < I_WIN) { const int kb = r / (NPROJ / 64), nb = r % (NPROJ / 64);
            transpose_item(FIN(IN_WIN) + (size_t)l * DM * DIN, DIN, DM, (bf16_t*)(F.ws + WS_WIN + l * al1m(SZ_WIN)), 64 * kb, 64 * nb, scr, lane, MapWin()); continue; } r -= I_WIN;
        if (r < I_GLU) { const int kb = r / 16, nb = r % 16;
            transpose_item(FIN(IN_WGLU) + (size_t)l * 1024 * 1024, 1024, 1024, (bf16_t*)(F.ws + WS_WGLU + l * al1m(SZ_WGLU)), 64 * kb, 64 * nb, scr, lane, MapId()); continue; } r -= I_GLU;
        if (r < 3 * I_BR) { const int z = r / I_BR, rr = r % I_BR, kb = rr / 32, nb = rr % 32;
            const float* src = FIN(IN_WBRP + z) + (size_t)l * 1024 * 2048;
            transpose_item(src, 2048, 1024, (bf16_t*)(F.ws + WS_WBR + l * al1m(SZ_WBR)) + (size_t)z * 2048 * 1024, 64 * kb, 64 * nb, scr, lane, MapId()); continue; } r -= 3 * I_BR;
        if (r < I_OUT) { const int kb = r / 32, nb = r % 32;
            transpose_item(FIN(IN_WOUT) + (size_t)l * 2048 * 2048, 2048, 2048, (bf16_t*)(F.ws + WS_WOUT + l * al1m(SZ_WOUT)), 64 * kb, 64 * nb, scr, lane, MapId()); continue; } r -= I_OUT;
        if (r < 4 * I_POOL) { const int z = r / I_POOL, rr = r % I_POOL, kb = rr / 4, nb = rr % 4;
            transpose_item(FIN(IN_WPOOL) + ((size_t)l * 4 + z) * 65536, 256, 256, (bf16_t*)(F.ws + WS_WPOOL + l * al1m(SZ_WPOOL)) + (size_t)z * 65536, 64 * kb, 64 * nb, scr, lane, MapId()); continue; } r -= 4 * I_POOL;
        {
            transpose_item(FIN(IN_WPHI) + ((size_t)l * 128 + r) * 4096, 64, 64, (bf16_t*)(F.ws + WS_WPHI + l * al1m(SZ_WPHI)) + (size_t)r * 4096, 0, 0, scr, lane, MapId()); }
    }
    for (int it = F.gw; it < 64; it += F.ngw) {
        const int l = it >> 5, j = (it >> 4) & 1, part = it & 15;
        const float* pe = FIN(IN_PE) + ((size_t)(l * 2 + j) * 64 + part * 4) * 64;
        const float* wp = FIN(IN_WPHI) + ((size_t)(l * 2 + j) * 64 + part * 4) * 4096;
        float s = 0.f;
#pragma unroll 16
        for (int i = 0; i < 256; ++i) s += pe[i] * wp[(size_t)i * 64 + lane];
        ((float*)(F.ws + WS_PEBP + l * al1m(SZ_PEBP)))[(j * 16 + part) * 64 + lane] = s;
    }
    for (int it = F.gw * 64 + lane; it < 2 * 4096; it += F.ngw * 64) {
        const int l = it >> 12, g = (it >> 6) & 63, n = it & 63;
        const double dt = exp_d((double)FIN(IN_LSTEP)[l * 64 + g]);
        const double lr = (double)FIN(IN_LRE)[(l * 64 + g) * 64 + n], li = (double)FIN(IN_LIM)[(l * 64 + g) * 64 + n];
        const double mag = exp_d(lr * dt); double sn, cs; sincos_d(li * dt, sn, cs);
        const double ar = mag * cs, ai = mag * sn, den = lr * lr + li * li;
        const double cr = ((ar - 1.0) * lr + ai * li) / den, ci = (ai * lr - (ar - 1.0) * li) / den;
        double pr = ar, pi = ai;
#pragma unroll
        for (int k = 0; k < 7; ++k) { const double t = pr * pr - pi * pi; pi = 2.0 * pr * pi; pr = t; }
        float* ab = (float*)(F.ws + WS_SAB + l * al1m(SZ_SAB)) + (g * 64 + n) * 4;
        ab[0] = (float)ar; ab[1] = (float)ai; ab[2] = (float)pr; ab[3] = (float)pi;
        float* bb = (float*)(F.ws + WS_SBB + l * al1m(SZ_SBB)) + (size_t)g * 16 * 128;
        const float* bre = FIN(IN_BRE) + ((size_t)(l * 64 + g) * 64 + n) * 16; const float* bim = FIN(IN_BIM) + ((size_t)(l * 64 + g) * 64 + n) * 16;
        unsigned* bb16 = (unsigned*)(F.ws + WS_SBB16 + l * al1m(SZ_SBB16));
        for (int c = 0; c < 16; c += 2) { const double br0 = bre[c], bi0 = bim[c], br1 = bre[c + 1], bi1 = bim[c + 1];
            const float r0 = (float)(cr * br0 - ci * bi0), i0 = (float)(cr * bi0 + ci * br0), r1 = (float)(cr * br1 - ci * bi1), i1 = (float)(cr * bi1 + ci * br1);
            bb[c * 128 + n] = r0; bb[c * 128 + 64 + n] = i0; bb[(c + 1) * 128 + n] = r1; bb[(c + 1) * 128 + 64 + n] = i1;
            bb16[(((g * 2 + 0) * 64 + n) * 16 + c) >> 1] = pk2(r0, r1); bb16[(((g * 2 + 1) * 64 + n) * 16 + c) >> 1] = pk2(i0, i1); }
        bf16_t* cm = (bf16_t*)(F.ws + WS_SCM + l * al1m(SZ_SCM)) + (size_t)g * 16 * 128;
        const float* cre = FIN(IN_CRE) + (size_t)(l * 64 + g) * 16 * 64; const float* cim = FIN(IN_CIM) + (size_t)(l * 64 + g) * 16 * 64;
        for (int c = 0; c < 16; ++c) *(unsigned*)(cm + c * 128 + 2 * n) = pk2(cre[c * 64 + n], -cim[c * 64 + n]);
    }
    bf16_t* H = (bf16_t*)(F.ws + WS_H);
    for (int m = F.gw; m < MROWS; m += F.ngw) rms_row_to_bf16(x_row_l0(F, m), FIN(IN_GPRE), H + (size_t)m * DM, lane);
}

__device__ __forceinline__ void phase_norm(Frame& F, int l) {
    const int lane = F.lane;
    const bf16_t* outb = (const bf16_t*)(F.ws + WS_OUTB);
    float* y0 = (float*)(F.ws + WS_Y0);
    bf16_t* H = (bf16_t*)(F.ws + WS_H);
    for (int r = F.bid; r < MROWS - MPT; r += F.G) {
        const int m = MPT + r, c0 = F.wave * 256 + 4 * lane;
        LAS float* red = (LAS float*)F.lds;
        const float* xrow = l == 0 ? FIN(IN_XS) + (size_t)r * DM : y0 + (size_t)m * DM;
        float* yrow = l == 0 ? y0 + (size_t)m * DM : F.out + O_YS + (size_t)r * DM;
        const f32x4 o = unpack4(*(const u32x2*)(outb + (size_t)m * DM + c0)), x = *(const f32x4*)(xrow + c0), g = *(const f32x4*)(FIN(IN_GPOST) + l * DM + c0);
        float s = wave_sum(o.x * o.x + o.y * o.y + o.z * o.z + o.w * o.w);
        __syncthreads();
        if (lane == 0) red[F.wave] = s;
        __syncthreads();
        s = 0.f;
#pragma unroll
        for (int w2 = 0; w2 < NWAVES; ++w2) s += red[w2];
        const float rstd = 1.f / sqrtf(s * (1.f / DM) + EPS);
        const f32x4 y = x + o * rstd * g;
        *(f32x4*)(yrow + c0) = y;
        if (l == 0) {
            float s2 = wave_sum(y.x * y.x + y.y * y.y + y.z * y.z + y.w * y.w);
            if (lane == 0) red[8 + F.wave] = s2;
            __syncthreads();
            s2 = 0.f;
#pragma unroll
            for (int w2 = 0; w2 < NWAVES; ++w2) s2 += red[8 + w2];
            const float rstd2 = 1.f / sqrtf(s2 * (1.f / DM) + EPS);
            const f32x4 g2 = *(const f32x4*)(FIN(IN_GPRE) + DM + c0);
            *(u32x2*)(H + (size_t)m * DM + c0) = pack4(y * rstd2 * g2);
        }
    }
    for (int m = F.gw; m < MPT; m += F.ngw) {
        const float* xrow = l == 0 ? x_row_l0(F, m) : y0 + (size_t)m * DM;
        float* yrow = l == 0 ? y0 + (size_t)m * DM : (m < MPT ? F.out + O_YP + (size_t)m * DM : F.out + O_YS + (size_t)(m - MPT) * DM);
        const float* gp = FIN(IN_GPOST) + l * DM;
        float v[4][8]; float s = 0.f;
#pragma unroll
        for (int j = 0; j < 4; ++j) { const u32x4 w = *(const u32x4*)(outb + (size_t)m * DM + 8 * (lane + 64 * j)); unpack8(w, v[j]);
#pragma unroll
            for (int e = 0; e < 8; ++e) s += v[j][e] * v[j][e]; }
        const float rstd = 1.f / sqrtf(wave_sum(s) * (1.f / DM) + EPS);
        float s2 = 0.f;
#pragma unroll
        for (int j = 0; j < 4; ++j) { const int c0 = 8 * (lane + 64 * j);
            const f32x4 g0 = *(const f32x4*)(gp + c0), g1 = *(const f32x4*)(gp + c0 + 4), x0 = *(const f32x4*)(xrow + c0), x1 = *(const f32x4*)(xrow + c0 + 4);
            f32x4 y0v, y1v;
#pragma unroll
            for (int e = 0; e < 4; ++e) { y0v[e] = x0[e] + v[j][e] * rstd * g0[e]; y1v[e] = x1[e] + v[j][4 + e] * rstd * g1[e]; v[j][e] = y0v[e]; v[j][4 + e] = y1v[e]; s2 += y0v[e] * y0v[e] + y1v[e] * y1v[e]; }
            *(f32x4*)(yrow + c0) = y0v; *(f32x4*)(yrow + c0 + 4) = y1v; }
        if (l == 0) {
            const float rstd2 = 1.f / sqrtf(wave_sum(s2) * (1.f / DM) + EPS);
            const float* g2 = FIN(IN_GPRE) + DM;
#pragma unroll
            for (int j = 0; j < 4; ++j) { const int c0 = 8 * (lane + 64 * j); const f32x4 g0 = *(const f32x4*)(g2 + c0), g1 = *(const f32x4*)(g2 + c0 + 4);
                f32x4 a, bq;
#pragma unroll
                for (int e = 0; e < 4; ++e) { a[e] = v[j][e] * rstd2 * g0[e]; bq[e] = v[j][4 + e] * rstd2 * g1[e]; }
                *(u32x4*)(H + (size_t)m * DM + c0) = pack8(a, bq); }
        }
    }
}
template <int KP>
__device__ __forceinline__ void skinny_stage(LAS unsigned char* lds, const bf16_t* A, int lda, int tid) {
    constexpr int CH = KP / 8;
#pragma unroll 8
    for (int i = tid; i < 32 * CH; i += NT) { const int r = i / CH, c = i % CH; *(LAS u32x4*)(lds + r * (KP * 2 + 16) + c * 16) = *(const u32x4*)(A + (size_t)r * lda + 8 * c); }
    __syncthreads();
}
template <int KP>
__device__ __forceinline__ void skinny_tile(const LAS unsigned char* lds, const bf16_t* Bt, int ldb, int n0, int kbeg, int klen, int lane, f32x4& d0, f32x4& d1) {
    const int rw = lane & 15, q = lane >> 4;
    const bf16_t* wrow = Bt + (size_t)(n0 + rw) * ldb + 32 * q;
    const LAS unsigned char* a0 = lds + rw * (KP * 2 + 16) + (kbeg + 32 * q) * 2;
    const LAS unsigned char* a1 = a0 + 16 * (KP * 2 + 16);
    d0 = (f32x4){0.f, 0.f, 0.f, 0.f}; d1 = d0;
#pragma unroll 4
    for (int k0 = 0; k0 < klen; k0 += 128) {
        bf16x8 w[4];
#pragma unroll
        for (int s = 0; s < 4; ++s) w[s] = *(const bf16x8*)(wrow + k0 + 8 * s);
#pragma unroll
        for (int s = 0; s < 4; ++s) { const bf16x8 b0 = *(const LAS bf16x8*)(a0 + k0 * 2 + 16 * s), b1 = *(const LAS bf16x8*)(a1 + k0 * 2 + 16 * s);
            d0 = __builtin_amdgcn_mfma_f32_16x16x32_bf16(w[s], b0, d0, 0, 0, 0); d1 = __builtin_amdgcn_mfma_f32_16x16x32_bf16(w[s], b1, d1, 0, 0, 0); }
    }
}

__device__ __forceinline__ void skinny_proj(Frame& F, int l) {
    constexpr int NTASK = NPROJ / 128;
    bf16_t* P = (bf16_t*)(F.ws + WS_P); float* gate = (float*)(F.ws + WS_GATE);
    const bf16_t* W = (const bf16_t*)(F.ws + WS_WIN + l * al1m(SZ_WIN));
    bool staged = false;
    const int ntile = (MPT / 256) * (NPROJ / 256), nlight = (ntile % F.G) ? F.G - (ntile % F.G) : F.G, first = F.G - nlight;
    for (int it = 0; it < 2; ++it) { int task;
        if (F.bid >= first) task = (F.bid - first) + it * nlight; else { if (it) break; task = 2 * nlight + (first - 1 - F.bid); }
        if (task >= NTASK) break;
        if (!staged) { skinny_stage<DM>(F.lds, (const bf16_t*)(F.ws + WS_H) + (size_t)MPT * DM, DM, F.tid); staged = true; }
        const int n0 = task * 128 + F.wave * 16; f32x4 d[2];
        skinny_tile<DM>(F.lds, W, DM, n0, 0, DM, F.lane, d[0], d[1]);
        const int n = n0 + 4 * (F.lane >> 4), pn = n >> 8;
        int mode; if (pn < 4) mode = 0; else if (pn < 8) mode = 1; else if (pn < 12) mode = 5; else if (pn < 16) mode = 3; else if (pn < 18) mode = 0;
        else if (pn < 22) mode = 1; else if (pn < 26) mode = 0; else if (pn < 30) mode = 1; else if (pn < 54) mode = 2; else mode = 4;
#pragma unroll
        for (int tt = 0; tt < 2; ++tt) { const int t = 16 * tt + (F.lane & 15), row = MPT + t; f32x4 v = d[tt];
            if (mode == 4) { const int c = n - C_AG; if (c < 48) {
#pragma unroll
                for (int j = 0; j < 4; ++j) v[j] = sigmoidf_(v[j]);
                *(f32x4*)(gate + (size_t)row * 64 + c) = v; } }
            else {
                if (mode == 3) *(f32x4*)(F.out + O_KVS + ((size_t)l * 32 + t) * 1024 + n - C_CK) = v;
                if (mode == 5) v = v * SM_SCALE_L2E;
                if (mode == 1) {
#pragma unroll
                    for (int j = 0; j < 4; ++j) v[j] = siluf_(v[j]); }
                if (mode == 2) {
#pragma unroll
                    for (int j = 0; j < 4; ++j) v[j] = sigmoidf_(v[j]); }
                *(u32x2*)(P + (size_t)row * NPROJ + n) = pack4(v);
            } }
    }
    __syncthreads();
}
__device__ __forceinline__ void skinny_pool(Frame& F, int l) {
    const bf16_t* P = (const bf16_t*)(F.ws + WS_P); bf16_t* apool = (bf16_t*)(F.ws + WS_ABR);
    const bf16_t* W = (const bf16_t*)(F.ws + WS_WPOOL + l * al1m(SZ_WPOOL)); const float* pscale = FIN(IN_PSCALE) + l * 1024;
    bool staged = false;
    for (int task = F.G - 1 - F.bid; task < 8; task += F.G) {
        if (!staged) { skinny_stage<1024>(F.lds, (const bf16_t*)(F.ws + WS_DIFF) + (size_t)MPT * 1024, 1024, F.tid); staged = true; }
        const int z = task >> 1, n0 = (task & 1) * 128 + F.wave * 16; f32x4 d[2];
        skinny_tile<1024>(F.lds, W + (size_t)z * 65536, 256, n0, z * 256, 256, F.lane, d[0], d[1]);
        const int col = z * 256 + n0 + 4 * (F.lane >> 4);
        const f32x4 ps = *(const f32x4*)(pscale + col);
#pragma unroll
        for (int tt = 0; tt < 2; ++tt) { const int row = MPT + 16 * tt + (F.lane & 15);
            const f32x4 zf = unpack4(*(const u32x2*)(P + (size_t)row * NPROJ + C_PZ + col));
            *(u32x2*)(apool + (size_t)row * 1024 + col) = pack4(d[tt] * ps * zf); }
    }
    __syncthreads();
}
__device__ __forceinline__ void skinny_glu(Frame& F, int l) {
    const bf16_t* P = (const bf16_t*)(F.ws + WS_P); const bf16_t* Z = (const bf16_t*)(F.ws + WS_Z); bf16_t* assm = (bf16_t*)(F.ws + WS_ABR + 2 * SZ_ABR1);
    const bf16_t* W = (const bf16_t*)(F.ws + WS_WGLU + l * al1m(SZ_WGLU));
    bool staged = false;
    for (int task = F.G - 9 - F.bid; task < 8; task += F.G) {
        if (task < 0) continue;
        if (!staged) { skinny_stage<1024>(F.lds, Z + (size_t)MPT * 1024, 1024, F.tid); staged = true; }
        const int n0 = task * 128 + F.wave * 16; f32x4 d[2];
        skinny_tile<1024>(F.lds, W, 1024, n0, 0, 1024, F.lane, d[0], d[1]);
        const int col = n0 + 4 * (F.lane >> 4);
#pragma unroll
        for (int tt = 0; tt < 2; ++tt) { const int row = MPT + 16 * tt + (F.lane & 15);
            const f32x4 zf = unpack4(*(const u32x2*)(Z + (size_t)row * 1024 + col)), sf = unpack4(*(const u32x2*)(P + (size_t)row * NPROJ + C_SZ + col));
            f32x4 v = d[tt];
#pragma unroll
            for (int j = 0; j < 4; ++j) v[j] = zf[j] * sigmoidf_(v[j]) * sf[j];
            *(u32x2*)(assm + (size_t)row * 1024 + col) = pack4(v); }
    }
    __syncthreads();
}
__device__ __forceinline__ void skinny_stage_att(Frame& F) {
    const bf16_t* P = (const bf16_t*)(F.ws + WS_P); const float* so = (const float*)(F.ws + WS_SOACC); const float* gate = (const float*)(F.ws + WS_GATE);
#pragma unroll 2
    for (int i = F.tid; i < 32 * 128; i += NT) { const int r = i >> 7, c = i & 127, head = c >> 3, d0 = (c & 7) * 8, row = MPT + r;
        const int unit = (r >> 2) * 16 + (head >> 2) * 4 + (r & 3);
        const float* sp = so + (size_t)unit * 768 + (head & 3) * 64 + d0; const float* gt = gate + (size_t)row * 64 + head * 3;
        const float g0 = gt[0], g1 = gt[1], g2 = gt[2];
        float zf[8]; unpack8(*(const u32x4*)(P + (size_t)row * NPROJ + C_AZ + head * 64 + d0), zf);
        f32x4 o[2];
#pragma unroll
        for (int h = 0; h < 2; ++h) { const f32x4 a = *(const f32x4*)(sp + 4 * h), b = *(const f32x4*)(sp + 256 + 4 * h), w = *(const f32x4*)(sp + 512 + 4 * h);
#pragma unroll
            for (int j = 0; j < 4; ++j) o[h][j] = (g0 * a[j] + g1 * b[j] + g2 * w[j]) * zf[4 * h + j]; }
        *(LAS u32x4*)(F.lds + r * (1024 * 2 + 16) + c * 16) = pack8(o[0], o[1]); }
    __syncthreads();
}
__device__ __forceinline__ void skinny_branch(Frame& F, int l) {
    const bf16_t* P = (const bf16_t*)(F.ws + WS_P); float* brp = (float*)(F.ws + WS_BRP);
    const bf16_t* W = (const bf16_t*)(F.ws + WS_WBR + l * al1m(SZ_WBR));
    for (int task = F.G - 1 - F.bid; task < 48; task += F.G) {
        const int z = task >> 4, n0 = (task & 15) * 128 + F.wave * 16; f32x4 d[2];
        __syncthreads();
        if (z == 1) skinny_stage_att(F);
        else skinny_stage<1024>(F.lds, (const bf16_t*)(F.ws + WS_ABR) + (size_t)z * MPAD * 1024 + (size_t)MPT * 1024, 1024, F.tid);
        skinny_tile<1024>(F.lds, W + (size_t)z * 2048 * 1024, 1024, n0, 0, 1024, F.lane, d[0], d[1]);
        const int col = n0 + 4 * (F.lane >> 4);
#pragma unroll
        for (int tt = 0; tt < 2; ++tt) { const int t = 16 * tt + (F.lane & 15), row = MPT + t;
            const f32x4 gm = unpack4(*(const u32x2*)(P + (size_t)row * NPROJ + C_MG + z * 2048 + col));
            *(f32x4*)(brp + ((size_t)z * 32 + t) * DM + col) = d[tt] * gm; }
    }
    __syncthreads();
}
__device__ __forceinline__ void skinny_out(Frame& F, int l) {
    const float* brp = (const float*)(F.ws + WS_BRP); bf16_t* outb = (bf16_t*)(F.ws + WS_OUTB);
    const bf16_t* W = (const bf16_t*)(F.ws + WS_WOUT + l * al1m(SZ_WOUT));
    bool staged = false;
    for (int task = F.G - 1 - F.bid; task < 64; task += F.G) {
        if (!staged) {
#pragma unroll 4
            for (int i = F.tid; i < 32 * (DM / 4); i += NT) { const int r = i / (DM / 4), c = i % (DM / 4);
                const f32x4 s = *(const f32x4*)(brp + (size_t)r * DM + 4 * c) + *(const f32x4*)(brp + (size_t)(32 + r) * DM + 4 * c) + *(const f32x4*)(brp + (size_t)(64 + r) * DM + 4 * c);
                *(LAS u32x2*)(F.lds + r * (DM * 2 + 16) + c * 8) = pack4(s); }
            __syncthreads(); staged = true; }
        const int tile = F.wave & 1, kq = F.wave >> 1, n0 = task * 32 + tile * 16; f32x4 d[2];
        skinny_tile<DM>(F.lds, W + kq * 512, DM, n0, kq * 512, 512, F.lane, d[0], d[1]);
        __syncthreads();
        LAS f32x4* red = (LAS f32x4*)F.lds;
        red[(F.wave * 2 + 0) * 64 + F.lane] = d[0]; red[(F.wave * 2 + 1) * 64 + F.lane] = d[1];
        staged = false;
        __syncthreads();
        if (kq == 0) {
#pragma unroll
            for (int tt = 0; tt < 2; ++tt) { f32x4 a = d[tt];
#pragma unroll
                for (int k2 = 1; k2 < 4; ++k2) a += red[((2 * k2 + tile) * 2 + tt) * 64 + F.lane];
                *(u32x2*)(outb + (size_t)(MPT + 16 * tt + (F.lane & 15)) * DM + n0 + 4 * (F.lane >> 4)) = pack4(a); } }
        __syncthreads();
    }
    __syncthreads();
}
__device__ __forceinline__ int keypos(int key) { return (key & ~12) | ((key & 4) << 1) | ((key & 8) >> 1); }

template <int W>
__device__ __forceinline__ void pool_diff_load(const bf16_t* P, const float* spool, int m, int c0, f32x4 (&v)[W]) {
    if (m < MPT) {
        const int s = m & (SEQ - 1);
#pragma unroll
        for (int j = 0; j < W; ++j) v[j] = (j <= s) ? unpack4(*(const u32x2*)(P + (size_t)(m - j) * NPROJ + C_PU + c0)) : (f32x4){0.f, 0.f, 0.f, 0.f};
    } else {
        const int b = (m - MPT) >> 2, i = (m - MPT) & 3;
#pragma unroll
        for (int j = 0; j < W; ++j) { const int idx = 15 + i - j;
            v[j] = (idx >= 15) ? unpack4(*(const u32x2*)(P + (size_t)(MPT + b * 4 + idx - 15) * NPROJ + C_PU + c0)) : *(const f32x4*)(spool + ((size_t)b * 15 + idx) * 1024 + c0); }
    }
}
template <int W>
__device__ __forceinline__ void pool_diff_store(bf16_t* D, int m, int c0, const f32x4 (&v)[W]) {
    int cnt = W; if (m < MPT) { const int s = m & (SEQ - 1); cnt = (s + 1 < W) ? s + 1 : W; }
    f32x4 sum = v[0];
#pragma unroll
    for (int j = 1; j < W; ++j) sum += v[j];
    *(u32x2*)(D + (size_t)m * 1024 + c0) = pack4(sum * (1.f / (float)cnt) - v[0]);
}
__device__ __forceinline__ void s2_pool_diff(Frame& F, int l) {
    const bf16_t* P = (const bf16_t*)(F.ws + WS_P); bf16_t* D = (bf16_t*)(F.ws + WS_DIFF);
    const float* spool = FIN(IN_SPOOL) + (size_t)l * SB * 15 * 1024;
    const int c0 = 4 * F.lane;
    for (int m = F.gw; m < MROWS; m += F.ngw) {
        f32x4 v2[2], v4[4], v8[8], v16[16];
        pool_diff_load<2>(P, spool, m, c0, v2); pool_diff_load<4>(P, spool, m, 256 + c0, v4); pool_diff_load<8>(P, spool, m, 512 + c0, v8); pool_diff_load<16>(P, spool, m, 768 + c0, v16);
        pool_diff_store<2>(D, m, c0, v2); pool_diff_store<4>(D, m, 256 + c0, v4); pool_diff_store<8>(D, m, 512 + c0, v8); pool_diff_store<16>(D, m, 768 + c0, v16);
    }
}

__device__ __forceinline__ void store8f(float* dst, const u32x4& x) { float f[8]; unpack8(x, f); *(f32x4*)dst = (f32x4){f[0], f[1], f[2], f[3]}; *(f32x4*)(dst + 4) = (f32x4){f[4], f[5], f[6], f[7]}; }

__device__ __forceinline__ void s2_state_outputs(Frame& F, int l) {
    const bf16_t* P = (const bf16_t*)(F.ws + WS_P);
    const int gt = F.gw * 64 + F.lane, ngt = F.ngw * 64;
    for (int it = gt; it < PB * 15 * 128; it += ngt) { const int c0 = (it & 127) * 8, r = (it >> 7) % 15, b = (it >> 7) / 15;
        store8f(F.out + O_POOLP + (((size_t)l * PB + b) * 15 + r) * 1024 + c0, *(const u32x4*)(P + (size_t)(b * SEQ + SEQ - 15 + r) * NPROJ + C_PU + c0)); }
    for (int it = gt; it < SB * 15 * 128; it += ngt) { const int c0 = (it & 127) * 8, r = (it >> 7) % 15, b = (it >> 7) / 15, e = 4 + r;
        float* dst = F.out + O_POOLS + (((size_t)l * SB + b) * 15 + r) * 1024 + c0;
        if (e < 15) { const float* sp = FIN(IN_SPOOL) + (((size_t)l * SB + b) * 15 + e) * 1024 + c0; *(f32x4*)dst = *(const f32x4*)sp; *(f32x4*)(dst + 4) = *(const f32x4*)(sp + 4); }
        else store8f(dst, *(const u32x4*)(P + (size_t)(MPT + b * 4 + e - 15) * NPROJ + C_PU + c0)); }
    for (int it = gt; it < PB * 512 * 64; it += ngt) { const int c0 = (it & 63) * 8, r = (it >> 6) & 511, b = it >> 15;
        store8f(F.out + O_WINP + (((size_t)l * PB + b) * 512 + r) * 512 + c0, *(const u32x4*)(P + (size_t)(b * SEQ + SEQ - 512 + r) * NPROJ + C_WK + c0)); }
    for (int it = gt; it < SB * 512 * 64; it += ngt) { const int c0 = (it & 63) * 8, r = (it >> 6) & 511, b = it >> 15;
        float* dst = F.out + O_WINS + (((size_t)l * SB + b) * 512 + r) * 512 + c0;
        if (r < 508) { const float* sp = FIN(IN_SWIN) + (((size_t)l * SB + b) * 512 + r + 4) * 512 + c0; *(f32x4*)dst = *(const f32x4*)sp; *(f32x4*)(dst + 4) = *(const f32x4*)(sp + 4); }
        else store8f(dst, *(const u32x4*)(P + (size_t)(MPT + b * 4 + r - 508) * NPROJ + C_WK + c0)); }
}

__device__ __forceinline__ void s2_vt_images(Frame& F) {
    const bf16_t* P = (const bf16_t*)(F.ws + WS_P);
    for (int it = F.gw; it < 2 * PB * 4 * 64; it += F.ngw) {
        const int which = it >> 9, b = (it >> 8) & 1, kvh = (it >> 6) & 3, blk = it & 63;
        const bf16_t* src = P + (size_t)(b * SEQ + blk * 64 + F.lane) * NPROJ + (which ? C_WK : C_SK) + kvh * 64;
        bf16_t* img = (bf16_t*)(F.ws + (which ? WS_KTWIN : WS_KTSEL)) + (size_t)((b * 4 + kvh) * 64 + blk) * 4096 + F.lane * 8;
        u32x4 v[8];
#pragma unroll
        for (int j = 0; j < 8; ++j) v[j] = *(const u32x4*)(src + 8 * j);
#pragma unroll
        for (int j = 0; j < 8; ++j) *(u32x4*)(img + j * 512) = v[j];
    }
    for (int it = F.gw; it < 2 * PB * 4 * 64; it += F.ngw) {
        const int which = it >> 9, b = (it >> 8) & 1, kvh = (it >> 6) & 3, blk = it & 63;
        const bf16_t* src = P + (size_t)(b * SEQ + blk * 64 + F.lane) * NPROJ + (which ? C_WV : C_SV) + kvh * 64;
        const int pos = keypos(F.lane);
        bf16_t* img = (bf16_t*)(F.ws + (which ? WS_VTWIN : WS_VTSEL)) + (size_t)((b * 4 + kvh) * 64 + blk) * 4096 + (pos >> 3) * 512 + (pos & 7);
        u32x4 v[8];
#pragma unroll
        for (int j = 0; j < 8; ++j) v[j] = *(const u32x4*)(src + 8 * j);
#pragma unroll
        for (int j = 0; j < 8; ++j) {
            img[(8 * j + 0) * 8] = (bf16_t)(v[j].x & 0xffffu); img[(8 * j + 1) * 8] = (bf16_t)(v[j].x >> 16);
            img[(8 * j + 2) * 8] = (bf16_t)(v[j].y & 0xffffu); img[(8 * j + 3) * 8] = (bf16_t)(v[j].y >> 16);
            img[(8 * j + 4) * 8] = (bf16_t)(v[j].z & 0xffffu); img[(8 * j + 5) * 8] = (bf16_t)(v[j].z >> 16);
            img[(8 * j + 6) * 8] = (bf16_t)(v[j].w & 0xffffu); img[(8 * j + 7) * 8] = (bf16_t)(v[j].w >> 16); }
    }
}

template <bool SAMPLE>
__device__ __forceinline__ void compress_unit(Frame& F, int l, int unit) {
    const int lane = F.lane, w = F.wave, col = lane & 15, q = lane >> 4, nl = col >> 2, k = col & 3;
    const int b = SAMPLE ? unit >> 5 : unit >> 3, n0 = SAMPLE ? (unit & 31) * 8 : (unit & 7) * 8;
    const bf16_t* wphi = (const bf16_t*)(F.ws + WS_WPHI + l * al1m(SZ_WPHI));
    const bf16_t* P = (const bf16_t*)(F.ws + WS_P);
    const float* cache = FIN(IN_CACHE); const int* pt = (const int*)FIN(IN_PT);
    f32x4 acc[2][2][4];
#pragma unroll
    for (int j = 0; j < 2; ++j)
#pragma unroll
        for (int nt = 0; nt < 2; ++nt)
#pragma unroll
            for (int et = 0; et < 4; ++et) acc[j][nt][et] = (f32x4){0.f, 0.f, 0.f, 0.f};
    size_t xoff[2];
#pragma unroll
    for (int nt = 0; nt < 2; ++nt) { const int blk = n0 + 4 * nt + nl;
        if (SAMPLE) { const int page = pt[b * 128 + (blk >> 1)]; xoff[nt] = ((((size_t)l * NPOOL + page) * 128 + (blk & 1) * 64) * 4) * 256 + k * 64 + 8 * q; }
        else xoff[nt] = (size_t)(b * SEQ + blk * 64) * NPROJ + C_CK + k * 64 + 8 * q; }
    bf16x8 ra[2][2][4];
    f32x4 rx[2][2][2][2];
#define CMP_LOAD(J, LPOS) do { _Pragma("unroll") for (int dc = 0; dc < 2; ++dc) { \
        _Pragma("unroll") for (int et = 0; et < 4; ++et) ra[J][dc][et] = *(const bf16x8*)(wphi + ((size_t)((J) * 64 + (LPOS)) * 64 + 16 * et + col) * 64 + 32 * dc + 8 * q); \
        _Pragma("unroll") for (int nt = 0; nt < 2; ++nt) { \
            if (SAMPLE) { const float* s_ = cache + xoff[nt] + ((size_t)(LPOS) * 4 + (J)) * 256 + 32 * dc; rx[J][dc][nt][0] = __builtin_nontemporal_load((const f32x4*)s_); rx[J][dc][nt][1] = __builtin_nontemporal_load((const f32x4*)(s_ + 4)); } \
            else rx[J][dc][nt][0] = __builtin_bit_cast(f32x4, *(const bf16x8*)(P + xoff[nt] + (size_t)(LPOS) * NPROJ + (J) * 256 + 32 * dc)); } } } while (0)
#define CMP_MMA(J) do { _Pragma("unroll") for (int dc = 0; dc < 2; ++dc) _Pragma("unroll") for (int nt = 0; nt < 2; ++nt) { \
        const bf16x8 bx_ = SAMPLE ? __builtin_bit_cast(bf16x8, pack8(rx[J][dc][nt][0], rx[J][dc][nt][1])) : __builtin_bit_cast(bf16x8, rx[J][dc][nt][0]); \
        _Pragma("unroll") for (int et = 0; et < 4; ++et) acc[J][nt][et] = __builtin_amdgcn_mfma_f32_16x16x32_bf16(ra[J][dc][et], bx_, acc[J][nt][et], 0, 0, 0); } } while (0)
    CMP_LOAD(0, w * 8);
#pragma unroll 1
    for (int li = 0; li < 8; ++li) { const int lpos = w * 8 + li;
        CMP_LOAD(1, lpos); __builtin_amdgcn_sched_barrier(0);
        CMP_MMA(0); __builtin_amdgcn_sched_barrier(0);
        if (li < 7) CMP_LOAD(0, lpos + 1);
        __builtin_amdgcn_sched_barrier(0);
        CMP_MMA(1); __builtin_amdgcn_sched_barrier(0);
    }
#undef CMP_LOAD
#undef CMP_MMA
    LAS float* red = (LAS float*)F.lds;
#pragma unroll
    for (int j = 0; j < 2; ++j)
#pragma unroll
        for (int nt = 0; nt < 2; ++nt)
#pragma unroll
            for (int et = 0; et < 4; ++et)
#pragma unroll
                for (int i = 0; i < 4; ++i) red[(w * 64 + ((j * 2 + nt) * 4 + et) * 4 + i) * 64 + lane] = acc[j][nt][et][i];
    __syncthreads();
    const LAS float* pb = (const LAS float*)(F.lds + 131072);
    bf16_t* kc = (bf16_t*)(F.ws + (SAMPLE ? WS_KCS : WS_KCP)); bf16_t* vct = (bf16_t*)(F.ws + (SAMPLE ? WS_VCTS : WS_VCTP));
    constexpr int NBLK = SAMPLE ? 256 : 64;
    for (int o = F.tid; o < 4096; o += NT) { const int r = o >> 6, ln = o & 63;
        float s = 0.f;
#pragma unroll
        for (int ww = 0; ww < 8; ++ww) s += red[(ww * 64 + r) * 64 + ln];
        const int j = r >> 5, nt = (r >> 4) & 1, et = (r >> 2) & 3, i = r & 3, e = 16 * et + 4 * (ln >> 4) + i, cc = ln & 15, blk = n0 + 4 * nt + (cc >> 2), kk = cc & 3;
        s += pb[j * 64 + e];
        if (j == 0) kc[((size_t)(b * 4 + kk) * NBLK + blk) * 64 + e] = (bf16_t)f2bf(s);
        else vct[(((size_t)(b * 4 + kk) * (NBLK / 64) + (blk >> 6)) * 64 + e) * 64 + keypos(blk & 63)] = (bf16_t)f2bf(s);
    }
    __syncthreads();
}

__device__ __forceinline__ void compress_prompt_piece(Frame& F, int l, int piece) {
    const int lane = F.lane, w = F.wave, col = lane & 15, q = lane >> 4, nl = col >> 2, k = col & 3;
    const int ntile = piece >> 3, j = (piece >> 2) & 1, et = piece & 3, b = ntile >> 4, n0 = (ntile & 15) * 4;
    const bf16_t* wphi = (const bf16_t*)(F.ws + WS_WPHI + l * al1m(SZ_WPHI)) + ((size_t)(j * 64) * 64 + 16 * et + col) * 64 + 8 * q;
    const bf16_t* xp = (const bf16_t*)(F.ws + WS_P) + (size_t)(b * SEQ + (n0 + nl) * 64) * NPROJ + C_CK + j * 256 + k * 64 + 8 * q;
    bf16x8 a[16], x[16];
#pragma unroll
    for (int li = 0; li < 8; ++li)
#pragma unroll
        for (int dc = 0; dc < 2; ++dc) { const int lpos = w * 8 + li;
            a[li * 2 + dc] = *(const bf16x8*)(wphi + (size_t)lpos * 4096 + 32 * dc); x[li * 2 + dc] = *(const bf16x8*)(xp + (size_t)lpos * NPROJ + 32 * dc); }
    f32x4 acc = {0.f, 0.f, 0.f, 0.f};
#pragma unroll
    for (int i = 0; i < 16; ++i) acc = __builtin_amdgcn_mfma_f32_16x16x32_bf16(a[i], x[i], acc, 0, 0, 0);
    LAS float* red = (LAS float*)F.lds;
    __syncthreads();
#pragma unroll
    for (int i = 0; i < 4; ++i) red[(w * 4 + i) * 64 + lane] = acc[i];
    __syncthreads();
    if (F.tid < 256) { const int i = F.tid >> 6, ln = F.tid & 63; float s = 0.f;
#pragma unroll
        for (int ww = 0; ww < 8; ++ww) s += red[(ww * 4 + i) * 64 + ln];
        const int e = 16 * et + 4 * (ln >> 4) + i, cc = ln & 15, blk = n0 + (cc >> 2), kk = cc & 3;
        s += ((const LAS float*)(F.lds + 131072))[j * 64 + e];
        if (j == 0) ((bf16_t*)(F.ws + WS_KCP))[(size_t)(b * 4 + kk) * 4096 + (e >> 3) * 512 + blk * 8 + (e & 7)] = (bf16_t)f2bf(s);
        else { const int pos = keypos(blk); ((bf16_t*)(F.ws + WS_VCTP))[(size_t)(b * 4 + kk) * 4096 + (pos >> 3) * 512 + e * 8 + (pos & 7)] = (bf16_t)f2bf(s); } }
    __syncthreads();
}

__device__ __forceinline__ void s2_compress(Frame& F, int l) {
    if (F.tid < 128) { const float* pp = (const float*)(F.ws + WS_PEBP + l * al1m(SZ_PEBP)); float s = 0.f;
#pragma unroll
        for (int p = 0; p < 16; ++p) s += pp[((F.tid >> 6) * 16 + p) * 64 + (F.tid & 63)];
        ((LAS float*)(F.lds + 131072))[F.tid] = s; }
    __syncthreads();
    for (int u = F.bid; u < 256; u += F.G) compress_unit<true>(F, l, u);
    for (int u = F.bid; u < 256; u += F.G) compress_prompt_piece(F, l, u);
}

#ifndef NSA_SGB
#define NSA_SGB 1
#endif
#define MFMA32(a, b, c) __builtin_amdgcn_mfma_f32_32x32x16_bf16((a), (b), (c), 0, 0, 0)
constexpr float NEG_BIG = -1e30f;
constexpr int AL_K = 0, AL_V = 8192, AL_SLOT = 16384  , AL_MASK = 4 * AL_SLOT  , AL_UNION = AL_MASK + 512,
              AL_TOT = 66560  , AL_IMP = AL_TOT  ;
__device__ __forceinline__ void dma16(const void* src, LAS unsigned char* dst) { __builtin_amdgcn_global_load_lds((const unsigned*)src, (LAS unsigned*)dst, 16, 0, 0); }
__device__ __forceinline__ void tile_dma(const bf16_t* kimg, const bf16_t* vimg, LAS unsigned char* slot, int w, int lane) {
    dma16(kimg + (unsigned)w * 512u + 8u * (unsigned)lane, slot + AL_K + w * 1024);
    dma16(vimg + (unsigned)w * 512u + 8u * (unsigned)lane, slot + AL_V + w * 1024);
}

template <int CTRL> __device__ __forceinline__ float quad_xor(float x) { return __int_as_float(__builtin_amdgcn_update_dpp(0, __float_as_int(x), CTRL, 0xF, 0xF, false)); }
struct FlashState { f32x16 o[2]; float m, l; };
__device__ __forceinline__ void flash_reset(FlashState& S) {
#pragma unroll
    for (int i = 0; i < 16; ++i) { S.o[0][i] = 0.f; S.o[1][i] = 0.f; }
    S.m = 0.f; S.l = 0.f;
}
__device__ __forceinline__ void flash_scores(const LAS unsigned char* kbuf, const bf16x8 (&qf)[4], int r, int h, float init, f32x16& s0, f32x16& s1) {
    bf16x8 kf[8];
#pragma unroll
    for (int ks = 0; ks < 4; ++ks) { kf[2 * ks] = *(const LAS bf16x8*)(kbuf + (2 * ks + h) * 1024 + r * 16); kf[2 * ks + 1] = *(const LAS bf16x8*)(kbuf + (2 * ks + h) * 1024 + (32 + r) * 16); }
    __builtin_amdgcn_sched_barrier(0);
#pragma unroll
    for (int i = 0; i < 16; ++i) { s0[i] = init; s1[i] = init; }
#pragma unroll
    for (int ks = 0; ks < 4; ++ks) { s0 = MFMA32(kf[2 * ks], qf[ks], s0); s1 = MFMA32(kf[2 * ks + 1], qf[ks], s1); }
}
__device__ __forceinline__ bf16x8 pack_p(const f32x16& p, int s) {
    u32x4 w; w.x = pk2(p[8 * s], p[8 * s + 1]); w.y = pk2(p[8 * s + 2], p[8 * s + 3]); w.z = pk2(p[8 * s + 4], p[8 * s + 5]); w.w = pk2(p[8 * s + 6], p[8 * s + 7]);
    return __builtin_bit_cast(bf16x8, w);
}
__device__ __forceinline__ void flash_vload(const LAS unsigned char* vbuf, int r, int h, bf16x8 (&vf)[8]) {
#pragma unroll
    for (int sub = 0; sub < 2; ++sub)
#pragma unroll
        for (int s = 0; s < 2; ++s)
#pragma unroll
            for (int dt = 0; dt < 2; ++dt) vf[(sub * 2 + s) * 2 + dt] = *(const LAS bf16x8*)(vbuf + (4 * sub + 2 * s + h) * 1024 + (32 * dt + r) * 16);
    __builtin_amdgcn_sched_barrier(0);
}
__device__ __forceinline__ void flash_pv(const bf16x8 (&vf)[8], const f32x16& p0, const f32x16& p1, f32x16 (&o)[2]) {
#pragma unroll
    for (int sub = 0; sub < 2; ++sub)
#pragma unroll
        for (int s = 0; s < 2; ++s) {
            const bf16x8 pb = pack_p(sub ? p1 : p0, s);
#pragma unroll
            for (int dt = 0; dt < 2; ++dt) o[dt] = MFMA32(vf[(sub * 2 + s) * 2 + dt], pb, o[dt]);
        }
}
__device__ __forceinline__ float xhalf_max(float x) {
    const auto r = __builtin_amdgcn_permlane32_swap(__float_as_uint(x), __float_as_uint(x), false, false);
    return fmaxf(__uint_as_float(r[0]), __uint_as_float(r[1]));
}
__device__ __forceinline__ void flash_mask(f32x16& s0, f32x16& s1, int lo, int hi, int h) {
#pragma unroll
    for (int i = 0; i < 16; ++i) { const int key = (i & 3) + 8 * (i >> 2) + 4 * h;
        s0[i] = (key >= lo && key <= hi) ? s0[i] : -INFINITY; s1[i] = (key + 32 >= lo && key + 32 <= hi) ? s1[i] : -INFINITY; }
}
__device__ __forceinline__ float flash_rowmax(const f32x16& s0, const f32x16& s1) {
    float mx = -INFINITY;
#pragma unroll
    for (int i = 0; i < 16; ++i) asm("v_max3_f32 %0, %1, %2, %3" : "=v"(mx) : "v"(mx), "v"(s0[i]), "v"(s1[i]));
    return xhalf_max(mx);
}
__device__ __forceinline__ void flash_first(FlashState& S, f32x16& s0, f32x16& s1, int lo, int hi, int h, bool masked) {
    if (masked) flash_mask(s0, s1, lo, hi, h);
    S.m = fmaxf(flash_rowmax(s0, s1), NEG_BIG);
    float ls = 0.f;
#pragma unroll
    for (int i = 0; i < 16; ++i) { s0[i] = __builtin_amdgcn_exp2f(s0[i] - S.m); s1[i] = __builtin_amdgcn_exp2f(s1[i] - S.m); ls += s0[i] + s1[i]; }
    S.l = ls;
}
__device__ __forceinline__ void flash_next(FlashState& S, f32x16& s0, f32x16& s1, float mused, int lo, int hi, int h, bool masked, bool first) {
    if (masked) flash_mask(s0, s1, lo, hi, h);
    const float corr = S.m - mused;
    if (__ballot(corr != 0.f) != 0ull) {
#pragma unroll
        for (int i = 0; i < 16; ++i) { s0[i] -= corr; s1[i] -= corr; } }
    const float mx = flash_rowmax(s0, s1);
    if (__ballot(mx > SM_THR || (first && mx < -SM_THR)) != 0ull) {
        const float d = (mx > NEG_BIG) ? (first ? mx : fmaxf(mx, 0.f)) : 0.f, alpha = __builtin_amdgcn_exp2f(-d);
        S.m += d; S.l *= alpha;
#pragma unroll
        for (int i = 0; i < 16; ++i) { S.o[0][i] *= alpha; S.o[1][i] *= alpha; s0[i] -= d; s1[i] -= d; }
    }
    float ls = 0.f;
#pragma unroll
    for (int i = 0; i < 16; ++i) { s0[i] = __builtin_amdgcn_exp2f(s0[i]); s1[i] = __builtin_amdgcn_exp2f(s1[i]); ls += s0[i] + s1[i]; }
    S.l += ls;
}

__device__ __forceinline__ void flash_kload(const LAS unsigned char* kbuf, int r, int h, bf16x8 (&kf)[8]) {
#pragma unroll
    for (int ks = 0; ks < 4; ++ks) { kf[2 * ks] = *(const LAS bf16x8*)(kbuf + (2 * ks + h) * 1024 + r * 16); kf[2 * ks + 1] = *(const LAS bf16x8*)(kbuf + (2 * ks + h) * 1024 + (32 + r) * 16); }
    __builtin_amdgcn_sched_barrier(0);
}
struct TileCtl { bool en, masked; int lo, hi; };
__device__ __forceinline__ void flash_pair(FlashState& S, const LAS unsigned char* ka, const LAS unsigned char* va, const LAS unsigned char* kb2, const LAS unsigned char* vb2,
                                           const bf16x8 (&qf)[4], const TileCtl& A, const TileCtl& B, bool first, int r, int h) {
    bf16x8 kf[8]; f32x16 a0, a1, b0, b1;
    flash_kload(ka, r, h, kf);
    { const float init = A.en ? -S.m : -INFINITY;
#pragma unroll
        for (int i = 0; i < 16; ++i) { a0[i] = init; a1[i] = init; }
#pragma unroll
        for (int ks = 0; ks < 4; ++ks) { a0 = MFMA32(kf[2 * ks], qf[ks], a0); a1 = MFMA32(kf[2 * ks + 1], qf[ks], a1); } }
    if (A.masked) flash_mask(a0, a1, A.lo, A.hi, h);
    { const float mx = flash_rowmax(a0, a1);
        if (__ballot(mx > SM_THR || (first && mx < -SM_THR)) != 0ull) { const float d = (mx > NEG_BIG) ? (first ? mx : fmaxf(mx, 0.f)) : 0.f, alpha = __builtin_amdgcn_exp2f(-d); S.m += d; S.l *= alpha;
#pragma unroll
            for (int i = 0; i < 16; ++i) { S.o[0][i] *= alpha; S.o[1][i] *= alpha; a0[i] -= d; a1[i] -= d; } } }
    flash_kload(kb2, r, h, kf);
    { const float init = B.en ? -S.m : -INFINITY;
#pragma unroll
        for (int i = 0; i < 16; ++i) { b0[i] = init; b1[i] = init; } }
    __builtin_amdgcn_sched_barrier(0);
#pragma unroll
    for (int k = 0; k < 8; ++k) {
        if (k & 1) b1 = MFMA32(kf[k], qf[k >> 1], b1); else b0 = MFMA32(kf[k], qf[k >> 1], b0);
#pragma unroll
        for (int e = 0; e < 4; ++e) { const int idx = 4 * k + e;
            if (idx < 16) { float t = __builtin_amdgcn_exp2f(a0[idx]); asm volatile("" : "+v"(t)); a0[idx] = t; }
            else { float t = __builtin_amdgcn_exp2f(a1[idx - 16]); asm volatile("" : "+v"(t)); a1[idx - 16] = t; } }
        __builtin_amdgcn_sched_barrier(0);
    }
    bf16x8 pa[4]; float ls = 0.f;
#pragma unroll
    for (int i = 0; i < 16; ++i) ls += a0[i] + a1[i];
    pa[0] = pack_p(a0, 0); pa[1] = pack_p(a0, 1); pa[2] = pack_p(a1, 0); pa[3] = pack_p(a1, 1);
    S.l += ls;
    __builtin_amdgcn_sched_barrier(0);
    if (B.masked) flash_mask(b0, b1, B.lo, B.hi, h);
    float alphaB = 1.f;
    { const float mx = flash_rowmax(b0, b1);
        if (__ballot(mx > SM_THR) != 0ull) { const float d = (mx > NEG_BIG) ? fmaxf(mx, 0.f) : 0.f; alphaB = __builtin_amdgcn_exp2f(-d); S.m += d; S.l *= alphaB;
#pragma unroll
            for (int i = 0; i < 16; ++i) { b0[i] -= d; b1[i] -= d; } } }
    { bf16x8 vf[8]; flash_vload(va, r, h, vf);
#pragma unroll
        for (int k = 0; k < 8; ++k) {
            S.o[k & 1] = MFMA32(vf[k], pa[k >> 1], S.o[k & 1]);
#pragma unroll
            for (int e = 0; e < 4; ++e) { const int idx = 4 * k + e;
                if (idx < 16) { float t = __builtin_amdgcn_exp2f(b0[idx]); asm volatile("" : "+v"(t)); b0[idx] = t; }
                else { float t = __builtin_amdgcn_exp2f(b1[idx - 16]); asm volatile("" : "+v"(t)); b1[idx - 16] = t; } }
            __builtin_amdgcn_sched_barrier(0);
        }
    }
    __builtin_amdgcn_sched_barrier(0);
    if (__ballot(alphaB != 1.f) != 0ull) {
#pragma unroll
        for (int i = 0; i < 16; ++i) { S.o[0][i] *= alphaB; S.o[1][i] *= alphaB; } }
    { bf16x8 vf[8]; flash_vload(vb2, r, h, vf);
        bf16x8 pb[4]; pb[0] = pack_p(b0, 0); pb[1] = pack_p(b0, 1); pb[2] = pack_p(b1, 0); pb[3] = pack_p(b1, 1);
        float l0 = 0.f, l1 = 0.f;
        __builtin_amdgcn_sched_barrier(0);
#pragma unroll
        for (int k = 0; k < 8; ++k) {
            S.o[k & 1] = MFMA32(vf[k], pb[k >> 1], S.o[k & 1]);
#pragma unroll
            for (int e = 0; e < 2; ++e) { const int idx = 2 * k + e; l0 += b0[idx]; l1 += b1[idx]; }
            asm volatile("" : "+v"(l0), "+v"(l1));
            __builtin_amdgcn_sched_barrier(0);
        }
        S.l += l0 + l1; }
}

__device__ __forceinline__ void nsa_prompt_unit(Frame& F, int l, int b, int kvh, int c) {
    int tid = threadIdx.x; asm volatile("" : "+v"(tid));
    const int lane = tid & 63, w = F.wave, r = lane & 31, h = lane >> 5, qi = r >> 2, g = r & 3, qloc = 8 * w + qi;
    const int tok = b * SEQ + 64 * c + qloc, head = kvh * 4 + g;
    const bf16_t* P = (const bf16_t*)(F.ws + WS_P);
    LAS unsigned char* kbuf = F.lds + AL_K; LAS unsigned char* vbuf = F.lds + AL_V;
    LAS float* imp = (LAS float*)(F.lds + AL_IMP); LAS unsigned* msk = (LAS unsigned*)(F.lds + AL_MASK); LAS unsigned* uni = (LAS unsigned*)(F.lds + AL_UNION);
    __syncthreads();
    tile_dma((const bf16_t*)(F.ws + WS_KCP) + (size_t)(b * 4 + kvh) * 4096, (const bf16_t*)(F.ws + WS_VCTP) + (size_t)(b * 4 + kvh) * 4096, F.lds, w, lane);
    bf16x8 qf[4];
#pragma unroll
    for (int ks = 0; ks < 4; ++ks) qf[ks] = *(const bf16x8*)(P + (size_t)tok * NPROJ + C_Q + head * 64 + 16 * ks + 8 * h);
    const float* gt = (const float*)(F.ws + WS_GATE) + (size_t)tok * 64 + head * 3;
    const float g_cmp = gt[0], g_sel = gt[1], g_win = gt[2];
    LAS f32x4* ltot = (LAS f32x4*)(F.lds + AL_TOT) + tid;
    FlashState S;
    {
        if (tid < 128) msk[tid] = 0u; if (tid < 2) uni[tid] = 0u;
        __syncthreads();
        flash_reset(S);
        f32x16 s0, s1; flash_scores(kbuf, qf, r, h, 0.f, s0, s1);
        const int nvalid = c + (qloc == 63 ? 1 : 0);
        bf16x8 vf[8]; flash_vload(vbuf, r, h, vf);
        flash_first(S, s0, s1, 0, nvalid - 1, h, true);
        const float lt = S.l + __shfl_xor(S.l, 32), inv = lt > 0.f ? 1.f / lt : 0.f;
#pragma unroll
        for (int i = 0; i < 16; ++i) { s0[i] *= inv; s1[i] *= inv; }
#pragma unroll
        for (int i = 0; i < 16; ++i) { float a = s0[i]; a += quad_xor<0xB1>(a); a += quad_xor<0x4E>(a); float bq = s1[i]; bq += quad_xor<0xB1>(bq); bq += quad_xor<0x4E>(bq);
            if (g == 0) { const int key = (i & 3) + 8 * (i >> 2) + 4 * h; imp[qloc * 65 + key] = a; imp[qloc * 65 + key + 32] = bq; } }
        flash_pv(vf, s0, s1, S.o);
    }
    __syncthreads();
    {
        const int n = lane; const bool cand = (n >= 1) && (n <= c - 2);
        const unsigned long long forced = 1ull | (1ull << c) | (c >= 1 ? (1ull << (c - 1)) : 0ull);
        unsigned long long um = 0ull;
#pragma unroll 1
        for (int qq = 0; qq < 8; ++qq) { const int q = w * 8 + qq;
            const unsigned kb_ = cand ? ((__float_as_uint(imp[q * 65 + n]) & ~63u) | (unsigned)(63 - n)) : 0u;
            int rank = 0;
            for (int j = 1; j <= c - 2; ++j) { const unsigned sj = __builtin_amdgcn_readlane(kb_, j); rank += (sj > kb_) ? 1 : 0; }
            const unsigned long long m = __ballot(cand && rank < 13) | forced;
            if (lane == 0) { msk[q * 2] = (unsigned)m; msk[q * 2 + 1] = (unsigned)(m >> 32); }
            um |= m; }
        if (lane == 0) { atomicOr((unsigned*)uni, (unsigned)um); atomicOr((unsigned*)(uni + 1), (unsigned)(um >> 32)); }
    }
    __syncthreads();
    const unsigned mlo = msk[qloc * 2], mhi = msk[qloc * 2 + 1], ulo = uni[0], uhi = uni[1];
#pragma unroll
    for (int i4 = 0; i4 < 8; ++i4) { const f32x16& o = S.o[i4 >> 2]; const int i = 4 * (i4 & 3); ltot[i4 * 512] = (f32x4){g_cmp * o[i], g_cmp * o[i + 1], g_cmp * o[i + 2], g_cmp * o[i + 3]}; }
#define NSA_POP(REM_) ((REM_) ? (t_ = sel ? __builtin_ctzll(REM_) : 63 - __builtin_clzll(REM_), (REM_) &= ~(1ull << t_), t_) : -1)
#define NSA_EN(N_) (sel ? ((((N_) < 32 ? mlo >> (N_) : mhi >> ((N_) - 32)) & 1u) != 0u) : true)
#define NSA_LOHI(N_) const int n_ = (N_), lo_ = (!sel && n_ == c - 8) ? qloc + 1 : 0, hi_ = (n_ == c) ? qloc : 63; const bool mk_ = (n_ == c) || (!sel && n_ == c - 8)
#define NSA_PV(SLOT_, S0_, S1_) do { bf16x8 vf[8]; flash_vload(vbuf + (SLOT_), r, h, vf); flash_pv(vf, S0_, S1_, S.o); } while (0)
#pragma unroll 1
    for (int pass = 0; pass < 2; ++pass) {
        const bool sel = pass == 0;
        flash_reset(S);
        const bf16_t* kb = (const bf16_t*)(F.ws + (sel ? WS_KTSEL : WS_KTWIN)) + (size_t)(b * 4 + kvh) * 64 * 4096;
        const bf16_t* vt = (const bf16_t*)(F.ws + (sel ? WS_VTSEL : WS_VTWIN)) + (size_t)(b * 4 + kvh) * 64 * 4096;
        unsigned long long rem;
        if (sel) rem = ((unsigned long long)uhi << 32) | ulo;
        else { const int lo = c >= 8 ? c - 8 : 0; rem = (c == 63 ? ~0ull : ((1ull << (c + 1)) - 1ull)) & ~((1ull << lo) - 1ull); }
        int t_;
        int tA = NSA_POP(rem), tB = NSA_POP(rem);
        int pr = 0; bool first = true;
        __syncthreads();
        tile_dma(kb + (size_t)tA * 4096, vt + (size_t)tA * 4096, F.lds, w, lane);
        if (tB >= 0) tile_dma(kb + (size_t)tB * 4096, vt + (size_t)tB * 4096, F.lds + AL_SLOT, w, lane);
        for (;;) {
            const int sa = pr, sb = pr + AL_SLOT;
            __syncthreads();
            const int nA = NSA_POP(rem), nB = NSA_POP(rem);
            if (nA >= 0) tile_dma(kb + (size_t)nA * 4096, vt + (size_t)nA * 4096, F.lds + (pr ^ (2 * AL_SLOT)), w, lane);
            if (nB >= 0) tile_dma(kb + (size_t)nB * 4096, vt + (size_t)nB * 4096, F.lds + (pr ^ (2 * AL_SLOT)) + AL_SLOT, w, lane);
            const bool enA = first || NSA_EN(tA), enB = tB >= 0 ? NSA_EN(tB) : false;
            if (__ballot(enA || enB) != 0ull) {
                TileCtl A, B;
                A.en = enA; A.masked = (tA == c) || (!sel && tA == c - 8); A.lo = (!sel && tA == c - 8) ? qloc + 1 : 0; A.hi = (tA == c) ? qloc : 63;
                B.en = enB; B.masked = (tB == c) || (!sel && tB == c - 8); B.lo = (!sel && tB == c - 8) ? qloc + 1 : 0; B.hi = (tB == c) ? qloc : 63;
                const int sbb = tB >= 0 ? sb : sa;
                flash_pair(S, kbuf + sa, vbuf + sa, kbuf + sbb, vbuf + sbb, qf, A, B, first, r, h);
            }
            first = false;
            if (nA < 0) break;
            tA = nA; tB = nB; pr ^= 2 * AL_SLOT;
        }
        const float lt = S.l + __shfl_xor(S.l, 32), sc = (sel ? g_sel : g_win) / lt;
#pragma unroll
        for (int i4 = 0; i4 < 8; ++i4) { const f32x16& o = S.o[i4 >> 2]; const int i = 4 * (i4 & 3); ltot[i4 * 512] += (f32x4){sc * o[i], sc * o[i + 1], sc * o[i + 2], sc * o[i + 3]}; }
    }
#undef NSA_PV
#undef NSA_LOHI
#undef NSA_EN
#undef NSA_POP
    bf16_t* ao = (bf16_t*)(F.ws + WS_ABR + SZ_ABR1) + (size_t)tok * 1024 + head * 64;
    const bf16_t* az = P + (size_t)tok * NPROJ + C_AZ + head * 64;
#pragma unroll
    for (int i4 = 0; i4 < 8; ++i4) { const int d = 32 * (i4 >> 2) + 8 * (i4 & 3) + 4 * h;
        const f32x4 t = ltot[i4 * 512]; const f32x4 zz = unpack4(*(const u32x2*)(az + d));
        *(u32x2*)(ao + d) = pack4(t * zz); }
}

constexpr int SL_Q = 0  , SL_SC = 1024  , SL_IMP = SL_SC + 4 * 1040 * 4  , SL_RED = SL_IMP + 264 * 4  ,
              SL_LIST = SL_RED + 128  , SL_KOFF = SL_LIST + 64  , SL_PART = SL_KOFF + 1040 * 4  , SL_OACC = SL_PART + 32768  ;
constexpr int KOFF_INVALID = -2147483647;

__device__ __forceinline__ void block_softmax4(LAS float* sc, int count, LAS float* red, int tid) {
    const int gh = tid >> 7, t = tid & 127, wv = tid >> 6;
    LAS float* row = sc + gh * 1040;
    float mx = -INFINITY;
    for (int i = t; i < count; i += 128) mx = fmaxf(mx, row[i]);
    mx = wave_max(mx);
    if ((tid & 63) == 0) red[wv] = mx;
    __syncthreads();
    mx = fmaxf(red[2 * gh], red[2 * gh + 1]);
    float sm = 0.f;
    for (int i = t; i < count; i += 128) { const float p = __expf(row[i] - mx); row[i] = p; sm += p; }
    sm = wave_sum(sm);
    if ((tid & 63) == 0) red[8 + wv] = sm;
    __syncthreads();
    const float inv = 1.f / (red[8 + 2 * gh] + red[8 + 2 * gh + 1]);
    for (int i = t; i < count; i += 128) row[i] *= inv;
    __syncthreads();
}
__device__ __forceinline__ void sample_scores(const float* base, const bf16_t* Pnew, int pcol, int count, const LAS int* koff, const LAS float* qv, LAS float* sc, int tid) {
#pragma unroll 1
    for (int idx = tid; idx < count; idx += NT) {
        const int ko = koff[idx];
        float d0 = -INFINITY, d1 = -INFINITY, d2 = -INFINITY, d3 = -INFINITY;
        if (ko != KOFF_INVALID) {
            f32x4 kx[16];
            if (ko >= 0) {
#pragma unroll
                for (int j = 0; j < 16; ++j) kx[j] = *(const f32x4*)(base + (size_t)ko + 4 * j); }
            else {
#pragma unroll
                for (int j = 0; j < 16; ++j) kx[j] = unpack4(*(const u32x2*)(Pnew + (size_t)(-1 - ko) * NPROJ + pcol + 4 * j)); }
            d0 = d1 = d2 = d3 = 0.f;
#pragma unroll
            for (int j4 = 0; j4 < 4; ++j4) {
#pragma unroll
                for (int jj = 0; jj < 4; ++jj) { const int j = 4 * j4 + jj; const f32x4 kq = kx[j];
                    const f32x4 q0 = *(const LAS f32x4*)(qv + 4 * j), q1 = *(const LAS f32x4*)(qv + 64 + 4 * j), q2 = *(const LAS f32x4*)(qv + 128 + 4 * j), q3 = *(const LAS f32x4*)(qv + 192 + 4 * j);
                    d0 += kq.x * q0.x + kq.y * q0.y + kq.z * q0.z + kq.w * q0.w; d1 += kq.x * q1.x + kq.y * q1.y + kq.z * q1.z + kq.w * q1.w;
                    d2 += kq.x * q2.x + kq.y * q2.y + kq.z * q2.z + kq.w * q2.w; d3 += kq.x * q3.x + kq.y * q3.y + kq.z * q3.z + kq.w * q3.w; }
                __builtin_amdgcn_sched_barrier(0);
            }
            d0 *= 0.125f; d1 *= 0.125f; d2 *= 0.125f; d3 *= 0.125f;
        }
        sc[idx] = d0; sc[1040 + idx] = d1; sc[2080 + idx] = d2; sc[3120 + idx] = d3;
    }
}
__device__ __forceinline__ void sample_pv(const float* base, const bf16_t* Pnew, int pcol, int count, const LAS int* koff, const LAS float* sc, LAS float* part, LAS float* oacc, int tid) {
    const int dq = tid & 15, ks = tid >> 4, per = (count + 31) >> 5, i0 = ks * per, i1 = (i0 + per < count) ? i0 + per : count;
    f32x4 a0 = {0.f, 0.f, 0.f, 0.f}, a1 = a0, a2 = a0, a3 = a0;
#pragma unroll 8
    for (int idx = i0; idx < i1; ++idx) { const int ko = koff[idx];
        f32x4 v = {0.f, 0.f, 0.f, 0.f};
        if (ko >= 0) v = *(const f32x4*)(base + (size_t)ko + 256 + 4 * dq);
        else if (ko != KOFF_INVALID) { const u32x2 x = *(const u32x2*)(Pnew + (size_t)(-1 - ko) * NPROJ + pcol + 256 + 4 * dq); v = (f32x4){bf2f(x.x & 0xffffu), __uint_as_float(x.x & 0xffff0000u), bf2f(x.y & 0xffffu), __uint_as_float(x.y & 0xffff0000u)}; }
        a0 += sc[idx] * v; a1 += sc[1040 + idx] * v; a2 += sc[2080 + idx] * v; a3 += sc[3120 + idx] * v; }
    *(LAS f32x4*)(part + ks * 256 + 4 * dq) = a0; *(LAS f32x4*)(part + ks * 256 + 64 + 4 * dq) = a1; *(LAS f32x4*)(part + ks * 256 + 128 + 4 * dq) = a2; *(LAS f32x4*)(part + ks * 256 + 192 + 4 * dq) = a3;
    __syncthreads();
    if (tid < 256) { float t = 0.f;
#pragma unroll 8
        for (int k = 0; k < 32; ++k) t += part[k * 256 + tid];
        oacc[tid] = t; }
    __syncthreads();
}

__device__ __forceinline__ void nsa_sample_unit(Frame& F, int l, int unit, int part_id) {
    const int tid = F.tid, qi = unit & 3, kvh = (unit >> 2) & 3, b = unit >> 4, row = MPT + b * 4 + qi;
    const bf16_t* P = (const bf16_t*)(F.ws + WS_P); const int* pt = (const int*)FIN(IN_PT);
    LAS float* qv = (LAS float*)(F.lds + SL_Q); LAS float* sc = (LAS float*)(F.lds + SL_SC); LAS float* imp = (LAS float*)(F.lds + SL_IMP); LAS float* red = (LAS float*)(F.lds + SL_RED);
    LAS int* list = (LAS int*)(F.lds + SL_LIST); LAS int* koff = (LAS int*)(F.lds + SL_KOFF); LAS float* part = (LAS float*)(F.lds + SL_PART); LAS float* oacc = (LAS float*)(F.lds + SL_OACC);
    __syncthreads();
    if (tid < 256) qv[tid] = bf2f(P[(size_t)row * NPROJ + C_Q + kvh * 256 + tid]) * (1.f / SM_SCALE_L2E);
    __syncthreads();
    float* soacc = (float*)(F.ws + WS_SOACC) + (size_t)unit * 768;
    if (part_id == 0) {
    {
        const int n = tid & 255, gp = tid >> 8;
        const bf16_t* kr = (const bf16_t*)(F.ws + WS_KCS) + ((size_t)(b * 4 + kvh) * 256 + n) * 64;
        float d0 = 0.f, d1 = 0.f;
#pragma unroll
        for (int j = 0; j < 8; ++j) { const u32x4 x = *(const u32x4*)(kr + 8 * j); float kf[8]; unpack8(x, kf);
#pragma unroll
            for (int e = 0; e < 8; ++e) { d0 += kf[e] * qv[(2 * gp) * 64 + 8 * j + e]; d1 += kf[e] * qv[(2 * gp + 1) * 64 + 8 * j + e]; } }
        sc[(2 * gp) * 1040 + n] = d0 * 0.125f; sc[(2 * gp + 1) * 1040 + n] = d1 * 0.125f;
    }
    __syncthreads();
    block_softmax4(sc, 256, red, tid);
    if (tid < 257) { float v; if (tid == 0 || tid >= 255) v = 1e4f; else v = sc[tid] + sc[1040 + tid] + sc[2080 + tid] + sc[3120 + tid]; imp[tid] = v; }
    {
        const int half = tid >> 8, gd = tid & 255, gh = gd >> 6, d = gd & 63;
        const bf16_t* vt = (const bf16_t*)(F.ws + WS_VCTS) + (size_t)(b * 4 + kvh) * 4 * 4096;
        float a = 0.f;
        for (int tl = 2 * half; tl < 2 * half + 2; ++tl) {
            const bf16_t* vr = vt + (size_t)tl * 4096 + d * 64;
#pragma unroll
            for (int j = 0; j < 8; ++j) { const u32x4 x = *(const u32x4*)(vr + 8 * j); float vf[8]; unpack8(x, vf);
#pragma unroll
                for (int e = 0; e < 8; ++e) a += sc[gh * 1040 + tl * 64 + keypos(8 * j + e)] * vf[e]; } }
        part[half * 256 + gd] = a;
    }
    __syncthreads();
    if (tid < 256) oacc[tid] = part[tid] + part[256 + tid];
    if (tid < 257) { const float si = imp[tid]; int rk = 0;
        for (int j = 0; j < 257; ++j) { const float sj = imp[j]; rk += (sj > si || (sj == si && j < tid)) ? 1 : 0; }
        if (rk < 16) list[rk] = tid; }
    __syncthreads();
    for (int idx = tid; idx < 1024; idx += NT) { const int blk = list[idx >> 6], kk = idx & 63; int ko;
        if (blk < 256) { const int page = pt[b * 128 + (blk >> 1)]; ko = (int)(((((size_t)l * NPOOL + page) * 128 + (blk & 1) * 64 + kk) * 4 + 2) * 256 + kvh * 64); }
        else ko = (kk <= qi) ? -1 - (MPT + b * 4 + kk) : KOFF_INVALID;
        koff[idx] = ko; }
    __syncthreads();
    sample_scores(FIN(IN_CACHE), P, C_SK + kvh * 64, 1024, koff, qv, sc, tid);
    __syncthreads();
    block_softmax4(sc, 1024, red, tid);
    sample_pv(FIN(IN_CACHE), P, C_SK + kvh * 64, 1024, koff, sc, part, oacc + 256, tid);
    soacc[tid] = oacc[tid];
    } else {
    for (int idx = tid; idx < 516; idx += NT) { int ko;
        if (idx < 512) ko = (idx > qi) ? (int)((((size_t)(l * SB + b) * 512 + idx) * 2) * 256 + kvh * 64) : KOFF_INVALID;
        else ko = (idx - 512 <= qi) ? -1 - (MPT + b * 4 + idx - 512) : KOFF_INVALID;
        koff[idx] = ko; }
    __syncthreads();
    sample_scores(FIN(IN_SWIN), P, C_WK + kvh * 64, 516, koff, qv, sc, tid);
    __syncthreads();
    block_softmax4(sc, 516, red, tid);
    sample_pv(FIN(IN_SWIN), P, C_WK + kvh * 64, 516, koff, sc, part, oacc + 512, tid);
    if (tid < 256) soacc[512 + tid] = oacc[512 + tid];
    }
    __syncthreads();
}

struct SsmPow { float r[4], i[4]; };
__device__ __forceinline__ void ssm_pows(float ar, float ai, SsmPow& p) {
    p.r[0] = ar; p.i[0] = ai;
    p.r[1] = ar * ar - ai * ai; p.i[1] = 2.f * ar * ai;
    p.r[2] = p.r[1] * ar - p.i[1] * ai; p.i[2] = p.r[1] * ai + p.i[1] * ar;
    p.r[3] = p.r[1] * p.r[1] - p.i[1] * p.i[1]; p.i[3] = 2.f * p.r[1] * p.i[1];
}
struct SsmUnit { SsmPow pw[2]; bf16x8 bfr[4]; float alr[2], ali[2]; };
__device__ __forceinline__ void ssm_unit_load(const Frame& F, int l, int g, int lane, SsmUnit& U) {
    const int n32 = lane & 31, h = lane >> 5;
    const float* sab = (const float*)(F.ws + WS_SAB + l * al1m(SZ_SAB)) + (size_t)g * 64 * 4;
    const bf16_t* bb16 = (const bf16_t*)(F.ws + WS_SBB16 + l * al1m(SZ_SBB16)) + (size_t)g * 2 * 64 * 16;
#pragma unroll
    for (int s = 0; s < 2; ++s) { const f32x4 ab = *(const f32x4*)(sab + (n32 + 32 * s) * 4); ssm_pows(ab.x, ab.y, U.pw[s]); U.alr[s] = ab.z; U.ali[s] = ab.w;
        U.bfr[2 * s] = *(const bf16x8*)(bb16 + (size_t)(n32 + 32 * s) * 16 + 8 * h); U.bfr[2 * s + 1] = *(const bf16x8*)(bb16 + (size_t)(64 + n32 + 32 * s) * 16 + 8 * h); }
}
template <bool FIX>
__device__ __forceinline__ void ssm_block32(const bf16x8& au, const SsmUnit& U, float (&Hr)[2], float (&Hi)[2], float (&H1r)[2], float (&H1i)[2], f32x16 (&Dr)[2], f32x16 (&Di)[2], int h) {
    f32x16 z;
#pragma unroll
    for (int i = 0; i < 16; ++i) z[i] = 0.f;
#pragma unroll
    for (int s = 0; s < 2; ++s) { Dr[s] = MFMA32(au, U.bfr[2 * s], z); Di[s] = MFMA32(au, U.bfr[2 * s + 1], z); }
#pragma unroll
    for (int s = 0; s < 2; ++s) {
        const float ar = U.pw[s].r[0], ai = U.pw[s].i[0], a4r = U.pw[s].r[3], a4i = U.pw[s].i[3];
#pragma unroll
        for (int j = 0; j < 4; ++j)
#pragma unroll
            for (int e = 1; e < 4; ++e) { const int i = 4 * j + e;
                const float nr = ar * Dr[s][i - 1] - ai * Di[s][i - 1] + Dr[s][i], ni = ar * Di[s][i - 1] + ai * Dr[s][i - 1] + Di[s][i]; Dr[s][i] = nr; Di[s][i] = ni; }
        float hr = Hr[s], hi = Hi[s];
#pragma unroll
        for (int j = 0; j < 4; ++j) {
            const float ownr = Dr[s][4 * j + 3], owni = Di[s][4 * j + 3], othr = __shfl_xor(ownr, 32), othi = __shfl_xor(owni, 32);
            const float evr = h ? othr : ownr, evi = h ? othi : owni, odr = h ? ownr : othr, odi = h ? owni : othi;
            const float inr0 = hr, ini0 = hi;
            float t = a4r * hr - a4i * hi + evr; hi = a4r * hi + a4i * hr + evi; hr = t;
            if (j == 0) { H1r[s] = hr; H1i[s] = hi; }
            const float inr1 = hr, ini1 = hi;
            t = a4r * hr - a4i * hi + odr; hi = a4r * hi + a4i * hr + odi; hr = t;
            if (FIX) { const float inr = h ? inr1 : inr0, ini = h ? ini1 : ini0;
#pragma unroll
                for (int e = 0; e < 4; ++e) { const int i = 4 * j + e; Dr[s][i] += U.pw[s].r[e] * inr - U.pw[s].i[e] * ini; Di[s][i] += U.pw[s].r[e] * ini + U.pw[s].i[e] * inr; } }
        }
        Hr[s] = hr; Hi[s] = hi;
    }
}
__device__ __forceinline__ bf16x8 ssm_load_au(const bf16_t* P, int m0, int ntok, int g, int lane) {
    const int t = lane & 31, h = lane >> 5;
    if (t < ntok) return *(const bf16x8*)(P + (size_t)(m0 + t) * NPROJ + C_SU + g * 16 + 8 * h);
    return (bf16x8){0, 0, 0, 0, 0, 0, 0, 0};
}
__device__ __forceinline__ void s2_ssm_pass1(Frame& F, int l) {
    const bf16_t* P = (const bf16_t*)(F.ws + WS_P); f32x2* E = (f32x2*)(F.ws + WS_SSME);
    const int lane = F.lane, n32 = lane & 31, h = lane >> 5;
    for (int u = F.gw; u < PB * 64 * SSM_NCH; u += F.ngw) {
        const int b = u >> 11, g = (u >> 5) & 63, ch = u & 31, m0 = b * SEQ + ch * SSM_L;
        SsmUnit U; ssm_unit_load(F, l, g, lane, U);
        float Hr[2] = {0.f, 0.f}, Hi[2] = {0.f, 0.f}, H1r[2], H1i[2];
        bf16x8 au = ssm_load_au(P, m0, 32, g, lane);
#pragma unroll 1
        for (int blk = 0; blk < SSM_L / 32; ++blk) {
            const bf16x8 an = ssm_load_au(P, m0 + 32 * ((blk + 1) & 3), 32, g, lane);
            f32x16 Dr[2], Di[2];
            ssm_block32<false>(au, U, Hr, Hi, H1r, H1i, Dr, Di, h);
            au = an;
        }
        if (h == 0) { f32x2* e = E + ((size_t)(b * 64 + g) * SSM_NCH + ch) * 64; e[n32] = (f32x2){Hr[0], Hi[0]}; e[32 + n32] = (f32x2){Hr[1], Hi[1]}; }
    }
}
__device__ __forceinline__ void s3_ssm_pass2(Frame& F, int l) {
    const bf16_t* P = (const bf16_t*)(F.ws + WS_P); const f32x2* E = (const f32x2*)(F.ws + WS_SSME); bf16_t* Z = (bf16_t*)(F.ws + WS_Z);
    LAS unsigned char* himg = F.lds + 65536 + F.wave * 8960;
    const int lane = F.lane, n32 = lane & 31, h = lane >> 5, tk = lane & 15, cq = lane >> 4;
    for (int u = F.gw; u < PB * 64 * SSM_NCH + SB * 64; u += F.ngw) {
        const bool smp = u >= PB * 64 * SSM_NCH;
        int b, g, ch, m0, nblk, ntok;
        if (!smp) { b = u >> 11; g = (u >> 5) & 63; ch = u & 31; m0 = b * SEQ + ch * SSM_L; nblk = SSM_L / 32; ntok = 32; }
        else { const int su = u - PB * 64 * SSM_NCH; b = su >> 6; g = su & 63; ch = 0; m0 = MPT + b * 4; nblk = 1; ntok = 4; }
        SsmUnit U; ssm_unit_load(F, l, g, lane, U);
        bf16x8 cmf[4];
        { const bf16_t* cm = (const bf16_t*)(F.ws + WS_SCM + l * al1m(SZ_SCM)) + (size_t)(g * 16 + tk) * 128 + 8 * cq;
#pragma unroll
            for (int ks = 0; ks < 4; ++ks) cmf[ks] = *(const bf16x8*)(cm + 32 * ks); }
        const f32x4 ds = *(const f32x4*)(FIN(IN_DSKIP) + l * 1024 + g * 16 + 4 * cq);
        float Hr[2] = {0.f, 0.f}, Hi[2] = {0.f, 0.f}, H1r[2] = {0.f, 0.f}, H1i[2] = {0.f, 0.f};
        if (!smp) { const f32x2* e = E + (size_t)(b * 64 + g) * SSM_NCH * 64;
            for (int j0 = 0; j0 < ch; j0 += 8) {
                f32x2 ev[8][2];
#pragma unroll
                for (int jj = 0; jj < 8; ++jj)
#pragma unroll
                    for (int s = 0; s < 2; ++s) ev[jj][s] = (j0 + jj < ch) ? e[(size_t)(j0 + jj) * 64 + n32 + 32 * s] : (f32x2){0.f, 0.f};
#pragma unroll
                for (int jj = 0; jj < 8; ++jj) if (j0 + jj < ch) {
#pragma unroll
                    for (int s = 0; s < 2; ++s) { const float nr = U.alr[s] * Hr[s] - U.ali[s] * Hi[s] + ev[jj][s].x, ni = U.alr[s] * Hi[s] + U.ali[s] * Hr[s] + ev[jj][s].y; Hr[s] = nr; Hi[s] = ni; } } } }
        else { const float* h0 = FIN(IN_SSSM) + ((size_t)(l * SB + b) * 2 * 64 + g) * 64 + n32;
#pragma unroll
            for (int s = 0; s < 2; ++s) { Hr[s] = h0[32 * s]; Hi[s] = h0[64 * 64 + 32 * s]; } }
        bf16x8 au = ssm_load_au(P, m0, ntok, g, lane);
#pragma unroll 1
        for (int blk = 0; blk < nblk; ++blk) {
            const bf16x8 an = ssm_load_au(P, m0 + 32 * ((blk + 1) & 3), ntok, g, lane);
            u32x2 uw[2];
#pragma unroll
            for (int tt = 0; tt < 2; ++tt) uw[tt] = (16 * tt + tk < ntok) ? *(const u32x2*)(P + (size_t)(m0 + 32 * blk + 16 * tt + tk) * NPROJ + C_SU + g * 16 + 4 * cq) : (u32x2){0u, 0u};
            f32x16 Dr[2], Di[2];
            ssm_block32<true>(au, U, Hr, Hi, H1r, H1i, Dr, Di, h);
            au = an;
#pragma unroll
            for (int i = 0; i < 16; ++i) { const int tl = (i & 3) + 8 * (i >> 2) + 4 * h;
                *(LAS unsigned*)(himg + tl * 272 + 4 * n32) = pk2(Dr[0][i], Di[0][i]); *(LAS unsigned*)(himg + tl * 272 + 4 * (32 + n32)) = pk2(Dr[1][i], Di[1][i]); }
            LDS_WAIT(); asm volatile("" ::: "memory");
#pragma unroll
            for (int tt = 0; tt < 2; ++tt) {
                f32x4 y = {0.f, 0.f, 0.f, 0.f};
#pragma unroll
                for (int ks = 0; ks < 4; ++ks) { const bf16x8 hf = *(const LAS bf16x8*)(himg + (16 * tt + tk) * 272 + (32 * ks + 8 * cq) * 2); y = __builtin_amdgcn_mfma_f32_16x16x32_bf16(cmf[ks], hf, y, 0, 0, 0); }
                const int t = 32 * blk + 16 * tt + tk;
                if (16 * tt + tk < ntok) { const f32x4 uu = unpack4(uw[tt]);
                    u32x2 o; o.x = pk2(gelu_tanh(y.x + ds.x * uu.x), gelu_tanh(y.y + ds.y * uu.y)); o.y = pk2(gelu_tanh(y.z + ds.z * uu.z), gelu_tanh(y.w + ds.w * uu.w));
                    *(u32x2*)(Z + (size_t)(m0 + t) * 1024 + g * 16 + 4 * cq) = o; }
            }
            LDS_WAIT(); asm volatile("" ::: "memory");
        }
        if (h == 0) {
            if (smp) { float* o = F.out + O_SSMS + ((size_t)(l * SB + b) * 2 * 64 + g) * 64 + n32;
#pragma unroll
                for (int s = 0; s < 2; ++s) { o[32 * s] = H1r[s]; o[64 * 64 + 32 * s] = H1i[s]; } }
            else if (ch == SSM_NCH - 1) { float* o = F.out + O_SSMP + ((size_t)(l * PB + b) * 2 * 64 + g) * 64 + n32;
#pragma unroll
                for (int s = 0; s < 2; ++s) { o[32 * s] = Hr[s]; o[64 * 64 + 32 * s] = Hi[s]; } }
        }
    }
}
struct Args { const float* in[27]; float* out; unsigned char* ws; int ph_lo, ph_hi; };
constexpr int N_PHASES = 15;

__global__ void __launch_bounds__(NT, 2) fwd_kernel(Args args) {
    extern __shared__ __attribute__((aligned(16))) unsigned char lds_raw[];
    Frame F;
    F.lds = (LAS unsigned char*)lds_raw;
    F.tid = threadIdx.x; F.lane = F.tid & 63; F.wave = __builtin_amdgcn_readfirstlane(F.tid >> 6);
    F.G = gridDim.x; F.bid = blockIdx.x; F.gw = F.bid * NWAVES + F.wave; F.ngw = F.G * NWAVES;
    F.out = args.out; F.ws = args.ws;
    volatile LAS unsigned* misc = (volatile LAS unsigned*)(F.lds + LDS_MISC);
    if (F.tid < 64) misc[F.tid] = 0u;
    __syncthreads();
    const int lo = args.ph_lo, hi = args.ph_hi;
#if MK_PER_PHASE
#define GRID_BAR() do { } while (0)
#else
    XcdBarrier bar = xcd_barrier_post((unsigned*)(F.ws + WS_CTL) + CW_BAR, misc + 8);
#define GRID_BAR() xcd_barrier(bar)
#endif
#ifdef ONLYPH
#define IN(k) ((((k)==0?0:(((k)-1)%7)+1))==ONLYPH && lo <= (k) && (k) < hi)
#else
#define IN(k) (lo <= (k) && (k) < hi)
#endif
#define BOTH(k) (IN(k) && IN((k) + 1))
#ifndef PROBE_PH
#define PROBE_PH -1
#endif
#define REPS(k) _Pragma("unroll 1") for (int rep_ = 0; rep_ < ((PROBE_PH) == (k) ? 2 : 1); ++rep_)
#define PHASE_BEGIN() do { int t_ = threadIdx.x; asm volatile("" : "+v"(t_)); F.tid = t_; F.lane = t_ & 63; F.wave = __builtin_amdgcn_readfirstlane(t_ >> 6); \
    F.gw = F.bid * NWAVES + F.wave; GAS unsigned char* w_ = (GAS unsigned char*)args.ws; asm volatile("" : "+s"(w_)); F.ws = (unsigned char*)w_; \
    GAS float* o_ = (GAS float*)args.out; asm volatile("" : "+s"(o_)); F.out = (float*)o_; } while (0)
    if (IN(0)) { PHASE_BEGIN(); REPS(0) phase_prologue(F); if (BOTH(0)) GRID_BAR(); }
    for (int l = 0; l < 2; ++l) {
        const int p0 = 1 + 7 * l;
        if (IN(p0)) {
            PHASE_BEGIN();
            pg8::Gemm g{(const bf16_t*)(F.ws + WS_H), (const bf16_t*)(F.ws + WS_WIN + l * al1m(SZ_WIN)), DM, DM, DM, 0, 0};
            pg8::TileOrder S; S.init(MPT / 256, NPROJ / 256, 1, 0, F.G, F.bid);
            EpiProj E{(bf16_t*)(F.ws + WS_P), (float*)(F.ws + WS_GATE), F.out, l};
            REPS(1) pg8::gemm_phase(F.lds, g, S, E);
            skinny_proj(F, l);
            if (BOTH(p0)) GRID_BAR();
        }
        if (IN(p0 + 1)) {
            PHASE_BEGIN();
            REPS(2) {
#ifndef SK_A
            REPS(21) s2_compress(F, l);
#endif
            __syncthreads();
#ifndef SK_B
            PHASE_BEGIN();
            REPS(22) s2_ssm_pass1(F, l);
#endif
#ifndef SK_C
            PHASE_BEGIN();
            REPS(23) s2_pool_diff(F, l);
#endif
#ifndef SK_D
            PHASE_BEGIN();
            REPS(24) s2_state_outputs(F, l);
#endif
#ifndef SK_E
            PHASE_BEGIN();
            REPS(25) s2_vt_images(F);
#endif
            }
            if (BOTH(p0 + 1)) GRID_BAR();
        }
        if (IN(p0 + 2)) {
            PHASE_BEGIN();
            REPS(33) s3_ssm_pass2(F, l);
            __syncthreads();
            if (BOTH(p0 + 2)) GRID_BAR();
        }
        if (IN(p0 + 3)) {
            PHASE_BEGIN();
            REPS(3) {
#ifndef SK_F
            REPS(31) for (int p = F.bid; p < 256; p += F.G) { const int bk = p >> 5, j = p & 31;
#pragma unroll 1
                for (int k2 = 0; k2 < 2; ++k2) nsa_prompt_unit(F, l, bk >> 2, bk & 3, k2 ? j : 63 - j); }
#endif
#ifndef SK_G
            PHASE_BEGIN();
            for (int uu = F.bid; uu < (((PROBE_PH) == 35 || (PROBE_PH) == 36 || (PROBE_PH) == 32) ? 512 : 256); uu += F.G) { const int u = uu & 255, part = (u >> 3) & 1;
                if (uu >= 256 && (PROBE_PH) != 32 && (PROBE_PH) != 35 + part) continue;
                nsa_sample_unit(F, l, (u & 7) | ((u >> 4) << 3), part); }
#endif
            __syncthreads();
            PHASE_BEGIN();
            REPS(4) {
            const int hi = (F.bid >> 3) & 1, idx = (F.bid >> 4) * 8 + (F.bid & 7);
            const int n1 = (F.G >> 4) * 8 + ((F.G & 15) > 8 ? (F.G & 15) - 8 : 0), n0 = F.G - n1;
            if (hi || n1 == 0) {
                pg8::Gemm g{(const bf16_t*)(F.ws + WS_Z), (const bf16_t*)(F.ws + WS_WGLU + l * al1m(SZ_WGLU)), 1024, 1024, 1024, 0, 0};
                pg8::TileOrder S; if (n1) S.init(MPT / 256, 4, 1, 0, n1, idx); else S.init(MPT / 256, 4, 1, 0, F.G, F.bid);
                EpiGlu E{(bf16_t*)(F.ws + WS_ABR + 2 * SZ_ABR1), (const bf16_t*)(F.ws + WS_P), (const bf16_t*)(F.ws + WS_Z)};
                pg8::gemm_phase(F.lds, g, S, E);
            }
            if (!hi) {
                pg8::Gemm g{(const bf16_t*)(F.ws + WS_DIFF), (const bf16_t*)(F.ws + WS_WPOOL + l * al1m(SZ_WPOOL)), 1024, 256, 256, 256, 65536};
                pg8::TileOrder S; S.init(MPT / 256, 1, 4, 0, n0, idx);
                EpiPool E{(bf16_t*)(F.ws + WS_ABR), (const bf16_t*)(F.ws + WS_P), FIN(IN_PSCALE) + l * 1024};
                pg8::gemm_phase(F.lds, g, S, E);
            }
            skinny_glu(F, l); skinny_pool(F, l);
            }
            }
            if (BOTH(p0 + 3)) GRID_BAR();
        }
        if (IN(p0 + 4)) {
            PHASE_BEGIN();
            pg8::Gemm g{(const bf16_t*)(F.ws + WS_ABR), (const bf16_t*)(F.ws + WS_WBR + l * al1m(SZ_WBR)), 1024, 1024, 1024, (size_t)MPAD * 1024, (size_t)2048 * 1024};
            pg8::TileOrder S; S.init(MPT / 256, 8, 3, 1, F.G, F.bid);
            EpiBranch E{(bf16_t*)(F.ws + WS_MERGED), (const bf16_t*)(F.ws + WS_P)};
            REPS(5) { pg8::gemm_phase(F.lds, g, S, E); skinny_branch(F, l); }
            if (BOTH(p0 + 4)) GRID_BAR();
        }
        if (IN(p0 + 5)) {
            PHASE_BEGIN();
            pg8::Gemm g{(const bf16_t*)(F.ws + WS_MERGED), (const bf16_t*)(F.ws + WS_WOUT + l * al1m(SZ_WOUT)), DM, DM, DM, 0, 0};
            pg8::TileOrder S; S.init(MPT / 256, 8, 1, 0, F.G, F.bid);
            EpiOut E{(bf16_t*)(F.ws + WS_OUTB)};
            REPS(6) { pg8::gemm_phase(F.lds, g, S, E); skinny_out(F, l); }
            if (BOTH(p0 + 5)) GRID_BAR();
        }
        if (IN(p0 + 6)) {
            PHASE_BEGIN();
            REPS(7) phase_norm(F, l);
            if (BOTH(p0 + 6)) GRID_BAR();
        }
    }
#undef IN
#undef BOTH
}

extern "C" void kernel_launch(void* const* d_in, const int* in_sizes, int n_in, void* d_out, int out_size, void* d_ws, size_t ws_size, hipStream_t stream) {
    static int grid = 0;
    if (grid == 0) {
        if (n_in != 27 || out_size != (int)O_TOTAL || ws_size < WS_END) { fprintf(stderr, "kernel_launch: unexpected problem shape (n_in %d, out %d, ws %zu < %zu)\n", n_in, out_size, ws_size, (size_t)WS_END); grid = -1; return; }
        int dev = 0, cus = 0, per_cu = 0;
        if (hipGetDevice(&dev) != hipSuccess || hipDeviceGetAttribute(&cus, hipDeviceAttributeMultiprocessorCount, dev) != hipSuccess) { grid = -1; return; }
        if (hipFuncSetAttribute((const void*)fwd_kernel, hipFuncAttributeMaxDynamicSharedMemorySize, LDS_BYTES) != hipSuccess) { fprintf(stderr, "kernel_launch: hipFuncSetAttribute failed\n"); grid = -1; return; }
        if (hipOccupancyMaxActiveBlocksPerMultiprocessor(&per_cu, (const void*)fwd_kernel, NT, LDS_BYTES) != hipSuccess || per_cu < 1)
            fprintf(stderr, "kernel_launch: note: occupancy query reports %d workgroups per CU\n", per_cu);
        (void)hipGetLastError();
        grid = cus;
    }
    if (grid < 0) return;
    if (hipMemsetAsync((char*)d_ws + WS_CTL, 0, CTL_ZERO_BYTES, stream) != hipSuccess) return;
    Args a{};
    for (int i = 0; i < 27; ++i) a.in[i] = (const float*)d_in[i];
    a.out = (float*)d_out; a.ws = (unsigned char*)d_ws;
#if MK_PER_PHASE
    for (int k = 0; k < N_PHASES; ++k) { a.ph_lo = k; a.ph_hi = k + 1; hipLaunchKernelGGL(fwd_kernel, dim3(grid), dim3(NT), LDS_BYTES, stream, a); }
#else
    a.ph_lo = 0; a.ph_hi = N_PHASES;
    hipLaunchKernelGGL(fwd_kernel, dim3(grid), dim3(NT), LDS_BYTES, stream, a);
#endif
    const hipError_t le = hipPeekAtLastError();
    if (le != hipSuccess) fprintf(stderr, "kernel_launch: launch failed: %s\n", hipGetErrorName(le));
}
```

```cpp
#define MK_PER_PHASE 0
#include <hip/hip_runtime.h>
#include <cstdio>
#include <cstdint>

#ifndef MK_PER_PHASE
#define MK_PER_PHASE 0
#endif

#define LAS __attribute__((address_space(3)))
#define GAS __attribute__((address_space(1)))
typedef unsigned short bf16_t;
typedef short bf16x8 __attribute__((ext_vector_type(8)));
typedef float f32x4 __attribute__((ext_vector_type(4)));
typedef float f32x2 __attribute__((ext_vector_type(2)));
typedef float f32x16 __attribute__((ext_vector_type(16)));
typedef unsigned u32x4 __attribute__((ext_vector_type(4)));
typedef unsigned u32x2 __attribute__((ext_vector_type(2)));
typedef __bf16 bf16x2_t __attribute__((ext_vector_type(2)));

constexpr int DM = 2048, SEQ = 4096, PB = 2, SB = 8, SQ = 4, PAST = 16384;
constexpr int MPT = PB * SEQ;
constexpr int MROWS = MPT + SB * SQ;
constexpr int MPAD = 8448;
constexpr int DIN = 13872, NPROJ = 14080;
constexpr int C_PU = 0, C_PZ = 1024, C_Q = 2048, C_CK = 3072, C_CV = 3328, C_SK = 3584, C_SV = 3840, C_WK = 4096, C_WV = 4352,
              C_AZ = 4608, C_SU = 5632, C_SZ = 6656, C_MG = 7680, C_AG = 13824;
constexpr int NPOOL = 1280;
constexpr int SSM_L = 128, SSM_NCH = SEQ / SSM_L;
constexpr float EPS = 1e-6f;
constexpr float SM_SCALE_L2E = 0.125f * 1.44269504088896f;
constexpr float SM_THR = 8.f;

constexpr size_t O_YP = 0, O_YS = 16777216, O_KVP = 16842752, O_KVS = 33619968, O_WINP = 33685504, O_WINS = 34734080,
                 O_POOLP = 38928384, O_POOLS = 38989824, O_SSMP = 39235584, O_SSMS = 39268352, O_TOTAL = 39399424;

constexpr size_t al1m(size_t x) { return (x + 1048575) & ~(size_t)1048575; }
constexpr size_t SZ_WIN = (size_t)NPROJ * DM * 2, SZ_WPOOL = 4 * 256 * 256 * 2, SZ_WGLU = 1024 * 1024 * 2, SZ_WBR = (size_t)3 * 2048 * 1024 * 2,
                 SZ_WOUT = (size_t)2048 * 2048 * 2, SZ_WPHI = 2 * 64 * 64 * 64 * 2, SZ_PEBP = 2 * 16 * 64 * 4, SZ_SAB = 64 * 64 * 4 * 4,
                 SZ_SBB = 64 * 16 * 2 * 64 * 4, SZ_SCM = 64 * 16 * 128 * 2;
constexpr size_t WS_CTL = 0, CTL_BYTES = 1048576, CTL_ZERO_BYTES = 32768;
constexpr size_t WS_WIN = CTL_BYTES;
constexpr size_t WS_WPOOL = WS_WIN + 2 * al1m(SZ_WIN);
constexpr size_t WS_WGLU = WS_WPOOL + 2 * al1m(SZ_WPOOL);
constexpr size_t WS_WBR = WS_WGLU + 2 * al1m(SZ_WGLU);
constexpr size_t WS_WOUT = WS_WBR + 2 * al1m(SZ_WBR);
constexpr size_t WS_WPHI = WS_WOUT + 2 * al1m(SZ_WOUT);
constexpr size_t WS_PEBP = WS_WPHI + 2 * al1m(SZ_WPHI);
constexpr size_t WS_SAB = WS_PEBP + 2 * al1m(SZ_PEBP);
constexpr size_t WS_SBB = WS_SAB + 2 * al1m(SZ_SAB);
constexpr size_t WS_SCM = WS_SBB + 2 * al1m(SZ_SBB);
constexpr size_t WS_H = WS_SCM + 2 * al1m(SZ_SCM);
constexpr size_t WS_P = WS_H + al1m((size_t)MPAD * DM * 2);
constexpr size_t WS_GATE = WS_P + al1m((size_t)MPAD * NPROJ * 2);
constexpr size_t WS_DIFF = WS_GATE + al1m((size_t)MPAD * 64 * 4);
constexpr size_t WS_ABR = WS_DIFF + al1m((size_t)MPAD * 1024 * 2);
constexpr size_t SZ_ABR1 = (size_t)MPAD * 1024 * 2;
constexpr size_t WS_Z = WS_ABR + al1m(3 * SZ_ABR1);
constexpr size_t WS_KCP = WS_Z + al1m(SZ_ABR1);
constexpr size_t WS_VCTP = WS_KCP + al1m(65536);
constexpr size_t WS_KCS = WS_VCTP + al1m(65536);
constexpr size_t WS_VCTS = WS_KCS + al1m(1048576);
constexpr size_t WS_VTSEL = WS_VCTS + al1m(1048576);
constexpr size_t WS_VTWIN = WS_VTSEL + al1m(4194304);
constexpr size_t WS_SSME = WS_VTWIN + al1m(4194304);
constexpr size_t WS_MERGED = WS_SSME + al1m(2097152);
constexpr size_t WS_OUTB = WS_MERGED + al1m((size_t)MPAD * DM * 2);
constexpr size_t WS_Y0 = WS_OUTB + al1m((size_t)MPAD * DM * 4);
constexpr size_t WS_BRP = WS_Y0 + al1m((size_t)MPAD * DM * 4);
constexpr size_t WS_SOACC = WS_BRP + al1m((size_t)3 * 32 * DM * 4);
constexpr size_t WS_SBB16 = WS_SOACC + al1m(128 * 768 * 4);
constexpr size_t SZ_SBB16 = 64 * 2 * 64 * 16 * 2;
constexpr size_t WS_KTSEL = WS_SBB16 + 2 * al1m(SZ_SBB16);
constexpr size_t WS_KTWIN = WS_KTSEL + al1m(4194304);
constexpr size_t WS_END = WS_KTWIN + al1m(4194304);

constexpr int CW_BAR = 4096;

constexpr int NWAVES = 8, NT = 512;
constexpr int LDS_BYTES = 147456;
constexpr int LDS_MISC = 143360;

__device__ __forceinline__ float bf2f(unsigned b) { return __uint_as_float(b << 16); }
__device__ __forceinline__ unsigned pk2(float lo, float hi) { f32x2 v = {lo, hi}; bf16x2_t b = __builtin_convertvector(v, bf16x2_t); return __builtin_bit_cast(unsigned, b); }
__device__ __forceinline__ unsigned f2bf(float f) { return pk2(f, 0.f) & 0xffffu; }
__device__ __forceinline__ float wave_sum(float v) {
#pragma unroll
    for (int o = 1; o < 64; o <<= 1) v += __shfl_xor(v, o);
    return v;
}
__device__ __forceinline__ float wave_max(float v) {
#pragma unroll
    for (int o = 1; o < 64; o <<= 1) v = fmaxf(v, __shfl_xor(v, o));
    return v;
}
__device__ __forceinline__ float sigmoidf_(float x) { return __builtin_amdgcn_rcpf(1.f + __expf(-x)); }
__device__ __forceinline__ float siluf_(float x) { return x * sigmoidf_(x); }
__device__ __forceinline__ float gelu_tanh(float y) { const float a = 1.5957691216f * (y + 0.044715f * y * y * y); return y * sigmoidf_(a); }
#define LDS_WAIT() asm volatile("s_waitcnt lgkmcnt(0)" ::: "memory")
#define VM_WAIT() asm volatile("s_waitcnt vmcnt(0)" ::: "memory")

#define XB_TMO      128
#define XB_XCNT(j)  (256  + 64 * (j))
#define XB_XSUB(j)  (1280 + 64 * (j))
#define XB_XGEN(j)  (2304 + 64 * (j))
#define XB_TOP      3328
#define XB_TOPGEN   3392
#define XCD_BAR_WORDS 3456
#define XB_SPIN_CAP (1u << 23)
__device__ __forceinline__ unsigned xb_ld(unsigned* p)              { return __hip_atomic_load(p, __ATOMIC_RELAXED, __HIP_MEMORY_SCOPE_AGENT); }
__device__ __forceinline__ unsigned xb_add(unsigned* p, unsigned v) { return __hip_atomic_fetch_add(p, v, __ATOMIC_RELAXED, __HIP_MEMORY_SCOPE_AGENT); }
__device__ __forceinline__ unsigned xb_xcc_id() { return (unsigned)__builtin_amdgcn_s_getreg((3 << 11) | 20) & 0xFu; }
#define XB_SPIN(cond, bar) do { unsigned _sp = 0; while (cond) { __builtin_amdgcn_s_sleep(1); \
    if ((++_sp & 255u) == 0u) { if (xb_ld(&(bar)[XB_TMO])) break; if (_sp > XB_SPIN_CAP) { atomicAdd(&(bar)[XB_TMO], 1u); break; } } } } while (0)
struct XcdBarrier { unsigned* bar; unsigned x; volatile LAS unsigned* st; };
__device__ __forceinline__ XcdBarrier xcd_barrier_post(unsigned* bar, volatile LAS unsigned* st) {
    XcdBarrier b; b.bar = bar; b.x = xb_xcc_id(); b.st = st;
    if (threadIdx.x == 0) (void)xb_add(&bar[XB_XCNT(b.x)], 1u);
    return b;
}
__device__ __forceinline__ void xcd_barrier_complete(unsigned* bar, unsigned x, unsigned& nloc, unsigned& nx) {
    const unsigned G = gridDim.x * gridDim.y * gridDim.z;
    unsigned sum, cnt, mine, sp = 0u;
    for (;;) {
        sum = 0u; cnt = 0u; mine = 0u;
#pragma unroll
        for (unsigned j = 0; j < 16; ++j) { const unsigned c = xb_ld(&bar[XB_XCNT(j)]); sum += c; cnt += (c > 0u) ? 1u : 0u; mine = (j == x) ? c : mine; }
        if (sum == G) break;
        __builtin_amdgcn_s_sleep(1);
        if ((++sp & 255u) == 0u) { if (xb_ld(&bar[XB_TMO])) break; if (sp > XB_SPIN_CAP) { atomicAdd(&bar[XB_TMO], 1u); break; } }
    }
    nloc = mine > 0u ? mine : 1u; nx = cnt > 0u ? cnt : 1u;
}
__device__ __forceinline__ void xcd_barrier(const XcdBarrier& b) {
    asm volatile("s_waitcnt vmcnt(0)" ::: "memory");
    __syncthreads();
    if (threadIdx.x == 0) {
        unsigned* bar = b.bar;
        __builtin_amdgcn_s_waitcnt(0);
        unsigned nloc = b.st[0], nx = b.st[1];
        if (nloc == 0u) { xcd_barrier_complete(bar, b.x, nloc, nx); b.st[0] = nloc; b.st[1] = nx; }
        const unsigned old = xb_add(&bar[XB_XSUB(b.x)], 1u);
        const unsigned gen = old / nloc;
        if (old + 1u == (gen + 1u) * nloc) {
            __builtin_amdgcn_fence(__ATOMIC_RELEASE, "agent");
            asm volatile("s_waitcnt vmcnt(0)" ::: "memory");
            const unsigned og = xb_add(&bar[XB_TOP], 1u);
            const unsigned tg = og / nx;
            if (og + 1u == (tg + 1u) * nx) xb_add(&bar[XB_TOPGEN], 1u);
            else XB_SPIN(xb_ld(&bar[XB_TOPGEN]) == tg, bar);
            __builtin_amdgcn_fence(__ATOMIC_ACQUIRE, "agent");
            xb_add(&bar[XB_XGEN(b.x)], 1u);
            asm volatile("s_waitcnt vmcnt(0)" ::: "memory");
        } else {
            XB_SPIN(xb_ld(&bar[XB_XGEN(b.x)]) == gen, bar);
            __builtin_amdgcn_fence(__ATOMIC_ACQUIRE, "agent");
            asm volatile("s_waitcnt vmcnt(0)" ::: "memory");
        }
    }
    __syncthreads();
}
namespace pg8 {
constexpr int BM = 256, BK = 64, HALF = 128, HTB = HALF * BK * 2, STAGE_BYTES = 8 * HTB, NXCD = 8, WGM = 8;
__host__ __device__ __forceinline__ int lds_byte(int r, int c) { const int st = (r >> 4) * 2 + (c >> 5), rr = r & 15, cc = c & 31, ob = rr * 64 + cc * 2; return st * 1024 + (ob ^ (((ob >> 9) & 1) << 5)); }
__host__ __device__ __forceinline__ void stage_rc(int b, int& R, int& C) { const int st = b / 1024, sb = b % 1024, swz = sb ^ (((sb >> 9) & 1) << 5); R = (st >> 1) * 16 + swz / 64; C = (st & 1) * 32 + (swz % 64) / 2; }
__host__ __device__ __forceinline__ int perm32(int rho) { const int n = rho >> 4, i = rho & 15; return 8 * (i >> 2) + 4 * n + (i & 3); }

struct Unit { int pm, pn, z; };
struct Gemm { const bf16_t* A; const bf16_t* Bt; int lda, ldb, K; size_t zA, zB; };

struct TileOrder {
    int nM, nN, nz, ntile, G, c, zin;
    __device__ void init(int nM_, int nN_, int nz_, int zin_, int G_, int c_) { nM = nM_; nN = nN_; nz = nz_; zin = zin_; ntile = nM * nN; G = G_; c = c_; }
    __device__ bool next(int i, Unit& u) const {
        long L; int z;
        if (zin) { z = i % nz; L = (long)(i / nz) * G + c; if (L >= ntile) return false; }
        else { const long LL = (long)i * G + c; if (LL >= (long)ntile * nz) return false; z = (int)(LL / ntile); L = LL % ntile; }
        int wgid = (int)L; { const int q = ntile / NXCD, r = ntile % NXCD, xcd = wgid % NXCD, off = wgid / NXCD; wgid = (xcd < r ? xcd * (q + 1) : r * (q + 1) + (xcd - r) * q) + off; }
        const int nig = WGM * nN, gid = wgid / nig, fm = gid * WGM, gsz = (nM - fm) < WGM ? (nM - fm) : WGM;
        u.pm = fm + ((wgid % nig) % gsz); u.pn = (wgid % nig) / gsz; u.z = z; return true;
    }
};

template <class Epi, class Sched>
__device__ __forceinline__ void gemm_phase(LAS unsigned char* lds, const Gemm g, const Sched& S, const Epi& E) {
    int tid = threadIdx.x; asm volatile("" : "+v"(tid));
    const int wid = __builtin_amdgcn_readfirstlane(tid >> 6), lane = tid & 63, wr = wid >> 2, wc = wid & 3, fr = lane & 15, fq = lane >> 4;
    const int K = g.K, nt = K / BK;
    unsigned voffA[2], voffB[2];
#pragma unroll
    for (int i = 0; i < 2; ++i) { int R, C; stage_rc(tid * 16 + i * 8192, R, C); const int Rb = (R & ~31) + perm32(R & 31);
        voffA[i] = (unsigned)(R * g.lda + C) * 2u; voffB[i] = (unsigned)(Rb * g.ldb + C) * 2u; }
    const size_t kstep = (size_t)(BK * 2);
    const size_t hstepA = (size_t)HALF * g.lda * 2, hstepB = (size_t)HALF * g.ldb * 2;
    const unsigned ldsw = (unsigned)wid * 1024u;
    const int aoff = lds_byte(wr * 64 + fr, fq * 8), boff = lds_byte(wc * 32 + fr, fq * 8);
#define PG8_SA(b, h) (((b) * 2 + (h)) * HTB)
#define PG8_SB(b, h) ((4 + (b) * 2 + (h)) * HTB)
#define PG8_STAGE(bufoff, gbase, voff) do { _Pragma("unroll") for (int _i = 0; _i < 2; ++_i) \
        __builtin_amdgcn_global_load_lds((const unsigned*)((const char*)(gbase) + (voff)[_i]), (LAS unsigned*)(lds + (bufoff) + ldsw + _i * 8192), 16, 0, 0); } while (0)
#define PG8_LDA(dst, b, h) do { _Pragma("unroll") for (int m = 0; m < 4; ++m) _Pragma("unroll") for (int k = 0; k < 2; ++k) dst[m][k] = *(const LAS bf16x8*)(lds + PG8_SA(b, h) + aoff + m * 2048 + k * 1024); } while (0)
#define PG8_LDB(dst, b, h) do { _Pragma("unroll") for (int n = 0; n < 2; ++n) _Pragma("unroll") for (int k = 0; k < 2; ++k) dst[n][k] = *(const LAS bf16x8*)(lds + PG8_SB(b, h) + boff + n * 2048 + k * 1024); } while (0)
#define PG8_MMA(ai, bj, At, Bt) do { __builtin_amdgcn_s_setprio(1); _Pragma("unroll") for (int m = 0; m < 4; ++m) _Pragma("unroll") for (int n = 0; n < 2; ++n) _Pragma("unroll") for (int k = 0; k < 2; ++k) \
        acc[ai][bj][m][n] = __builtin_amdgcn_mfma_f32_16x16x32_bf16(Bt[n][k], At[m][k], acc[ai][bj][m][n], 0, 0, 0); __builtin_amdgcn_s_setprio(0); } while (0)
#define PG8_WAIT_V(n) asm volatile("s_waitcnt vmcnt(" #n ")" ::: "memory")
#define PG8_WAIT_L(n) asm volatile("s_waitcnt lgkmcnt(" #n ")" ::: "memory")
#define PG8_BAR __builtin_amdgcn_s_barrier()
#define PG8_SCHED __builtin_amdgcn_sched_barrier(0)
#define PG8_UA(u) ((const char*)(g.A + (size_t)(u).z * g.zA) + (size_t)(u).pm * (2 * hstepA))
#define PG8_UB(u) ((const char*)(g.Bt + (size_t)(u).z * g.zB) + (size_t)(u).pn * (2 * hstepB))
    Unit cur, nxt; int ui = 0;
    if (!S.next(0, cur)) return;
    f32x4 acc[2][2][4][2];
#pragma unroll
    for (int a = 0; a < 2; ++a)
#pragma unroll
        for (int b = 0; b < 2; ++b)
#pragma unroll
            for (int m = 0; m < 4; ++m)
#pragma unroll
                for (int n = 0; n < 2; ++n) acc[a][b][m][n] = (f32x4){0.f, 0.f, 0.f, 0.f};
    bf16x8 At[4][2], B0[2][2], B1[2][2];
    const char* cA = PG8_UA(cur); const char* cB = PG8_UB(cur);
    PG8_STAGE(PG8_SB(0, 0), cB, voffB); PG8_STAGE(PG8_SB(0, 1), cB + hstepB, voffB); PG8_STAGE(PG8_SA(0, 0), cA, voffA); PG8_STAGE(PG8_SA(0, 1), cA + hstepA, voffA);
    if (wr == 1) PG8_BAR;
    PG8_WAIT_V(2); PG8_BAR;
    PG8_STAGE(PG8_SB(1, 0), cB + kstep, voffB); PG8_STAGE(PG8_SA(1, 0), cA + kstep, voffA); PG8_STAGE(PG8_SB(1, 1), cB + hstepB + kstep, voffB);
    PG8_WAIT_V(6); PG8_BAR;
    for (;;) {
        const bool has_next = S.next(ui + 1, nxt);
        const char* nA = has_next ? PG8_UA(nxt) : cA; const char* nB = has_next ? PG8_UB(nxt) : cB;
#pragma unroll 1
        for (int t = 0; t < nt; t += 2) {
            const bool last = (t == nt - 2);
            const char* a1 = cA + (size_t)(t + 1) * kstep;
            const char* a2 = last ? nA : cA + (size_t)(t + 2) * kstep; const char* b2 = last ? nB : cB + (size_t)(t + 2) * kstep;
            const char* a3 = a2 + kstep; const char* b3 = b2 + kstep;
            PG8_LDB(B0, 0, 0); PG8_LDB(B1, 0, 1); PG8_SCHED; PG8_LDA(At, 0, 0); PG8_STAGE(PG8_SA(1, 1), a1 + hstepA, voffA);
            PG8_WAIT_V(8); PG8_WAIT_L(0); PG8_BAR; PG8_MMA(0, 0, At, B0); PG8_MMA(0, 1, At, B1); PG8_BAR; PG8_SCHED;
            PG8_LDA(At, 0, 1); PG8_STAGE(PG8_SB(0, 0), b2, voffB); PG8_STAGE(PG8_SB(0, 1), b2 + hstepB, voffB); PG8_STAGE(PG8_SA(0, 0), a2, voffA);
            PG8_WAIT_V(8); PG8_WAIT_L(0); PG8_BAR; PG8_MMA(1, 0, At, B0); PG8_MMA(1, 1, At, B1); PG8_BAR; PG8_SCHED;
            PG8_LDB(B0, 1, 0); PG8_LDB(B1, 1, 1); PG8_SCHED; PG8_LDA(At, 1, 0); PG8_STAGE(PG8_SA(0, 1), a2 + hstepA, voffA);
            PG8_WAIT_V(8); PG8_WAIT_L(0); PG8_BAR; PG8_MMA(0, 0, At, B0); PG8_MMA(0, 1, At, B1); PG8_BAR; PG8_SCHED;
            PG8_LDA(At, 1, 1); PG8_STAGE(PG8_SB(1, 0), b3, voffB); PG8_STAGE(PG8_SB(1, 1), b3 + hstepB, voffB); PG8_STAGE(PG8_SA(1, 0), a3, voffA);
            PG8_WAIT_V(8); PG8_WAIT_L(0); PG8_BAR; PG8_MMA(1, 0, At, B0); PG8_MMA(1, 1, At, B1); PG8_BAR; PG8_SCHED;
        }
        if (wr == 0) PG8_BAR;
        const bool keep = E(acc, cur, wr, wc, fr, fq);
        if (!has_next) break;
        if (!keep) {
#pragma unroll
            for (int a = 0; a < 2; ++a)
#pragma unroll
                for (int b = 0; b < 2; ++b)
#pragma unroll
                    for (int m = 0; m < 4; ++m)
#pragma unroll
                        for (int n = 0; n < 2; ++n) acc[a][b][m][n] = (f32x4){0.f, 0.f, 0.f, 0.f};
        }
        cur = nxt; cA = nA; cB = nB; ++ui;
        if (wr == 1) PG8_BAR;
    }
    PG8_WAIT_V(0);
    PG8_BAR;
#undef PG8_SA
#undef PG8_SB
#undef PG8_STAGE
#undef PG8_LDA
#undef PG8_LDB
#undef PG8_MMA
#undef PG8_WAIT_V
#undef PG8_WAIT_L
#undef PG8_BAR
#undef PG8_SCHED
#undef PG8_UA
#undef PG8_UB
}
}
#define EPI_ARGS f32x4 (&acc)[2][2][4][2], const pg8::Unit& u, int wr, int wc, int fr, int fq
#define EPI_FOR_ROWS _Pragma("unroll") for (int ai = 0; ai < 2; ++ai) _Pragma("unroll") for (int m = 0; m < 4; ++m)
#define EPI_ROW (u.pm * 256 + ai * 128 + wr * 64 + m * 16 + fr)
#define EPI_FOR_COLS _Pragma("unroll") for (int bj = 0; bj < 2; ++bj)
#define EPI_COL (u.pn * 256 + bj * 128 + wc * 32 + 8 * fq)

__device__ __forceinline__ u32x4 pack8(const f32x4& a, const f32x4& b) { u32x4 w; w.x = pk2(a[0], a[1]); w.y = pk2(a[2], a[3]); w.z = pk2(b[0], b[1]); w.w = pk2(b[2], b[3]); return w; }
__device__ __forceinline__ void unpack8(const u32x4& w, float (&f)[8]) {
    f[0] = bf2f(w.x & 0xffffu); f[1] = __uint_as_float(w.x & 0xffff0000u); f[2] = bf2f(w.y & 0xffffu); f[3] = __uint_as_float(w.y & 0xffff0000u);
    f[4] = bf2f(w.z & 0xffffu); f[5] = __uint_as_float(w.z & 0xffff0000u); f[6] = bf2f(w.w & 0xffffu); f[7] = __uint_as_float(w.w & 0xffff0000u);
}

__device__ __forceinline__ u32x2 pack4(const f32x4& v) { u32x2 w; w.x = pk2(v[0], v[1]); w.y = pk2(v[2], v[3]); return w; }
__device__ __forceinline__ f32x4 unpack4(const u32x2& x) { return (f32x4){bf2f(x.x & 0xffffu), __uint_as_float(x.x & 0xffff0000u), bf2f(x.y & 0xffffu), __uint_as_float(x.y & 0xffff0000u)}; }

struct EpiProj {
    bf16_t* P; float* gate; float* out; int layer;
    __device__ __forceinline__ bool operator()(EPI_ARGS) const {
        const int pn = u.pn;
        int mode;
        if (pn < 4) mode = 0; else if (pn < 8) mode = 1; else if (pn < 12) mode = 5; else if (pn < 16) mode = 3; else if (pn < 18) mode = 0;
        else if (pn < 22) mode = 1; else if (pn < 26) mode = 0; else if (pn < 30) mode = 1; else if (pn < 54) mode = 2; else mode = 4;
        if (mode == 0) {
            EPI_FOR_ROWS { bf16_t* rp = P + (size_t)EPI_ROW * NPROJ; EPI_FOR_COLS { *(u32x4*)(rp + EPI_COL) = pack8(acc[ai][bj][m][0], acc[ai][bj][m][1]); } }
        } else if (mode == 5) {
            EPI_FOR_ROWS { bf16_t* rp = P + (size_t)EPI_ROW * NPROJ; EPI_FOR_COLS { *(u32x4*)(rp + EPI_COL) = pack8(acc[ai][bj][m][0] * SM_SCALE_L2E, acc[ai][bj][m][1] * SM_SCALE_L2E); } }
        } else if (mode == 1) {
            EPI_FOR_ROWS { bf16_t* rp = P + (size_t)EPI_ROW * NPROJ; EPI_FOR_COLS { f32x4 a = acc[ai][bj][m][0], b = acc[ai][bj][m][1];
#pragma unroll
                for (int j = 0; j < 4; ++j) { a[j] = siluf_(a[j]); b[j] = siluf_(b[j]); }
                *(u32x4*)(rp + EPI_COL) = pack8(a, b); } }
        } else if (mode == 2) {
            EPI_FOR_ROWS { bf16_t* rp = P + (size_t)EPI_ROW * NPROJ; EPI_FOR_COLS { f32x4 a = acc[ai][bj][m][0], b = acc[ai][bj][m][1];
#pragma unroll
                for (int j = 0; j < 4; ++j) { a[j] = sigmoidf_(a[j]); b[j] = sigmoidf_(b[j]); }
                *(u32x4*)(rp + EPI_COL) = pack8(a, b); } }
        } else if (mode == 3) {
            EPI_FOR_ROWS { const int row = EPI_ROW; bf16_t* rp = P + (size_t)row * NPROJ;
                float* op = nullptr;
                if (row < MPT) op = out + O_KVP + ((size_t)layer * MPT + row) * 1024;
                else if (row < MROWS) op = out + O_KVS + ((size_t)layer * 32 + (row - MPT)) * 1024;
                EPI_FOR_COLS { const int col = EPI_COL; *(u32x4*)(rp + col) = pack8(acc[ai][bj][m][0], acc[ai][bj][m][1]);
                    if (op) { *(f32x4*)(op + col - C_CK) = acc[ai][bj][m][0]; *(f32x4*)(op + col - C_CK + 4) = acc[ai][bj][m][1]; } } }
        } else {
            EPI_FOR_ROWS { float* gp = gate + (size_t)EPI_ROW * 64; EPI_FOR_COLS { const int c = EPI_COL - C_AG; if (c < 48) { f32x4 a = acc[ai][bj][m][0], b = acc[ai][bj][m][1];
#pragma unroll
                for (int j = 0; j < 4; ++j) { a[j] = sigmoidf_(a[j]); b[j] = sigmoidf_(b[j]); }
                *(f32x4*)(gp + c) = a; *(f32x4*)(gp + c + 4) = b; } } }
        }
        return false;
    }
};

struct EpiPool {
    bf16_t* apool; const bf16_t* P; const float* pscale;
    __device__ __forceinline__ bool operator()(EPI_ARGS) const {
        asm volatile("" ::: "memory");
#pragma unroll
        for (int ai = 0; ai < 2; ++ai) {
            u32x4 zw[4][2];
#pragma unroll
            for (int m = 0; m < 4; ++m) EPI_FOR_COLS { const int col = u.z * 256 + bj * 128 + wc * 32 + 8 * fq; zw[m][bj] = *(const u32x4*)(P + (size_t)EPI_ROW * NPROJ + C_PZ + col); }
            __builtin_amdgcn_sched_barrier(0);
#pragma unroll
            for (int m = 0; m < 4; ++m) EPI_FOR_COLS { const int col = u.z * 256 + bj * 128 + wc * 32 + 8 * fq; float zf[8]; unpack8(zw[m][bj], zf);
                const f32x4 s0 = *(const f32x4*)(pscale + col), s1 = *(const f32x4*)(pscale + col + 4);
                f32x4 a = acc[ai][bj][m][0], b = acc[ai][bj][m][1];
#pragma unroll
                for (int j = 0; j < 4; ++j) { a[j] = a[j] * s0[j] * zf[j]; b[j] = b[j] * s1[j] * zf[4 + j]; }
                *(u32x4*)(apool + (size_t)EPI_ROW * 1024 + col) = pack8(a, b); }
            __builtin_amdgcn_sched_barrier(0);
        }
        return false;
    }
};

struct EpiGlu {
    bf16_t* assm; const bf16_t* P; const bf16_t* Z;
    __device__ __forceinline__ bool operator()(EPI_ARGS) const {
#pragma unroll
        for (int ai = 0; ai < 2; ++ai) {
            u32x4 zw[4][2], sw[4][2];
#pragma unroll
            for (int m = 0; m < 4; ++m) EPI_FOR_COLS { const int row = EPI_ROW, col = EPI_COL; zw[m][bj] = *(const u32x4*)(Z + (size_t)row * 1024 + col); sw[m][bj] = *(const u32x4*)(P + (size_t)row * NPROJ + C_SZ + col); }
            __builtin_amdgcn_sched_barrier(0);
#pragma unroll
            for (int m = 0; m < 4; ++m) EPI_FOR_COLS { float zf[8], sf[8]; unpack8(zw[m][bj], zf); unpack8(sw[m][bj], sf);
                f32x4 a = acc[ai][bj][m][0], b = acc[ai][bj][m][1];
#pragma unroll
                for (int j = 0; j < 4; ++j) { a[j] = zf[j] * sigmoidf_(a[j]) * sf[j]; b[j] = zf[4 + j] * sigmoidf_(b[j]) * sf[4 + j]; }
                *(u32x4*)(assm + (size_t)EPI_ROW * 1024 + EPI_COL) = pack8(a, b); }
            __builtin_amdgcn_sched_barrier(0);
        }
        return false;
    }
};

struct EpiBranch {
    bf16_t* merged; const bf16_t* P;
    __device__ __forceinline__ bool operator()(EPI_ARGS) const {
        const int z = u.z;
#pragma unroll
        for (int ai = 0; ai < 2; ++ai) {
            u32x4 gzw[4][2], gnw[4][2];
#pragma unroll
            for (int m = 0; m < 4; ++m) EPI_FOR_COLS { const bf16_t* gp = P + (size_t)EPI_ROW * NPROJ + C_MG + EPI_COL; gzw[m][bj] = *(const u32x4*)(gp + z * 2048); gnw[m][bj] = *(const u32x4*)(gp + (z < 2 ? z + 1 : 2) * 2048); }
            __builtin_amdgcn_sched_barrier(0);
#pragma unroll
            for (int m = 0; m < 4; ++m) EPI_FOR_COLS { float gz[8], gn[8]; unpack8(gzw[m][bj], gz); unpack8(gnw[m][bj], gn);
                f32x4& a = acc[ai][bj][m][0]; f32x4& b = acc[ai][bj][m][1];
                if (z < 2) {
#pragma unroll
                    for (int j = 0; j < 4; ++j) { a[j] *= fmaxf(gz[j], 1e-30f) * __builtin_amdgcn_rcpf(fmaxf(gn[j], 1e-30f)); b[j] *= fmaxf(gz[4 + j], 1e-30f) * __builtin_amdgcn_rcpf(fmaxf(gn[4 + j], 1e-30f)); }
                } else {
                    f32x4 a2, b2;
#pragma unroll
                    for (int j = 0; j < 4; ++j) { a2[j] = a[j] * fmaxf(gz[j], 1e-30f); b2[j] = b[j] * fmaxf(gz[4 + j], 1e-30f); }
                    *(u32x4*)(merged + (size_t)EPI_ROW * DM + EPI_COL) = pack8(a2, b2);
                } }
            __builtin_amdgcn_sched_barrier(0);
        }
        return z < 2;
    }
};

struct EpiOut {
    bf16_t* outb;
    __device__ __forceinline__ bool operator()(EPI_ARGS) const {
        EPI_FOR_ROWS { bf16_t* rp = outb + (size_t)EPI_ROW * DM; EPI_FOR_COLS { *(u32x4*)(rp + EPI_COL) = pack8(acc[ai][bj][m][0], acc[ai][bj][m][1]); } }
        return false;
    }
};
struct Frame {
    LAS unsigned char* lds;
    int tid, lane, wave, G, bid, gw, ngw;
    float* out; unsigned char* ws;
};
#define FIN(i) ((const float*)(const GAS float*)(((const float* const __attribute__((address_space(4)))*)__builtin_amdgcn_kernarg_segment_ptr())[i]))
#define IN_XP 0
#define IN_XS 1
#define IN_CACHE 2
#define IN_PT 3
#define IN_SWIN 4
#define IN_SPOOL 5
#define IN_SSSM 6
#define IN_GPRE 7
#define IN_GPOST 8
#define IN_WIN 9
#define IN_WPOOL 10
#define IN_PSCALE 11
#define IN_PE 12
#define IN_WPHI 13
#define IN_LRE 14
#define IN_LIM 15
#define IN_LSTEP 16
#define IN_BRE 17
#define IN_BIM 18
#define IN_CRE 19
#define IN_CIM 20
#define IN_DSKIP 21
#define IN_WGLU 22
#define IN_WBRP 23
#define IN_WBRN 24
#define IN_WBRS 25
#define IN_WOUT 26

template <class MAP>
__device__ __forceinline__ void transpose_item(const float* W, int ldw, int K, bf16_t* WT, int k0, int nd0, LAS float* scr, int lane, const MAP& map) {
    const int nq = 4 * (lane & 15), ns = map(nd0 + nq), kr = lane >> 4;
    f32x4 v[16];
#pragma unroll
    for (int i = 0; i < 16; ++i) v[i] = ns >= 0 ? *(const f32x4*)(W + (size_t)(k0 + 4 * i + kr) * ldw + ns) : (f32x4){0.f, 0.f, 0.f, 0.f};
#pragma unroll
    for (int i = 0; i < 16; ++i) { LAS float* d = scr + (4 * i + kr) * 65 + nq; d[0] = v[i].x; d[1] = v[i].y; d[2] = v[i].z; d[3] = v[i].w; }
    LDS_WAIT(); asm volatile("" ::: "memory");
    const int c = lane & 7;
#pragma unroll
    for (int j = 0; j < 8; ++j) { const int n = (lane >> 3) + 8 * j; const LAS float* s = scr + (8 * c) * 65 + n;
        u32x4 o; o.x = pk2(s[0 * 65], s[1 * 65]); o.y = pk2(s[2 * 65], s[3 * 65]); o.z = pk2(s[4 * 65], s[5 * 65]); o.w = pk2(s[6 * 65], s[7 * 65]);
        *(u32x4*)(WT + (size_t)(nd0 + n) * K + k0 + 8 * c) = o; }
    LDS_WAIT(); asm volatile("" ::: "memory");
}
struct MapId { __device__ __forceinline__ int operator()(int n) const { return n; } };
struct MapWin { __device__ __forceinline__ int operator()(int n) const { return n < C_AZ ? n : (n < C_AG ? n + 48 : (n < C_AG + 48 ? n - C_AG + 4608 : -1)); } };

__device__ __forceinline__ double exp_d(double x) {
    const double r = x * (1.0 / 64.0); double t = 1.0, s = 1.0;
#pragma unroll
    for (int k = 1; k <= 14; ++k) { t *= r / (double)k; s += t; }
#pragma unroll
    for (int k = 0; k < 6; ++k) s *= s;
    return s;
}
__device__ __forceinline__ void sincos_d(double x, double& sn, double& cs) {
    const double k = rint(x * 0.63661977236758134308);
    double r = fma(-k, 1.57079632679489655800e+00, x); r = fma(-k, 6.12323399573676603587e-17, r);
    const double r2 = r * r;
    double sp = 1.0, cp = 1.0, ts = 1.0, tc = 1.0;
#pragma unroll
    for (int i = 1; i <= 9; ++i) { ts *= -r2 / (double)((2 * i) * (2 * i + 1)); sp += ts; tc *= -r2 / (double)((2 * i - 1) * (2 * i)); cp += tc; }
    sp *= r;
    const int q = ((int)k) & 3;
    sn = (q == 0) ? sp : (q == 1) ? cp : (q == 2) ? -sp : -cp;
    cs = (q == 0) ? cp : (q == 1) ? -sp : (q == 2) ? -cp : sp;
}

__device__ __forceinline__ void rms_row_to_bf16(const float* xrow, const float* g, bf16_t* orow, int lane) {
    const f32x4* xr = (const f32x4*)xrow + lane; const f32x4* gr = (const f32x4*)g + lane;
    f32x4 v[8]; float s = 0.f;
#pragma unroll
    for (int j = 0; j < 8; ++j) { v[j] = xr[64 * j]; s += (v[j].x * v[j].x + v[j].y * v[j].y) + (v[j].z * v[j].z + v[j].w * v[j].w); }
    const float rstd = 1.f / sqrtf(wave_sum(s) * (1.f / DM) + EPS);
    u32x2* o8 = (u32x2*)orow + lane;
#pragma unroll
    for (int j = 0; j < 8; ++j) { const f32x4 gg = gr[64 * j]; u32x2 w; w.x = pk2(v[j].x * rstd * gg.x, v[j].y * rstd * gg.y); w.y = pk2(v[j].z * rstd * gg.z, v[j].w * rstd * gg.w); o8[64 * j] = w; }
}
__device__ __forceinline__ const float* x_row_l0(const Frame& F, int m) {
    const GAS float* s0 = (const GAS float*)FIN(IN_XP); const GAS float* s1 = (const GAS float*)FIN(IN_XS);
    asm volatile("" : "+s"(s0), "+s"(s1));
    return (const float*)(m < MPT ? s0 + (size_t)m * DM : s1 + (size_t)(m - MPT) * DM); }

__device__ __forceinline__ void phase_prologue(Frame& F) {
    LAS float* scr = (LAS float*)(F.lds + F.wave * 16640);
    const int lane = F.lane;
    constexpr int I_WIN = 32 * (NPROJ / 64), I_GLU = 16 * 16, I_BR = 16 * 32, I_OUT = 32 * 32, I_POOL = 4 * 4, I_PHI = 1;
    constexpr int PER_L = I_WIN + I_GLU + 3 * I_BR + I_OUT + 4 * I_POOL + 128 * I_PHI;
    for (int it = F.gw; it < 2 * PER_L; it += F.ngw) {
        const int l = it / PER_L; int r = it % PER_L;
        if (r < I_WIN) { const int kb = r / (NPROJ / 64), nb = r % (NPROJ / 64);
            transpose_item(FIN(IN_WIN) + (size_t)l * DM * DIN, DIN, DM, (bf16_t*)(F.ws + WS_WIN + l * al1m(SZ_WIN)), 64 * kb, 64 * nb, scr, lane, MapWin()); continue; } r -= I_WIN;
        if (r < I_GLU) { const int kb = r / 16, nb = r % 16;
            transpose_item(FIN(IN_WGLU) + (size_t)l * 1024 * 1024, 1024, 1024, (bf16_t*)(F.ws + WS_WGLU + l * al1m(SZ_WGLU)), 64 * kb, 64 * nb, scr, lane, MapId()); continue; } r -= I_GLU;
        if (r < 3 * I_BR) { const int z = r / I_BR, rr = r % I_BR, kb = rr / 32, nb = rr % 32;
            const float* src = FIN(IN_WBRP + z) + (size_t)l * 1024 * 2048;
            transpose_item(src, 2048, 1024, (bf16_t*)(F.ws + WS_WBR + l * al1m(SZ_WBR)) + (size_t)z * 2048 * 1024, 64 * kb, 64 * nb, scr, lane, MapId()); continue; } r -= 3 * I_BR;
        if (r < I_OUT) { const int kb = r / 32, nb = r % 32;
            transpose_item(FIN(IN_WOUT) + (size_t)l * 2048 * 2048, 2048, 2048, (bf16_t*)(F.ws + WS_WOUT + l * al1m(SZ_WOUT)), 64 * kb, 64 * nb, scr, lane, MapId()); continue; } r -= I_OUT;
        if (r < 4 * I_POOL) { const int z = r / I_POOL, rr = r % I_POOL, kb = rr / 4, nb = rr % 4;
            transpose_item(FIN(IN_WPOOL) + ((size_t)l * 4 + z) * 65536, 256, 256, (bf16_t*)(F.ws + WS_WPOOL + l * al1m(SZ_WPOOL)) + (size_t)z * 65536, 64 * kb, 64 * nb, scr, lane, MapId()); continue; } r -= 4 * I_POOL;
        {
            transpose_item(FIN(IN_WPHI) + ((size_t)l * 128 + r) * 4096, 64, 64, (bf16_t*)(F.ws + WS_WPHI + l * al1m(SZ_WPHI)) + (size_t)r * 4096, 0, 0, scr, lane, MapId()); }
    }
    for (int it = F.gw; it < 64; it += F.ngw) {
        const int l = it >> 5, j = (it >> 4) & 1, part = it & 15;
        const float* pe = FIN(IN_PE) + ((size_t)(l * 2 + j) * 64 + part * 4) * 64;
        const float* wp = FIN(IN_WPHI) + ((size_t)(l * 2 + j) * 64 + part * 4) * 4096;
        float s = 0.f;
#pragma unroll 16
        for (int i = 0; i < 256; ++i) s += pe[i] * wp[(size_t)i * 64 + lane];
        ((float*)(F.ws + WS_PEBP + l * al1m(SZ_PEBP)))[(j * 16 + part) * 64 + lane] = s;
    }
    for (int it = F.gw * 64 + lane; it < 2 * 4096; it += F.ngw * 64) {
        const int l = it >> 12, g = (it >> 6) & 63, n = it & 63;
        const double dt = exp_d((double)FIN(IN_LSTEP)[l * 64 + g]);
        const double lr = (double)FIN(IN_LRE)[(l * 64 + g) * 64 + n], li = (double)FIN(IN_LIM)[(l * 64 + g) * 64 + n];
        const double mag = exp_d(lr * dt); double sn, cs; sincos_d(li * dt, sn, cs);
        const double ar = mag * cs, ai = mag * sn, den = lr * lr + li * li;
        const double cr = ((ar - 1.0) * lr + ai * li) / den, ci = (ai * lr - (ar - 1.0) * li) / den;
        double pr = ar, pi = ai;
#pragma unroll
        for (int k = 0; k < 7; ++k) { const double t = pr * pr - pi * pi; pi = 2.0 * pr * pi; pr = t; }
        float* ab = (float*)(F.ws + WS_SAB + l * al1m(SZ_SAB)) + (g * 64 + n) * 4;
        ab[0] = (float)ar; ab[1] = (float)ai; ab[2] = (float)pr; ab[3] = (float)pi;
        float* bb = (float*)(F.ws + WS_SBB + l * al1m(SZ_SBB)) + (size_t)g * 16 * 128;
        const float* bre = FIN(IN_BRE) + ((size_t)(l * 64 + g) * 64 + n) * 16; const float* bim = FIN(IN_BIM) + ((size_t)(l * 64 + g) * 64 + n) * 16;
        unsigned* bb16 = (unsigned*)(F.ws + WS_SBB16 + l * al1m(SZ_SBB16));
        for (int c = 0; c < 16; c += 2) { const double br0 = bre[c], bi0 = bim[c], br1 = bre[c + 1], bi1 = bim[c + 1];
            const float r0 = (float)(cr * br0 - ci * bi0), i0 = (float)(cr * bi0 + ci * br0), r1 = (float)(cr * br1 - ci * bi1), i1 = (float)(cr * bi1 + ci * br1);
            bb[c * 128 + n] = r0; bb[c * 128 + 64 + n] = i0; bb[(c + 1) * 128 + n] = r1; bb[(c + 1) * 128 + 64 + n] = i1;
            bb16[(((g * 2 + 0) * 64 + n) * 16 + c) >> 1] = pk2(r0, r1); bb16[(((g * 2 + 1) * 64 + n) * 16 + c) >> 1] = pk2(i0, i1); }
        bf16_t* cm = (bf16_t*)(F.ws + WS_SCM + l * al1m(SZ_SCM)) + (size_t)g * 16 * 128;
        const float* cre = FIN(IN_CRE) + (size_t)(l * 64 + g) * 16 * 64; const float* cim = FIN(IN_CIM) + (size_t)(l * 64 + g) * 16 * 64;
        for (int c = 0; c < 16; ++c) *(unsigned*)(cm + c * 128 + 2 * n) = pk2(cre[c * 64 + n], -cim[c * 64 + n]);
    }
    bf16_t* H = (bf16_t*)(F.ws + WS_H);
    for (int m = F.gw; m < MROWS; m += F.ngw) rms_row_to_bf16(x_row_l0(F, m), FIN(IN_GPRE), H + (size_t)m * DM, lane);
}

__device__ __forceinline__ void phase_norm(Frame& F, int l) {
    const int lane = F.lane;
    const bf16_t* outb = (const bf16_t*)(F.ws + WS_OUTB);
    float* y0 = (float*)(F.ws + WS_Y0);
    bf16_t* H = (bf16_t*)(F.ws + WS_H);
    for (int r = F.bid; r < MROWS - MPT; r += F.G) {
        const int m = MPT + r, c0 = F.wave * 256 + 4 * lane;
        LAS float* red = (LAS float*)F.lds;
        const float* xrow = l == 0 ? FIN(IN_XS) + (size_t)r * DM : y0 + (size_t)m * DM;
        float* yrow = l == 0 ? y0 + (size_t)m * DM : F.out + O_YS + (size_t)r * DM;
        const f32x4 o = unpack4(*(const u32x2*)(outb + (size_t)m * DM + c0)), x = *(const f32x4*)(xrow + c0), g = *(const f32x4*)(FIN(IN_GPOST) + l * DM + c0);
        float s = wave_sum(o.x * o.x + o.y * o.y + o.z * o.z + o.w * o.w);
        __syncthreads();
        if (lane == 0) red[F.wave] = s;
        __syncthreads();
        s = 0.f;
#pragma unroll
        for (int w2 = 0; w2 < NWAVES; ++w2) s += red[w2];
        const float rstd = 1.f / sqrtf(s * (1.f / DM) + EPS);
        const f32x4 y = x + o * rstd * g;
        *(f32x4*)(yrow + c0) = y;
        if (l == 0) {
            float s2 = wave_sum(y.x * y.x + y.y * y.y + y.z * y.z + y.w * y.w);
            if (lane == 0) red[8 + F.wave] = s2;
            __syncthreads();
            s2 = 0.f;
#pragma unroll
            for (int w2 = 0; w2 < NWAVES; ++w2) s2 += red[8 + w2];
            const float rstd2 = 1.f / sqrtf(s2 * (1.f / DM) + EPS);
            const f32x4 g2 = *(const f32x4*)(FIN(IN_GPRE) + DM + c0);
            *(u32x2*)(H + (size_t)m * DM + c0) = pack4(y * rstd2 * g2);
        }
    }
    for (int m = F.gw; m < MPT; m += F.ngw) {
        const float* xrow = l == 0 ? x_row_l0(F, m) : y0 + (size_t)m * DM;
        float* yrow = l == 0 ? y0 + (size_t)m * DM : (m < MPT ? F.out + O_YP + (size_t)m * DM : F.out + O_YS + (size_t)(m - MPT) * DM);
        const float* gp = FIN(IN_GPOST) + l * DM;
        float v[4][8]; float s = 0.f;
#pragma unroll
        for (int j = 0; j < 4; ++j) { const u32x4 w = *(const u32x4*)(outb + (size_t)m * DM + 8 * (lane + 64 * j)); unpack8(w, v[j]);
#pragma unroll
            for (int e = 0; e < 8; ++e) s += v[j][e] * v[j][e]; }
        const float rstd = 1.f / sqrtf(wave_sum(s) * (1.f / DM) + EPS);
        float s2 = 0.f;
#pragma unroll
        for (int j = 0; j < 4; ++j) { const int c0 = 8 * (lane + 64 * j);
            const f32x4 g0 = *(const f32x4*)(gp + c0), g1 = *(const f32x4*)(gp + c0 + 4), x0 = *(const f32x4*)(xrow + c0), x1 = *(const f32x4*)(xrow + c0 + 4);
            f32x4 y0v, y1v;
#pragma unroll
            for (int e = 0; e < 4; ++e) { y0v[e] = x0[e] + v[j][e] * rstd * g0[e]; y1v[e] = x1[e] + v[j][4 + e] * rstd * g1[e]; v[j][e] = y0v[e]; v[j][4 + e] = y1v[e]; s2 += y0v[e] * y0v[e] + y1v[e] * y1v[e]; }
            *(f32x4*)(yrow + c0) = y0v; *(f32x4*)(yrow + c0 + 4) = y1v; }
        if (l == 0) {
            const float rstd2 = 1.f / sqrtf(wave_sum(s2) * (1.f / DM) + EPS);
            const float* g2 = FIN(IN_GPRE) + DM;
#pragma unroll
            for (int j = 0; j < 4; ++j) { const int c0 = 8 * (lane + 64 * j); const f32x4 g0 = *(const f32x4*)(g2 + c0), g1 = *(const f32x4*)(g2 + c0 + 4);
                f32x4 a, bq;
#pragma unroll
                for (int e = 0; e < 4; ++e) { a[e] = v[j][e] * rstd2 * g0[e]; bq[e] = v[j][4 + e] * rstd2 * g1[e]; }
                *(u32x4*)(H + (size_t)m * DM + c0) = pack8(a, bq); }
        }
    }
}
template <int KP>
__device__ __forceinline__ void skinny_stage(LAS unsigned char* lds, const bf16_t* A, int lda, int tid) {
    constexpr int CH = KP / 8;
#pragma unroll 8
    for (int i = tid; i < 32 * CH; i += NT) { const int r = i / CH, c = i % CH; *(LAS u32x4*)(lds + r * (KP * 2 + 16) + c * 16) = *(const u32x4*)(A + (size_t)r * lda + 8 * c); }
    __syncthreads();
}
template <int KP>
__device__ __forceinline__ void skinny_tile(const LAS unsigned char* lds, const bf16_t* Bt, int ldb, int n0, int kbeg, int klen, int lane, f32x4& d0, f32x4& d1) {
    const int rw = lane & 15, q = lane >> 4;
    const bf16_t* wrow = Bt + (size_t)(n0 + rw) * ldb + 32 * q;
    const LAS unsigned char* a0 = lds + rw * (KP * 2 + 16) + (kbeg + 32 * q) * 2;
    const LAS unsigned char* a1 = a0 + 16 * (KP * 2 + 16);
    d0 = (f32x4){0.f, 0.f, 0.f, 0.f}; d1 = d0;
#pragma unroll 4
    for (int k0 = 0; k0 < klen; k0 += 128) {
        bf16x8 w[4];
#pragma unroll
        for (int s = 0; s < 4; ++s) w[s] = *(const bf16x8*)(wrow + k0 + 8 * s);
#pragma unroll
        for (int s = 0; s < 4; ++s) { const bf16x8 b0 = *(const LAS bf16x8*)(a0 + k0 * 2 + 16 * s), b1 = *(const LAS bf16x8*)(a1 + k0 * 2 + 16 * s);
            d0 = __builtin_amdgcn_mfma_f32_16x16x32_bf16(w[s], b0, d0, 0, 0, 0); d1 = __builtin_amdgcn_mfma_f32_16x16x32_bf16(w[s], b1, d1, 0, 0, 0); }
    }
}

__device__ __forceinline__ void skinny_proj(Frame& F, int l) {
    constexpr int NTASK = NPROJ / 128;
    bf16_t* P = (bf16_t*)(F.ws + WS_P); float* gate = (float*)(F.ws + WS_GATE);
    const bf16_t* W = (const bf16_t*)(F.ws + WS_WIN + l * al1m(SZ_WIN));
    bool staged = false;
    const int ntile = (MPT / 256) * (NPROJ / 256), nlight = (ntile % F.G) ? F.G - (ntile % F.G) : F.G, first = F.G - nlight;
    for (int it = 0; it < 2; ++it) { int task;
        if (F.bid >= first) task = (F.bid - first) + it * nlight; else { if (it) break; task = 2 * nlight + (first - 1 - F.bid); }
        if (task >= NTASK) break;
        if (!staged) { skinny_stage<DM>(F.lds, (const bf16_t*)(F.ws + WS_H) + (size_t)MPT * DM, DM, F.tid); staged = true; }
        const int n0 = task * 128 + F.wave * 16; f32x4 d[2];
        skinny_tile<DM>(F.lds, W, DM, n0, 0, DM, F.lane, d[0], d[1]);
        const int n = n0 + 4 * (F.lane >> 4), pn = n >> 8;
        int mode; if (pn < 4) mode = 0; else if (pn < 8) mode = 1; else if (pn < 12) mode = 5; else if (pn < 16) mode = 3; else if (pn < 18) mode = 0;
        else if (pn < 22) mode = 1; else if (pn < 26) mode = 0; else if (pn < 30) mode = 1; else if (pn < 54) mode = 2; else mode = 4;
#pragma unroll
        for (int tt = 0; tt < 2; ++tt) { const int t = 16 * tt + (F.lane & 15), row = MPT + t; f32x4 v = d[tt];
            if (mode == 4) { const int c = n - C_AG; if (c < 48) {
#pragma unroll
                for (int j = 0; j < 4; ++j) v[j] = sigmoidf_(v[j]);
                *(f32x4*)(gate + (size_t)row * 64 + c) = v; } }
            else {
                if (mode == 3) *(f32x4*)(F.out + O_KVS + ((size_t)l * 32 + t) * 1024 + n - C_CK) = v;
                if (mode == 5) v = v * SM_SCALE_L2E;
                if (mode == 1) {
#pragma unroll
                    for (int j = 0; j < 4; ++j) v[j] = siluf_(v[j]); }
                if (mode == 2) {
#pragma unroll
                    for (int j = 0; j < 4; ++j) v[j] = sigmoidf_(v[j]); }
                *(u32x2*)(P + (size_t)row * NPROJ + n) = pack4(v);
            } }
    }
    __syncthreads();
}
__device__ __forceinline__ void skinny_pool(Frame& F, int l) {
    const bf16_t* P = (const bf16_t*)(F.ws + WS_P); bf16_t* apool = (bf16_t*)(F.ws + WS_ABR);
    const bf16_t* W = (const bf16_t*)(F.ws + WS_WPOOL + l * al1m(SZ_WPOOL)); const float* pscale = FIN(IN_PSCALE) + l * 1024;
    bool staged = false;
    for (int task = F.G - 1 - F.bid; task < 8; task += F.G) {
        if (!staged) { skinny_stage<1024>(F.lds, (const bf16_t*)(F.ws + WS_DIFF) + (size_t)MPT * 1024, 1024, F.tid); staged = true; }
        const int z = task >> 1, n0 = (task & 1) * 128 + F.wave * 16; f32x4 d[2];
        skinny_tile<1024>(F.lds, W + (size_t)z * 65536, 256, n0, z * 256, 256, F.lane, d[0], d[1]);
        const int col = z * 256 + n0 + 4 * (F.lane >> 4);
        const f32x4 ps = *(const f32x4*)(pscale + col);
#pragma unroll
        for (int tt = 0; tt < 2; ++tt) { const int row = MPT + 16 * tt + (F.lane & 15);
            const f32x4 zf = unpack4(*(const u32x2*)(P + (size_t)row * NPROJ + C_PZ + col));
            *(u32x2*)(apool + (size_t)row * 1024 + col) = pack4(d[tt] * ps * zf); }
    }
    __syncthreads();
}
__device__ __forceinline__ void skinny_glu(Frame& F, int l) {
    const bf16_t* P = (const bf16_t*)(F.ws + WS_P); const bf16_t* Z = (const bf16_t*)(F.ws + WS_Z); bf16_t* assm = (bf16_t*)(F.ws + WS_ABR + 2 * SZ_ABR1);
    const bf16_t* W = (const bf16_t*)(F.ws + WS_WGLU + l * al1m(SZ_WGLU));
    bool staged = false;
    for (int task = F.G - 9 - F.bid; task < 8; task += F.G) {
        if (task < 0) continue;
        if (!staged) { skinny_stage<1024>(F.lds, Z + (size_t)MPT * 1024, 1024, F.tid); staged = true; }
        const int n0 = task * 128 + F.wave * 16; f32x4 d[2];
        skinny_tile<1024>(F.lds, W, 1024, n0, 0, 1024, F.lane, d[0], d[1]);
        const int col = n0 + 4 * (F.lane >> 4);
#pragma unroll
        for (int tt = 0; tt < 2; ++tt) { const int row = MPT + 16 * tt + (F.lane & 15);
            const f32x4 zf = unpack4(*(const u32x2*)(Z + (size_t)row * 1024 + col)), sf = unpack4(*(const u32x2*)(P + (size_t)row * NPROJ + C_SZ + col));
            f32x4 v = d[tt];
#pragma unroll
            for (int j = 0; j < 4; ++j) v[j] = zf[j] * sigmoidf_(v[j]) * sf[j];
            *(u32x2*)(assm + (size_t)row * 1024 + col) = pack4(v); }
    }
    __syncthreads();
}
__device__ __forceinline__ void skinny_stage_att(Frame& F) {
    const bf16_t* P = (const bf16_t*)(F.ws + WS_P); const float* so = (const float*)(F.ws + WS_SOACC); const float* gate = (const float*)(F.ws + WS_GATE);
#pragma unroll 2
    for (int i = F.tid; i < 32 * 128; i += NT) { const int r = i >> 7, c = i & 127, head = c >> 3, d0 = (c & 7) * 8, row = MPT + r;
        const int unit = (r >> 2) * 16 + (head >> 2) * 4 + (r & 3);
        const float* sp = so + (size_t)unit * 768 + (head & 3) * 64 + d0; const float* gt = gate + (size_t)row * 64 + head * 3;
        const float g0 = gt[0], g1 = gt[1], g2 = gt[2];
        float zf[8]; unpack8(*(const u32x4*)(P + (size_t)row * NPROJ + C_AZ + head * 64 + d0), zf);
        f32x4 o[2];
#pragma unroll
        for (int h = 0; h < 2; ++h) { const f32x4 a = *(const f32x4*)(sp + 4 * h), b = *(const f32x4*)(sp + 256 + 4 * h), w = *(const f32x4*)(sp + 512 + 4 * h);
#pragma unroll
            for (int j = 0; j < 4; ++j) o[h][j] = (g0 * a[j] + g1 * b[j] + g2 * w[j]) * zf[4 * h + j]; }
        *(LAS u32x4*)(F.lds + r * (1024 * 2 + 16) + c * 16) = pack8(o[0], o[1]); }
    __syncthreads();
}
__device__ __forceinline__ void skinny_branch(Frame& F, int l) {
    const bf16_t* P = (const bf16_t*)(F.ws + WS_P); float* brp = (float*)(F.ws + WS_BRP);
    const bf16_t* W = (const bf16_t*)(F.ws + WS_WBR + l * al1m(SZ_WBR));
    for (int task = F.G - 1 - F.bid; task < 48; task += F.G) {
        const int z = task >> 4, n0 = (task & 15) * 128 + F.wave * 16; f32x4 d[2];
        __syncthreads();
        if (z == 1) skinny_stage_att(F);
        else skinny_stage<1024>(F.lds, (const bf16_t*)(F.ws + WS_ABR) + (size_t)z * MPAD * 1024 + (size_t)MPT * 1024, 1024, F.tid);
        skinny_tile<1024>(F.lds, W + (size_t)z * 2048 * 1024, 1024, n0, 0, 1024, F.lane, d[0], d[1]);
        const int col = n0 + 4 * (F.lane >> 4);
#pragma unroll
        for (int tt = 0; tt < 2; ++tt) { const int t = 16 * tt + (F.lane & 15), row = MPT + t;
            const f32x4 gm = unpack4(*(const u32x2*)(P + (size_t)row * NPROJ + C_MG + z * 2048 + col));
            *(f32x4*)(brp + ((size_t)z * 32 + t) * DM + col) = d[tt] * gm; }
    }
    __syncthreads();
}
__device__ __forceinline__ void skinny_out(Frame& F, int l) {
    const float* brp = (const float*)(F.ws + WS_BRP); bf16_t* outb = (bf16_t*)(F.ws + WS_OUTB);
    const bf16_t* W = (const bf16_t*)(F.ws + WS_WOUT + l * al1m(SZ_WOUT));
    bool staged = false;
    for (int task = F.G - 1 - F.bid; task < 64; task += F.G) {
        if (!staged) {
#pragma unroll 4
            for (int i = F.tid; i < 32 * (DM / 4); i += NT) { const int r = i / (DM / 4), c = i % (DM / 4);
                const f32x4 s = *(const f32x4*)(brp + (size_t)r * DM + 4 * c) + *(const f32x4*)(brp + (size_t)(32 + r) * DM + 4 * c) + *(const f32x4*)(brp + (size_t)(64 + r) * DM + 4 * c);
                *(LAS u32x2*)(F.lds + r * (DM * 2 + 16) + c * 8) = pack4(s); }
            __syncthreads(); staged = true; }
        const int tile = F.wave & 1, kq = F.wave >> 1, n0 = task * 32 + tile * 16; f32x4 d[2];
        skinny_tile<DM>(F.lds, W + kq * 512, DM, n0, kq * 512, 512, F.lane, d[0], d[1]);
        __syncthreads();
        LAS f32x4* red = (LAS f32x4*)F.lds;
        red[(F.wave * 2 + 0) * 64 + F.lane] = d[0]; red[(F.wave * 2 + 1) * 64 + F.lane] = d[1];
        staged = false;
        __syncthreads();
        if (kq == 0) {
#pragma unroll
            for (int tt = 0; tt < 2; ++tt) { f32x4 a = d[tt];
#pragma unroll
                for (int k2 = 1; k2 < 4; ++k2) a += red[((2 * k2 + tile) * 2 + tt) * 64 + F.lane];
                *(u32x2*)(outb + (size_t)(MPT + 16 * tt + (F.lane & 15)) * DM + n0 + 4 * (F.lane >> 4)) = pack4(a); } }
        __syncthreads();
    }
    __syncthreads();
}
__device__ __forceinline__ int keypos(int key) { return (key & ~12) | ((key & 4) << 1) | ((key & 8) >> 1); }

template <int W>
__device__ __forceinline__ void pool_diff_load(const bf16_t* P, const float* spool, int m, int c0, f32x4 (&v)[W]) {
    if (m < MPT) {
        const int s = m & (SEQ - 1);
#pragma unroll
        for (int j = 0; j < W; ++j) v[j] = (j <= s) ? unpack4(*(const u32x2*)(P + (size_t)(m - j) * NPROJ + C_PU + c0)) : (f32x4){0.f, 0.f, 0.f, 0.f};
    } else {
        const int b = (m - MPT) >> 2, i = (m - MPT) & 3;
#pragma unroll
        for (int j = 0; j < W; ++j) { const int idx = 15 + i - j;
            v[j] = (idx >= 15) ? unpack4(*(const u32x2*)(P + (size_t)(MPT + b * 4 + idx - 15) * NPROJ + C_PU + c0)) : *(const f32x4*)(spool + ((size_t)b * 15 + idx) * 1024 + c0); }
    }
}
template <int W>
__device__ __forceinline__ void pool_diff_store(bf16_t* D, int m, int c0, const f32x4 (&v)[W]) {
    int cnt = W; if (m < MPT) { const int s = m & (SEQ - 1); cnt = (s + 1 < W) ? s + 1 : W; }
    f32x4 sum = v[0];
#pragma unroll
    for (int j = 1; j < W; ++j) sum += v[j];
    *(u32x2*)(D + (size_t)m * 1024 + c0) = pack4(sum * (1.f / (float)cnt) - v[0]);
}
__device__ __forceinline__ void s2_pool_diff(Frame& F, int l) {
    const bf16_t* P = (const bf16_t*)(F.ws + WS_P); bf16_t* D = (bf16_t*)(F.ws + WS_DIFF);
    const float* spool = FIN(IN_SPOOL) + (size_t)l * SB * 15 * 1024;
    const int c0 = 4 * F.lane;
    for (int m = F.gw; m < MROWS; m += F.ngw) {
        f32x4 v2[2], v4[4], v8[8], v16[16];
        pool_diff_load<2>(P, spool, m, c0, v2); pool_diff_load<4>(P, spool, m, 256 + c0, v4); pool_diff_load<8>(P, spool, m, 512 + c0, v8); pool_diff_load<16>(P, spool, m, 768 + c0, v16);
        pool_diff_store<2>(D, m, c0, v2); pool_diff_store<4>(D, m, 256 + c0, v4); pool_diff_store<8>(D, m, 512 + c0, v8); pool_diff_store<16>(D, m, 768 + c0, v16);
    }
}

__device__ __forceinline__ void store8f(float* dst, const u32x4& x) { float f[8]; unpack8(x, f); *(f32x4*)dst = (f32x4){f[0], f[1], f[2], f[3]}; *(f32x4*)(dst + 4) = (f32x4){f[4], f[5], f[6], f[7]}; }

__device__ __forceinline__ void s2_state_outputs(Frame& F, int l) {
    const bf16_t* P = (const bf16_t*)(F.ws + WS_P);
    const int gt = F.gw * 64 + F.lane, ngt = F.ngw * 64;
    for (int it = gt; it < PB * 15 * 128; it += ngt) { const int c0 = (it & 127) * 8, r = (it >> 7) % 15, b = (it >> 7) / 15;
        store8f(F.out + O_POOLP + (((size_t)l * PB + b) * 15 + r) * 1024 + c0, *(const u32x4*)(P + (size_t)(b * SEQ + SEQ - 15 + r) * NPROJ + C_PU + c0)); }
    for (int it = gt; it < SB * 15 * 128; it += ngt) { const int c0 = (it & 127) * 8, r = (it >> 7) % 15, b = (it >> 7) / 15, e = 4 + r;
        float* dst = F.out + O_POOLS + (((size_t)l * SB + b) * 15 + r) * 1024 + c0;
        if (e < 15) { const float* sp = FIN(IN_SPOOL) + (((size_t)l * SB + b) * 15 + e) * 1024 + c0; *(f32x4*)dst = *(const f32x4*)sp; *(f32x4*)(dst + 4) = *(const f32x4*)(sp + 4); }
        else store8f(dst, *(const u32x4*)(P + (size_t)(MPT + b * 4 + e - 15) * NPROJ + C_PU + c0)); }
    for (int it = gt; it < PB * 512 * 64; it += ngt) { const int c0 = (it & 63) * 8, r = (it >> 6) & 511, b = it >> 15;
        store8f(F.out + O_WINP + (((size_t)l * PB + b) * 512 + r) * 512 + c0, *(const u32x4*)(P + (size_t)(b * SEQ + SEQ - 512 + r) * NPROJ + C_WK + c0)); }
    for (int it = gt; it < SB * 512 * 64; it += ngt) { const int c0 = (it & 63) * 8, r = (it >> 6) & 511, b = it >> 15;
        float* dst = F.out + O_WINS + (((size_t)l * SB + b) * 512 + r) * 512 + c0;
        if (r < 508) { const float* sp = FIN(IN_SWIN) + (((size_t)l * SB + b) * 512 + r + 4) * 512 + c0; *(f32x4*)dst = *(const f32x4*)sp; *(f32x4*)(dst + 4) = *(const f32x4*)(sp + 4); }
        else store8f(dst, *(const u32x4*)(P + (size_t)(MPT + b * 4 + r - 508) * NPROJ + C_WK + c0)); }
}

__device__ __forceinline__ void s2_vt_images(Frame& F) {
    const bf16_t* P = (const bf16_t*)(F.ws + WS_P);
    for (int it = F.gw; it < 2 * PB * 4 * 64; it += F.ngw) {
        const int which = it >> 9, b = (it >> 8) & 1, kvh = (it >> 6) & 3, blk = it & 63;
        const bf16_t* src = P + (size_t)(b * SEQ + blk * 64 + F.lane) * NPROJ + (which ? C_WK : C_SK) + kvh * 64;
        bf16_t* img = (bf16_t*)(F.ws + (which ? WS_KTWIN : WS_KTSEL)) + (size_t)((b * 4 + kvh) * 64 + blk) * 4096 + F.lane * 8;
        u32x4 v[8];
#pragma unroll
        for (int j = 0; j < 8; ++j) v[j] = *(const u32x4*)(src + 8 * j);
#pragma unroll
        for (int j = 0; j < 8; ++j) *(u32x4*)(img + j * 512) = v[j];
    }
    for (int it = F.gw; it < 2 * PB * 4 * 64; it += F.ngw) {
        const int which = it >> 9, b = (it >> 8) & 1, kvh = (it >> 6) & 3, blk = it & 63;
        const bf16_t* src = P + (size_t)(b * SEQ + blk * 64 + F.lane) * NPROJ + (which ? C_WV : C_SV) + kvh * 64;
        const int pos = keypos(F.lane);
        bf16_t* img = (bf16_t*)(F.ws + (which ? WS_VTWIN : WS_VTSEL)) + (size_t)((b * 4 + kvh) * 64 + blk) * 4096 + (pos >> 3) * 512 + (pos & 7);
        u32x4 v[8];
#pragma unroll
        for (int j = 0; j < 8; ++j) v[j] = *(const u32x4*)(src + 8 * j);
#pragma unroll
        for (int j = 0; j < 8; ++j) {
            img[(8 * j + 0) * 8] = (bf16_t)(v[j].x & 0xffffu); img[(8 * j + 1) * 8] = (bf16_t)(v[j].x >> 16);
            img[(8 * j + 2) * 8] = (bf16_t)(v[j].y & 0xffffu); img[(8 * j + 3) * 8] = (bf16_t)(v[j].y >> 16);
            img[(8 * j + 4) * 8] = (bf16_t)(v[j].z & 0xffffu); img[(8 * j + 5) * 8] = (bf16_t)(v[j].z >> 16);
            img[(8 * j + 6) * 8] = (bf16_t)(v[j].w & 0xffffu); img[(8 * j + 7) * 8] = (bf16_t)(v[j].w >> 16); }
    }
}

template <bool SAMPLE>
__device__ __forceinline__ void compress_unit(Frame& F, int l, int unit) {
    const int lane = F.lane, w = F.wave, col = lane & 15, q = lane >> 4, nl = col >> 2, k = col & 3;
    const int b = SAMPLE ? unit >> 5 : unit >> 3, n0 = SAMPLE ? (unit & 31) * 8 : (unit & 7) * 8;
    const bf16_t* wphi = (const bf16_t*)(F.ws + WS_WPHI + l * al1m(SZ_WPHI));
    const bf16_t* P = (const bf16_t*)(F.ws + WS_P);
    const float* cache = FIN(IN_CACHE); const int* pt = (const int*)FIN(IN_PT);
    f32x4 acc[2][2][4];
#pragma unroll
    for (int j = 0; j < 2; ++j)
#pragma unroll
        for (int nt = 0; nt < 2; ++nt)
#pragma unroll
            for (int et = 0; et < 4; ++et) acc[j][nt][et] = (f32x4){0.f, 0.f, 0.f, 0.f};
    size_t xoff[2];
#pragma unroll
    for (int nt = 0; nt < 2; ++nt) { const int blk = n0 + 4 * nt + nl;
        if (SAMPLE) { const int page = pt[b * 128 + (blk >> 1)]; xoff[nt] = ((((size_t)l * NPOOL + page) * 128 + (blk & 1) * 64) * 4) * 256 + k * 64 + 8 * q; }
        else xoff[nt] = (size_t)(b * SEQ + blk * 64) * NPROJ + C_CK + k * 64 + 8 * q; }
    bf16x8 ra[2][2][4];
    f32x4 rx[2][2][2][2];
#define CMP_LOAD(J, LPOS) do { _Pragma("unroll") for (int dc = 0; dc < 2; ++dc) { \
        _Pragma("unroll") for (int et = 0; et < 4; ++et) ra[J][dc][et] = *(const bf16x8*)(wphi + ((size_t)((J) * 64 + (LPOS)) * 64 + 16 * et + col) * 64 + 32 * dc + 8 * q); \
        _Pragma("unroll") for (int nt = 0; nt < 2; ++nt) { \
            if (SAMPLE) { const float* s_ = cache + xoff[nt] + ((size_t)(LPOS) * 4 + (J)) * 256 + 32 * dc; rx[J][dc][nt][0] = __builtin_nontemporal_load((const f32x4*)s_); rx[J][dc][nt][1] = __builtin_nontemporal_load((const f32x4*)(s_ + 4)); } \
            else rx[J][dc][nt][0] = __builtin_bit_cast(f32x4, *(const bf16x8*)(P + xoff[nt] + (size_t)(LPOS) * NPROJ + (J) * 256 + 32 * dc)); } } } while (0)
#define CMP_MMA(J) do { _Pragma("unroll") for (int dc = 0; dc < 2; ++dc) _Pragma("unroll") for (int nt = 0; nt < 2; ++nt) { \
        const bf16x8 bx_ = SAMPLE ? __builtin_bit_cast(bf16x8, pack8(rx[J][dc][nt][0], rx[J][dc][nt][1])) : __builtin_bit_cast(bf16x8, rx[J][dc][nt][0]); \
        _Pragma("unroll") for (int et = 0; et < 4; ++et) acc[J][nt][et] = __builtin_amdgcn_mfma_f32_16x16x32_bf16(ra[J][dc][et], bx_, acc[J][nt][et], 0, 0, 0); } } while (0)
    CMP_LOAD(0, w * 8);
#pragma unroll 1
    for (int li = 0; li < 8; ++li) { const int lpos = w * 8 + li;
        CMP_LOAD(1, lpos); __builtin_amdgcn_sched_barrier(0);
        CMP_MMA(0); __builtin_amdgcn_sched_barrier(0);
        if (li < 7) CMP_LOAD(0, lpos + 1);
        __builtin_amdgcn_sched_barrier(0);
        CMP_MMA(1); __builtin_amdgcn_sched_barrier(0);
    }
#undef CMP_LOAD
#undef CMP_MMA
    LAS float* red = (LAS float*)F.lds;
#pragma unroll
    for (int j = 0; j < 2; ++j)
#pragma unroll
        for (int nt = 0; nt < 2; ++nt)
#pragma unroll
            for (int et = 0; et < 4; ++et)
#pragma unroll
                for (int i = 0; i < 4; ++i) red[(w * 64 + ((j * 2 + nt) * 4 + et) * 4 + i) * 64 + lane] = acc[j][nt][et][i];
    __syncthreads();
    const LAS float* pb = (const LAS float*)(F.lds + 131072);
    bf16_t* kc = (bf16_t*)(F.ws + (SAMPLE ? WS_KCS : WS_KCP)); bf16_t* vct = (bf16_t*)(F.ws + (SAMPLE ? WS_VCTS : WS_VCTP));
    constexpr int NBLK = SAMPLE ? 256 : 64;
    for (int o = F.tid; o < 4096; o += NT) { const int r = o >> 6, ln = o & 63;
        float s = 0.f;
#pragma unroll
        for (int ww = 0; ww < 8; ++ww) s += red[(ww * 64 + r) * 64 + ln];
        const int j = r >> 5, nt = (r >> 4) & 1, et = (r >> 2) & 3, i = r & 3, e = 16 * et + 4 * (ln >> 4) + i, cc = ln & 15, blk = n0 + 4 * nt + (cc >> 2), kk = cc & 3;
        s += pb[j * 64 + e];
        if (j == 0) kc[((size_t)(b * 4 + kk) * NBLK + blk) * 64 + e] = (bf16_t)f2bf(s);
        else vct[(((size_t)(b * 4 + kk) * (NBLK / 64) + (blk >> 6)) * 64 + e) * 64 + keypos(blk & 63)] = (bf16_t)f2bf(s);
    }
    __syncthreads();
}

__device__ __forceinline__ void compress_prompt_piece(Frame& F, int l, int piece) {
    const int lane = F.lane, w = F.wave, col = lane & 15, q = lane >> 4, nl = col >> 2, k = col & 3;
    const int ntile = piece >> 3, j = (piece >> 2) & 1, et = piece & 3, b = ntile >> 4, n0 = (ntile & 15) * 4;
    const bf16_t* wphi = (const bf16_t*)(F.ws + WS_WPHI + l * al1m(SZ_WPHI)) + ((size_t)(j * 64) * 64 + 16 * et + col) * 64 + 8 * q;
    const bf16_t* xp = (const bf16_t*)(F.ws + WS_P) + (size_t)(b * SEQ + (n0 + nl) * 64) * NPROJ + C_CK + j * 256 + k * 64 + 8 * q;
    bf16x8 a[16], x[16];
#pragma unroll
    for (int li = 0; li < 8; ++li)
#pragma unroll
        for (int dc = 0; dc < 2; ++dc) { const int lpos = w * 8 + li;
            a[li * 2 + dc] = *(const bf16x8*)(wphi + (size_t)lpos * 4096 + 32 * dc); x[li * 2 + dc] = *(const bf16x8*)(xp + (size_t)lpos * NPROJ + 32 * dc); }
    f32x4 acc = {0.f, 0.f, 0.f, 0.f};
#pragma unroll
    for (int i = 0; i < 16; ++i) acc = __builtin_amdgcn_mfma_f32_16x16x32_bf16(a[i], x[i], acc, 0, 0, 0);
    LAS float* red = (LAS float*)F.lds;
    __syncthreads();
#pragma unroll
    for (int i = 0; i < 4; ++i) red[(w * 4 + i) * 64 + lane] = acc[i];
    __syncthreads();
    if (F.tid < 256) { const int i = F.tid >> 6, ln = F.tid & 63; float s = 0.f;
#pragma unroll
        for (int ww = 0; ww < 8; ++ww) s += red[(ww * 4 + i) * 64 + ln];
        const int e = 16 * et + 4 * (ln >> 4) + i, cc = ln & 15, blk = n0 + (cc >> 2), kk = cc & 3;
        s += ((const LAS float*)(F.lds + 131072))[j * 64 + e];
        if (j == 0) ((bf16_t*)(F.ws + WS_KCP))[(size_t)(b * 4 + kk) * 4096 + (e >> 3) * 512 + blk * 8 + (e & 7)] = (bf16_t)f2bf(s);
        else { const int pos = keypos(blk); ((bf16_t*)(F.ws + WS_VCTP))[(size_t)(b * 4 + kk) * 4096 + (pos >> 3) * 512 + e * 8 + (pos & 7)] = (bf16_t)f2bf(s); } }
    __syncthreads();
}

__device__ __forceinline__ void s2_compress(Frame& F, int l) {
    if (F.tid < 128) { const float* pp = (const float*)(F.ws + WS_PEBP + l * al1m(SZ_PEBP)); float s = 0.f;
#pragma unroll
        for (int p = 0; p < 16; ++p) s += pp[((F.tid >> 6) * 16 + p) * 64 + (F.tid & 63)];
        ((LAS float*)(F.lds + 131072))[F.tid] = s; }
    __syncthreads();
    for (int u = F.bid; u < 256; u += F.G) compress_unit<true>(F, l, u);
    for (int u = F.bid; u < 256; u += F.G) compress_prompt_piece(F, l, u);
}

#ifndef NSA_SGB
#define NSA_SGB 1
#endif
#define MFMA32(a, b, c) __builtin_amdgcn_mfma_f32_32x32x16_bf16((a), (b), (c), 0, 0, 0)
constexpr float NEG_BIG = -1e30f;
constexpr int AL_K = 0, AL_V = 8192, AL_SLOT = 16384  , AL_MASK = 4 * AL_SLOT  , AL_UNION = AL_MASK + 512,
              AL_TOT = 66560  , AL_IMP = AL_TOT  ;
__device__ __forceinline__ void dma16(const void* src, LAS unsigned char* dst) { __builtin_amdgcn_global_load_lds((const unsigned*)src, (LAS unsigned*)dst, 16, 0, 0); }
__device__ __forceinline__ void tile_dma(const bf16_t* kimg, const bf16_t* vimg, LAS unsigned char* slot, int w, int lane) {
    dma16(kimg + (unsigned)w * 512u + 8u * (unsigned)lane, slot + AL_K + w * 1024);
    dma16(vimg + (unsigned)w * 512u + 8u * (unsigned)lane, slot + AL_V + w * 1024);
}

template <int CTRL> __device__ __forceinline__ float quad_xor(float x) { return __int_as_float(__builtin_amdgcn_update_dpp(0, __float_as_int(x), CTRL, 0xF, 0xF, false)); }
struct FlashState { f32x16 o[2]; float m, l; };
__device__ __forceinline__ void flash_reset(FlashState& S) {
#pragma unroll
    for (int i = 0; i < 16; ++i) { S.o[0][i] = 0.f; S.o[1][i] = 0.f; }
    S.m = 0.f; S.l = 0.f;
}
__device__ __forceinline__ void flash_scores(const LAS unsigned char* kbuf, const bf16x8 (&qf)[4], int r, int h, float init, f32x16& s0, f32x16& s1) {
    bf16x8 kf[8];
#pragma unroll
    for (int ks = 0; ks < 4; ++ks) { kf[2 * ks] = *(const LAS bf16x8*)(kbuf + (2 * ks + h) * 1024 + r * 16); kf[2 * ks + 1] = *(const LAS bf16x8*)(kbuf + (2 * ks + h) * 1024 + (32 + r) * 16); }
    __builtin_amdgcn_sched_barrier(0);
#pragma unroll
    for (int i = 0; i < 16; ++i) { s0[i] = init; s1[i] = init; }
#pragma unroll
    for (int ks = 0; ks < 4; ++ks) { s0 = MFMA32(kf[2 * ks], qf[ks], s0); s1 = MFMA32(kf[2 * ks + 1], qf[ks], s1); }
}
__device__ __forceinline__ bf16x8 pack_p(const f32x16& p, int s) {
    u32x4 w; w.x = pk2(p[8 * s], p[8 * s + 1]); w.y = pk2(p[8 * s + 2], p[8 * s + 3]); w.z = pk2(p[8 * s + 4], p[8 * s + 5]); w.w = pk2(p[8 * s + 6], p[8 * s + 7]);
    return __builtin_bit_cast(bf16x8, w);
}
__device__ __forceinline__ void flash_vload(const LAS unsigned char* vbuf, int r, int h, bf16x8 (&vf)[8]) {
#pragma unroll
    for (int sub = 0; sub < 2; ++sub)
#pragma unroll
        for (int s = 0; s < 2; ++s)
#pragma unroll
            for (int dt = 0; dt < 2; ++dt) vf[(sub * 2 + s) * 2 + dt] = *(const LAS bf16x8*)(vbuf + (4 * sub + 2 * s + h) * 1024 + (32 * dt + r) * 16);
    __builtin_amdgcn_sched_barrier(0);
}
__device__ __forceinline__ void flash_pv(const bf16x8 (&vf)[8], const f32x16& p0, const f32x16& p1, f32x16 (&o)[2]) {
#pragma unroll
    for (int sub = 0; sub < 2; ++sub)
#pragma unroll
        for (int s = 0; s < 2; ++s) {
            const bf16x8 pb = pack_p(sub ? p1 : p0, s);
#pragma unroll
            for (int dt = 0; dt < 2; ++dt) o[dt] = MFMA32(vf[(sub * 2 + s) * 2 + dt], pb, o[dt]);
        }
}
__device__ __forceinline__ float xhalf_max(float x) {
    const auto r = __builtin_amdgcn_permlane32_swap(__float_as_uint(x), __float_as_uint(x), false, false);
    return fmaxf(__uint_as_float(r[0]), __uint_as_float(r[1]));
}
__device__ __forceinline__ void flash_mask(f32x16& s0, f32x16& s1, int lo, int hi, int h) {
#pragma unroll
    for (int i = 0; i < 16; ++i) { const int key = (i & 3) + 8 * (i >> 2) + 4 * h;
        s0[i] = (key >= lo && key <= hi) ? s0[i] : -INFINITY; s1[i] = (key + 32 >= lo && key + 32 <= hi) ? s1[i] : -INFINITY; }
}
__device__ __forceinline__ float flash_rowmax(const f32x16& s0, const f32x16& s1) {
    float mx = -INFINITY;
#pragma unroll
    for (int i = 0; i < 16; ++i) asm("v_max3_f32 %0, %1, %2, %3" : "=v"(mx) : "v"(mx), "v"(s0[i]), "v"(s1[i]));
    return xhalf_max(mx);
}
__device__ __forceinline__ void flash_first(FlashState& S, f32x16& s0, f32x16& s1, int lo, int hi, int h, bool masked) {
    if (masked) flash_mask(s0, s1, lo, hi, h);
    S.m = fmaxf(flash_rowmax(s0, s1), NEG_BIG);
    float ls = 0.f;
#pragma unroll
    for (int i = 0; i < 16; ++i) { s0[i] = __builtin_amdgcn_exp2f(s0[i] - S.m); s1[i] = __builtin_amdgcn_exp2f(s1[i] - S.m); ls += s0[i] + s1[i]; }
    S.l = ls;
}
__device__ __forceinline__ void flash_next(FlashState& S, f32x16& s0, f32x16& s1, float mused, int lo, int hi, int h, bool masked, bool first) {
    if (masked) flash_mask(s0, s1, lo, hi, h);
    const float corr = S.m - mused;
    if (__ballot(corr != 0.f) != 0ull) {
#pragma unroll
        for (int i = 0; i < 16; ++i) { s0[i] -= corr; s1[i] -= corr; } }
    const float mx = flash_rowmax(s0, s1);
    if (__ballot(mx > SM_THR || (first && mx < -SM_THR)) != 0ull) {
        const float d = (mx > NEG_BIG) ? (first ? mx : fmaxf(mx, 0.f)) : 0.f, alpha = __builtin_amdgcn_exp2f(-d);
        S.m += d; S.l *= alpha;
#pragma unroll
        for (int i = 0; i < 16; ++i) { S.o[0][i] *= alpha; S.o[1][i] *= alpha; s0[i] -= d; s1[i] -= d; }
    }
    float ls = 0.f;
#pragma unroll
    for (int i = 0; i < 16; ++i) { s0[i] = __builtin_amdgcn_exp2f(s0[i]); s1[i] = __builtin_amdgcn_exp2f(s1[i]); ls += s0[i] + s1[i]; }
    S.l += ls;
}

__device__ __forceinline__ void flash_kload(const LAS unsigned char* kbuf, int r, int h, bf16x8 (&kf)[8]) {
#pragma unroll
    for (int ks = 0; ks < 4; ++ks) { kf[2 * ks] = *(const LAS bf16x8*)(kbuf + (2 * ks + h) * 1024 + r * 16); kf[2 * ks + 1] = *(const LAS bf16x8*)(kbuf + (2 * ks + h) * 1024 + (32 + r) * 16); }
    __builtin_amdgcn_sched_barrier(0);
}
struct TileCtl { bool en, masked; int lo, hi; };
__device__ __forceinline__ void flash_pair(FlashState& S, const LAS unsigned char* ka, const LAS unsigned char* va, const LAS unsigned char* kb2, const LAS unsigned char* vb2,
                                           const bf16x8 (&qf)[4], const TileCtl& A, const TileCtl& B, bool first, int r, int h) {
    bf16x8 kf[8]; f32x16 a0, a1, b0, b1;
    flash_kload(ka, r, h, kf);
    { const float init = A.en ? -S.m : -INFINITY;
#pragma unroll
        for (int i = 0; i < 16; ++i) { a0[i] = init; a1[i] = init; }
#pragma unroll
        for (int ks = 0; ks < 4; ++ks) { a0 = MFMA32(kf[2 * ks], qf[ks], a0); a1 = MFMA32(kf[2 * ks + 1], qf[ks], a1); } }
    if (A.masked) flash_mask(a0, a1, A.lo, A.hi, h);
    { const float mx = flash_rowmax(a0, a1);
        if (__ballot(mx > SM_THR || (first && mx < -SM_THR)) != 0ull) { const float d = (mx > NEG_BIG) ? (first ? mx : fmaxf(mx, 0.f)) : 0.f, alpha = __builtin_amdgcn_exp2f(-d); S.m += d; S.l *= alpha;
#pragma unroll
            for (int i = 0; i < 16; ++i) { S.o[0][i] *= alpha; S.o[1][i] *= alpha; a0[i] -= d; a1[i] -= d; } } }
    flash_kload(kb2, r, h, kf);
    { const float init = B.en ? -S.m : -INFINITY;
#pragma unroll
        for (int i = 0; i < 16; ++i) { b0[i] = init; b1[i] = init; } }
    __builtin_amdgcn_sched_barrier(0);
#pragma unroll
    for (int k = 0; k < 8; ++k) {
        if (k & 1) b1 = MFMA32(kf[k], qf[k >> 1], b1); else b0 = MFMA32(kf[k], qf[k >> 1], b0);
#pragma unroll
        for (int e = 0; e < 4; ++e) { const int idx = 4 * k + e;
            if (idx < 16) { float t = __builtin_amdgcn_exp2f(a0[idx]); asm volatile("" : "+v"(t)); a0[idx] = t; }
            else { float t = __builtin_amdgcn_exp2f(a1[idx - 16]); asm volatile("" : "+v"(t)); a1[idx - 16] = t; } }
        __builtin_amdgcn_sched_barrier(0);
    }
    bf16x8 pa[4]; float ls = 0.f;
#pragma unroll
    for (int i = 0; i < 16; ++i) ls += a0[i] + a1[i];
    pa[0] = pack_p(a0, 0); pa[1] = pack_p(a0, 1); pa[2] = pack_p(a1, 0); pa[3] = pack_p(a1, 1);
    S.l += ls;
    __builtin_amdgcn_sched_barrier(0);
    if (B.masked) flash_mask(b0, b1, B.lo, B.hi, h);
    float alphaB = 1.f;
    { const float mx = flash_rowmax(b0, b1);
        if (__ballot(mx > SM_THR) != 0ull) { const float d = (mx > NEG_BIG) ? fmaxf(mx, 0.f) : 0.f; alphaB = __builtin_amdgcn_exp2f(-d); S.m += d; S.l *= alphaB;
#pragma unroll
            for (int i = 0; i < 16; ++i) { b0[i] -= d; b1[i] -= d; } } }
    { bf16x8 vf[8]; flash_vload(va, r, h, vf);
#pragma unroll
        for (int k = 0; k < 8; ++k) {
            S.o[k & 1] = MFMA32(vf[k], pa[k >> 1], S.o[k & 1]);
#pragma unroll
            for (int e = 0; e < 4; ++e) { const int idx = 4 * k + e;
                if (idx < 16) { float t = __builtin_amdgcn_exp2f(b0[idx]); asm volatile("" : "+v"(t)); b0[idx] = t; }
                else { float t = __builtin_amdgcn_exp2f(b1[idx - 16]); asm volatile("" : "+v"(t)); b1[idx - 16] = t; } }
            __builtin_amdgcn_sched_barrier(0);
        }
    }
    __builtin_amdgcn_sched_barrier(0);
    if (__ballot(alphaB != 1.f) != 0ull) {
#pragma unroll
        for (int i = 0; i < 16; ++i) { S.o[0][i] *= alphaB; S.o[1][i] *= alphaB; } }
    { bf16x8 vf[8]; flash_vload(vb2, r, h, vf);
        bf16x8 pb[4]; pb[0] = pack_p(b0, 0); pb[1] = pack_p(b0, 1); pb[2] = pack_p(b1, 0); pb[3] = pack_p(b1, 1);
        float l0 = 0.f, l1 = 0.f;
        __builtin_amdgcn_sched_barrier(0);
#pragma unroll
        for (int k = 0; k < 8; ++k) {
            S.o[k & 1] = MFMA32(vf[k], pb[k >> 1], S.o[k & 1]);
#pragma unroll
            for (int e = 0; e < 2; ++e) { const int idx = 2 * k + e; l0 += b0[idx]; l1 += b1[idx]; }
            asm volatile("" : "+v"(l0), "+v"(l1));
            __builtin_amdgcn_sched_barrier(0);
        }
        S.l += l0 + l1; }
}

__device__ __forceinline__ void nsa_prompt_unit(Frame& F, int l, int b, int kvh, int c) {
    int tid = threadIdx.x; asm volatile("" : "+v"(tid));
    const int lane = tid & 63, w = F.wave, r = lane & 31, h = lane >> 5, qi = r >> 2, g = r & 3, qloc = 8 * w + qi;
    const int tok = b * SEQ + 64 * c + qloc, head = kvh * 4 + g;
    const bf16_t* P = (const bf16_t*)(F.ws + WS_P);
    LAS unsigned char* kbuf = F.lds + AL_K; LAS unsigned char* vbuf = F.lds + AL_V;
    LAS float* imp = (LAS float*)(F.lds + AL_IMP); LAS unsigned* msk = (LAS unsigned*)(F.lds + AL_MASK); LAS unsigned* uni = (LAS unsigned*)(F.lds + AL_UNION);
    __syncthreads();
    tile_dma((const bf16_t*)(F.ws + WS_KCP) + (size_t)(b * 4 + kvh) * 4096, (const bf16_t*)(F.ws + WS_VCTP) + (size_t)(b * 4 + kvh) * 4096, F.lds, w, lane);
    bf16x8 qf[4];
#pragma unroll
    for (int ks = 0; ks < 4; ++ks) qf[ks] = *(const bf16x8*)(P + (size_t)tok * NPROJ + C_Q + head * 64 + 16 * ks + 8 * h);
    const float* gt = (const float*)(F.ws + WS_GATE) + (size_t)tok * 64 + head * 3;
    const float g_cmp = gt[0], g_sel = gt[1], g_win = gt[2];
    LAS f32x4* ltot = (LAS f32x4*)(F.lds + AL_TOT) + tid;
    FlashState S;
    {
        if (tid < 128) msk[tid] = 0u; if (tid < 2) uni[tid] = 0u;
        __syncthreads();
        flash_reset(S);
        f32x16 s0, s1; flash_scores(kbuf, qf, r, h, 0.f, s0, s1);
        const int nvalid = c + (qloc == 63 ? 1 : 0);
        bf16x8 vf[8]; flash_vload(vbuf, r, h, vf);
        flash_first(S, s0, s1, 0, nvalid - 1, h, true);
        const float lt = S.l + __shfl_xor(S.l, 32), inv = lt > 0.f ? 1.f / lt : 0.f;
#pragma unroll
        for (int i = 0; i < 16; ++i) { s0[i] *= inv; s1[i] *= inv; }
#pragma unroll
        for (int i = 0; i < 16; ++i) { float a = s0[i]; a += quad_xor<0xB1>(a); a += quad_xor<0x4E>(a); float bq = s1[i]; bq += quad_xor<0xB1>(bq); bq += quad_xor<0x4E>(bq);
            if (g == 0) { const int key = (i & 3) + 8 * (i >> 2) + 4 * h; imp[qloc * 65 + key] = a; imp[qloc * 65 + key + 32] = bq; } }
        flash_pv(vf, s0, s1, S.o);
    }
    __syncthreads();
    {
        const int n = lane; const bool cand = (n >= 1) && (n <= c - 2);
        const unsigned long long forced = 1ull | (1ull << c) | (c >= 1 ? (1ull << (c - 1)) : 0ull);
        unsigned long long um = 0ull;
#pragma unroll 1
        for (int qq = 0; qq < 8; ++qq) { const int q = w * 8 + qq;
            const unsigned kb_ = cand ? ((__float_as_uint(imp[q * 65 + n]) & ~63u) | (unsigned)(63 - n)) : 0u;
            int rank = 0;
            for (int j = 1; j <= c - 2; ++j) { const unsigned sj = __builtin_amdgcn_readlane(kb_, j); rank += (sj > kb_) ? 1 : 0; }
            const unsigned long long m = __ballot(cand && rank < 13) | forced;
            if (lane == 0) { msk[q * 2] = (unsigned)m; msk[q * 2 + 1] = (unsigned)(m >> 32); }
            um |= m; }
        if (lane == 0) { atomicOr((unsigned*)uni, (unsigned)um); atomicOr((unsigned*)(uni + 1), (unsigned)(um >> 32)); }
    }
    __syncthreads();
    const unsigned mlo = msk[qloc * 2], mhi = msk[qloc * 2 + 1], ulo = uni[0], uhi = uni[1];
#pragma unroll
    for (int i4 = 0; i4 < 8; ++i4) { const f32x16& o = S.o[i4 >> 2]; const int i = 4 * (i4 & 3); ltot[i4 * 512] = (f32x4){g_cmp * o[i], g_cmp * o[i + 1], g_cmp * o[i + 2], g_cmp * o[i + 3]}; }
#define NSA_POP(REM_) ((REM_) ? (t_ = sel ? __builtin_ctzll(REM_) : 63 - __builtin_clzll(REM_), (REM_) &= ~(1ull << t_), t_) : -1)
#define NSA_EN(N_) (sel ? ((((N_) < 32 ? mlo >> (N_) : mhi >> ((N_) - 32)) & 1u) != 0u) : true)
#define NSA_LOHI(N_) const int n_ = (N_), lo_ = (!sel && n_ == c - 8) ? qloc + 1 : 0, hi_ = (n_ == c) ? qloc : 63; const bool mk_ = (n_ == c) || (!sel && n_ == c - 8)
#define NSA_PV(SLOT_, S0_, S1_) do { bf16x8 vf[8]; flash_vload(vbuf + (SLOT_), r, h, vf); flash_pv(vf, S0_, S1_, S.o); } while (0)
#pragma unroll 1
    for (int pass = 0; pass < 2; ++pass) {
        const bool sel = pass == 0;
        flash_reset(S);
        const bf16_t* kb = (const bf16_t*)(F.ws + (sel ? WS_KTSEL : WS_KTWIN)) + (size_t)(b * 4 + kvh) * 64 * 4096;
        const bf16_t* vt = (const bf16_t*)(F.ws + (sel ? WS_VTSEL : WS_VTWIN)) + (size_t)(b * 4 + kvh) * 64 * 4096;
        unsigned long long rem;
        if (sel) rem = ((unsigned long long)uhi << 32) | ulo;
        else { const int lo = c >= 8 ? c - 8 : 0; rem = (c == 63 ? ~0ull : ((1ull << (c + 1)) - 1ull)) & ~((1ull << lo) - 1ull); }
        int t_;
        int tA = NSA_POP(rem), tB = NSA_POP(rem);
        int pr = 0; bool first = true;
        __syncthreads();
        tile_dma(kb + (size_t)tA * 4096, vt + (size_t)tA * 4096, F.lds, w, lane);
        if (tB >= 0) tile_dma(kb + (size_t)tB * 4096, vt + (size_t)tB * 4096, F.lds + AL_SLOT, w, lane);
        for (;;) {
            const int sa = pr, sb = pr + AL_SLOT;
            __syncthreads();
            const int nA = NSA_POP(rem), nB = NSA_POP(rem);
            if (nA >= 0) tile_dma(kb + (size_t)nA * 4096, vt + (size_t)nA * 4096, F.lds + (pr ^ (2 * AL_SLOT)), w, lane);
            if (nB >= 0) tile_dma(kb + (size_t)nB * 4096, vt + (size_t)nB * 4096, F.lds + (pr ^ (2 * AL_SLOT)) + AL_SLOT, w, lane);
            const bool enA = first || NSA_EN(tA), enB = tB >= 0 ? NSA_EN(tB) : false;
            if (__ballot(enA || enB) != 0ull) {
                TileCtl A, B;
                A.en = enA; A.masked = (tA == c) || (!sel && tA == c - 8); A.lo = (!sel && tA == c - 8) ? qloc + 1 : 0; A.hi = (tA == c) ? qloc : 63;
                B.en = enB; B.masked = (tB == c) || (!sel && tB == c - 8); B.lo = (!sel && tB == c - 8) ? qloc + 1 : 0; B.hi = (tB == c) ? qloc : 63;
                const int sbb = tB >= 0 ? sb : sa;
                flash_pair(S, kbuf + sa, vbuf + sa, kbuf + sbb, vbuf + sbb, qf, A, B, first, r, h);
            }
            first = false;
            if (nA < 0) break;
            tA = nA; tB = nB; pr ^= 2 * AL_SLOT;
        }
        const float lt = S.l + __shfl_xor(S.l, 32), sc = (sel ? g_sel : g_win) / lt;
#pragma unroll
        for (int i4 = 0; i4 < 8; ++i4) { const f32x16& o = S.o[i4 >> 2]; const int i = 4 * (i4 & 3); ltot[i4 * 512] += (f32x4){sc * o[i], sc * o[i + 1], sc * o[i + 2], sc * o[i + 3]}; }
    }
#undef NSA_PV
#undef NSA_LOHI
#undef NSA_EN
#undef NSA_POP
    bf16_t* ao = (bf16_t*)(F.ws + WS_ABR + SZ_ABR1) + (size_t)tok * 1024 + head * 64;
    const bf16_t* az = P + (size_t)tok * NPROJ + C_AZ + head * 64;
#pragma unroll
    for (int i4 = 0; i4 < 8; ++i4) { const int d = 32 * (i4 >> 2) + 8 * (i4 & 3) + 4 * h;
        const f32x4 t = ltot[i4 * 512]; const f32x4 zz = unpack4(*(const u32x2*)(az + d));
        *(u32x2*)(ao + d) = pack4(t * zz); }
}

constexpr int SL_Q = 0  , SL_SC = 1024  , SL_IMP = SL_SC + 4 * 1040 * 4  , SL_RED = SL_IMP + 264 * 4  ,
              SL_LIST = SL_RED + 128  , SL_KOFF = SL_LIST + 64  , SL_PART = SL_KOFF + 1040 * 4  , SL_OACC = SL_PART + 32768  , SL_PT = SL_OACC + 3072  ;
constexpr int KOFF_INVALID = -2147483647;

__device__ __forceinline__ void block_softmax4(LAS float* sc, int count, LAS float* red, int tid) {
    const int gh = tid >> 7, t = tid & 127, wv = tid >> 6;
    LAS float* row = sc + gh * 1040;
    float mx = -INFINITY;
    for (int i = t; i < count; i += 128) mx = fmaxf(mx, row[i]);
    mx = wave_max(mx);
    if ((tid & 63) == 0) red[wv] = mx;
    __syncthreads();
    mx = fmaxf(red[2 * gh], red[2 * gh + 1]);
    float sm = 0.f;
    for (int i = t; i < count; i += 128) { const float p = __expf(row[i] - mx); row[i] = p; sm += p; }
    sm = wave_sum(sm);
    if ((tid & 63) == 0) red[8 + wv] = sm;
    __syncthreads();
    const float inv = 1.f / (red[8 + 2 * gh] + red[8 + 2 * gh + 1]);
    for (int i = t; i < count; i += 128) row[i] *= inv;
    __syncthreads();
}
__device__ __forceinline__ void sample_scores(const float* base, const bf16_t* Pnew, int pcol, int count, const LAS int* koff, const LAS float* qv, LAS float* sc, int tid) {
#pragma unroll 1
    for (int idx = tid; idx < count; idx += NT) {
        const int ko = koff[idx];
        float d0 = -INFINITY, d1 = -INFINITY, d2 = -INFINITY, d3 = -INFINITY;
        if (ko != KOFF_INVALID) {
            f32x4 kx[16];
            if (ko >= 0) {
#pragma unroll
                for (int j = 0; j < 16; ++j) kx[j] = *(const f32x4*)(base + (size_t)ko + 4 * j); }
            else {
#pragma unroll
                for (int j = 0; j < 16; ++j) kx[j] = unpack4(*(const u32x2*)(Pnew + (size_t)(-1 - ko) * NPROJ + pcol + 4 * j)); }
            d0 = d1 = d2 = d3 = 0.f;
#pragma unroll
            for (int j4 = 0; j4 < 4; ++j4) {
#pragma unroll
                for (int jj = 0; jj < 4; ++jj) { const int j = 4 * j4 + jj; const f32x4 kq = kx[j];
                    const f32x4 q0 = *(const LAS f32x4*)(qv + 4 * j), q1 = *(const LAS f32x4*)(qv + 64 + 4 * j), q2 = *(const LAS f32x4*)(qv + 128 + 4 * j), q3 = *(const LAS f32x4*)(qv + 192 + 4 * j);
                    d0 += kq.x * q0.x + kq.y * q0.y + kq.z * q0.z + kq.w * q0.w; d1 += kq.x * q1.x + kq.y * q1.y + kq.z * q1.z + kq.w * q1.w;
                    d2 += kq.x * q2.x + kq.y * q2.y + kq.z * q2.z + kq.w * q2.w; d3 += kq.x * q3.x + kq.y * q3.y + kq.z * q3.z + kq.w * q3.w; }
                __builtin_amdgcn_sched_barrier(0);
            }
            d0 *= 0.125f; d1 *= 0.125f; d2 *= 0.125f; d3 *= 0.125f;
        }
        sc[idx] = d0; sc[1040 + idx] = d1; sc[2080 + idx] = d2; sc[3120 + idx] = d3;
    }
}
__device__ __forceinline__ void sample_pv(const float* base, const bf16_t* Pnew, int pcol, int count, const LAS int* koff, const LAS float* sc, LAS float* part, LAS float* oacc, int tid) {
    const int dq = tid & 15, ks = tid >> 4, per = (count + 31) >> 5, i0 = ks * per, i1 = (i0 + per < count) ? i0 + per : count;
    f32x4 a0 = {0.f, 0.f, 0.f, 0.f}, a1 = a0, a2 = a0, a3 = a0;
#pragma unroll 8
    for (int idx = i0; idx < i1; ++idx) { const int ko = koff[idx];
        f32x4 v = {0.f, 0.f, 0.f, 0.f};
        if (ko >= 0) v = *(const f32x4*)(base + (size_t)ko + 256 + 4 * dq);
        else if (ko != KOFF_INVALID) { const u32x2 x = *(const u32x2*)(Pnew + (size_t)(-1 - ko) * NPROJ + pcol + 256 + 4 * dq); v = (f32x4){bf2f(x.x & 0xffffu), __uint_as_float(x.x & 0xffff0000u), bf2f(x.y & 0xffffu), __uint_as_float(x.y & 0xffff0000u)}; }
        a0 += sc[idx] * v; a1 += sc[1040 + idx] * v; a2 += sc[2080 + idx] * v; a3 += sc[3120 + idx] * v; }
    *(LAS f32x4*)(part + ks * 256 + 4 * dq) = a0; *(LAS f32x4*)(part + ks * 256 + 64 + 4 * dq) = a1; *(LAS f32x4*)(part + ks * 256 + 128 + 4 * dq) = a2; *(LAS f32x4*)(part + ks * 256 + 192 + 4 * dq) = a3;
    __syncthreads();
    if (tid < 256) { float t = 0.f;
#pragma unroll 8
        for (int k = 0; k < 32; ++k) t += part[k * 256 + tid];
        oacc[tid] = t; }
    __syncthreads();
}

__device__ __forceinline__ void nsa_sample_unit(Frame& F, int l, int unit, int part_id) {
    const int tid = F.tid, qi = unit & 3, kvh = (unit >> 2) & 3, b = unit >> 4, row = MPT + b * 4 + qi;
    const bf16_t* P = (const bf16_t*)(F.ws + WS_P); const int* pt = (const int*)FIN(IN_PT);
    LAS float* qv = (LAS float*)(F.lds + SL_Q); LAS float* sc = (LAS float*)(F.lds + SL_SC); LAS float* imp = (LAS float*)(F.lds + SL_IMP); LAS float* red = (LAS float*)(F.lds + SL_RED);
    LAS int* list = (LAS int*)(F.lds + SL_LIST); LAS int* koff = (LAS int*)(F.lds + SL_KOFF); LAS float* part = (LAS float*)(F.lds + SL_PART); LAS float* oacc = (LAS float*)(F.lds + SL_OACC);
    LAS int* ptl = (LAS int*)(F.lds + SL_PT);
    __syncthreads();
    if (part_id == 0 && tid >= 256 && tid < 384) ptl[tid - 256] = pt[b * 128 + tid - 256];
    if (tid < 256) qv[tid] = bf2f(P[(size_t)row * NPROJ + C_Q + kvh * 256 + tid]) * (1.f / SM_SCALE_L2E);
    __syncthreads();
    float* soacc = (float*)(F.ws + WS_SOACC) + (size_t)unit * 768;
    if (part_id == 0) {
    {
        const int n = tid & 255, gp = tid >> 8;
        const bf16_t* kr = (const bf16_t*)(F.ws + WS_KCS) + ((size_t)(b * 4 + kvh) * 256 + n) * 64;
        float d0 = 0.f, d1 = 0.f;
#pragma unroll
        for (int j = 0; j < 8; ++j) { const u32x4 x = *(const u32x4*)(kr + 8 * j); float kf[8]; unpack8(x, kf);
#pragma unroll
            for (int e = 0; e < 8; ++e) { d0 += kf[e] * qv[(2 * gp) * 64 + 8 * j + e]; d1 += kf[e] * qv[(2 * gp + 1) * 64 + 8 * j + e]; } }
        sc[(2 * gp) * 1040 + n] = d0 * 0.125f; sc[(2 * gp + 1) * 1040 + n] = d1 * 0.125f;
    }
    __syncthreads();
    block_softmax4(sc, 256, red, tid);
    if (tid < 257) { float v; if (tid == 0 || tid >= 255) v = 1e4f; else v = sc[tid] + sc[1040 + tid] + sc[2080 + tid] + sc[3120 + tid]; imp[tid] = v; }
    {
        const int half = tid >> 8, gd = tid & 255, gh = gd >> 6, d = gd & 63;
        const bf16_t* vt = (const bf16_t*)(F.ws + WS_VCTS) + (size_t)(b * 4 + kvh) * 4 * 4096;
        float a = 0.f;
        for (int tl = 2 * half; tl < 2 * half + 2; ++tl) {
            const bf16_t* vr = vt + (size_t)tl * 4096 + d * 64;
#pragma unroll
            for (int j = 0; j < 8; ++j) { const u32x4 x = *(const u32x4*)(vr + 8 * j); float vf[8]; unpack8(x, vf);
#pragma unroll
                for (int e = 0; e < 8; ++e) a += sc[gh * 1040 + tl * 64 + keypos(8 * j + e)] * vf[e]; } }
        part[half * 256 + gd] = a;
    }
    __syncthreads();
    if (tid < 256) oacc[tid] = part[tid] + part[256 + tid];
    if (tid < 257) { const float si = imp[tid]; int rk = 0;
        for (int j = 0; j < 257; ++j) { const float sj = imp[j]; rk += (sj > si || (sj == si && j < tid)) ? 1 : 0; }
        if (rk < 16) list[rk] = tid; }
    __syncthreads();
    for (int idx = tid; idx < 1024; idx += NT) { const int blk = list[idx >> 6], kk = idx & 63; int ko;
        if (blk < 256) { const int page = ptl[blk >> 1]; ko = (int)(((((size_t)l * NPOOL + page) * 128 + (blk & 1) * 64 + kk) * 4 + 2) * 256 + kvh * 64); }
        else ko = (kk <= qi) ? -1 - (MPT + b * 4 + kk) : KOFF_INVALID;
        koff[idx] = ko; }
    __syncthreads();
    sample_scores(FIN(IN_CACHE), P, C_SK + kvh * 64, 1024, koff, qv, sc, tid);
    __syncthreads();
    block_softmax4(sc, 1024, red, tid);
    sample_pv(FIN(IN_CACHE), P, C_SK + kvh * 64, 1024, koff, sc, part, oacc + 256, tid);
    soacc[tid] = oacc[tid];
    } else {
    for (int idx = tid; idx < 516; idx += NT) { int ko;
        if (idx < 512) ko = (idx > qi) ? (int)((((size_t)(l * SB + b) * 512 + idx) * 2) * 256 + kvh * 64) : KOFF_INVALID;
        else ko = (idx - 512 <= qi) ? -1 - (MPT + b * 4 + idx - 512) : KOFF_INVALID;
        koff[idx] = ko; }
    __syncthreads();
    sample_scores(FIN(IN_SWIN), P, C_WK + kvh * 64, 516, koff, qv, sc, tid);
    __syncthreads();
    block_softmax4(sc, 516, red, tid);
    sample_pv(FIN(IN_SWIN), P, C_WK + kvh * 64, 516, koff, sc, part, oacc + 512, tid);
    if (tid < 256) soacc[512 + tid] = oacc[512 + tid];
    }
    __syncthreads();
}

struct SsmPow { float r[4], i[4]; };
__device__ __forceinline__ void ssm_pows(float ar, float ai, SsmPow& p) {
    p.r[0] = ar; p.i[0] = ai;
    p.r[1] = ar * ar - ai * ai; p.i[1] = 2.f * ar * ai;
    p.r[2] = p.r[1] * ar - p.i[1] * ai; p.i[2] = p.r[1] * ai + p.i[1] * ar;
    p.r[3] = p.r[1] * p.r[1] - p.i[1] * p.i[1]; p.i[3] = 2.f * p.r[1] * p.i[1];
}
struct SsmUnit { SsmPow pw[2]; bf16x8 bfr[4]; float alr[2], ali[2]; };
__device__ __forceinline__ void ssm_unit_load(const Frame& F, int l, int g, int lane, SsmUnit& U) {
    const int n32 = lane & 31, h = lane >> 5;
    const float* sab = (const float*)(F.ws + WS_SAB + l * al1m(SZ_SAB)) + (size_t)g * 64 * 4;
    const bf16_t* bb16 = (const bf16_t*)(F.ws + WS_SBB16 + l * al1m(SZ_SBB16)) + (size_t)g * 2 * 64 * 16;
#pragma unroll
    for (int s = 0; s < 2; ++s) { const f32x4 ab = *(const f32x4*)(sab + (n32 + 32 * s) * 4); ssm_pows(ab.x, ab.y, U.pw[s]); U.alr[s] = ab.z; U.ali[s] = ab.w;
        U.bfr[2 * s] = *(const bf16x8*)(bb16 + (size_t)(n32 + 32 * s) * 16 + 8 * h); U.bfr[2 * s + 1] = *(const bf16x8*)(bb16 + (size_t)(64 + n32 + 32 * s) * 16 + 8 * h); }
}
template <bool FIX>
__device__ __forceinline__ void ssm_block32(const bf16x8& au, const SsmUnit& U, float (&Hr)[2], float (&Hi)[2], float (&H1r)[2], float (&H1i)[2], f32x16 (&Dr)[2], f32x16 (&Di)[2], int h) {
    f32x16 z;
#pragma unroll
    for (int i = 0; i < 16; ++i) z[i] = 0.f;
#pragma unroll
    for (int s = 0; s < 2; ++s) { Dr[s] = MFMA32(au, U.bfr[2 * s], z); Di[s] = MFMA32(au, U.bfr[2 * s + 1], z); }
#pragma unroll
    for (int s = 0; s < 2; ++s) {
        const float ar = U.pw[s].r[0], ai = U.pw[s].i[0], a4r = U.pw[s].r[3], a4i = U.pw[s].i[3];
#pragma unroll
        for (int j = 0; j < 4; ++j)
#pragma unroll
            for (int e = 1; e < 4; ++e) { const int i = 4 * j + e;
                const float nr = ar * Dr[s][i - 1] - ai * Di[s][i - 1] + Dr[s][i], ni = ar * Di[s][i - 1] + ai * Dr[s][i - 1] + Di[s][i]; Dr[s][i] = nr; Di[s][i] = ni; }
        float hr = Hr[s], hi = Hi[s];
#pragma unroll
        for (int j = 0; j < 4; ++j) {
            const float ownr = Dr[s][4 * j + 3], owni = Di[s][4 * j + 3], othr = __shfl_xor(ownr, 32), othi = __shfl_xor(owni, 32);
            const float evr = h ? othr : ownr, evi = h ? othi : owni, odr = h ? ownr : othr, odi = h ? owni : othi;
            const float inr0 = hr, ini0 = hi;
            float t = a4r * hr - a4i * hi + evr; hi = a4r * hi + a4i * hr + evi; hr = t;
            if (j == 0) { H1r[s] = hr; H1i[s] = hi; }
            const float inr1 = hr, ini1 = hi;
            t = a4r * hr - a4i * hi + odr; hi = a4r * hi + a4i * hr + odi; hr = t;
            if (FIX) { const float inr = h ? inr1 : inr0, ini = h ? ini1 : ini0;
#pragma unroll
                for (int e = 0; e < 4; ++e) { const int i = 4 * j + e; Dr[s][i] += U.pw[s].r[e] * inr - U.pw[s].i[e] * ini; Di[s][i] += U.pw[s].r[e] * ini + U.pw[s].i[e] * inr; } }
        }
        Hr[s] = hr; Hi[s] = hi;
    }
}
__device__ __forceinline__ bf16x8 ssm_load_au(const bf16_t* P, int m0, int ntok, int g, int lane) {
    const int t = lane & 31, h = lane >> 5;
    if (t < ntok) return *(const bf16x8*)(P + (size_t)(m0 + t) * NPROJ + C_SU + g * 16 + 8 * h);
    return (bf16x8){0, 0, 0, 0, 0, 0, 0, 0};
}
__device__ __forceinline__ void s2_ssm_pass1(Frame& F, int l) {
    const bf16_t* P = (const bf16_t*)(F.ws + WS_P); f32x2* E = (f32x2*)(F.ws + WS_SSME);
    const int lane = F.lane, n32 = lane & 31, h = lane >> 5;
    for (int u = F.gw; u < PB * 64 * SSM_NCH; u += F.ngw) {
        const int b = u >> 11, g = (u >> 5) & 63, ch = u & 31, m0 = b * SEQ + ch * SSM_L;
        SsmUnit U; ssm_unit_load(F, l, g, lane, U);
        float Hr[2] = {0.f, 0.f}, Hi[2] = {0.f, 0.f}, H1r[2], H1i[2];
        bf16x8 au = ssm_load_au(P, m0, 32, g, lane);
#pragma unroll 1
        for (int blk = 0; blk < SSM_L / 32; ++blk) {
            const bf16x8 an = ssm_load_au(P, m0 + 32 * ((blk + 1) & 3), 32, g, lane);
            f32x16 Dr[2], Di[2];
            ssm_block32<false>(au, U, Hr, Hi, H1r, H1i, Dr, Di, h);
            au = an;
        }
        if (h == 0) { f32x2* e = E + ((size_t)(b * 64 + g) * SSM_NCH + ch) * 64; e[n32] = (f32x2){Hr[0], Hi[0]}; e[32 + n32] = (f32x2){Hr[1], Hi[1]}; }
    }
}
__device__ __forceinline__ void s3_ssm_pass2(Frame& F, int l) {
    const bf16_t* P = (const bf16_t*)(F.ws + WS_P); const f32x2* E = (const f32x2*)(F.ws + WS_SSME); bf16_t* Z = (bf16_t*)(F.ws + WS_Z);
    LAS unsigned char* himg = F.lds + 65536 + F.wave * 8960;
    const int lane = F.lane, n32 = lane & 31, h = lane >> 5, tk = lane & 15, cq = lane >> 4;
    for (int u = F.gw; u < PB * 64 * SSM_NCH + SB * 64; u += F.ngw) {
        const bool smp = u >= PB * 64 * SSM_NCH;
        int b, g, ch, m0, nblk, ntok;
        if (!smp) { b = u >> 11; g = (u >> 5) & 63; ch = (u & 31) ^ (b & 1 ? 31 : 0); m0 = b * SEQ + ch * SSM_L; nblk = SSM_L / 32; ntok = 32; }
        else { const int su = u - PB * 64 * SSM_NCH; b = su >> 6; g = su & 63; ch = 0; m0 = MPT + b * 4; nblk = 1; ntok = 4; }
        SsmUnit U; ssm_unit_load(F, l, g, lane, U);
        bf16x8 cmf[4];
        { const bf16_t* cm = (const bf16_t*)(F.ws + WS_SCM + l * al1m(SZ_SCM)) + (size_t)(g * 16 + tk) * 128 + 8 * cq;
#pragma unroll
            for (int ks = 0; ks < 4; ++ks) cmf[ks] = *(const bf16x8*)(cm + 32 * ks); }
        const f32x4 ds = *(const f32x4*)(FIN(IN_DSKIP) + l * 1024 + g * 16 + 4 * cq);
        float Hr[2] = {0.f, 0.f}, Hi[2] = {0.f, 0.f}, H1r[2] = {0.f, 0.f}, H1i[2] = {0.f, 0.f};
        if (!smp) { const f32x2* e = E + (size_t)(b * 64 + g) * SSM_NCH * 64;
            for (int j0 = 0; j0 < ch; j0 += 8) {
                f32x2 ev[8][2];
#pragma unroll
                for (int jj = 0; jj < 8; ++jj)
#pragma unroll
                    for (int s = 0; s < 2; ++s) ev[jj][s] = (j0 + jj < ch) ? e[(size_t)(j0 + jj) * 64 + n32 + 32 * s] : (f32x2){0.f, 0.f};
#pragma unroll
                for (int jj = 0; jj < 8; ++jj) if (j0 + jj < ch) {
#pragma unroll
                    for (int s = 0; s < 2; ++s) { const float nr = U.alr[s] * Hr[s] - U.ali[s] * Hi[s] + ev[jj][s].x, ni = U.alr[s] * Hi[s] + U.ali[s] * Hr[s] + ev[jj][s].y; Hr[s] = nr; Hi[s] = ni; } } } }
        else { const float* h0 = FIN(IN_SSSM) + ((size_t)(l * SB + b) * 2 * 64 + g) * 64 + n32;
#pragma unroll
            for (int s = 0; s < 2; ++s) { Hr[s] = h0[32 * s]; Hi[s] = h0[64 * 64 + 32 * s]; } }
        bf16x8 au = ssm_load_au(P, m0, ntok, g, lane);
#pragma unroll 1
        for (int blk = 0; blk < nblk; ++blk) {
            const bf16x8 an = ssm_load_au(P, m0 + 32 * ((blk + 1) & 3), ntok, g, lane);
            u32x2 uw[2];
#pragma unroll
            for (int tt = 0; tt < 2; ++tt) uw[tt] = (16 * tt + tk < ntok) ? *(const u32x2*)(P + (size_t)(m0 + 32 * blk + 16 * tt + tk) * NPROJ + C_SU + g * 16 + 4 * cq) : (u32x2){0u, 0u};
            f32x16 Dr[2], Di[2];
            ssm_block32<true>(au, U, Hr, Hi, H1r, H1i, Dr, Di, h);
            au = an;
#pragma unroll
            for (int i = 0; i < 16; ++i) { const int tl = (i & 3) + 8 * (i >> 2) + 4 * h;
                *(LAS unsigned*)(himg + tl * 272 + 4 * n32) = pk2(Dr[0][i], Di[0][i]); *(LAS unsigned*)(himg + tl * 272 + 4 * (32 + n32)) = pk2(Dr[1][i], Di[1][i]); }
            LDS_WAIT(); asm volatile("" ::: "memory");
#pragma unroll
            for (int tt = 0; tt < 2; ++tt) {
                f32x4 y = {0.f, 0.f, 0.f, 0.f};
#pragma unroll
                for (int ks = 0; ks < 4; ++ks) { const bf16x8 hf = *(const LAS bf16x8*)(himg + (16 * tt + tk) * 272 + (32 * ks + 8 * cq) * 2); y = __builtin_amdgcn_mfma_f32_16x16x32_bf16(cmf[ks], hf, y, 0, 0, 0); }
                const int t = 32 * blk + 16 * tt + tk;
                if (16 * tt + tk < ntok) { const f32x4 uu = unpack4(uw[tt]);
                    u32x2 o; o.x = pk2(gelu_tanh(y.x + ds.x * uu.x), gelu_tanh(y.y + ds.y * uu.y)); o.y = pk2(gelu_tanh(y.z + ds.z * uu.z), gelu_tanh(y.w + ds.w * uu.w));
                    *(u32x2*)(Z + (size_t)(m0 + t) * 1024 + g * 16 + 4 * cq) = o; }
            }
            LDS_WAIT(); asm volatile("" ::: "memory");
        }
        if (h == 0) {
            if (smp) { float* o = F.out + O_SSMS + ((size_t)(l * SB + b) * 2 * 64 + g) * 64 + n32;
#pragma unroll
                for (int s = 0; s < 2; ++s) { o[32 * s] = H1r[s]; o[64 * 64 + 32 * s] = H1i[s]; } }
            else if (ch == SSM_NCH - 1) { float* o = F.out + O_SSMP + ((size_t)(l * PB + b) * 2 * 64 + g) * 64 + n32;
#pragma unroll
                for (int s = 0; s < 2; ++s) { o[32 * s] = Hr[s]; o[64 * 64 + 32 * s] = Hi[s]; } }
        }
    }
}
struct Args { const float* in[27]; float* out; unsigned char* ws; int ph_lo, ph_hi; };
constexpr int N_PHASES = 15;

__global__ void __launch_bounds__(NT, 2) fwd_kernel(Args args) {
    extern __shared__ __attribute__((aligned(16))) unsigned char lds_raw[];
    Frame F;
    F.lds = (LAS unsigned char*)lds_raw;
    F.tid = threadIdx.x; F.lane = F.tid & 63; F.wave = __builtin_amdgcn_readfirstlane(F.tid >> 6);
    F.G = gridDim.x; F.bid = blockIdx.x; F.gw = F.bid * NWAVES + F.wave; F.ngw = F.G * NWAVES;
    F.out = args.out; F.ws = args.ws;
    volatile LAS unsigned* misc = (volatile LAS unsigned*)(F.lds + LDS_MISC);
    if (F.tid < 64) misc[F.tid] = 0u;
    __syncthreads();
    const int lo = args.ph_lo, hi = args.ph_hi;
#if MK_PER_PHASE
#define GRID_BAR() do { } while (0)
#else
    XcdBarrier bar = xcd_barrier_post((unsigned*)(F.ws + WS_CTL) + CW_BAR, misc + 8);
#define GRID_BAR() xcd_barrier(bar)
#endif
#ifdef ONLYPH
#define IN(k) ((((k)==0?0:(((k)-1)%7)+1))==ONLYPH && lo <= (k) && (k) < hi)
#else
#define IN(k) (lo <= (k) && (k) < hi)
#endif
#define BOTH(k) (IN(k) && IN((k) + 1))
#ifndef PROBE_PH
#define PROBE_PH -1
#endif
#define REPS(k) _Pragma("unroll 1") for (int rep_ = 0; rep_ < ((PROBE_PH) == (k) ? 2 : 1); ++rep_)
#define PHASE_BEGIN() do { int t_ = threadIdx.x; asm volatile("" : "+v"(t_)); F.tid = t_; F.lane = t_ & 63; F.wave = __builtin_amdgcn_readfirstlane(t_ >> 6); \
    F.gw = F.bid * NWAVES + F.wave; GAS unsigned char* w_ = (GAS unsigned char*)args.ws; asm volatile("" : "+s"(w_)); F.ws = (unsigned char*)w_; \
    GAS float* o_ = (GAS float*)args.out; asm volatile("" : "+s"(o_)); F.out = (float*)o_; } while (0)
    if (IN(0)) { PHASE_BEGIN(); REPS(0) phase_prologue(F); if (BOTH(0)) GRID_BAR(); }
    for (int l = 0; l < 2; ++l) {
        const int p0 = 1 + 7 * l;
        if (IN(p0)) {
            PHASE_BEGIN();
            pg8::Gemm g{(const bf16_t*)(F.ws + WS_H), (const bf16_t*)(F.ws + WS_WIN + l * al1m(SZ_WIN)), DM, DM, DM, 0, 0};
            pg8::TileOrder S; S.init(MPT / 256, NPROJ / 256, 1, 0, F.G, F.bid);
            EpiProj E{(bf16_t*)(F.ws + WS_P), (float*)(F.ws + WS_GATE), F.out, l};
            REPS(1) pg8::gemm_phase(F.lds, g, S, E);
            skinny_proj(F, l);
            if (BOTH(p0)) GRID_BAR();
        }
        if (IN(p0 + 1)) {
            PHASE_BEGIN();
            REPS(2) {
#ifndef SK_A
            REPS(21) s2_compress(F, l);
#endif
            __syncthreads();
#ifndef SK_B
            PHASE_BEGIN();
            REPS(22) s2_ssm_pass1(F, l);
#endif
#ifndef SK_C
            PHASE_BEGIN();
            REPS(23) s2_pool_diff(F, l);
#endif
#ifndef SK_D
            PHASE_BEGIN();
            REPS(24) s2_state_outputs(F, l);
#endif
#ifndef SK_E
            PHASE_BEGIN();
            REPS(25) s2_vt_images(F);
#endif
            }
            if (BOTH(p0 + 1)) GRID_BAR();
        }
        if (IN(p0 + 2)) {
            PHASE_BEGIN();
            REPS(33) s3_ssm_pass2(F, l);
            __syncthreads();
            if (BOTH(p0 + 2)) GRID_BAR();
        }
        if (IN(p0 + 3)) {
            PHASE_BEGIN();
            REPS(3) {
#ifndef SK_F
            REPS(31) for (int p = F.bid; p < 256; p += F.G) { const int bk = p >> 5, j = p & 31;
#pragma unroll 1
                for (int k2 = 0; k2 < 2; ++k2) nsa_prompt_unit(F, l, bk >> 2, bk & 3, k2 ? j : 63 - j); }
#endif
#ifndef SK_G
            PHASE_BEGIN();
            for (int uu = F.bid; uu < (((PROBE_PH) == 35 || (PROBE_PH) == 36) ? 2048 : (PROBE_PH) == 32 ? 512 : 256); uu += F.G) { const int u = uu & 255, part = (u >> 3) & 1;
                if (uu >= 256 && (PROBE_PH) != 32 && (PROBE_PH) != 35 + part) continue;
                nsa_sample_unit(F, l, (u & 7) | ((u >> 4) << 3), part); }
#endif
            __syncthreads();
            PHASE_BEGIN();
            REPS(4) {
            const int hi = (F.bid >> 3) & 1, idx = (F.bid >> 4) * 8 + (F.bid & 7);
            const int n1 = (F.G >> 4) * 8 + ((F.G & 15) > 8 ? (F.G & 15) - 8 : 0), n0 = F.G - n1;
            if (hi || n1 == 0) {
                pg8::Gemm g{(const bf16_t*)(F.ws + WS_Z), (const bf16_t*)(F.ws + WS_WGLU + l * al1m(SZ_WGLU)), 1024, 1024, 1024, 0, 0};
                pg8::TileOrder S; if (n1) S.init(MPT / 256, 4, 1, 0, n1, idx); else S.init(MPT / 256, 4, 1, 0, F.G, F.bid);
                EpiGlu E{(bf16_t*)(F.ws + WS_ABR + 2 * SZ_ABR1), (const bf16_t*)(F.ws + WS_P), (const bf16_t*)(F.ws + WS_Z)};
                pg8::gemm_phase(F.lds, g, S, E);
            }
            if (!hi) {
                pg8::Gemm g{(const bf16_t*)(F.ws + WS_DIFF), (const bf16_t*)(F.ws + WS_WPOOL + l * al1m(SZ_WPOOL)), 1024, 256, 256, 256, 65536};
                pg8::TileOrder S; S.init(MPT / 256, 1, 4, 0, n0, idx);
                EpiPool E{(bf16_t*)(F.ws + WS_ABR), (const bf16_t*)(F.ws + WS_P), FIN(IN_PSCALE) + l * 1024};
                pg8::gemm_phase(F.lds, g, S, E);
            }
            skinny_glu(F, l); skinny_pool(F, l);
            }
            }
            if (BOTH(p0 + 3)) GRID_BAR();
        }
        if (IN(p0 + 4)) {
            PHASE_BEGIN();
            pg8::Gemm g{(const bf16_t*)(F.ws + WS_ABR), (const bf16_t*)(F.ws + WS_WBR + l * al1m(SZ_WBR)), 1024, 1024, 1024, (size_t)MPAD * 1024, (size_t)2048 * 1024};
            pg8::TileOrder S; S.init(MPT / 256, 8, 3, 1, F.G, F.bid);
            EpiBranch E{(bf16_t*)(F.ws + WS_MERGED), (const bf16_t*)(F.ws + WS_P)};
            REPS(5) { pg8::gemm_phase(F.lds, g, S, E); skinny_branch(F, l); }
            if (BOTH(p0 + 4)) GRID_BAR();
        }
        if (IN(p0 + 5)) {
            PHASE_BEGIN();
            pg8::Gemm g{(const bf16_t*)(F.ws + WS_MERGED), (const bf16_t*)(F.ws + WS_WOUT + l * al1m(SZ_WOUT)), DM, DM, DM, 0, 0};
            pg8::TileOrder S; S.init(MPT / 256, 8, 1, 0, F.G, F.bid);
            EpiOut E{(bf16_t*)(F.ws + WS_OUTB)};
            REPS(6) { pg8::gemm_phase(F.lds, g, S, E); skinny_out(F, l); }
            if (BOTH(p0 + 5)) GRID_BAR();
        }
        if (IN(p0 + 6)) {
            PHASE_BEGIN();
            REPS(7) phase_norm(F, l);
            if (BOTH(p0 + 6)) GRID_BAR();
        }
    }
#undef IN
#undef BOTH
}

extern "C" void kernel_launch(void* const* d_in, const int* in_sizes, int n_in, void* d_out, int out_size, void* d_ws, size_t ws_size, hipStream_t stream) {
    static int grid = 0;
    if (grid == 0) {
        if (n_in != 27 || out_size != (int)O_TOTAL || ws_size < WS_END) { fprintf(stderr, "kernel_launch: unexpected problem shape (n_in %d, out %d, ws %zu < %zu)\n", n_in, out_size, ws_size, (size_t)WS_END); grid = -1; return; }
        int dev = 0, cus = 0, per_cu = 0;
        if (hipGetDevice(&dev) != hipSuccess || hipDeviceGetAttribute(&cus, hipDeviceAttributeMultiprocessorCount, dev) != hipSuccess) { grid = -1; return; }
        if (hipFuncSetAttribute((const void*)fwd_kernel, hipFuncAttributeMaxDynamicSharedMemorySize, LDS_BYTES) != hipSuccess) { fprintf(stderr, "kernel_launch: hipFuncSetAttribute failed\n"); grid = -1; return; }
        if (hipOccupancyMaxActiveBlocksPerMultiprocessor(&per_cu, (const void*)fwd_kernel, NT, LDS_BYTES) != hipSuccess || per_cu < 1)
            fprintf(stderr, "kernel_launch: note: occupancy query reports %d workgroups per CU\n", per_cu);
        (void)hipGetLastError();
        grid = cus;
    }
    if (grid < 0) return;
    if (hipMemsetAsync((char*)d_ws + WS_CTL, 0, CTL_ZERO_BYTES, stream) != hipSuccess) return;
    Args a{};
    for (int i = 0; i < 27; ++i) a.in[i] = (const float*)d_in[i];
    a.out = (float*)d_out; a.ws = (unsigned char*)d_ws;
#if MK_PER_PHASE
    for (int k = 0; k < N_PHASES; ++k) { a.ph_lo = k; a.ph_hi = k + 1; hipLaunchKernelGGL(fwd_kernel, dim3(grid), dim3(NT), LDS_BYTES, stream, a); }
#else
    a.ph_lo = 0; a.ph_hi = N_PHASES;
    hipLaunchKernelGGL(fwd_kernel, dim3(grid), dim3(NT), LDS_BYTES, stream, a);
#endif
    const hipError_t le = hipPeekAtLastError();
    if (le != hipSuccess) fprintf(stderr, "kernel_launch: launch failed: %s\n", hipGetErrorName(le));
}
```

```cpp
#define MK_PER_PHASE 0
#include <hip/hip_runtime.h>
#include <cstdio>
#include <cstdint>

#ifndef MK_PER_PHASE
#define MK_PER_PHASE 0
#endif

#define LAS __attribute__((address_space(3)))
#define GAS __attribute__((address_space(1)))
typedef unsigned short bf16_t;
typedef short bf16x8 __attribute__((ext_vector_type(8)));
typedef float f32x4 __attribute__((ext_vector_type(4)));
typedef float f32x2 __attribute__((ext_vector_type(2)));
typedef float f32x16 __attribute__((ext_vector_type(16)));
typedef unsigned u32x4 __attribute__((ext_vector_type(4)));
typedef unsigned u32x2 __attribute__((ext_vector_type(2)));
typedef __bf16 bf16x2_t __attribute__((ext_vector_type(2)));

constexpr int DM = 2048, SEQ = 4096, PB = 2, SB = 8, SQ = 4, PAST = 16384;
constexpr int MPT = PB * SEQ;
constexpr int MROWS = MPT + SB * SQ;
constexpr int MPAD = 8448;
constexpr int DIN = 13872, NPROJ = 14080;
constexpr int C_PU = 0, C_PZ = 1024, C_Q = 2048, C_CK = 3072, C_CV = 3328, C_SK = 3584, C_SV = 3840, C_WK = 4096, C_WV = 4352,
              C_AZ = 4608, C_SU = 5632, C_SZ = 6656, C_MG = 7680, C_AG = 13824;
constexpr int NPOOL = 1280;
constexpr int SSM_L = 128, SSM_NCH = SEQ / SSM_L;
constexpr float EPS = 1e-6f;
constexpr float SM_SCALE_L2E = 0.125f * 1.44269504088896f;
constexpr float SM_THR = 8.f;

constexpr size_t O_YP = 0, O_YS = 16777216, O_KVP = 16842752, O_KVS = 33619968, O_WINP = 33685504, O_WINS = 34734080,
                 O_POOLP = 38928384, O_POOLS = 38989824, O_SSMP = 39235584, O_SSMS = 39268352, O_TOTAL = 39399424;

constexpr size_t al1m(size_t x) { return (x + 1048575) & ~(size_t)1048575; }
constexpr size_t SZ_WIN = (size_t)NPROJ * DM * 2, SZ_WPOOL = 4 * 256 * 256 * 2, SZ_WGLU = 1024 * 1024 * 2, SZ_WBR = (size_t)3 * 2048 * 1024 * 2,
                 SZ_WOUT = (size_t)2048 * 2048 * 2, SZ_WPHI = 2 * 64 * 64 * 64 * 2, SZ_PEBP = 2 * 16 * 64 * 4, SZ_SAB = 64 * 64 * 4 * 4,
                 SZ_SBB = 64 * 16 * 2 * 64 * 4, SZ_SCM = 64 * 16 * 128 * 2;
constexpr size_t WS_CTL = 0, CTL_BYTES = 1048576, CTL_ZERO_BYTES = 32768;
constexpr size_t WS_WIN = CTL_BYTES;
constexpr size_t WS_WPOOL = WS_WIN + 2 * al1m(SZ_WIN);
constexpr size_t WS_WGLU = WS_WPOOL + 2 * al1m(SZ_WPOOL);
constexpr size_t WS_WBR = WS_WGLU + 2 * al1m(SZ_WGLU);
constexpr size_t WS_WOUT = WS_WBR + 2 * al1m(SZ_WBR);
constexpr size_t WS_WPHI = WS_WOUT + 2 * al1m(SZ_WOUT);
constexpr size_t WS_PEBP = WS_WPHI + 2 * al1m(SZ_WPHI);
constexpr size_t WS_SAB = WS_PEBP + 2 * al1m(SZ_PEBP);
constexpr size_t WS_SBB = WS_SAB + 2 * al1m(SZ_SAB);
constexpr size_t WS_SCM = WS_SBB + 2 * al1m(SZ_SBB);
constexpr size_t WS_H = WS_SCM + 2 * al1m(SZ_SCM);
constexpr size_t WS_P = WS_H + al1m((size_t)MPAD * DM * 2);
constexpr size_t WS_GATE = WS_P + al1m((size_t)MPAD * NPROJ * 2);
constexpr size_t WS_DIFF = WS_GATE + al1m((size_t)MPAD * 64 * 4);
constexpr size_t WS_ABR = WS_DIFF + al1m((size_t)MPAD * 1024 * 2);
constexpr size_t SZ_ABR1 = (size_t)MPAD * 1024 * 2;
constexpr size_t WS_Z = WS_ABR + al1m(3 * SZ_ABR1);
constexpr size_t WS_KCP = WS_Z + al1m(SZ_ABR1);
constexpr size_t WS_VCTP = WS_KCP + al1m(65536);
constexpr size_t WS_KCS = WS_VCTP + al1m(65536);
constexpr size_t WS_VCTS = WS_KCS + al1m(1048576);
constexpr size_t WS_VTSEL = WS_VCTS + al1m(1048576);
constexpr size_t WS_VTWIN = WS_VTSEL + al1m(4194304);
constexpr size_t WS_SSME = WS_VTWIN + al1m(4194304);
constexpr size_t WS_MERGED = WS_SSME + al1m(2097152);
constexpr size_t WS_OUTB = WS_MERGED + al1m((size_t)MPAD * DM * 2);
constexpr size_t WS_Y0 = WS_OUTB + al1m((size_t)MPAD * DM * 4);
constexpr size_t WS_BRP = WS_Y0 + al1m((size_t)MPAD * DM * 4);
constexpr size_t WS_SOACC = WS_BRP + al1m((size_t)3 * 32 * DM * 4);
constexpr size_t WS_SBB16 = WS_SOACC + al1m(128 * 768 * 4);
constexpr size_t SZ_SBB16 = 64 * 2 * 64 * 16 * 2;
constexpr size_t WS_KTSEL = WS_SBB16 + 2 * al1m(SZ_SBB16);
constexpr size_t WS_KTWIN = WS_KTSEL + al1m(4194304);
constexpr size_t WS_END = WS_KTWIN + al1m(4194304);

constexpr int CW_BAR = 4096;

constexpr int NWAVES = 8, NT = 512;
constexpr int LDS_BYTES = 147456;
constexpr int LDS_MISC = 143360;

__device__ __forceinline__ float bf2f(unsigned b) { return __uint_as_float(b << 16); }
__device__ __forceinline__ unsigned pk2(float lo, float hi) { f32x2 v = {lo, hi}; bf16x2_t b = __builtin_convertvector(v, bf16x2_t); return __builtin_bit_cast(unsigned, b); }
__device__ __forceinline__ unsigned f2bf(float f) { return pk2(f, 0.f) & 0xffffu; }
__device__ __forceinline__ float wave_sum(float v) {
#pragma unroll
    for (int o = 1; o < 64; o <<= 1) v += __shfl_xor(v, o);
    return v;
}
__device__ __forceinline__ float wave_max(float v) {
#pragma unroll
    for (int o = 1; o < 64; o <<= 1) v = fmaxf(v, __shfl_xor(v, o));
    return v;
}
__device__ __forceinline__ float sigmoidf_(float x) { return __builtin_amdgcn_rcpf(1.f + __expf(-x)); }
__device__ __forceinline__ float siluf_(float x) { return x * sigmoidf_(x); }
__device__ __forceinline__ float gelu_tanh(float y) { const float a = 1.5957691216f * (y + 0.044715f * y * y * y); return y * sigmoidf_(a); }
#define LDS_WAIT() asm volatile("s_waitcnt lgkmcnt(0)" ::: "memory")
#define VM_WAIT() asm volatile("s_waitcnt vmcnt(0)" ::: "memory")

#define XB_TMO      128
#define XB_XCNT(j)  (256  + 64 * (j))
#define XB_XSUB(j)  (1280 + 64 * (j))
#define XB_XGEN(j)  (2304 + 64 * (j))
#define XB_TOP      3328
#define XB_TOPGEN   3392
#define XCD_BAR_WORDS 3456
#define XB_SPIN_CAP (1u << 23)
__device__ __forceinline__ unsigned xb_ld(unsigned* p)              { return __hip_atomic_load(p, __ATOMIC_RELAXED, __HIP_MEMORY_SCOPE_AGENT); }
__device__ __forceinline__ unsigned xb_add(unsigned* p, unsigned v) { return __hip_atomic_fetch_add(p, v, __ATOMIC_RELAXED, __HIP_MEMORY_SCOPE_AGENT); }
__device__ __forceinline__ unsigned xb_xcc_id() { return (unsigned)__builtin_amdgcn_s_getreg((3 << 11) | 20) & 0xFu; }
#define XB_SPIN(cond, bar) do { unsigned _sp = 0; while (cond) { __builtin_amdgcn_s_sleep(1); \
    if ((++_sp & 255u) == 0u) { if (xb_ld(&(bar)[XB_TMO])) break; if (_sp > XB_SPIN_CAP) { atomicAdd(&(bar)[XB_TMO], 1u); break; } } } } while (0)
struct XcdBarrier { unsigned* bar; unsigned x; volatile LAS unsigned* st; };
__device__ __forceinline__ XcdBarrier xcd_barrier_post(unsigned* bar, volatile LAS unsigned* st) {
    XcdBarrier b; b.bar = bar; b.x = xb_xcc_id(); b.st = st;
    if (threadIdx.x == 0) (void)xb_add(&bar[XB_XCNT(b.x)], 1u);
    return b;
}
__device__ __forceinline__ void xcd_barrier_complete(unsigned* bar, unsigned x, unsigned& nloc, unsigned& nx) {
    const unsigned G = gridDim.x * gridDim.y * gridDim.z;
    unsigned sum, cnt, mine, sp = 0u;
    for (;;) {
        sum = 0u; cnt = 0u; mine = 0u;
#pragma unroll
        for (unsigned j = 0; j < 16; ++j) { const unsigned c = xb_ld(&bar[XB_XCNT(j)]); sum += c; cnt += (c > 0u) ? 1u : 0u; mine = (j == x) ? c : mine; }
        if (sum == G) break;
        __builtin_amdgcn_s_sleep(1);
        if ((++sp & 255u) == 0u) { if (xb_ld(&bar[XB_TMO])) break; if (sp > XB_SPIN_CAP) { atomicAdd(&bar[XB_TMO], 1u); break; } }
    }
    nloc = mine > 0u ? mine : 1u; nx = cnt > 0u ? cnt : 1u;
}
__device__ __forceinline__ void xcd_barrier(const XcdBarrier& b) {
    asm volatile("s_waitcnt vmcnt(0)" ::: "memory");
    __syncthreads();
    if (threadIdx.x == 0) {
        unsigned* bar = b.bar;
        __builtin_amdgcn_s_waitcnt(0);
        unsigned nloc = b.st[0], nx = b.st[1];
        if (nloc == 0u) { xcd_barrier_complete(bar, b.x, nloc, nx); b.st[0] = nloc; b.st[1] = nx; }
        const unsigned old = xb_add(&bar[XB_XSUB(b.x)], 1u);
        const unsigned gen = old / nloc;
        if (old + 1u == (gen + 1u) * nloc) {
            __builtin_amdgcn_fence(__ATOMIC_RELEASE, "agent");
            asm volatile("s_waitcnt vmcnt(0)" ::: "memory");
            const unsigned og = xb_add(&bar[XB_TOP], 1u);
            const unsigned tg = og / nx;
            if (og + 1u == (tg + 1u) * nx) xb_add(&bar[XB_TOPGEN], 1u);
            else XB_SPIN(xb_ld(&bar[XB_TOPGEN]) == tg, bar);
            __builtin_amdgcn_fence(__ATOMIC_ACQUIRE, "agent");
            xb_add(&bar[XB_XGEN(b.x)], 1u);
            asm volatile("s_waitcnt vmcnt(0)" ::: "memory");
        } else {
            XB_SPIN(xb_ld(&bar[XB_XGEN(b.x)]) == gen, bar);
            __builtin_amdgcn_fence(__ATOMIC_ACQUIRE, "agent");
            asm volatile("s_waitcnt vmcnt(0)" ::: "memory");
        }
    }
    __syncthreads();
}
namespace pg8 {
constexpr int BM = 256, BK = 64, HALF = 128, HTB = HALF * BK * 2, STAGE_BYTES = 8 * HTB, NXCD = 8, WGM = 8;
__host__ __device__ __forceinline__ int lds_byte(int r, int c) { const int st = (r >> 4) * 2 + (c >> 5), rr = r & 15, cc = c & 31, ob = rr * 64 + cc * 2; return st * 1024 + (ob ^ (((ob >> 9) & 1) << 5)); }
__host__ __device__ __forceinline__ void stage_rc(int b, int& R, int& C) { const int st = b / 1024, sb = b % 1024, swz = sb ^ (((sb >> 9) & 1) << 5); R = (st >> 1) * 16 + swz / 64; C = (st & 1) * 32 + (swz % 64) / 2; }
__host__ __device__ __forceinline__ int perm32(int rho) { const int n = rho >> 4, i = rho & 15; return 8 * (i >> 2) + 4 * n + (i & 3); }

struct Unit { int pm, pn, z; };
struct Gemm { const bf16_t* A; const bf16_t* Bt; int lda, ldb, K; size_t zA, zB; };

struct TileOrder {
    int nM, nN, nz, ntile, G, c, zin;
    __device__ void init(int nM_, int nN_, int nz_, int zin_, int G_, int c_) { nM = nM_; nN = nN_; nz = nz_; zin = zin_; ntile = nM * nN; G = G_; c = c_; }
    __device__ bool next(int i, Unit& u) const {
        long L; int z;
        if (zin) { z = i % nz; L = (long)(i / nz) * G + c; if (L >= ntile) return false; }
        else { const long LL = (long)i * G + c; if (LL >= (long)ntile * nz) return false; z = (int)(LL / ntile); L = LL % ntile; }
        int wgid = (int)L; { const int q = ntile / NXCD, r = ntile % NXCD, xcd = wgid % NXCD, off = wgid / NXCD; wgid = (xcd < r ? xcd * (q + 1) : r * (q + 1) + (xcd - r) * q) + off; }
        const int nig = WGM * nN, gid = wgid / nig, fm = gid * WGM, gsz = (nM - fm) < WGM ? (nM - fm) : WGM;
        u.pm = fm + ((wgid % nig) % gsz); u.pn = (wgid % nig) / gsz; u.z = z; return true;
    }
};

template <class Epi, class Sched>
__device__ __forceinline__ void gemm_phase(LAS unsigned char* lds, const Gemm g, const Sched& S, const Epi& E) {
    int tid = threadIdx.x; asm volatile("" : "+v"(tid));
    const int wid = __builtin_amdgcn_readfirstlane(tid >> 6), lane = tid & 63, wr = wid >> 2, wc = wid & 3, fr = lane & 15, fq = lane >> 4;
    const int K = g.K, nt = K / BK;
    unsigned voffA[2], voffB[2];
#pragma unroll
    for (int i = 0; i < 2; ++i) { int R, C; stage_rc(tid * 16 + i * 8192, R, C); const int Rb = (R & ~31) + perm32(R & 31);
        voffA[i] = (unsigned)(R * g.lda + C) * 2u; voffB[i] = (unsigned)(Rb * g.ldb + C) * 2u; }
    const size_t kstep = (size_t)(BK * 2);
    const size_t hstepA = (size_t)HALF * g.lda * 2, hstepB = (size_t)HALF * g.ldb * 2;
    const unsigned ldsw = (unsigned)wid * 1024u;
    const int aoff = lds_byte(wr * 64 + fr, fq * 8), boff = lds_byte(wc * 32 + fr, fq * 8);
#define PG8_SA(b, h) (((b) * 2 + (h)) * HTB)
#define PG8_SB(b, h) ((4 + (b) * 2 + (h)) * HTB)
#define PG8_STAGE(bufoff, gbase, voff) do { _Pragma("unroll") for (int _i = 0; _i < 2; ++_i) \
        __builtin_amdgcn_global_load_lds((const unsigned*)((const char*)(gbase) + (voff)[_i]), (LAS unsigned*)(lds + (bufoff) + ldsw + _i * 8192), 16, 0, 0); } while (0)
#define PG8_LDA(dst, b, h) do { _Pragma("unroll") for (int m = 0; m < 4; ++m) _Pragma("unroll") for (int k = 0; k < 2; ++k) dst[m][k] = *(const LAS bf16x8*)(lds + PG8_SA(b, h) + aoff + m * 2048 + k * 1024); } while (0)
#define PG8_LDB(dst, b, h) do { _Pragma("unroll") for (int n = 0; n < 2; ++n) _Pragma("unroll") for (int k = 0; k < 2; ++k) dst[n][k] = *(const LAS bf16x8*)(lds + PG8_SB(b, h) + boff + n * 2048 + k * 1024); } while (0)
#define PG8_MMA(ai, bj, At, Bt) do { __builtin_amdgcn_s_setprio(1); _Pragma("unroll") for (int m = 0; m < 4; ++m) _Pragma("unroll") for (int n = 0; n < 2; ++n) _Pragma("unroll") for (int k = 0; k < 2; ++k) \
        acc[ai][bj][m][n] = __builtin_amdgcn_mfma_f32_16x16x32_bf16(Bt[n][k], At[m][k], acc[ai][bj][m][n], 0, 0, 0); __builtin_amdgcn_s_setprio(0); } while (0)
#define PG8_WAIT_V(n) asm volatile("s_waitcnt vmcnt(" #n ")" ::: "memory")
#define PG8_WAIT_L(n) asm volatile("s_waitcnt lgkmcnt(" #n ")" ::: "memory")
#define PG8_BAR __builtin_amdgcn_s_barrier()
#define PG8_SCHED __builtin_amdgcn_sched_barrier(0)
#define PG8_UA(u) ((const char*)(g.A + (size_t)(u).z * g.zA) + (size_t)(u).pm * (2 * hstepA))
#define PG8_UB(u) ((const char*)(g.Bt + (size_t)(u).z * g.zB) + (size_t)(u).pn * (2 * hstepB))
    Unit cur, nxt; int ui = 0;
    if (!S.next(0, cur)) return;
    f32x4 acc[2][2][4][2];
#pragma unroll
    for (int a = 0; a < 2; ++a)
#pragma unroll
        for (int b = 0; b < 2; ++b)
#pragma unroll
            for (int m = 0; m < 4; ++m)
#pragma unroll
                for (int n = 0; n < 2; ++n) acc[a][b][m][n] = (f32x4){0.f, 0.f, 0.f, 0.f};
    bf16x8 At[4][2], B0[2][2], B1[2][2];
    const char* cA = PG8_UA(cur); const char* cB = PG8_UB(cur);
    PG8_STAGE(PG8_SB(0, 0), cB, voffB); PG8_STAGE(PG8_SB(0, 1), cB + hstepB, voffB); PG8_STAGE(PG8_SA(0, 0), cA, voffA); PG8_STAGE(PG8_SA(0, 1), cA + hstepA, voffA);
    if (wr == 1) PG8_BAR;
    PG8_WAIT_V(2); PG8_BAR;
    PG8_STAGE(PG8_SB(1, 0), cB + kstep, voffB); PG8_STAGE(PG8_SA(1, 0), cA + kstep, voffA); PG8_STAGE(PG8_SB(1, 1), cB + hstepB + kstep, voffB);
    PG8_WAIT_V(6); PG8_BAR;
    for (;;) {
        const bool has_next = S.next(ui + 1, nxt);
        const char* nA = has_next ? PG8_UA(nxt) : cA; const char* nB = has_next ? PG8_UB(nxt) : cB;
#pragma unroll 1
        for (int t = 0; t < nt; t += 2) {
            const bool last = (t == nt - 2);
            const char* a1 = cA + (size_t)(t + 1) * kstep;
            const char* a2 = last ? nA : cA + (size_t)(t + 2) * kstep; const char* b2 = last ? nB : cB + (size_t)(t + 2) * kstep;
            const char* a3 = a2 + kstep; const char* b3 = b2 + kstep;
            PG8_LDB(B0, 0, 0); PG8_LDB(B1, 0, 1); PG8_SCHED; PG8_LDA(At, 0, 0); PG8_STAGE(PG8_SA(1, 1), a1 + hstepA, voffA);
            PG8_WAIT_V(8); PG8_WAIT_L(0); PG8_BAR; PG8_MMA(0, 0, At, B0); PG8_MMA(0, 1, At, B1); PG8_BAR; PG8_SCHED;
            PG8_LDA(At, 0, 1); PG8_STAGE(PG8_SB(0, 0), b2, voffB); PG8_STAGE(PG8_SB(0, 1), b2 + hstepB, voffB); PG8_STAGE(PG8_SA(0, 0), a2, voffA);
            PG8_WAIT_V(8); PG8_WAIT_L(0); PG8_BAR; PG8_MMA(1, 0, At, B0); PG8_MMA(1, 1, At, B1); PG8_BAR; PG8_SCHED;
            PG8_LDB(B0, 1, 0); PG8_LDB(B1, 1, 1); PG8_SCHED; PG8_LDA(At, 1, 0); PG8_STAGE(PG8_SA(0, 1), a2 + hstepA, voffA);
            PG8_WAIT_V(8); PG8_WAIT_L(0); PG8_BAR; PG8_MMA(0, 0, At, B0); PG8_MMA(0, 1, At, B1); PG8_BAR; PG8_SCHED;
            PG8_LDA(At, 1, 1); PG8_STAGE(PG8_SB(1, 0), b3, voffB); PG8_STAGE(PG8_SB(1, 1), b3 + hstepB, voffB); PG8_STAGE(PG8_SA(1, 0), a3, voffA);
            PG8_WAIT_V(8); PG8_WAIT_L(0); PG8_BAR; PG8_MMA(1, 0, At, B0); PG8_MMA(1, 1, At, B1); PG8_BAR; PG8_SCHED;
        }
        if (wr == 0) PG8_BAR;
        const bool keep = E(acc, cur, wr, wc, fr, fq);
        if (!has_next) break;
        if (!keep) {
#pragma unroll
            for (int a = 0; a < 2; ++a)
#pragma unroll
                for (int b = 0; b < 2; ++b)
#pragma unroll
                    for (int m = 0; m < 4; ++m)
#pragma unroll
                        for (int n = 0; n < 2; ++n) acc[a][b][m][n] = (f32x4){0.f, 0.f, 0.f, 0.f};
        }
        cur = nxt; cA = nA; cB = nB; ++ui;
        if (wr == 1) PG8_BAR;
    }
    PG8_WAIT_V(0);
    PG8_BAR;
#undef PG8_SA
#undef PG8_SB
#undef PG8_STAGE
#undef PG8_LDA
#undef PG8_LDB
#undef PG8_MMA
#undef PG8_WAIT_V
#undef PG8_WAIT_L
#undef PG8_BAR
#undef PG8_SCHED
#undef PG8_UA
#undef PG8_UB
}
}
#define EPI_ARGS f32x4 (&acc)[2][2][4][2], const pg8::Unit& u, int wr, int wc, int fr, int fq
#define EPI_FOR_ROWS _Pragma("unroll") for (int ai = 0; ai < 2; ++ai) _Pragma("unroll") for (int m = 0; m < 4; ++m)
#define EPI_ROW (u.pm * 256 + ai * 128 + wr * 64 + m * 16 + fr)
#define EPI_FOR_COLS _Pragma("unroll") for (int bj = 0; bj < 2; ++bj)
#define EPI_COL (u.pn * 256 + bj * 128 + wc * 32 + 8 * fq)

__device__ __forceinline__ u32x4 pack8(const f32x4& a, const f32x4& b) { u32x4 w; w.x = pk2(a[0], a[1]); w.y = pk2(a[2], a[3]); w.z = pk2(b[0], b[1]); w.w = pk2(b[2], b[3]); return w; }
__device__ __forceinline__ void unpack8(const u32x4& w, float (&f)[8]) {
    f[0] = bf2f(w.x & 0xffffu); f[1] = __uint_as_float(w.x & 0xffff0000u); f[2] = bf2f(w.y & 0xffffu); f[3] = __uint_as_float(w.y & 0xffff0000u);
    f[4] = bf2f(w.z & 0xffffu); f[5] = __uint_as_float(w.z & 0xffff0000u); f[6] = bf2f(w.w & 0xffffu); f[7] = __uint_as_float(w.w & 0xffff0000u);
}

__device__ __forceinline__ u32x2 pack4(const f32x4& v) { u32x2 w; w.x = pk2(v[0], v[1]); w.y = pk2(v[2], v[3]); return w; }
__device__ __forceinline__ f32x4 unpack4(const u32x2& x) { return (f32x4){bf2f(x.x & 0xffffu), __uint_as_float(x.x & 0xffff0000u), bf2f(x.y & 0xffffu), __uint_as_float(x.y & 0xffff0000u)}; }

struct EpiProj {
    bf16_t* P; float* gate; float* out; int layer;
    __device__ __forceinline__ bool operator()(EPI_ARGS) const {
        const int pn = u.pn;
        int mode;
        if (pn < 4) mode = 0; else if (pn < 8) mode = 1; else if (pn < 12) mode = 5; else if (pn < 16) mode = 3; else if (pn < 18) mode = 0;
        else if (pn < 22) mode = 1; else if (pn < 26) mode = 0; else if (pn < 30) mode = 1; else if (pn < 54) mode = 2; else mode = 4;
        if (mode == 0) {
            EPI_FOR_ROWS { bf16_t* rp = P + (size_t)EPI_ROW * NPROJ; EPI_FOR_COLS { *(u32x4*)(rp + EPI_COL) = pack8(acc[ai][bj][m][0], acc[ai][bj][m][1]); } }
        } else if (mode == 5) {
            EPI_FOR_ROWS { bf16_t* rp = P + (size_t)EPI_ROW * NPROJ; EPI_FOR_COLS { *(u32x4*)(rp + EPI_COL) = pack8(acc[ai][bj][m][0] * SM_SCALE_L2E, acc[ai][bj][m][1] * SM_SCALE_L2E); } }
        } else if (mode == 1) {
            EPI_FOR_ROWS { bf16_t* rp = P + (size_t)EPI_ROW * NPROJ; EPI_FOR_COLS { f32x4 a = acc[ai][bj][m][0], b = acc[ai][bj][m][1];
#pragma unroll
                for (int j = 0; j < 4; ++j) { a[j] = siluf_(a[j]); b[j] = siluf_(b[j]); }
                *(u32x4*)(rp + EPI_COL) = pack8(a, b); } }
        } else if (mode == 2) {
            EPI_FOR_ROWS { bf16_t* rp = P + (size_t)EPI_ROW * NPROJ; EPI_FOR_COLS { f32x4 a = acc[ai][bj][m][0], b = acc[ai][bj][m][1];
#pragma unroll
                for (int j = 0; j < 4; ++j) { a[j] = sigmoidf_(a[j]); b[j] = sigmoidf_(b[j]); }
                *(u32x4*)(rp + EPI_COL) = pack8(a, b); } }
        } else if (mode == 3) {
            EPI_FOR_ROWS { const int row = EPI_ROW; bf16_t* rp = P + (size_t)row * NPROJ;
                float* op = nullptr;
                if (row < MPT) op = out + O_KVP + ((size_t)layer * MPT + row) * 1024;
                else if (row < MROWS) op = out + O_KVS + ((size_t)layer * 32 + (row - MPT)) * 1024;
                EPI_FOR_COLS { const int col = EPI_COL; *(u32x4*)(rp + col) = pack8(acc[ai][bj][m][0], acc[ai][bj][m][1]);
                    if (op) { *(f32x4*)(op + col - C_CK) = acc[ai][bj][m][0]; *(f32x4*)(op + col - C_CK + 4) = acc[ai][bj][m][1]; } } }
        } else {
            EPI_FOR_ROWS { float* gp = gate + (size_t)EPI_ROW * 64; EPI_FOR_COLS { const int c = EPI_COL - C_AG; if (c < 48) { f32x4 a = acc[ai][bj][m][0], b = acc[ai][bj][m][1];
#pragma unroll
                for (int j = 0; j < 4; ++j) { a[j] = sigmoidf_(a[j]); b[j] = sigmoidf_(b[j]); }
                *(f32x4*)(gp + c) = a; *(f32x4*)(gp + c + 4) = b; } } }
        }
        return false;
    }
};

struct EpiPool {
    bf16_t* apool; const bf16_t* P; const float* pscale;
    __device__ __forceinline__ bool operator()(EPI_ARGS) const {
        asm volatile("" ::: "memory");
#pragma unroll
        for (int ai = 0; ai < 2; ++ai) {
            u32x4 zw[4][2];
#pragma unroll
            for (int m = 0; m < 4; ++m) EPI_FOR_COLS { const int col = u.z * 256 + bj * 128 + wc * 32 + 8 * fq; zw[m][bj] = *(const u32x4*)(P + (size_t)EPI_ROW * NPROJ + C_PZ + col); }
            __builtin_amdgcn_sched_barrier(0);
#pragma unroll
            for (int m = 0; m < 4; ++m) EPI_FOR_COLS { const int col = u.z * 256 + bj * 128 + wc * 32 + 8 * fq; float zf[8]; unpack8(zw[m][bj], zf);
                const f32x4 s0 = *(const f32x4*)(pscale + col), s1 = *(const f32x4*)(pscale + col + 4);
                f32x4 a = acc[ai][bj][m][0], b = acc[ai][bj][m][1];
#pragma unroll
                for (int j = 0; j < 4; ++j) { a[j] = a[j] * s0[j] * zf[j]; b[j] = b[j] * s1[j] * zf[4 + j]; }
                *(u32x4*)(apool + (size_t)EPI_ROW * 1024 + col) = pack8(a, b); }
            __builtin_amdgcn_sched_barrier(0);
        }
        return false;
    }
};

struct EpiGlu {
    bf16_t* assm; const bf16_t* P; const bf16_t* Z;
    __device__ __forceinline__ bool operator()(EPI_ARGS) const {
#pragma unroll
        for (int ai = 0; ai < 2; ++ai) {
            u32x4 zw[4][2], sw[4][2];
#pragma unroll
            for (int m = 0; m < 4; ++m) EPI_FOR_COLS { const int row = EPI_ROW, col = EPI_COL; zw[m][bj] = *(const u32x4*)(Z + (size_t)row * 1024 + col); sw[m][bj] = *(const u32x4*)(P + (size_t)row * NPROJ + C_SZ + col); }
            __builtin_amdgcn_sched_barrier(0);
#pragma unroll
            for (int m = 0; m < 4; ++m) EPI_FOR_COLS { float zf[8], sf[8]; unpack8(zw[m][bj], zf); unpack8(sw[m][bj], sf);
                f32x4 a = acc[ai][bj][m][0], b = acc[ai][bj][m][1];
#pragma unroll
                for (int j = 0; j < 4; ++j) { a[j] = zf[j] * sigmoidf_(a[j]) * sf[j]; b[j] = zf[4 + j] * sigmoidf_(b[j]) * sf[4 + j]; }
                *(u32x4*)(assm + (size_t)EPI_ROW * 1024 + EPI_COL) = pack8(a, b); }
            __builtin_amdgcn_sched_barrier(0);
        }
        return false;
    }
};

struct EpiBranch {
    bf16_t* merged; const bf16_t* P;
    __device__ __forceinline__ bool operator()(EPI_ARGS) const {
        const int z = u.z;
#pragma unroll
        for (int ai = 0; ai < 2; ++ai) {
            u32x4 gzw[4][2], gnw[4][2];
#pragma unroll
            for (int m = 0; m < 4; ++m) EPI_FOR_COLS { const bf16_t* gp = P + (size_t)EPI_ROW * NPROJ + C_MG + EPI_COL; gzw[m][bj] = *(const u32x4*)(gp + z * 2048); gnw[m][bj] = *(const u32x4*)(gp + (z < 2 ? z + 1 : 2) * 2048); }
            __builtin_amdgcn_sched_barrier(0);
#pragma unroll
            for (int m = 0; m < 4; ++m) EPI_FOR_COLS { float gz[8], gn[8]; unpack8(gzw[m][bj], gz); unpack8(gnw[m][bj], gn);
                f32x4& a = acc[ai][bj][m][0]; f32x4& b = acc[ai][bj][m][1];
                if (z < 2) {
#pragma unroll
                    for (int j = 0; j < 4; ++j) { a[j] *= fmaxf(gz[j], 1e-30f) * __builtin_amdgcn_rcpf(fmaxf(gn[j], 1e-30f)); b[j] *= fmaxf(gz[4 + j], 1e-30f) * __builtin_amdgcn_rcpf(fmaxf(gn[4 + j], 1e-30f)); }
                } else {
                    f32x4 a2, b2;
#pragma unroll
                    for (int j = 0; j < 4; ++j) { a2[j] = a[j] * fmaxf(gz[j], 1e-30f); b2[j] = b[j] * fmaxf(gz[4 + j], 1e-30f); }
                    *(u32x4*)(merged + (size_t)EPI_ROW * DM + EPI_COL) = pack8(a2, b2);
                } }
            __builtin_amdgcn_sched_barrier(0);
        }
        return z < 2;
    }
};

struct EpiOut {
    bf16_t* outb;
    __device__ __forceinline__ bool operator()(EPI_ARGS) const {
        EPI_FOR_ROWS { bf16_t* rp = outb + (size_t)EPI_ROW * DM; EPI_FOR_COLS { *(u32x4*)(rp + EPI_COL) = pack8(acc[ai][bj][m][0], acc[ai][bj][m][1]); } }
        return false;
    }
};
struct Frame {
    LAS unsigned char* lds;
    int tid, lane, wave, G, bid, gw, ngw;
    float* out; unsigned char* ws;
};
#define FIN(i) ((const float*)(const GAS float*)(((const float* const __attribute__((address_space(4)))*)__builtin_amdgcn_kernarg_segment_ptr())[i]))
#define IN_XP 0
#define IN_XS 1
#define IN_CACHE 2
#define IN_PT 3
#define IN_SWIN 4
#define IN_SPOOL 5
#define IN_SSSM 6
#define IN_GPRE 7
#define IN_GPOST 8
#define IN_WIN 9
#define IN_WPOOL 10
#define IN_PSCALE 11
#define IN_PE 12
#define IN_WPHI 13
#define IN_LRE 14
#define IN_LIM 15
#define IN_LSTEP 16
#define IN_BRE 17
#define IN_BIM 18
#define IN_CRE 19
#define IN_CIM 20
#define IN_DSKIP 21
#define IN_WGLU 22
#define IN_WBRP 23
#define IN_WBRN 24
#define IN_WBRS 25
#define IN_WOUT 26

template <class MAP>
__device__ __forceinline__ void transpose_item(const float* W, int ldw, int K, bf16_t* WT, int k0, int nd0, LAS float* scr, int lane, const MAP& map) {
    const int nq = 4 * (lane & 15), ns = map(nd0 + nq), kr = lane >> 4;
    f32x4 v[16];
#pragma unroll
    for (int i = 0; i < 16; ++i) v[i] = ns >= 0 ? *(const f32x4*)(W + (size_t)(k0 + 4 * i + kr) * ldw + ns) : (f32x4){0.f, 0.f, 0.f, 0.f};
#pragma unroll
    for (int i = 0; i < 16; ++i) { LAS float* d = scr + (4 * i + kr) * 65 + nq; d[0] = v[i].x; d[1] = v[i].y; d[2] = v[i].z; d[3] = v[i].w; }
    LDS_WAIT(); asm volatile("" ::: "memory");
    const int c = lane & 7;
#pragma unroll
    for (int j = 0; j < 8; ++j) { const int n = (lane >> 3) + 8 * j; const LAS float* s = scr + (8 * c) * 65 + n;
        u32x4 o; o.x = pk2(s[0 * 65], s[1 * 65]); o.y = pk2(s[2 * 65], s[3 * 65]); o.z = pk2(s[4 * 65], s[5 * 65]); o.w = pk2(s[6 * 65], s[7 * 65]);
        *(u32x4*)(WT + (size_t)(nd0 + n) * K + k0 + 8 * c) = o; }
    LDS_WAIT(); asm volatile("" ::: "memory");
}
struct MapId { __device__ __forceinline__ int operator()(int n) const { return n; } };
struct MapWin { __device__ __forceinline__ int operator()(int n) const { return n < C_AZ ? n : (n < C_AG ? n + 48 : (n < C_AG + 48 ? n - C_AG + 4608 : -1)); } };

__device__ __forceinline__ double exp_d(double x) {
    const double r = x * (1.0 / 64.0); double t = 1.0, s = 1.0;
#pragma unroll
    for (int k = 1; k <= 14; ++k) { t *= r / (double)k; s += t; }
#pragma unroll
    for (int k = 0; k < 6; ++k) s *= s;
    return s;
}
__device__ __forceinline__ void sincos_d(double x, double& sn, double& cs) {
    const double k = rint(x * 0.63661977236758134308);
    double r = fma(-k, 1.57079632679489655800e+00, x); r = fma(-k, 6.12323399573676603587e-17, r);
    const double r2 = r * r;
    double sp = 1.0, cp = 1.0, ts = 1.0, tc = 1.0;
#pragma unroll
    for (int i = 1; i <= 9; ++i) { ts *= -r2 / (double)((2 * i) * (2 * i + 1)); sp += ts; tc *= -r2 / (double)((2 * i - 1) * (2 * i)); cp += tc; }
    sp *= r;
    const int q = ((int)k) & 3;
    sn = (q == 0) ? sp : (q == 1) ? cp : (q == 2) ? -sp : -cp;
    cs = (q == 0) ? cp : (q == 1) ? -sp : (q == 2) ? -cp : sp;
}

__device__ __forceinline__ void rms_row_to_bf16(const float* xrow, const float* g, bf16_t* orow, int lane) {
    const f32x4* xr = (const f32x4*)xrow + lane; const f32x4* gr = (const f32x4*)g + lane;
    f32x4 v[8]; float s = 0.f;
#pragma unroll
    for (int j = 0; j < 8; ++j) { v[j] = xr[64 * j]; s += (v[j].x * v[j].x + v[j].y * v[j].y) + (v[j].z * v[j].z + v[j].w * v[j].w); }
    const float rstd = 1.f / sqrtf(wave_sum(s) * (1.f / DM) + EPS);
    u32x2* o8 = (u32x2*)orow + lane;
#pragma unroll
    for (int j = 0; j < 8; ++j) { const f32x4 gg = gr[64 * j]; u32x2 w; w.x = pk2(v[j].x * rstd * gg.x, v[j].y * rstd * gg.y); w.y = pk2(v[j].z * rstd * gg.z, v[j].w * rstd * gg.w); o8[64 * j] = w; }
}
__device__ __forceinline__ const float* x_row_l0(const Frame& F, int m) {
    const GAS float* s0 = (const GAS float*)FIN(IN_XP); const GAS float* s1 = (const GAS float*)FIN(IN_XS);
    asm volatile("" : "+s"(s0), "+s"(s1));
    return (const float*)(m < MPT ? s0 + (size_t)m * DM : s1 + (size_t)(m - MPT) * DM); }

__device__ __forceinline__ void phase_prologue(Frame& F) {
    LAS float* scr = (LAS float*)(F.lds + F.wave * 16640);
    const int lane = F.lane;
    constexpr int I_WIN = 32 * (NPROJ / 64), I_GLU = 16 * 16, I_BR = 16 * 32, I_OUT = 32 * 32, I_POOL = 4 * 4, I_PHI = 1;
    constexpr int PER_L = I_WIN + I_GLU + 3 * I_BR + I_OUT + 4 * I_POOL + 128 * I_PHI;
    for (int it = F.gw; it < 2 * PER_L; it += F.ngw) {
        const int l = it / PER_L; int r = it % PER_L;
        if (r < I_WIN) { const int kb = r / (NPROJ / 64), nb = r % (NPROJ / 64);
            transpose_item(FIN(IN_WIN) + (size_t)l * DM * DIN, DIN, DM, (bf16_t*)(F.ws + WS_WIN + l * al1m(SZ_WIN)), 64 * kb, 64 * nb, scr, lane, MapWin()); continue; } r -= I_WIN;
        if (r < I_GLU) { const int kb = r / 16, nb = r % 16;
            transpose_item(FIN(IN_WGLU) + (size_t)l * 1024 * 1024, 1024, 1024, (bf16_t*)(F.ws + WS_WGLU + l * al1m(SZ_WGLU)), 64 * kb, 64 * nb, scr, lane, MapId()); continue; } r -= I_GLU;
        if (r < 3 * I_BR) { const int z = r / I_BR, rr = r % I_BR, kb = rr / 32, nb = rr % 32;
            const float* src = FIN(IN_WBRP + z) + (size_t)l * 1024 * 2048;
            transpose_item(src, 2048, 1024, (bf16_t*)(F.ws + WS_WBR + l * al1m(SZ_WBR)) + (size_t)z * 2048 * 1024, 64 * kb, 64 * nb, scr, lane, MapId()); continue; } r -= 3 * I_BR;
        if (r < I_OUT) { const int kb = r / 32, nb = r % 32;
            transpose_item(FIN(IN_WOUT) + (size_t)l * 2048 * 2048, 2048, 2048, (bf16_t*)(F.ws + WS_WOUT + l * al1m(SZ_WOUT)), 64 * kb, 64 * nb, scr, lane, MapId()); continue; } r -= I_OUT;
        if (r < 4 * I_POOL) { const int z = r / I_POOL, rr = r % I_POOL, kb = rr / 4, nb = rr % 4;
            transpose_item(FIN(IN_WPOOL) + ((size_t)l * 4 + z) * 65536, 256, 256, (bf16_t*)(F.ws + WS_WPOOL + l * al1m(SZ_WPOOL)) + (size_t)z * 65536, 64 * kb, 64 * nb, scr, lane, MapId()); continue; } r -= 4 * I_POOL;
        {
            transpose_item(FIN(IN_WPHI) + ((size_t)l * 128 + r) * 4096, 64, 64, (bf16_t*)(F.ws + WS_WPHI + l * al1m(SZ_WPHI)) + (size_t)r * 4096, 0, 0, scr, lane, MapId()); }
    }
    for (int it = F.gw; it < 64; it += F.ngw) {
        const int l = it >> 5, j = (it >> 4) & 1, part = it & 15;
        const float* pe = FIN(IN_PE) + ((size_t)(l * 2 + j) * 64 + part * 4) * 64;
        const float* wp = FIN(IN_WPHI) + ((size_t)(l * 2 + j) * 64 + part * 4) * 4096;
        float s = 0.f;
#pragma unroll 16
        for (int i = 0; i < 256; ++i) s += pe[i] * wp[(size_t)i * 64 + lane];
        ((float*)(F.ws + WS_PEBP + l * al1m(SZ_PEBP)))[(j * 16 + part) * 64 + lane] = s;
    }
    for (int it = F.gw * 64 + lane; it < 2 * 4096; it += F.ngw * 64) {
        const int l = it >> 12, g = (it >> 6) & 63, n = it & 63;
        const double dt = exp_d((double)FIN(IN_LSTEP)[l * 64 + g]);
        const double lr = (double)FIN(IN_LRE)[(l * 64 + g) * 64 + n], li = (double)FIN(IN_LIM)[(l * 64 + g) * 64 + n];
        const double mag = exp_d(lr * dt); double sn, cs; sincos_d(li * dt, sn, cs);
        const double ar = mag * cs, ai = mag * sn, den = lr * lr + li * li;
        const double cr = ((ar - 1.0) * lr + ai * li) / den, ci = (ai * lr - (ar - 1.0) * li) / den;
        double pr = ar, pi = ai;
#pragma unroll
        for (int k = 0; k < 7; ++k) { const double t = pr * pr - pi * pi; pi = 2.0 * pr * pi; pr = t; }
        float* ab = (float*)(F.ws + WS_SAB + l * al1m(SZ_SAB)) + (g * 64 + n) * 4;
        ab[0] = (float)ar; ab[1] = (float)ai; ab[2] = (float)pr; ab[3] = (float)pi;
        float* bb = (float*)(F.ws + WS_SBB + l * al1m(SZ_SBB)) + (size_t)g * 16 * 128;
        const float* bre = FIN(IN_BRE) + ((size_t)(l * 64 + g) * 64 + n) * 16; const float* bim = FIN(IN_BIM) + ((size_t)(l * 64 + g) * 64 + n) * 16;
        unsigned* bb16 = (unsigned*)(F.ws + WS_SBB16 + l * al1m(SZ_SBB16));
        for (int c = 0; c < 16; c += 2) { const double br0 = bre[c], bi0 = bim[c], br1 = bre[c + 1], bi1 = bim[c + 1];
            const float r0 = (float)(cr * br0 - ci * bi0), i0 = (float)(cr * bi0 + ci * br0), r1 = (float)(cr * br1 - ci * bi1), i1 = (float)(cr * bi1 + ci * br1);
            bb[c * 128 + n] = r0; bb[c * 128 + 64 + n] = i0; bb[(c + 1) * 128 + n] = r1; bb[(c + 1) * 128 + 64 + n] = i1;
            bb16[(((g * 2 + 0) * 64 + n) * 16 + c) >> 1] = pk2(r0, r1); bb16[(((g * 2 + 1) * 64 + n) * 16 + c) >> 1] = pk2(i0, i1); }
        bf16_t* cm = (bf16_t*)(F.ws + WS_SCM + l * al1m(SZ_SCM)) + (size_t)g * 16 * 128;
        const float* cre = FIN(IN_CRE) + (size_t)(l * 64 + g) * 16 * 64; const float* cim = FIN(IN_CIM) + (size_t)(l * 64 + g) * 16 * 64;
        for (int c = 0; c < 16; ++c) *(unsigned*)(cm + c * 128 + 2 * n) = pk2(cre[c * 64 + n], -cim[c * 64 + n]);
    }
    bf16_t* H = (bf16_t*)(F.ws + WS_H);
    for (int m = F.gw; m < MROWS; m += F.ngw) rms_row_to_bf16(x_row_l0(F, m), FIN(IN_GPRE), H + (size_t)m * DM, lane);
}

__device__ __forceinline__ void phase_norm(Frame& F, int l) {
    const int lane = F.lane;
    const bf16_t* outb = (const bf16_t*)(F.ws + WS_OUTB);
    float* y0 = (float*)(F.ws + WS_Y0);
    bf16_t* H = (bf16_t*)(F.ws + WS_H);
    for (int r = F.bid; r < MROWS - MPT; r += F.G) {
        const int m = MPT + r, c0 = F.wave * 256 + 4 * lane;
        LAS float* red = (LAS float*)F.lds;
        const float* xrow = l == 0 ? FIN(IN_XS) + (size_t)r * DM : y0 + (size_t)m * DM;
        float* yrow = l == 0 ? y0 + (size_t)m * DM : F.out + O_YS + (size_t)r * DM;
        const f32x4 o = unpack4(*(const u32x2*)(outb + (size_t)m * DM + c0)), x = *(const f32x4*)(xrow + c0), g = *(const f32x4*)(FIN(IN_GPOST) + l * DM + c0);
        float s = wave_sum(o.x * o.x + o.y * o.y + o.z * o.z + o.w * o.w);
        __syncthreads();
        if (lane == 0) red[F.wave] = s;
        __syncthreads();
        s = 0.f;
#pragma unroll
        for (int w2 = 0; w2 < NWAVES; ++w2) s += red[w2];
        const float rstd = 1.f / sqrtf(s * (1.f / DM) + EPS);
        const f32x4 y = x + o * rstd * g;
        *(f32x4*)(yrow + c0) = y;
        if (l == 0) {
            float s2 = wave_sum(y.x * y.x + y.y * y.y + y.z * y.z + y.w * y.w);
            if (lane == 0) red[8 + F.wave] = s2;
            __syncthreads();
            s2 = 0.f;
#pragma unroll
            for (int w2 = 0; w2 < NWAVES; ++w2) s2 += red[8 + w2];
            const float rstd2 = 1.f / sqrtf(s2 * (1.f / DM) + EPS);
            const f32x4 g2 = *(const f32x4*)(FIN(IN_GPRE) + DM + c0);
            *(u32x2*)(H + (size_t)m * DM + c0) = pack4(y * rstd2 * g2);
        }
    }
    for (int m = F.gw; m < MPT; m += F.ngw) {
        const float* xrow = l == 0 ? x_row_l0(F, m) : y0 + (size_t)m * DM;
        float* yrow = l == 0 ? y0 + (size_t)m * DM : (m < MPT ? F.out + O_YP + (size_t)m * DM : F.out + O_YS + (size_t)(m - MPT) * DM);
        const float* gp = FIN(IN_GPOST) + l * DM;
        float v[4][8]; float s = 0.f;
#pragma unroll
        for (int j = 0; j < 4; ++j) { const u32x4 w = *(const u32x4*)(outb + (size_t)m * DM + 8 * (lane + 64 * j)); unpack8(w, v[j]);
#pragma unroll
            for (int e = 0; e < 8; ++e) s += v[j][e] * v[j][e]; }
        const float rstd = 1.f / sqrtf(wave_sum(s) * (1.f / DM) + EPS);
        float s2 = 0.f;
#pragma unroll
        for (int j = 0; j < 4; ++j) { const int c0 = 8 * (lane + 64 * j);
            const f32x4 g0 = *(const f32x4*)(gp + c0), g1 = *(const f32x4*)(gp + c0 + 4), x0 = *(const f32x4*)(xrow + c0), x1 = *(const f32x4*)(xrow + c0 + 4);
            f32x4 y0v, y1v;
#pragma unroll
            for (int e = 0; e < 4; ++e) { y0v[e] = x0[e] + v[j][e] * rstd * g0[e]; y1v[e] = x1[e] + v[j][4 + e] * rstd * g1[e]; v[j][e] = y0v[e]; v[j][4 + e] = y1v[e]; s2 += y0v[e] * y0v[e] + y1v[e] * y1v[e]; }
            *(f32x4*)(yrow + c0) = y0v; *(f32x4*)(yrow + c0 + 4) = y1v; }
        if (l == 0) {
            const float rstd2 = 1.f / sqrtf(wave_sum(s2) * (1.f / DM) + EPS);
            const float* g2 = FIN(IN_GPRE) + DM;
#pragma unroll
            for (int j = 0; j < 4; ++j) { const int c0 = 8 * (lane + 64 * j); const f32x4 g0 = *(const f32x4*)(g2 + c0), g1 = *(const f32x4*)(g2 + c0 + 4);
                f32x4 a, bq;
#pragma unroll
                for (int e = 0; e < 4; ++e) { a[e] = v[j][e] * rstd2 * g0[e]; bq[e] = v[j][4 + e] * rstd2 * g1[e]; }
                *(u32x4*)(H + (size_t)m * DM + c0) = pack8(a, bq); }
        }
    }
}
template <int KP>
__device__ __forceinline__ void skinny_stage(LAS unsigned char* lds, const bf16_t* A, int lda, int tid) {
    constexpr int CH = KP / 8;
#pragma unroll 8
    for (int i = tid; i < 32 * CH; i += NT) { const int r = i / CH, c = i % CH; *(LAS u32x4*)(lds + r * (KP * 2 + 16) + c * 16) = *(const u32x4*)(A + (size_t)r * lda + 8 * c); }
    __syncthreads();
}
template <int KP>
__device__ __forceinline__ void skinny_tile(const LAS unsigned char* lds, const bf16_t* Bt, int ldb, int n0, int kbeg, int klen, int lane, f32x4& d0, f32x4& d1) {
    const int rw = lane & 15, q = lane >> 4;
    const bf16_t* wrow = Bt + (size_t)(n0 + rw) * ldb + 32 * q;
    const LAS unsigned char* a0 = lds + rw * (KP * 2 + 16) + (kbeg + 32 * q) * 2;
    const LAS unsigned char* a1 = a0 + 16 * (KP * 2 + 16);
    d0 = (f32x4){0.f, 0.f, 0.f, 0.f}; d1 = d0;
#pragma unroll 4
    for (int k0 = 0; k0 < klen; k0 += 128) {
        bf16x8 w[4];
#pragma unroll
        for (int s = 0; s < 4; ++s) w[s] = *(const bf16x8*)(wrow + k0 + 8 * s);
#pragma unroll
        for (int s = 0; s < 4; ++s) { const bf16x8 b0 = *(const LAS bf16x8*)(a0 + k0 * 2 + 16 * s), b1 = *(const LAS bf16x8*)(a1 + k0 * 2 + 16 * s);
            d0 = __builtin_amdgcn_mfma_f32_16x16x32_bf16(w[s], b0, d0, 0, 0, 0); d1 = __builtin_amdgcn_mfma_f32_16x16x32_bf16(w[s], b1, d1, 0, 0, 0); }
    }
}

__device__ __forceinline__ void skinny_proj(Frame& F, int l) {
    constexpr int NTASK = NPROJ / 128;
    bf16_t* P = (bf16_t*)(F.ws + WS_P); float* gate = (float*)(F.ws + WS_GATE);
    const bf16_t* W = (const bf16_t*)(F.ws + WS_WIN + l * al1m(SZ_WIN));
    bool staged = false;
    const int ntile = (MPT / 256) * (NPROJ / 256), nlight = (ntile % F.G) ? F.G - (ntile % F.G) : F.G, first = F.G - nlight;
    for (int it = 0; it < 2; ++it) { int task;
        if (F.bid >= first) task = (F.bid - first) + it * nlight; else { if (it) break; task = 2 * nlight + (first - 1 - F.bid); }
        if (task >= NTASK) break;
        if (!staged) { skinny_stage<DM>(F.lds, (const bf16_t*)(F.ws + WS_H) + (size_t)MPT * DM, DM, F.tid); staged = true; }
        const int n0 = task * 128 + F.wave * 16; f32x4 d[2];
        skinny_tile<DM>(F.lds, W, DM, n0, 0, DM, F.lane, d[0], d[1]);
        const int n = n0 + 4 * (F.lane >> 4), pn = n >> 8;
        int mode; if (pn < 4) mode = 0; else if (pn < 8) mode = 1; else if (pn < 12) mode = 5; else if (pn < 16) mode = 3; else if (pn < 18) mode = 0;
        else if (pn < 22) mode = 1; else if (pn < 26) mode = 0; else if (pn < 30) mode = 1; else if (pn < 54) mode = 2; else mode = 4;
#pragma unroll
        for (int tt = 0; tt < 2; ++tt) { const int t = 16 * tt + (F.lane & 15), row = MPT + t; f32x4 v = d[tt];
            if (mode == 4) { const int c = n - C_AG; if (c < 48) {
#pragma unroll
                for (int j = 0; j < 4; ++j) v[j] = sigmoidf_(v[j]);
                *(f32x4*)(gate + (size_t)row * 64 + c) = v; } }
            else {
                if (mode == 3) *(f32x4*)(F.out + O_KVS + ((size_t)l * 32 + t) * 1024 + n - C_CK) = v;
                if (mode == 5) v = v * SM_SCALE_L2E;
                if (mode == 1) {
#pragma unroll
                    for (int j = 0; j < 4; ++j) v[j] = siluf_(v[j]); }
                if (mode == 2) {
#pragma unroll
                    for (int j = 0; j < 4; ++j) v[j] = sigmoidf_(v[j]); }
                *(u32x2*)(P + (size_t)row * NPROJ + n) = pack4(v);
            } }
    }
    __syncthreads();
}
__device__ __forceinline__ void skinny_pool(Frame& F, int l) {
    const bf16_t* P = (const bf16_t*)(F.ws + WS_P); bf16_t* apool = (bf16_t*)(F.ws + WS_ABR);
    const bf16_t* W = (const bf16_t*)(F.ws + WS_WPOOL + l * al1m(SZ_WPOOL)); const float* pscale = FIN(IN_PSCALE) + l * 1024;
    bool staged = false;
    for (int task = F.G - 1 - F.bid; task < 8; task += F.G) {
        if (!staged) { skinny_stage<1024>(F.lds, (const bf16_t*)(F.ws + WS_DIFF) + (size_t)MPT * 1024, 1024, F.tid); staged = true; }
        const int z = task >> 1, n0 = (task & 1) * 128 + F.wave * 16; f32x4 d[2];
        skinny_tile<1024>(F.lds, W + (size_t)z * 65536, 256, n0, z * 256, 256, F.lane, d[0], d[1]);
        const int col = z * 256 + n0 + 4 * (F.lane >> 4);
        const f32x4 ps = *(const f32x4*)(pscale + col);
#pragma unroll
        for (int tt = 0; tt < 2; ++tt) { const int row = MPT + 16 * tt + (F.lane & 15);
            const f32x4 zf = unpack4(*(const u32x2*)(P + (size_t)row * NPROJ + C_PZ + col));
            *(u32x2*)(apool + (size_t)row * 1024 + col) = pack4(d[tt] * ps * zf); }
    }
    __syncthreads();
}
__device__ __forceinline__ void skinny_glu(Frame& F, int l) {
    const bf16_t* P = (const bf16_t*)(F.ws + WS_P); const bf16_t* Z = (const bf16_t*)(F.ws + WS_Z); bf16_t* assm = (bf16_t*)(F.ws + WS_ABR + 2 * SZ_ABR1);
    const bf16_t* W = (const bf16_t*)(F.ws + WS_WGLU + l * al1m(SZ_WGLU));
    bool staged = false;
    for (int task = F.G - 17 - F.bid; task < 8; task += F.G) {
        if (task < 0) continue;
        if (!staged) { skinny_stage<1024>(F.lds, Z + (size_t)MPT * 1024, 1024, F.tid); staged = true; }
        const int n0 = task * 128 + F.wave * 16; f32x4 d[2];
        skinny_tile<1024>(F.lds, W, 1024, n0, 0, 1024, F.lane, d[0], d[1]);
        const int col = n0 + 4 * (F.lane >> 4);
#pragma unroll
        for (int tt = 0; tt < 2; ++tt) { const int row = MPT + 16 * tt + (F.lane & 15);
            const f32x4 zf = unpack4(*(const u32x2*)(Z + (size_t)row * 1024 + col)), sf = unpack4(*(const u32x2*)(P + (size_t)row * NPROJ + C_SZ + col));
            f32x4 v = d[tt];
#pragma unroll
            for (int j = 0; j < 4; ++j) v[j] = zf[j] * sigmoidf_(v[j]) * sf[j];
            *(u32x2*)(assm + (size_t)row * 1024 + col) = pack4(v); }
    }
    __syncthreads();
}
__device__ __forceinline__ void skinny_stage_att(Frame& F) {
    const bf16_t* P = (const bf16_t*)(F.ws + WS_P); const float* so = (const float*)(F.ws + WS_SOACC); const float* gate = (const float*)(F.ws + WS_GATE);
#pragma unroll 2
    for (int i = F.tid; i < 32 * 128; i += NT) { const int r = i >> 7, c = i & 127, head = c >> 3, d0 = (c & 7) * 8, row = MPT + r;
        const int unit = (r >> 2) * 16 + (head >> 2) * 4 + (r & 3);
        const float* sp = so + (size_t)unit * 768 + (head & 3) * 64 + d0; const float* gt = gate + (size_t)row * 64 + head * 3;
        const float g0 = gt[0], g1 = gt[1], g2 = gt[2];
        float zf[8]; unpack8(*(const u32x4*)(P + (size_t)row * NPROJ + C_AZ + head * 64 + d0), zf);
        f32x4 o[2];
#pragma unroll
        for (int h = 0; h < 2; ++h) { const f32x4 a = *(const f32x4*)(sp + 4 * h), b = *(const f32x4*)(sp + 256 + 4 * h), w = *(const f32x4*)(sp + 512 + 4 * h);
#pragma unroll
            for (int j = 0; j < 4; ++j) o[h][j] = (g0 * a[j] + g1 * b[j] + g2 * w[j]) * zf[4 * h + j]; }
        *(LAS u32x4*)(F.lds + r * (1024 * 2 + 16) + c * 16) = pack8(o[0], o[1]); }
    __syncthreads();
}
__device__ __forceinline__ void skinny_branch(Frame& F, int l) {
    const bf16_t* P = (const bf16_t*)(F.ws + WS_P); float* brp = (float*)(F.ws + WS_BRP);
    const bf16_t* W = (const bf16_t*)(F.ws + WS_WBR + l * al1m(SZ_WBR));
    for (int task = F.G - 1 - F.bid; task < 48; task += F.G) {
        const int z = task >> 4, n0 = (task & 15) * 128 + F.wave * 16; f32x4 d[2];
        __syncthreads();
        if (z == 1) skinny_stage_att(F);
        else skinny_stage<1024>(F.lds, (const bf16_t*)(F.ws + WS_ABR) + (size_t)z * MPAD * 1024 + (size_t)MPT * 1024, 1024, F.tid);
        skinny_tile<1024>(F.lds, W + (size_t)z * 2048 * 1024, 1024, n0, 0, 1024, F.lane, d[0], d[1]);
        const int col = n0 + 4 * (F.lane >> 4);
#pragma unroll
        for (int tt = 0; tt < 2; ++tt) { const int t = 16 * tt + (F.lane & 15), row = MPT + t;
            const f32x4 gm = unpack4(*(const u32x2*)(P + (size_t)row * NPROJ + C_MG + z * 2048 + col));
            *(f32x4*)(brp + ((size_t)z * 32 + t) * DM + col) = d[tt] * gm; }
    }
    __syncthreads();
}
__device__ __forceinline__ void skinny_out(Frame& F, int l) {
    const float* brp = (const float*)(F.ws + WS_BRP); bf16_t* outb = (bf16_t*)(F.ws + WS_OUTB);
    const bf16_t* W = (const bf16_t*)(F.ws + WS_WOUT + l * al1m(SZ_WOUT));
    bool staged = false;
    for (int task = F.G - 1 - F.bid; task < 64; task += F.G) {
        if (!staged) {
#pragma unroll 4
            for (int i = F.tid; i < 32 * (DM / 4); i += NT) { const int r = i / (DM / 4), c = i % (DM / 4);
                const f32x4 s = *(const f32x4*)(brp + (size_t)r * DM + 4 * c) + *(const f32x4*)(brp + (size_t)(32 + r) * DM + 4 * c) + *(const f32x4*)(brp + (size_t)(64 + r) * DM + 4 * c);
                *(LAS u32x2*)(F.lds + r * (DM * 2 + 16) + c * 8) = pack4(s); }
            __syncthreads(); staged = true; }
        const int tile = F.wave & 1, kq = F.wave >> 1, n0 = task * 32 + tile * 16; f32x4 d[2];
        skinny_tile<DM>(F.lds, W + kq * 512, DM, n0, kq * 512, 512, F.lane, d[0], d[1]);
        __syncthreads();
        LAS f32x4* red = (LAS f32x4*)F.lds;
        red[(F.wave * 2 + 0) * 64 + F.lane] = d[0]; red[(F.wave * 2 + 1) * 64 + F.lane] = d[1];
        staged = false;
        __syncthreads();
        if (kq == 0) {
#pragma unroll
            for (int tt = 0; tt < 2; ++tt) { f32x4 a = d[tt];
#pragma unroll
                for (int k2 = 1; k2 < 4; ++k2) a += red[((2 * k2 + tile) * 2 + tt) * 64 + F.lane];
                *(u32x2*)(outb + (size_t)(MPT + 16 * tt + (F.lane & 15)) * DM + n0 + 4 * (F.lane >> 4)) = pack4(a); } }
        __syncthreads();
    }
    __syncthreads();
}
__device__ __forceinline__ int keypos(int key) { return (key & ~12) | ((key & 4) << 1) | ((key & 8) >> 1); }

template <int W>
__device__ __forceinline__ void pool_diff_load(const bf16_t* P, const float* spool, int m, int c0, f32x4 (&v)[W]) {
    if (m < MPT) {
        const int s = m & (SEQ - 1);
#pragma unroll
        for (int j = 0; j < W; ++j) v[j] = (j <= s) ? unpack4(*(const u32x2*)(P + (size_t)(m - j) * NPROJ + C_PU + c0)) : (f32x4){0.f, 0.f, 0.f, 0.f};
    } else {
        const int b = (m - MPT) >> 2, i = (m - MPT) & 3;
#pragma unroll
        for (int j = 0; j < W; ++j) { const int idx = 15 + i - j;
            v[j] = (idx >= 15) ? unpack4(*(const u32x2*)(P + (size_t)(MPT + b * 4 + idx - 15) * NPROJ + C_PU + c0)) : *(const f32x4*)(spool + ((size_t)b * 15 + idx) * 1024 + c0); }
    }
}
template <int W>
__device__ __forceinline__ void pool_diff_store(bf16_t* D, int m, int c0, const f32x4 (&v)[W]) {
    int cnt = W; if (m < MPT) { const int s = m & (SEQ - 1); cnt = (s + 1 < W) ? s + 1 : W; }
    f32x4 sum = v[0];
#pragma unroll
    for (int j = 1; j < W; ++j) sum += v[j];
    *(u32x2*)(D + (size_t)m * 1024 + c0) = pack4(sum * (1.f / (float)cnt) - v[0]);
}
__device__ __forceinline__ void s2_pool_diff(Frame& F, int l) {
    const bf16_t* P = (const bf16_t*)(F.ws + WS_P); bf16_t* D = (bf16_t*)(F.ws + WS_DIFF);
    const float* spool = FIN(IN_SPOOL) + (size_t)l * SB * 15 * 1024;
    const int c0 = 4 * F.lane;
    for (int m = F.gw; m < MROWS; m += F.ngw) {
        f32x4 v2[2], v4[4], v8[8], v16[16];
        pool_diff_load<2>(P, spool, m, c0, v2); pool_diff_load<4>(P, spool, m, 256 + c0, v4); pool_diff_load<8>(P, spool, m, 512 + c0, v8); pool_diff_load<16>(P, spool, m, 768 + c0, v16);
        pool_diff_store<2>(D, m, c0, v2); pool_diff_store<4>(D, m, 256 + c0, v4); pool_diff_store<8>(D, m, 512 + c0, v8); pool_diff_store<16>(D, m, 768 + c0, v16);
    }
}

__device__ __forceinline__ void store8f(float* dst, const u32x4& x) { float f[8]; unpack8(x, f); *(f32x4*)dst = (f32x4){f[0], f[1], f[2], f[3]}; *(f32x4*)(dst + 4) = (f32x4){f[4], f[5], f[6], f[7]}; }

__device__ __forceinline__ void s2_state_outputs(Frame& F, int l) {
    const bf16_t* P = (const bf16_t*)(F.ws + WS_P);
    const int gt = F.gw * 64 + F.lane, ngt = F.ngw * 64;
    for (int it = gt; it < PB * 15 * 128; it += ngt) { const int c0 = (it & 127) * 8, r = (it >> 7) % 15, b = (it >> 7) / 15;
        store8f(F.out + O_POOLP + (((size_t)l * PB + b) * 15 + r) * 1024 + c0, *(const u32x4*)(P + (size_t)(b * SEQ + SEQ - 15 + r) * NPROJ + C_PU + c0)); }
    for (int it = gt; it < SB * 15 * 128; it += ngt) { const int c0 = (it & 127) * 8, r = (it >> 7) % 15, b = (it >> 7) / 15, e = 4 + r;
        float* dst = F.out + O_POOLS + (((size_t)l * SB + b) * 15 + r) * 1024 + c0;
        if (e < 15) { const float* sp = FIN(IN_SPOOL) + (((size_t)l * SB + b) * 15 + e) * 1024 + c0; *(f32x4*)dst = *(const f32x4*)sp; *(f32x4*)(dst + 4) = *(const f32x4*)(sp + 4); }
        else store8f(dst, *(const u32x4*)(P + (size_t)(MPT + b * 4 + e - 15) * NPROJ + C_PU + c0)); }
    for (int it = gt; it < PB * 512 * 64; it += ngt) { const int c0 = (it & 63) * 8, r = (it >> 6) & 511, b = it >> 15;
        store8f(F.out + O_WINP + (((size_t)l * PB + b) * 512 + r) * 512 + c0, *(const u32x4*)(P + (size_t)(b * SEQ + SEQ - 512 + r) * NPROJ + C_WK + c0)); }
    for (int it = gt; it < SB * 512 * 64; it += ngt) { const int c0 = (it & 63) * 8, r = (it >> 6) & 511, b = it >> 15;
        float* dst = F.out + O_WINS + (((size_t)l * SB + b) * 512 + r) * 512 + c0;
        if (r < 508) { const float* sp = FIN(IN_SWIN) + (((size_t)l * SB + b) * 512 + r + 4) * 512 + c0; *(f32x4*)dst = *(const f32x4*)sp; *(f32x4*)(dst + 4) = *(const f32x4*)(sp + 4); }
        else store8f(dst, *(const u32x4*)(P + (size_t)(MPT + b * 4 + r - 508) * NPROJ + C_WK + c0)); }
}

__device__ __forceinline__ void s2_vt_images(Frame& F) {
    const bf16_t* P = (const bf16_t*)(F.ws + WS_P);
    for (int it = F.gw; it < 2 * PB * 4 * 64; it += F.ngw) {
        const int which = it >> 9, b = (it >> 8) & 1, kvh = (it >> 6) & 3, blk = it & 63;
        const bf16_t* src = P + (size_t)(b * SEQ + blk * 64 + F.lane) * NPROJ + (which ? C_WK : C_SK) + kvh * 64;
        bf16_t* img = (bf16_t*)(F.ws + (which ? WS_KTWIN : WS_KTSEL)) + (size_t)((b * 4 + kvh) * 64 + blk) * 4096 + F.lane * 8;
        u32x4 v[8];
#pragma unroll
        for (int j = 0; j < 8; ++j) v[j] = *(const u32x4*)(src + 8 * j);
#pragma unroll
        for (int j = 0; j < 8; ++j) *(u32x4*)(img + j * 512) = v[j];
    }
    for (int it = F.gw; it < 2 * PB * 4 * 64; it += F.ngw) {
        const int which = it >> 9, b = (it >> 8) & 1, kvh = (it >> 6) & 3, blk = it & 63;
        const bf16_t* src = P + (size_t)(b * SEQ + blk * 64 + F.lane) * NPROJ + (which ? C_WV : C_SV) + kvh * 64;
        const int pos = keypos(F.lane);
        bf16_t* img = (bf16_t*)(F.ws + (which ? WS_VTWIN : WS_VTSEL)) + (size_t)((b * 4 + kvh) * 64 + blk) * 4096 + (pos >> 3) * 512 + (pos & 7);
        u32x4 v[8];
#pragma unroll
        for (int j = 0; j < 8; ++j) v[j] = *(const u32x4*)(src + 8 * j);
#pragma unroll
        for (int j = 0; j < 8; ++j) {
            img[(8 * j + 0) * 8] = (bf16_t)(v[j].x & 0xffffu); img[(8 * j + 1) * 8] = (bf16_t)(v[j].x >> 16);
            img[(8 * j + 2) * 8] = (bf16_t)(v[j].y & 0xffffu); img[(8 * j + 3) * 8] = (bf16_t)(v[j].y >> 16);
            img[(8 * j + 4) * 8] = (bf16_t)(v[j].z & 0xffffu); img[(8 * j + 5) * 8] = (bf16_t)(v[j].z >> 16);
            img[(8 * j + 6) * 8] = (bf16_t)(v[j].w & 0xffffu); img[(8 * j + 7) * 8] = (bf16_t)(v[j].w >> 16); }
    }
}

template <bool SAMPLE>
__device__ __forceinline__ void compress_unit(Frame& F, int l, int unit) {
    const int lane = F.lane, w = F.wave, col = lane & 15, q = lane >> 4, nl = col >> 2, k = col & 3;
    const int b = SAMPLE ? unit >> 5 : unit >> 3, n0 = SAMPLE ? (unit & 31) * 8 : (unit & 7) * 8;
    const bf16_t* wphi = (const bf16_t*)(F.ws + WS_WPHI + l * al1m(SZ_WPHI));
    const bf16_t* P = (const bf16_t*)(F.ws + WS_P);
    const float* cache = FIN(IN_CACHE); const int* pt = (const int*)FIN(IN_PT);
    f32x4 acc[2][2][4];
#pragma unroll
    for (int j = 0; j < 2; ++j)
#pragma unroll
        for (int nt = 0; nt < 2; ++nt)
#pragma unroll
            for (int et = 0; et < 4; ++et) acc[j][nt][et] = (f32x4){0.f, 0.f, 0.f, 0.f};
    size_t xoff[2];
#pragma unroll
    for (int nt = 0; nt < 2; ++nt) { const int blk = n0 + 4 * nt + nl;
        if (SAMPLE) { const int page = pt[b * 128 + (blk >> 1)]; xoff[nt] = ((((size_t)l * NPOOL + page) * 128 + (blk & 1) * 64) * 4) * 256 + k * 64 + 8 * q; }
        else xoff[nt] = (size_t)(b * SEQ + blk * 64) * NPROJ + C_CK + k * 64 + 8 * q; }
    bf16x8 ra[2][2][4];
    f32x4 rx[2][2][2][2];
#define CMP_LOAD(J, LPOS) do { _Pragma("unroll") for (int dc = 0; dc < 2; ++dc) { \
        _Pragma("unroll") for (int et = 0; et < 4; ++et) ra[J][dc][et] = *(const bf16x8*)(wphi + ((size_t)((J) * 64 + (LPOS)) * 64 + 16 * et + col) * 64 + 32 * dc + 8 * q); \
        _Pragma("unroll") for (int nt = 0; nt < 2; ++nt) { \
            if (SAMPLE) { const float* s_ = cache + xoff[nt] + ((size_t)(LPOS) * 4 + (J)) * 256 + 32 * dc; rx[J][dc][nt][0] = __builtin_nontemporal_load((const f32x4*)s_); rx[J][dc][nt][1] = __builtin_nontemporal_load((const f32x4*)(s_ + 4)); } \
            else rx[J][dc][nt][0] = __builtin_bit_cast(f32x4, *(const bf16x8*)(P + xoff[nt] + (size_t)(LPOS) * NPROJ + (J) * 256 + 32 * dc)); } } } while (0)
#define CMP_MMA(J) do { _Pragma("unroll") for (int dc = 0; dc < 2; ++dc) _Pragma("unroll") for (int nt = 0; nt < 2; ++nt) { \
        const bf16x8 bx_ = SAMPLE ? __builtin_bit_cast(bf16x8, pack8(rx[J][dc][nt][0], rx[J][dc][nt][1])) : __builtin_bit_cast(bf16x8, rx[J][dc][nt][0]); \
        _Pragma("unroll") for (int et = 0; et < 4; ++et) acc[J][nt][et] = __builtin_amdgcn_mfma_f32_16x16x32_bf16(ra[J][dc][et], bx_, acc[J][nt][et], 0, 0, 0); } } while (0)
    CMP_LOAD(0, w * 8);
#pragma unroll 1
    for (int li = 0; li < 8; ++li) { const int lpos = w * 8 + li;
        CMP_LOAD(1, lpos); __builtin_amdgcn_sched_barrier(0);
        CMP_MMA(0); __builtin_amdgcn_sched_barrier(0);
        if (li < 7) CMP_LOAD(0, lpos + 1);
        __builtin_amdgcn_sched_barrier(0);
        CMP_MMA(1); __builtin_amdgcn_sched_barrier(0);
    }
#undef CMP_LOAD
#undef CMP_MMA
    LAS float* red = (LAS float*)F.lds;
#pragma unroll
    for (int j = 0; j < 2; ++j)
#pragma unroll
        for (int nt = 0; nt < 2; ++nt)
#pragma unroll
            for (int et = 0; et < 4; ++et)
#pragma unroll
                for (int i = 0; i < 4; ++i) red[(w * 64 + ((j * 2 + nt) * 4 + et) * 4 + i) * 64 + lane] = acc[j][nt][et][i];
    __syncthreads();
    const LAS float* pb = (const LAS float*)(F.lds + 131072);
    bf16_t* kc = (bf16_t*)(F.ws + (SAMPLE ? WS_KCS : WS_KCP)); bf16_t* vct = (bf16_t*)(F.ws + (SAMPLE ? WS_VCTS : WS_VCTP));
    constexpr int NBLK = SAMPLE ? 256 : 64;
    for (int o = F.tid; o < 4096; o += NT) { const int r = o >> 6, ln = o & 63;
        float s = 0.f;
#pragma unroll
        for (int ww = 0; ww < 8; ++ww) s += red[(ww * 64 + r) * 64 + ln];
        const int j = r >> 5, nt = (r >> 4) & 1, et = (r >> 2) & 3, i = r & 3, e = 16 * et + 4 * (ln >> 4) + i, cc = ln & 15, blk = n0 + 4 * nt + (cc >> 2), kk = cc & 3;
        s += pb[j * 64 + e];
        if (j == 0) kc[((size_t)(b * 4 + kk) * NBLK + blk) * 64 + e] = (bf16_t)f2bf(s);
        else vct[(((size_t)(b * 4 + kk) * (NBLK / 64) + (blk >> 6)) * 64 + e) * 64 + keypos(blk & 63)] = (bf16_t)f2bf(s);
    }
    __syncthreads();
}

__device__ __forceinline__ void compress_prompt_piece(Frame& F, int l, int piece) {
    const int lane = F.lane, w = F.wave, col = lane & 15, q = lane >> 4, nl = col >> 2, k = col & 3;
    const int ntile = piece >> 3, j = (piece >> 2) & 1, et = piece & 3, b = ntile >> 4, n0 = (ntile & 15) * 4;
    const bf16_t* wphi = (const bf16_t*)(F.ws + WS_WPHI + l * al1m(SZ_WPHI)) + ((size_t)(j * 64) * 64 + 16 * et + col) * 64 + 8 * q;
    const bf16_t* xp = (const bf16_t*)(F.ws + WS_P) + (size_t)(b * SEQ + (n0 + nl) * 64) * NPROJ + C_CK + j * 256 + k * 64 + 8 * q;
    bf16x8 a[16], x[16];
#pragma unroll
    for (int li = 0; li < 8; ++li)
#pragma unroll
        for (int dc = 0; dc < 2; ++dc) { const int lpos = w * 8 + li;
            a[li * 2 + dc] = *(const bf16x8*)(wphi + (size_t)lpos * 4096 + 32 * dc); x[li * 2 + dc] = *(const bf16x8*)(xp + (size_t)lpos * NPROJ + 32 * dc); }
    f32x4 acc = {0.f, 0.f, 0.f, 0.f};
#pragma unroll
    for (int i = 0; i < 16; ++i) acc = __builtin_amdgcn_mfma_f32_16x16x32_bf16(a[i], x[i], acc, 0, 0, 0);
    LAS float* red = (LAS float*)F.lds;
    __syncthreads();
#pragma unroll
    for (int i = 0; i < 4; ++i) red[(w * 4 + i) * 64 + lane] = acc[i];
    __syncthreads();
    if (F.tid < 256) { const int i = F.tid >> 6, ln = F.tid & 63; float s = 0.f;
#pragma unroll
        for (int ww = 0; ww < 8; ++ww) s += red[(ww * 4 + i) * 64 + ln];
        const int e = 16 * et + 4 * (ln >> 4) + i, cc = ln & 15, blk = n0 + (cc >> 2), kk = cc & 3;
        s += ((const LAS float*)(F.lds + 131072))[j * 64 + e];
        if (j == 0) ((bf16_t*)(F.ws + WS_KCP))[(size_t)(b * 4 + kk) * 4096 + (e >> 3) * 512 + blk * 8 + (e & 7)] = (bf16_t)f2bf(s);
        else { const int pos = keypos(blk); ((bf16_t*)(F.ws + WS_VCTP))[(size_t)(b * 4 + kk) * 4096 + (pos >> 3) * 512 + e * 8 + (pos & 7)] = (bf16_t)f2bf(s); } }
    __syncthreads();
}

__device__ __forceinline__ void s2_compress(Frame& F, int l) {
    if (F.tid < 128) { const float* pp = (const float*)(F.ws + WS_PEBP + l * al1m(SZ_PEBP)); float s = 0.f;
#pragma unroll
        for (int p = 0; p < 16; ++p) s += pp[((F.tid >> 6) * 16 + p) * 64 + (F.tid & 63)];
        ((LAS float*)(F.lds + 131072))[F.tid] = s; }
    __syncthreads();
    for (int u = F.bid; u < 256; u += F.G) compress_unit<true>(F, l, u);
    for (int u = F.bid; u < 256; u += F.G) compress_prompt_piece(F, l, u);
}

#ifndef NSA_SGB
#define NSA_SGB 1
#endif
#define MFMA32(a, b, c) __builtin_amdgcn_mfma_f32_32x32x16_bf16((a), (b), (c), 0, 0, 0)
constexpr float NEG_BIG = -1e30f;
constexpr int AL_K = 0, AL_V = 8192, AL_SLOT = 16384  , AL_MASK = 4 * AL_SLOT  , AL_UNION = AL_MASK + 512,
              AL_TOT = 66560  , AL_IMP = AL_TOT  ;
__device__ __forceinline__ void dma16(const void* src, LAS unsigned char* dst) { __builtin_amdgcn_global_load_lds((const unsigned*)src, (LAS unsigned*)dst, 16, 0, 0); }
__device__ __forceinline__ void tile_dma(const bf16_t* kimg, const bf16_t* vimg, LAS unsigned char* slot, int w, int lane) {
    dma16(kimg + (unsigned)w * 512u + 8u * (unsigned)lane, slot + AL_K + w * 1024);
    dma16(vimg + (unsigned)w * 512u + 8u * (unsigned)lane, slot + AL_V + w * 1024);
}

template <int CTRL> __device__ __forceinline__ float quad_xor(float x) { return __int_as_float(__builtin_amdgcn_update_dpp(0, __float_as_int(x), CTRL, 0xF, 0xF, false)); }
struct FlashState { f32x16 o[2]; float m, l; };
__device__ __forceinline__ void flash_reset(FlashState& S) {
#pragma unroll
    for (int i = 0; i < 16; ++i) { S.o[0][i] = 0.f; S.o[1][i] = 0.f; }
    S.m = 0.f; S.l = 0.f;
}
__device__ __forceinline__ void flash_scores(const LAS unsigned char* kbuf, const bf16x8 (&qf)[4], int r, int h, float init, f32x16& s0, f32x16& s1) {
    bf16x8 kf[8];
#pragma unroll
    for (int ks = 0; ks < 4; ++ks) { kf[2 * ks] = *(const LAS bf16x8*)(kbuf + (2 * ks + h) * 1024 + r * 16); kf[2 * ks + 1] = *(const LAS bf16x8*)(kbuf + (2 * ks + h) * 1024 + (32 + r) * 16); }
    __builtin_amdgcn_sched_barrier(0);
#pragma unroll
    for (int i = 0; i < 16; ++i) { s0[i] = init; s1[i] = init; }
#pragma unroll
    for (int ks = 0; ks < 4; ++ks) { s0 = MFMA32(kf[2 * ks], qf[ks], s0); s1 = MFMA32(kf[2 * ks + 1], qf[ks], s1); }
}
__device__ __forceinline__ bf16x8 pack_p(const f32x16& p, int s) {
    u32x4 w; w.x = pk2(p[8 * s], p[8 * s + 1]); w.y = pk2(p[8 * s + 2], p[8 * s + 3]); w.z = pk2(p[8 * s + 4], p[8 * s + 5]); w.w = pk2(p[8 * s + 6], p[8 * s + 7]);
    return __builtin_bit_cast(bf16x8, w);
}
__device__ __forceinline__ void flash_vload(const LAS unsigned char* vbuf, int r, int h, bf16x8 (&vf)[8]) {
#pragma unroll
    for (int sub = 0; sub < 2; ++sub)
#pragma unroll
        for (int s = 0; s < 2; ++s)
#pragma unroll
            for (int dt = 0; dt < 2; ++dt) vf[(sub * 2 + s) * 2 + dt] = *(const LAS bf16x8*)(vbuf + (4 * sub + 2 * s + h) * 1024 + (32 * dt + r) * 16);
    __builtin_amdgcn_sched_barrier(0);
}
__device__ __forceinline__ void flash_pv(const bf16x8 (&vf)[8], const f32x16& p0, const f32x16& p1, f32x16 (&o)[2]) {
#pragma unroll
    for (int sub = 0; sub < 2; ++sub)
#pragma unroll
        for (int s = 0; s < 2; ++s) {
            const bf16x8 pb = pack_p(sub ? p1 : p0, s);
#pragma unroll
            for (int dt = 0; dt < 2; ++dt) o[dt] = MFMA32(vf[(sub * 2 + s) * 2 + dt], pb, o[dt]);
        }
}
__device__ __forceinline__ float xhalf_max(float x) {
    const auto r = __builtin_amdgcn_permlane32_swap(__float_as_uint(x), __float_as_uint(x), false, false);
    return fmaxf(__uint_as_float(r[0]), __uint_as_float(r[1]));
}
__device__ __forceinline__ void flash_mask(f32x16& s0, f32x16& s1, int lo, int hi, int h) {
#pragma unroll
    for (int i = 0; i < 16; ++i) { const int key = (i & 3) + 8 * (i >> 2) + 4 * h;
        s0[i] = (key >= lo && key <= hi) ? s0[i] : -INFINITY; s1[i] = (key + 32 >= lo && key + 32 <= hi) ? s1[i] : -INFINITY; }
}
__device__ __forceinline__ float flash_rowmax(const f32x16& s0, const f32x16& s1) {
    float mx = -INFINITY;
#pragma unroll
    for (int i = 0; i < 16; ++i) asm("v_max3_f32 %0, %1, %2, %3" : "=v"(mx) : "v"(mx), "v"(s0[i]), "v"(s1[i]));
    return xhalf_max(mx);
}
__device__ __forceinline__ void flash_first(FlashState& S, f32x16& s0, f32x16& s1, int lo, int hi, int h, bool masked) {
    if (masked) flash_mask(s0, s1, lo, hi, h);
    S.m = fmaxf(flash_rowmax(s0, s1), NEG_BIG);
    float ls = 0.f;
#pragma unroll
    for (int i = 0; i < 16; ++i) { s0[i] = __builtin_amdgcn_exp2f(s0[i] - S.m); s1[i] = __builtin_amdgcn_exp2f(s1[i] - S.m); ls += s0[i] + s1[i]; }
    S.l = ls;
}
__device__ __forceinline__ void flash_next(FlashState& S, f32x16& s0, f32x16& s1, float mused, int lo, int hi, int h, bool masked, bool first) {
    if (masked) flash_mask(s0, s1, lo, hi, h);
    const float corr = S.m - mused;
    if (__ballot(corr != 0.f) != 0ull) {
#pragma unroll
        for (int i = 0; i < 16; ++i) { s0[i] -= corr; s1[i] -= corr; } }
    const float mx = flash_rowmax(s0, s1);
    if (__ballot(mx > SM_THR || (first && mx < -SM_THR)) != 0ull) {
        const float d = (mx > NEG_BIG) ? (first ? mx : fmaxf(mx, 0.f)) : 0.f, alpha = __builtin_amdgcn_exp2f(-d);
        S.m += d; S.l *= alpha;
#pragma unroll
        for (int i = 0; i < 16; ++i) { S.o[0][i] *= alpha; S.o[1][i] *= alpha; s0[i] -= d; s1[i] -= d; }
    }
    float ls = 0.f;
#pragma unroll
    for (int i = 0; i < 16; ++i) { s0[i] = __builtin_amdgcn_exp2f(s0[i]); s1[i] = __builtin_amdgcn_exp2f(s1[i]); ls += s0[i] + s1[i]; }
    S.l += ls;
}

__device__ __forceinline__ void flash_kload(const LAS unsigned char* kbuf, int r, int h, bf16x8 (&kf)[8]) {
#pragma unroll
    for (int ks = 0; ks < 4; ++ks) { kf[2 * ks] = *(const LAS bf16x8*)(kbuf + (2 * ks + h) * 1024 + r * 16); kf[2 * ks + 1] = *(const LAS bf16x8*)(kbuf + (2 * ks + h) * 1024 + (32 + r) * 16); }
    __builtin_amdgcn_sched_barrier(0);
}
struct TileCtl { bool en, masked; int lo, hi; };
__device__ __forceinline__ void flash_pair(FlashState& S, const LAS unsigned char* ka, const LAS unsigned char* va, const LAS unsigned char* kb2, const LAS unsigned char* vb2,
                                           const bf16x8 (&qf)[4], const TileCtl& A, const TileCtl& B, bool first, int r, int h) {
    bf16x8 kf[8]; f32x16 a0, a1, b0, b1;
    flash_kload(ka, r, h, kf);
    { const float init = A.en ? -S.m : -INFINITY;
#pragma unroll
        for (int i = 0; i < 16; ++i) { a0[i] = init; a1[i] = init; }
#pragma unroll
        for (int ks = 0; ks < 4; ++ks) { a0 = MFMA32(kf[2 * ks], qf[ks], a0); a1 = MFMA32(kf[2 * ks + 1], qf[ks], a1); } }
    if (A.masked) flash_mask(a0, a1, A.lo, A.hi, h);
    { const float mx = flash_rowmax(a0, a1);
        if (__ballot(mx > SM_THR || (first && mx < -SM_THR)) != 0ull) { const float d = (mx > NEG_BIG) ? (first ? mx : fmaxf(mx, 0.f)) : 0.f, alpha = __builtin_amdgcn_exp2f(-d); S.m += d; S.l *= alpha;
#pragma unroll
            for (int i = 0; i < 16; ++i) { S.o[0][i] *= alpha; S.o[1][i] *= alpha; a0[i] -= d; a1[i] -= d; } } }
    flash_kload(kb2, r, h, kf);
    { const float init = B.en ? -S.m : -INFINITY;
#pragma unroll
        for (int i = 0; i < 16; ++i) { b0[i] = init; b1[i] = init; } }
    __builtin_amdgcn_sched_barrier(0);
#pragma unroll
    for (int k = 0; k < 8; ++k) {
        if (k & 1) b1 = MFMA32(kf[k], qf[k >> 1], b1); else b0 = MFMA32(kf[k], qf[k >> 1], b0);
#pragma unroll
        for (int e = 0; e < 4; ++e) { const int idx = 4 * k + e;
            if (idx < 16) { float t = __builtin_amdgcn_exp2f(a0[idx]); asm volatile("" : "+v"(t)); a0[idx] = t; }
            else { float t = __builtin_amdgcn_exp2f(a1[idx - 16]); asm volatile("" : "+v"(t)); a1[idx - 16] = t; } }
        __builtin_amdgcn_sched_barrier(0);
    }
    bf16x8 pa[4]; float ls = 0.f;
#pragma unroll
    for (int i = 0; i < 16; ++i) ls += a0[i] + a1[i];
    pa[0] = pack_p(a0, 0); pa[1] = pack_p(a0, 1); pa[2] = pack_p(a1, 0); pa[3] = pack_p(a1, 1);
    S.l += ls;
    __builtin_amdgcn_sched_barrier(0);
    if (B.masked) flash_mask(b0, b1, B.lo, B.hi, h);
    float alphaB = 1.f;
    { const float mx = flash_rowmax(b0, b1);
        if (__ballot(mx > SM_THR) != 0ull) { const float d = (mx > NEG_BIG) ? fmaxf(mx, 0.f) : 0.f; alphaB = __builtin_amdgcn_exp2f(-d); S.m += d; S.l *= alphaB;
#pragma unroll
            for (int i = 0; i < 16; ++i) { b0[i] -= d; b1[i] -= d; } } }
    { bf16x8 vf[8]; flash_vload(va, r, h, vf);
#pragma unroll
        for (int k = 0; k < 8; ++k) {
            S.o[k & 1] = MFMA32(vf[k], pa[k >> 1], S.o[k & 1]);
#pragma unroll
            for (int e = 0; e < 4; ++e) { const int idx = 4 * k + e;
                if (idx < 16) { float t = __builtin_amdgcn_exp2f(b0[idx]); asm volatile("" : "+v"(t)); b0[idx] = t; }
                else { float t = __builtin_amdgcn_exp2f(b1[idx - 16]); asm volatile("" : "+v"(t)); b1[idx - 16] = t; } }
            __builtin_amdgcn_sched_barrier(0);
        }
    }
    __builtin_amdgcn_sched_barrier(0);
    if (__ballot(alphaB != 1.f) != 0ull) {
#pragma unroll
        for (int i = 0; i < 16; ++i) { S.o[0][i] *= alphaB; S.o[1][i] *= alphaB; } }
    { bf16x8 vf[8]; flash_vload(vb2, r, h, vf);
        bf16x8 pb[4]; pb[0] = pack_p(b0, 0); pb[1] = pack_p(b0, 1); pb[2] = pack_p(b1, 0); pb[3] = pack_p(b1, 1);
        float l0 = 0.f, l1 = 0.f;
        __builtin_amdgcn_sched_barrier(0);
#pragma unroll
        for (int k = 0; k < 8; ++k) {
            S.o[k & 1] = MFMA32(vf[k], pb[k >> 1], S.o[k & 1]);
#pragma unroll
            for (int e = 0; e < 2; ++e) { const int idx = 2 * k + e; l0 += b0[idx]; l1 += b1[idx]; }
            asm volatile("" : "+v"(l0), "+v"(l1));
            __builtin_amdgcn_sched_barrier(0);
        }
        S.l += l0 + l1; }
}

__device__ __forceinline__ void nsa_prompt_unit(Frame& F, int l, int b, int kvh, int c) {
    int tid = threadIdx.x; asm volatile("" : "+v"(tid));
    const int lane = tid & 63, w = F.wave, r = lane & 31, h = lane >> 5, qi = r >> 2, g = r & 3, qloc = 8 * w + qi;
    const int tok = b * SEQ + 64 * c + qloc, head = kvh * 4 + g;
    const bf16_t* P = (const bf16_t*)(F.ws + WS_P);
    LAS unsigned char* kbuf = F.lds + AL_K; LAS unsigned char* vbuf = F.lds + AL_V;
    LAS float* imp = (LAS float*)(F.lds + AL_IMP); LAS unsigned* msk = (LAS unsigned*)(F.lds + AL_MASK); LAS unsigned* uni = (LAS unsigned*)(F.lds + AL_UNION);
    __syncthreads();
    tile_dma((const bf16_t*)(F.ws + WS_KCP) + (size_t)(b * 4 + kvh) * 4096, (const bf16_t*)(F.ws + WS_VCTP) + (size_t)(b * 4 + kvh) * 4096, F.lds, w, lane);
    bf16x8 qf[4];
#pragma unroll
    for (int ks = 0; ks < 4; ++ks) qf[ks] = *(const bf16x8*)(P + (size_t)tok * NPROJ + C_Q + head * 64 + 16 * ks + 8 * h);
    const float* gt = (const float*)(F.ws + WS_GATE) + (size_t)tok * 64 + head * 3;
    const float g_cmp = gt[0], g_sel = gt[1], g_win = gt[2];
    LAS f32x4* ltot = (LAS f32x4*)(F.lds + AL_TOT) + tid;
    FlashState S;
    {
        if (tid < 128) msk[tid] = 0u; if (tid < 2) uni[tid] = 0u;
        __syncthreads();
        flash_reset(S);
        f32x16 s0, s1; flash_scores(kbuf, qf, r, h, 0.f, s0, s1);
        const int nvalid = c + (qloc == 63 ? 1 : 0);
        bf16x8 vf[8]; flash_vload(vbuf, r, h, vf);
        flash_first(S, s0, s1, 0, nvalid - 1, h, true);
        const float lt = S.l + __shfl_xor(S.l, 32), inv = lt > 0.f ? 1.f / lt : 0.f;
#pragma unroll
        for (int i = 0; i < 16; ++i) { s0[i] *= inv; s1[i] *= inv; }
#pragma unroll
        for (int i = 0; i < 16; ++i) { float a = s0[i]; a += quad_xor<0xB1>(a); a += quad_xor<0x4E>(a); float bq = s1[i]; bq += quad_xor<0xB1>(bq); bq += quad_xor<0x4E>(bq);
            if (g == 0) { const int key = (i & 3) + 8 * (i >> 2) + 4 * h; imp[qloc * 65 + key] = a; imp[qloc * 65 + key + 32] = bq; } }
        flash_pv(vf, s0, s1, S.o);
    }
    __syncthreads();
    {
        const int n = lane; const bool cand = (n >= 1) && (n <= c - 2);
        const unsigned long long forced = 1ull | (1ull << c) | (c >= 1 ? (1ull << (c - 1)) : 0ull);
        unsigned long long um = 0ull;
#pragma unroll 1
        for (int qq = 0; qq < 8; ++qq) { const int q = w * 8 + qq;
            const unsigned kb_ = cand ? ((__float_as_uint(imp[q * 65 + n]) & ~63u) | (unsigned)(63 - n)) : 0u;
            int rank = 0;
            for (int j = 1; j <= c - 2; ++j) { const unsigned sj = __builtin_amdgcn_readlane(kb_, j); rank += (sj > kb_) ? 1 : 0; }
            const unsigned long long m = __ballot(cand && rank < 13) | forced;
            if (lane == 0) { msk[q * 2] = (unsigned)m; msk[q * 2 + 1] = (unsigned)(m >> 32); }
            um |= m; }
        if (lane == 0) { atomicOr((unsigned*)uni, (unsigned)um); atomicOr((unsigned*)(uni + 1), (unsigned)(um >> 32)); }
    }
    __syncthreads();
    const unsigned mlo = msk[qloc * 2], mhi = msk[qloc * 2 + 1], ulo = uni[0], uhi = uni[1];
#pragma unroll
    for (int i4 = 0; i4 < 8; ++i4) { const f32x16& o = S.o[i4 >> 2]; const int i = 4 * (i4 & 3); ltot[i4 * 512] = (f32x4){g_cmp * o[i], g_cmp * o[i + 1], g_cmp * o[i + 2], g_cmp * o[i + 3]}; }
#define NSA_POP(REM_) ((REM_) ? (t_ = sel ? __builtin_ctzll(REM_) : 63 - __builtin_clzll(REM_), (REM_) &= ~(1ull << t_), t_) : -1)
#define NSA_EN(N_) (sel ? ((((N_) < 32 ? mlo >> (N_) : mhi >> ((N_) - 32)) & 1u) != 0u) : true)
#define NSA_LOHI(N_) const int n_ = (N_), lo_ = (!sel && n_ == c - 8) ? qloc + 1 : 0, hi_ = (n_ == c) ? qloc : 63; const bool mk_ = (n_ == c) || (!sel && n_ == c - 8)
#define NSA_PV(SLOT_, S0_, S1_) do { bf16x8 vf[8]; flash_vload(vbuf + (SLOT_), r, h, vf); flash_pv(vf, S0_, S1_, S.o); } while (0)
#pragma unroll 1
    for (int pass = 0; pass < 2; ++pass) {
        const bool sel = pass == 0;
        flash_reset(S);
        const bf16_t* kb = (const bf16_t*)(F.ws + (sel ? WS_KTSEL : WS_KTWIN)) + (size_t)(b * 4 + kvh) * 64 * 4096;
        const bf16_t* vt = (const bf16_t*)(F.ws + (sel ? WS_VTSEL : WS_VTWIN)) + (size_t)(b * 4 + kvh) * 64 * 4096;
        unsigned long long rem;
        if (sel) rem = ((unsigned long long)uhi << 32) | ulo;
        else { const int lo = c >= 8 ? c - 8 : 0; rem = (c == 63 ? ~0ull : ((1ull << (c + 1)) - 1ull)) & ~((1ull << lo) - 1ull); }
        int t_;
        int tA = NSA_POP(rem), tB = NSA_POP(rem);
        int pr = 0; bool first = true;
        __syncthreads();
        tile_dma(kb + (size_t)tA * 4096, vt + (size_t)tA * 4096, F.lds, w, lane);
        if (tB >= 0) tile_dma(kb + (size_t)tB * 4096, vt + (size_t)tB * 4096, F.lds + AL_SLOT, w, lane);
        for (;;) {
            const int sa = pr, sb = pr + AL_SLOT;
            __syncthreads();
            const int nA = NSA_POP(rem), nB = NSA_POP(rem);
            if (nA >= 0) tile_dma(kb + (size_t)nA * 4096, vt + (size_t)nA * 4096, F.lds + (pr ^ (2 * AL_SLOT)), w, lane);
            if (nB >= 0) tile_dma(kb + (size_t)nB * 4096, vt + (size_t)nB * 4096, F.lds + (pr ^ (2 * AL_SLOT)) + AL_SLOT, w, lane);
            const bool enA = first || NSA_EN(tA), enB = tB >= 0 ? NSA_EN(tB) : false;
            if (__ballot(enA || enB) != 0ull) {
                TileCtl A, B;
                A.en = enA; A.masked = (tA == c) || (!sel && tA == c - 8); A.lo = (!sel && tA == c - 8) ? qloc + 1 : 0; A.hi = (tA == c) ? qloc : 63;
                B.en = enB; B.masked = (tB == c) || (!sel && tB == c - 8); B.lo = (!sel && tB == c - 8) ? qloc + 1 : 0; B.hi = (tB == c) ? qloc : 63;
                const int sbb = tB >= 0 ? sb : sa;
                flash_pair(S, kbuf + sa, vbuf + sa, kbuf + sbb, vbuf + sbb, qf, A, B, first, r, h);
            }
            first = false;
            if (nA < 0) break;
            tA = nA; tB = nB; pr ^= 2 * AL_SLOT;
        }
        const float lt = S.l + __shfl_xor(S.l, 32), sc = (sel ? g_sel : g_win) / lt;
#pragma unroll
        for (int i4 = 0; i4 < 8; ++i4) { const f32x16& o = S.o[i4 >> 2]; const int i = 4 * (i4 & 3); ltot[i4 * 512] += (f32x4){sc * o[i], sc * o[i + 1], sc * o[i + 2], sc * o[i + 3]}; }
    }
#undef NSA_PV
#undef NSA_LOHI
#undef NSA_EN
#undef NSA_POP
    bf16_t* ao = (bf16_t*)(F.ws + WS_ABR + SZ_ABR1) + (size_t)tok * 1024 + head * 64;
    const bf16_t* az = P + (size_t)tok * NPROJ + C_AZ + head * 64;
#pragma unroll
    for (int i4 = 0; i4 < 8; ++i4) { const int d = 32 * (i4 >> 2) + 8 * (i4 & 3) + 4 * h;
        const f32x4 t = ltot[i4 * 512]; const f32x4 zz = unpack4(*(const u32x2*)(az + d));
        *(u32x2*)(ao + d) = pack4(t * zz); }
}

constexpr int SL_Q = 0  , SL_SC = 1024  , SL_IMP = SL_SC + 4 * 1040 * 4  , SL_RED = SL_IMP + 264 * 4  ,
              SL_LIST = SL_RED + 128  , SL_KOFF = SL_LIST + 64  , SL_PART = SL_KOFF + 1040 * 4  , SL_OACC = SL_PART + 32768  , SL_PT = SL_OACC + 3072  ;
constexpr int KOFF_INVALID = -2147483647;

__device__ __forceinline__ void block_softmax4(LAS float* sc, int count, LAS float* red, int tid) {
    const int gh = tid >> 7, t = tid & 127, wv = tid >> 6;
    LAS float* row = sc + gh * 1040;
    float mx = -INFINITY;
    for (int i = t; i < count; i += 128) mx = fmaxf(mx, row[i]);
    mx = wave_max(mx);
    if ((tid & 63) == 0) red[wv] = mx;
    __syncthreads();
    mx = fmaxf(red[2 * gh], red[2 * gh + 1]);
    float sm = 0.f;
    for (int i = t; i < count; i += 128) { const float p = __expf(row[i] - mx); row[i] = p; sm += p; }
    sm = wave_sum(sm);
    if ((tid & 63) == 0) red[8 + wv] = sm;
    __syncthreads();
    const float inv = 1.f / (red[8 + 2 * gh] + red[8 + 2 * gh + 1]);
    for (int i = t; i < count; i += 128) row[i] *= inv;
    __syncthreads();
}
__device__ __forceinline__ void sample_scores(const float* base, const bf16_t* Pnew, int pcol, int count, const LAS int* koff, const LAS float* qv, LAS float* sc, int tid) {
#pragma unroll 1
    for (int idx = tid; idx < count; idx += NT) {
        const int ko = koff[idx];
        float d0 = -INFINITY, d1 = -INFINITY, d2 = -INFINITY, d3 = -INFINITY;
        if (ko != KOFF_INVALID) {
            f32x4 kx[16];
            if (ko >= 0) {
#pragma unroll
                for (int j = 0; j < 16; ++j) kx[j] = *(const f32x4*)(base + (size_t)ko + 4 * j); }
            else {
#pragma unroll
                for (int j = 0; j < 16; ++j) kx[j] = unpack4(*(const u32x2*)(Pnew + (size_t)(-1 - ko) * NPROJ + pcol + 4 * j)); }
            d0 = d1 = d2 = d3 = 0.f;
#pragma unroll
            for (int j4 = 0; j4 < 4; ++j4) {
#pragma unroll
                for (int jj = 0; jj < 4; ++jj) { const int j = 4 * j4 + jj; const f32x4 kq = kx[j];
                    const f32x4 q0 = *(const LAS f32x4*)(qv + 4 * j), q1 = *(const LAS f32x4*)(qv + 64 + 4 * j), q2 = *(const LAS f32x4*)(qv + 128 + 4 * j), q3 = *(const LAS f32x4*)(qv + 192 + 4 * j);
                    d0 += kq.x * q0.x + kq.y * q0.y + kq.z * q0.z + kq.w * q0.w; d1 += kq.x * q1.x + kq.y * q1.y + kq.z * q1.z + kq.w * q1.w;
                    d2 += kq.x * q2.x + kq.y * q2.y + kq.z * q2.z + kq.w * q2.w; d3 += kq.x * q3.x + kq.y * q3.y + kq.z * q3.z + kq.w * q3.w; }
                __builtin_amdgcn_sched_barrier(0);
            }
            d0 *= 0.125f; d1 *= 0.125f; d2 *= 0.125f; d3 *= 0.125f;
        }
        sc[idx] = d0; sc[1040 + idx] = d1; sc[2080 + idx] = d2; sc[3120 + idx] = d3;
    }
}
__device__ __forceinline__ void sample_pv(const float* base, const bf16_t* Pnew, int pcol, int count, const LAS int* koff, const LAS float* sc, LAS float* part, LAS float* oacc, int tid) {
    const int dq = tid & 15, ks = tid >> 4, per = (count + 31) >> 5, i0 = ks * per, i1 = (i0 + per < count) ? i0 + per : count;
    f32x4 a0 = {0.f, 0.f, 0.f, 0.f}, a1 = a0, a2 = a0, a3 = a0;
#pragma unroll 8
    for (int idx = i0; idx < i1; ++idx) { const int ko = koff[idx];
        f32x4 v = {0.f, 0.f, 0.f, 0.f};
        if (ko >= 0) v = *(const f32x4*)(base + (size_t)ko + 256 + 4 * dq);
        else if (ko != KOFF_INVALID) { const u32x2 x = *(const u32x2*)(Pnew + (size_t)(-1 - ko) * NPROJ + pcol + 256 + 4 * dq); v = (f32x4){bf2f(x.x & 0xffffu), __uint_as_float(x.x & 0xffff0000u), bf2f(x.y & 0xffffu), __uint_as_float(x.y & 0xffff0000u)}; }
        a0 += sc[idx] * v; a1 += sc[1040 + idx] * v; a2 += sc[2080 + idx] * v; a3 += sc[3120 + idx] * v; }
    *(LAS f32x4*)(part + ks * 256 + 4 * dq) = a0; *(LAS f32x4*)(part + ks * 256 + 64 + 4 * dq) = a1; *(LAS f32x4*)(part + ks * 256 + 128 + 4 * dq) = a2; *(LAS f32x4*)(part + ks * 256 + 192 + 4 * dq) = a3;
    __syncthreads();
    if (tid < 256) { float t = 0.f;
#pragma unroll 8
        for (int k = 0; k < 32; ++k) t += part[k * 256 + tid];
        oacc[tid] = t; }
    __syncthreads();
}

__device__ __forceinline__ void nsa_sample_unit(Frame& F, int l, int unit, int part_id) {
    const int tid = F.tid, qi = unit & 3, kvh = (unit >> 2) & 3, b = unit >> 4, row = MPT + b * 4 + qi;
    const bf16_t* P = (const bf16_t*)(F.ws + WS_P); const int* pt = (const int*)FIN(IN_PT);
    LAS float* qv = (LAS float*)(F.lds + SL_Q); LAS float* sc = (LAS float*)(F.lds + SL_SC); LAS float* imp = (LAS float*)(F.lds + SL_IMP); LAS float* red = (LAS float*)(F.lds + SL_RED);
    LAS int* list = (LAS int*)(F.lds + SL_LIST); LAS int* koff = (LAS int*)(F.lds + SL_KOFF); LAS float* part = (LAS float*)(F.lds + SL_PART); LAS float* oacc = (LAS float*)(F.lds + SL_OACC);
    LAS int* ptl = (LAS int*)(F.lds + SL_PT);
    __syncthreads();
    if (part_id == 0 && tid >= 256 && tid < 384) ptl[tid - 256] = pt[b * 128 + tid - 256];
    if (tid < 256) qv[tid] = bf2f(P[(size_t)row * NPROJ + C_Q + kvh * 256 + tid]) * (1.f / SM_SCALE_L2E);
    __syncthreads();
    float* soacc = (float*)(F.ws + WS_SOACC) + (size_t)unit * 768;
    if (part_id == 0) {
    {
        const int n = tid & 255, gp = tid >> 8;
        const bf16_t* kr = (const bf16_t*)(F.ws + WS_KCS) + ((size_t)(b * 4 + kvh) * 256 + n) * 64;
        float d0 = 0.f, d1 = 0.f;
#pragma unroll
        for (int j = 0; j < 8; ++j) { const u32x4 x = *(const u32x4*)(kr + 8 * j); float kf[8]; unpack8(x, kf);
#pragma unroll
            for (int e = 0; e < 8; ++e) { d0 += kf[e] * qv[(2 * gp) * 64 + 8 * j + e]; d1 += kf[e] * qv[(2 * gp + 1) * 64 + 8 * j + e]; } }
        sc[(2 * gp) * 1040 + n] = d0 * 0.125f; sc[(2 * gp + 1) * 1040 + n] = d1 * 0.125f;
    }
    __syncthreads();
    block_softmax4(sc, 256, red, tid);
    if (tid < 257) { float v; if (tid == 0 || tid >= 255) v = 1e4f; else v = sc[tid] + sc[1040 + tid] + sc[2080 + tid] + sc[3120 + tid]; imp[tid] = v; }
    {
        const int half = tid >> 8, gd = tid & 255, gh = gd >> 6, d = gd & 63;
        const bf16_t* vt = (const bf16_t*)(F.ws + WS_VCTS) + (size_t)(b * 4 + kvh) * 4 * 4096;
        float a = 0.f;
        for (int tl = 2 * half; tl < 2 * half + 2; ++tl) {
            const bf16_t* vr = vt + (size_t)tl * 4096 + d * 64;
#pragma unroll
            for (int j = 0; j < 8; ++j) { const u32x4 x = *(const u32x4*)(vr + 8 * j); float vf[8]; unpack8(x, vf);
#pragma unroll
                for (int e = 0; e < 8; ++e) a += sc[gh * 1040 + tl * 64 + keypos(8 * j + e)] * vf[e]; } }
        part[half * 256 + gd] = a;
    }
    __syncthreads();
    if (tid < 256) oacc[tid] = part[tid] + part[256 + tid];
    if (tid < 257) { const float si = imp[tid]; int rk = 0;
        for (int j = 0; j < 257; ++j) { const float sj = imp[j]; rk += (sj > si || (sj == si && j < tid)) ? 1 : 0; }
        if (rk < 16) list[rk] = tid; }
    __syncthreads();
    for (int idx = tid; idx < 1024; idx += NT) { const int blk = list[idx >> 6], kk = idx & 63; int ko;
        if (blk < 256) { const int page = ptl[blk >> 1]; ko = (int)(((((size_t)l * NPOOL + page) * 128 + (blk & 1) * 64 + kk) * 4 + 2) * 256 + kvh * 64); }
        else ko = (kk <= qi) ? -1 - (MPT + b * 4 + kk) : KOFF_INVALID;
        koff[idx] = ko; }
    __syncthreads();
    sample_scores(FIN(IN_CACHE), P, C_SK + kvh * 64, 1024, koff, qv, sc, tid);
    __syncthreads();
    block_softmax4(sc, 1024, red, tid);
    sample_pv(FIN(IN_CACHE), P, C_SK + kvh * 64, 1024, koff, sc, part, oacc + 256, tid);
    soacc[tid] = oacc[tid];
    } else {
    for (int idx = tid; idx < 516; idx += NT) { int ko;
        if (idx < 512) ko = (idx > qi) ? (int)((((size_t)(l * SB + b) * 512 + idx) * 2) * 256 + kvh * 64) : KOFF_INVALID;
        else ko = (idx - 512 <= qi) ? -1 - (MPT + b * 4 + idx - 512) : KOFF_INVALID;
        koff[idx] = ko; }
    __syncthreads();
    sample_scores(FIN(IN_SWIN), P, C_WK + kvh * 64, 516, koff, qv, sc, tid);
    __syncthreads();
    block_softmax4(sc, 516, red, tid);
    sample_pv(FIN(IN_SWIN), P, C_WK + kvh * 64, 516, koff, sc, part, oacc + 512, tid);
    if (tid < 256) soacc[512 + tid] = oacc[512 + tid];
    }
    __syncthreads();
}

struct SsmPow { float r[4], i[4]; };
__device__ __forceinline__ void ssm_pows(float ar, float ai, SsmPow& p) {
    p.r[0] = ar; p.i[0] = ai;
    p.r[1] = ar * ar - ai * ai; p.i[1] = 2.f * ar * ai;
    p.r[2] = p.r[1] * ar - p.i[1] * ai; p.i[2] = p.r[1] * ai + p.i[1] * ar;
    p.r[3] = p.r[1] * p.r[1] - p.i[1] * p.i[1]; p.i[3] = 2.f * p.r[1] * p.i[1];
}
struct SsmUnit { SsmPow pw[2]; bf16x8 bfr[4]; float alr[2], ali[2]; };
__device__ __forceinline__ void ssm_unit_load(const Frame& F, int l, int g, int lane, SsmUnit& U) {
    const int n32 = lane & 31, h = lane >> 5;
    const float* sab = (const float*)(F.ws + WS_SAB + l * al1m(SZ_SAB)) + (size_t)g * 64 * 4;
    const bf16_t* bb16 = (const bf16_t*)(F.ws + WS_SBB16 + l * al1m(SZ_SBB16)) + (size_t)g * 2 * 64 * 16;
#pragma unroll
    for (int s = 0; s < 2; ++s) { const f32x4 ab = *(const f32x4*)(sab + (n32 + 32 * s) * 4); ssm_pows(ab.x, ab.y, U.pw[s]); U.alr[s] = ab.z; U.ali[s] = ab.w;
        U.bfr[2 * s] = *(const bf16x8*)(bb16 + (size_t)(n32 + 32 * s) * 16 + 8 * h); U.bfr[2 * s + 1] = *(const bf16x8*)(bb16 + (size_t)(64 + n32 + 32 * s) * 16 + 8 * h); }
}
template <bool FIX>
__device__ __forceinline__ void ssm_block32(const bf16x8& au, const SsmUnit& U, float (&Hr)[2], float (&Hi)[2], float (&H1r)[2], float (&H1i)[2], f32x16 (&Dr)[2], f32x16 (&Di)[2], int h) {
    f32x16 z;
#pragma unroll
    for (int i = 0; i < 16; ++i) z[i] = 0.f;
#pragma unroll
    for (int s = 0; s < 2; ++s) { Dr[s] = MFMA32(au, U.bfr[2 * s], z); Di[s] = MFMA32(au, U.bfr[2 * s + 1], z); }
#pragma unroll
    for (int s = 0; s < 2; ++s) {
        const float ar = U.pw[s].r[0], ai = U.pw[s].i[0], a4r = U.pw[s].r[3], a4i = U.pw[s].i[3];
#pragma unroll
        for (int j = 0; j < 4; ++j)
#pragma unroll
            for (int e = 1; e < 4; ++e) { const int i = 4 * j + e;
                const float nr = ar * Dr[s][i - 1] - ai * Di[s][i - 1] + Dr[s][i], ni = ar * Di[s][i - 1] + ai * Dr[s][i - 1] + Di[s][i]; Dr[s][i] = nr; Di[s][i] = ni; }
        float hr = Hr[s], hi = Hi[s];
#pragma unroll
        for (int j = 0; j < 4; ++j) {
            const float ownr = Dr[s][4 * j + 3], owni = Di[s][4 * j + 3], othr = __shfl_xor(ownr, 32), othi = __shfl_xor(owni, 32);
            const float evr = h ? othr : ownr, evi = h ? othi : owni, odr = h ? ownr : othr, odi = h ? owni : othi;
            const float inr0 = hr, ini0 = hi;
            float t = a4r * hr - a4i * hi + evr; hi = a4r * hi + a4i * hr + evi; hr = t;
            if (j == 0) { H1r[s] = hr; H1i[s] = hi; }
            const float inr1 = hr, ini1 = hi;
            t = a4r * hr - a4i * hi + odr; hi = a4r * hi + a4i * hr + odi; hr = t;
            if (FIX) { const float inr = h ? inr1 : inr0, ini = h ? ini1 : ini0;
#pragma unroll
                for (int e = 0; e < 4; ++e) { const int i = 4 * j + e; Dr[s][i] += U.pw[s].r[e] * inr - U.pw[s].i[e] * ini; Di[s][i] += U.pw[s].r[e] * ini + U.pw[s].i[e] * inr; } }
        }
        Hr[s] = hr; Hi[s] = hi;
    }
}
__device__ __forceinline__ bf16x8 ssm_load_au(const bf16_t* P, int m0, int ntok, int g, int lane) {
    const int t = lane & 31, h = lane >> 5;
    if (t < ntok) return *(const bf16x8*)(P + (size_t)(m0 + t) * NPROJ + C_SU + g * 16 + 8 * h);
    return (bf16x8){0, 0, 0, 0, 0, 0, 0, 0};
}
__device__ __forceinline__ void s2_ssm_pass1(Frame& F, int l) {
    const bf16_t* P = (const bf16_t*)(F.ws + WS_P); f32x2* E = (f32x2*)(F.ws + WS_SSME);
    const int lane = F.lane, n32 = lane & 31, h = lane >> 5;
    for (int u = F.gw; u < PB * 64 * SSM_NCH; u += F.ngw) {
        const int b = u >> 11, g = (u >> 5) & 63, ch = u & 31, m0 = b * SEQ + ch * SSM_L;
        SsmUnit U; ssm_unit_load(F, l, g, lane, U);
        float Hr[2] = {0.f, 0.f}, Hi[2] = {0.f, 0.f}, H1r[2], H1i[2];
        bf16x8 au = ssm_load_au(P, m0, 32, g, lane);
#pragma unroll 1
        for (int blk = 0; blk < SSM_L / 32; ++blk) {
            const bf16x8 an = ssm_load_au(P, m0 + 32 * ((blk + 1) & 3), 32, g, lane);
            f32x16 Dr[2], Di[2];
            ssm_block32<false>(au, U, Hr, Hi, H1r, H1i, Dr, Di, h);
            au = an;
        }
        if (h == 0) { f32x2* e = E + ((size_t)(b * 64 + g) * SSM_NCH + ch) * 64; e[n32] = (f32x2){Hr[0], Hi[0]}; e[32 + n32] = (f32x2){Hr[1], Hi[1]}; }
    }
}
__device__ __forceinline__ void s3_ssm_pass2(Frame& F, int l) {
    const bf16_t* P = (const bf16_t*)(F.ws + WS_P); const f32x2* E = (const f32x2*)(F.ws + WS_SSME); bf16_t* Z = (bf16_t*)(F.ws + WS_Z);
    LAS unsigned char* himg = F.lds + 65536 + F.wave * 8960;
    const int lane = F.lane, n32 = lane & 31, h = lane >> 5, tk = lane & 15, cq = lane >> 4;
    for (int u = F.gw; u < PB * 64 * SSM_NCH + SB * 64; u += F.ngw) {
        const bool smp = u >= PB * 64 * SSM_NCH;
        int b, g, ch, m0, nblk, ntok;
        if (!smp) { b = u >> 11; g = (u >> 5) & 63; ch = (u & 31) ^ (b & 1 ? 31 : 0); m0 = b * SEQ + ch * SSM_L; nblk = SSM_L / 32; ntok = 32; }
        else { const int su = u - PB * 64 * SSM_NCH; b = su >> 6; g = su & 63; ch = 0; m0 = MPT + b * 4; nblk = 1; ntok = 4; }
        SsmUnit U; ssm_unit_load(F, l, g, lane, U);
        bf16x8 cmf[4];
        { const bf16_t* cm = (const bf16_t*)(F.ws + WS_SCM + l * al1m(SZ_SCM)) + (size_t)(g * 16 + tk) * 128 + 8 * cq;
#pragma unroll
            for (int ks = 0; ks < 4; ++ks) cmf[ks] = *(const bf16x8*)(cm + 32 * ks); }
        const f32x4 ds = *(const f32x4*)(FIN(IN_DSKIP) + l * 1024 + g * 16 + 4 * cq);
        float Hr[2] = {0.f, 0.f}, Hi[2] = {0.f, 0.f}, H1r[2] = {0.f, 0.f}, H1i[2] = {0.f, 0.f};
        if (!smp) { const f32x2* e = E + (size_t)(b * 64 + g) * SSM_NCH * 64;
            for (int j0 = 0; j0 < ch; j0 += 8) {
                f32x2 ev[8][2];
#pragma unroll
                for (int jj = 0; jj < 8; ++jj)
#pragma unroll
                    for (int s = 0; s < 2; ++s) ev[jj][s] = (j0 + jj < ch) ? e[(size_t)(j0 + jj) * 64 + n32 + 32 * s] : (f32x2){0.f, 0.f};
#pragma unroll
                for (int jj = 0; jj < 8; ++jj) if (j0 + jj < ch) {
#pragma unroll
                    for (int s = 0; s < 2; ++s) { const float nr = U.alr[s] * Hr[s] - U.ali[s] * Hi[s] + ev[jj][s].x, ni = U.alr[s] * Hi[s] + U.ali[s] * Hr[s] + ev[jj][s].y; Hr[s] = nr; Hi[s] = ni; } } } }
        else { const float* h0 = FIN(IN_SSSM) + ((size_t)(l * SB + b) * 2 * 64 + g) * 64 + n32;
#pragma unroll
            for (int s = 0; s < 2; ++s) { Hr[s] = h0[32 * s]; Hi[s] = h0[64 * 64 + 32 * s]; } }
        bf16x8 au = ssm_load_au(P, m0, ntok, g, lane);
#pragma unroll 1
        for (int blk = 0; blk < nblk; ++blk) {
            const bf16x8 an = ssm_load_au(P, m0 + 32 * ((blk + 1) & 3), ntok, g, lane);
            u32x2 uw[2];
#pragma unroll
            for (int tt = 0; tt < 2; ++tt) uw[tt] = (16 * tt + tk < ntok) ? *(const u32x2*)(P + (size_t)(m0 + 32 * blk + 16 * tt + tk) * NPROJ + C_SU + g * 16 + 4 * cq) : (u32x2){0u, 0u};
            f32x16 Dr[2], Di[2];
            ssm_block32<true>(au, U, Hr, Hi, H1r, H1i, Dr, Di, h);
            au = an;
#pragma unroll
            for (int i = 0; i < 16; ++i) { const int tl = (i & 3) + 8 * (i >> 2) + 4 * h;
                *(LAS unsigned*)(himg + tl * 272 + 4 * n32) = pk2(Dr[0][i], Di[0][i]); *(LAS unsigned*)(himg + tl * 272 + 4 * (32 + n32)) = pk2(Dr[1][i], Di[1][i]); }
            LDS_WAIT(); asm volatile("" ::: "memory");
#pragma unroll
            for (int tt = 0; tt < 2; ++tt) {
                f32x4 y = {0.f, 0.f, 0.f, 0.f};
#pragma unroll
                for (int ks = 0; ks < 4; ++ks) { const bf16x8 hf = *(const LAS bf16x8*)(himg + (16 * tt + tk) * 272 + (32 * ks + 8 * cq) * 2); y = __builtin_amdgcn_mfma_f32_16x16x32_bf16(cmf[ks], hf, y, 0, 0, 0); }
                const int t = 32 * blk + 16 * tt + tk;
                if (16 * tt + tk < ntok) { const f32x4 uu = unpack4(uw[tt]);
                    u32x2 o; o.x = pk2(gelu_tanh(y.x + ds.x * uu.x), gelu_tanh(y.y + ds.y * uu.y)); o.y = pk2(gelu_tanh(y.z + ds.z * uu.z), gelu_tanh(y.w + ds.w * uu.w));
                    *(u32x2*)(Z + (size_t)(m0 + t) * 1024 + g * 16 + 4 * cq) = o; }
            }
            LDS_WAIT(); asm volatile("" ::: "memory");
        }
        if (h == 0) {
            if (smp) { float* o = F.out + O_SSMS + ((size_t)(l * SB + b) * 2 * 64 + g) * 64 + n32;
#pragma unroll
                for (int s = 0; s < 2; ++s) { o[32 * s] = H1r[s]; o[64 * 64 + 32 * s] = H1i[s]; } }
            else if (ch == SSM_NCH - 1) { float* o = F.out + O_SSMP + ((size_t)(l * PB + b) * 2 * 64 + g) * 64 + n32;
#pragma unroll
                for (int s = 0; s < 2; ++s) { o[32 * s] = Hr[s]; o[64 * 64 + 32 * s] = Hi[s]; } }
        }
    }
}
struct Args { const float* in[27]; float* out; unsigned char* ws; int ph_lo, ph_hi; };
constexpr int N_PHASES = 15;

__global__ void __launch_bounds__(NT, 2) fwd_kernel(Args args) {
    extern __shared__ __attribute__((aligned(16))) unsigned char lds_raw[];
    Frame F;
    F.lds = (LAS unsigned char*)lds_raw;
    F.tid = threadIdx.x; F.lane = F.tid & 63; F.wave = __builtin_amdgcn_readfirstlane(F.tid >> 6);
    F.G = gridDim.x; F.bid = blockIdx.x; F.gw = F.bid * NWAVES + F.wave; F.ngw = F.G * NWAVES;
    F.out = args.out; F.ws = args.ws;
    volatile LAS unsigned* misc = (volatile LAS unsigned*)(F.lds + LDS_MISC);
    if (F.tid < 64) misc[F.tid] = 0u;
    __syncthreads();
    const int lo = args.ph_lo, hi = args.ph_hi;
#if MK_PER_PHASE
#define GRID_BAR() do { } while (0)
#else
    XcdBarrier bar = xcd_barrier_post((unsigned*)(F.ws + WS_CTL) + CW_BAR, misc + 8);
#define GRID_BAR() xcd_barrier(bar)
#endif
#ifdef ONLYPH
#define IN(k) ((((k)==0?0:(((k)-1)%7)+1))==ONLYPH && lo <= (k) && (k) < hi)
#else
#define IN(k) (lo <= (k) && (k) < hi)
#endif
#define BOTH(k) (IN(k) && IN((k) + 1))
#ifndef PROBE_PH
#define PROBE_PH -1
#endif
#define REPS(k) _Pragma("unroll 1") for (int rep_ = 0; rep_ < ((PROBE_PH) == (k) ? 2 : 1); ++rep_)
#define PHASE_BEGIN() do { int t_ = threadIdx.x; asm volatile("" : "+v"(t_)); F.tid = t_; F.lane = t_ & 63; F.wave = __builtin_amdgcn_readfirstlane(t_ >> 6); \
    F.gw = F.bid * NWAVES + F.wave; GAS unsigned char* w_ = (GAS unsigned char*)args.ws; asm volatile("" : "+s"(w_)); F.ws = (unsigned char*)w_; \
    GAS float* o_ = (GAS float*)args.out; asm volatile("" : "+s"(o_)); F.out = (float*)o_; } while (0)
    if (IN(0)) { PHASE_BEGIN(); REPS(0) phase_prologue(F); if (BOTH(0)) GRID_BAR(); }
    for (int l = 0; l < 2; ++l) {
        const int p0 = 1 + 7 * l;
        if (IN(p0)) {
            PHASE_BEGIN();
            pg8::Gemm g{(const bf16_t*)(F.ws + WS_H), (const bf16_t*)(F.ws + WS_WIN + l * al1m(SZ_WIN)), DM, DM, DM, 0, 0};
            pg8::TileOrder S; S.init(MPT / 256, NPROJ / 256, 1, 0, F.G, F.bid);
            EpiProj E{(bf16_t*)(F.ws + WS_P), (float*)(F.ws + WS_GATE), F.out, l};
            REPS(1) pg8::gemm_phase(F.lds, g, S, E);
            skinny_proj(F, l);
            if (BOTH(p0)) GRID_BAR();
        }
        if (IN(p0 + 1)) {
            PHASE_BEGIN();
            REPS(2) {
#ifndef SK_A
            REPS(21) s2_compress(F, l);
#endif
            __syncthreads();
#ifndef SK_B
            PHASE_BEGIN();
            REPS(22) s2_ssm_pass1(F, l);
#endif
#ifndef SK_C
            PHASE_BEGIN();
            REPS(23) s2_pool_diff(F, l);
#endif
#ifndef SK_D
            PHASE_BEGIN();
            REPS(24) s2_state_outputs(F, l);
#endif
#ifndef SK_E
            PHASE_BEGIN();
            REPS(25) s2_vt_images(F);
#endif
            }
            if (BOTH(p0 + 1)) GRID_BAR();
        }
        if (IN(p0 + 2)) {
            PHASE_BEGIN();
            REPS(33) s3_ssm_pass2(F, l);
            __syncthreads();
            if (BOTH(p0 + 2)) GRID_BAR();
        }
        if (IN(p0 + 3)) {
            PHASE_BEGIN();
            REPS(3) {
#ifndef SK_F
            REPS(31) for (int p = F.bid; p < 256; p += F.G) { const int bk = p >> 5, j = p & 31;
#pragma unroll 1
                for (int k2 = 0; k2 < 2; ++k2) nsa_prompt_unit(F, l, bk >> 2, bk & 3, k2 ? j : 63 - j); }
#endif
#ifndef SK_G
            PHASE_BEGIN();
            for (int uu = F.bid; uu < (((PROBE_PH) == 35 || (PROBE_PH) == 36) ? 2048 : (PROBE_PH) == 32 ? 512 : 256); uu += F.G) { const int u = uu & 255, part = (u >> 3) & 1;
                if (uu >= 256 && (PROBE_PH) != 32 && (PROBE_PH) != 35 + part) continue;
                nsa_sample_unit(F, l, (u & 7) | ((u >> 4) << 3), part); }
#endif
            __syncthreads();
            PHASE_BEGIN();
            REPS(4) {
            const int hi = (F.bid >> 3) & 1, idx = (F.bid >> 4) * 8 + (F.bid & 7);
            const int n1 = (F.G >> 4) * 8 + ((F.G & 15) > 8 ? (F.G & 15) - 8 : 0), n0 = F.G - n1;
            if (hi || n1 == 0) {
                pg8::Gemm g{(const bf16_t*)(F.ws + WS_Z), (const bf16_t*)(F.ws + WS_WGLU + l * al1m(SZ_WGLU)), 1024, 1024, 1024, 0, 0};
                pg8::TileOrder S; if (n1) S.init(MPT / 256, 4, 1, 0, n1, idx); else S.init(MPT / 256, 4, 1, 0, F.G, F.bid);
                EpiGlu E{(bf16_t*)(F.ws + WS_ABR + 2 * SZ_ABR1), (const bf16_t*)(F.ws + WS_P), (const bf16_t*)(F.ws + WS_Z)};
                pg8::gemm_phase(F.lds, g, S, E);
            }
            if (!hi) {
                pg8::Gemm g{(const bf16_t*)(F.ws + WS_DIFF), (const bf16_t*)(F.ws + WS_WPOOL + l * al1m(SZ_WPOOL)), 1024, 256, 256, 256, 65536};
                pg8::TileOrder S; S.init(MPT / 256, 1, 4, 0, n0, idx);
                EpiPool E{(bf16_t*)(F.ws + WS_ABR), (const bf16_t*)(F.ws + WS_P), FIN(IN_PSCALE) + l * 1024};
                pg8::gemm_phase(F.lds, g, S, E);
            }
            skinny_glu(F, l); skinny_pool(F, l);
            }
            }
            if (BOTH(p0 + 3)) GRID_BAR();
        }
        if (IN(p0 + 4)) {
            PHASE_BEGIN();
            pg8::Gemm g{(const bf16_t*)(F.ws + WS_ABR), (const bf16_t*)(F.ws + WS_WBR + l * al1m(SZ_WBR)), 1024, 1024, 1024, (size_t)MPAD * 1024, (size_t)2048 * 1024};
            pg8::TileOrder S; S.init(MPT / 256, 8, 3, 1, F.G, F.bid);
            EpiBranch E{(bf16_t*)(F.ws + WS_MERGED), (const bf16_t*)(F.ws + WS_P)};
            REPS(5) { pg8::gemm_phase(F.lds, g, S, E); skinny_branch(F, l); }
            if (BOTH(p0 + 4)) GRID_BAR();
        }
        if (IN(p0 + 5)) {
            PHASE_BEGIN();
            pg8::Gemm g{(const bf16_t*)(F.ws + WS_MERGED), (const bf16_t*)(F.ws + WS_WOUT + l * al1m(SZ_WOUT)), DM, DM, DM, 0, 0};
            pg8::TileOrder S; S.init(MPT / 256, 8, 1, 0, F.G, F.bid);
            EpiOut E{(bf16_t*)(F.ws + WS_OUTB)};
            REPS(6) { pg8::gemm_phase(F.lds, g, S, E); skinny_out(F, l); }
            if (BOTH(p0 + 5)) GRID_BAR();
        }
        if (IN(p0 + 6)) {
            PHASE_BEGIN();
            REPS(7) phase_norm(F, l);
            if (BOTH(p0 + 6)) GRID_BAR();
        }
    }
#undef IN
#undef BOTH
}

extern "C" void kernel_launch(void* const* d_in, const int* in_sizes, int n_in, void* d_out, int out_size, void* d_ws, size_t ws_size, hipStream_t stream) {
    static int grid = 0;
    if (grid == 0) {
        if (n_in != 27 || out_size != (int)O_TOTAL || ws_size < WS_END) { fprintf(stderr, "kernel_launch: unexpected problem shape (n_in %d, out %d, ws %zu < %zu)\n", n_in, out_size, ws_size, (size_t)WS_END); grid = -1; return; }
        int dev = 0, cus = 0, per_cu = 0;
        if (hipGetDevice(&dev) != hipSuccess || hipDeviceGetAttribute(&cus, hipDeviceAttributeMultiprocessorCount, dev) != hipSuccess) { grid = -1; return; }
        if (hipFuncSetAttribute((const void*)fwd_kernel, hipFuncAttributeMaxDynamicSharedMemorySize, LDS_BYTES) != hipSuccess) { fprintf(stderr, "kernel_launch: hipFuncSetAttribute failed\n"); grid = -1; return; }
        if (hipOccupancyMaxActiveBlocksPerMultiprocessor(&per_cu, (const void*)fwd_kernel, NT, LDS_BYTES) != hipSuccess || per_cu < 1)
            fprintf(stderr, "kernel_launch: note: occupancy query reports %d workgroups per CU\n", per_cu);
        (void)hipGetLastError();
        grid = cus;
    }
    if (grid < 0) return;
    if (hipMemsetAsync((char*)d_ws + WS_CTL, 0, CTL_ZERO_BYTES, stream) != hipSuccess) return;
    Args a{};
    for (int i = 0; i < 27; ++i) a.in[i] = (const float*)d_in[i];
    a.out = (float*)d_out; a.ws = (unsigned char*)d_ws;
#if MK_PER_PHASE
    for (int k = 0; k < N_PHASES; ++k) { a.ph_lo = k; a.ph_hi = k + 1; hipLaunchKernelGGL(fwd_kernel, dim3(grid), dim3(NT), LDS_BYTES, stream, a); }
#else
    a.ph_lo = 0; a.ph_hi = N_PHASES;
    hipLaunchKernelGGL(fwd_kernel, dim3(grid), dim3(NT), LDS_BYTES, stream, a);
#endif
    const hipError_t le = hipPeekAtLastError();
    if (le != hipSuccess) fprintf(stderr, "kernel_launch: launch failed: %s\n", hipGetErrorName(le));
}
```

```cpp
#define MK_PER_PHASE 0
#include <hip/hip_runtime.h>
#include <cstdio>
#include <cstdint>

#ifndef MK_PER_PHASE
#define MK_PER_PHASE 0
#endif

#define LAS __attribute__((address_space(3)))
#define GAS __attribute__((address_space(1)))
typedef unsigned short bf16_t;
typedef short bf16x8 __attribute__((ext_vector_type(8)));
typedef float f32x4 __attribute__((ext_vector_type(4)));
typedef float f32x2 __attribute__((ext_vector_type(2)));
typedef float f32x16 __attribute__((ext_vector_type(16)));
typedef unsigned u32x4 __attribute__((ext_vector_type(4)));
typedef unsigned u32x2 __attribute__((ext_vector_type(2)));
typedef __bf16 bf16x2_t __attribute__((ext_vector_type(2)));

constexpr int DM = 2048, SEQ = 4096, PB = 2, SB = 8, SQ = 4, PAST = 16384;
constexpr int MPT = PB * SEQ;
constexpr int MROWS = MPT + SB * SQ;
constexpr int MPAD = 8448;
constexpr int DIN = 13872, NPROJ = 14080;
constexpr int C_PU = 0, C_PZ = 1024, C_Q = 2048, C_CK = 3072, C_CV = 3328, C_SK = 3584, C_SV = 3840, C_WK = 4096, C_WV = 4352,
              C_AZ = 4608, C_SU = 5632, C_SZ = 6656, C_MG = 7680, C_AG = 13824;
constexpr int NPOOL = 1280;
constexpr int SSM_L = 128, SSM_NCH = SEQ / SSM_L;
constexpr float EPS = 1e-6f;
constexpr float SM_SCALE_L2E = 0.125f * 1.44269504088896f;
constexpr float SM_THR = 8.f;

constexpr size_t O_YP = 0, O_YS = 16777216, O_KVP = 16842752, O_KVS = 33619968, O_WINP = 33685504, O_WINS = 34734080,
                 O_POOLP = 38928384, O_POOLS = 38989824, O_SSMP = 39235584, O_SSMS = 39268352, O_TOTAL = 39399424;

constexpr size_t al1m(size_t x) { return (x + 1048575) & ~(size_t)1048575; }
constexpr size_t SZ_WIN = (size_t)NPROJ * DM * 2, SZ_WPOOL = 4 * 256 * 256 * 2, SZ_WGLU = 1024 * 1024 * 2, SZ_WBR = (size_t)3 * 2048 * 1024 * 2,
                 SZ_WOUT = (size_t)2048 * 2048 * 2, SZ_WPHI = 2 * 64 * 64 * 64 * 2, SZ_PEBP = 2 * 16 * 64 * 4, SZ_SAB = 64 * 64 * 4 * 4,
                 SZ_SBB = 64 * 16 * 2 * 64 * 4, SZ_SCM = 64 * 16 * 128 * 2;
constexpr size_t WS_CTL = 0, CTL_BYTES = 1048576, CTL_ZERO_BYTES = 32768;
constexpr size_t WS_WIN = CTL_BYTES;
constexpr size_t WS_WPOOL = WS_WIN + 2 * al1m(SZ_WIN);
constexpr size_t WS_WGLU = WS_WPOOL + 2 * al1m(SZ_WPOOL);
constexpr size_t WS_WBR = WS_WGLU + 2 * al1m(SZ_WGLU);
constexpr size_t WS_WOUT = WS_WBR + 2 * al1m(SZ_WBR);
constexpr size_t WS_WPHI = WS_WOUT + 2 * al1m(SZ_WOUT);
constexpr size_t WS_PEBP = WS_WPHI + 2 * al1m(SZ_WPHI);
constexpr size_t WS_SAB = WS_PEBP + 2 * al1m(SZ_PEBP);
constexpr size_t WS_SBB = WS_SAB + 2 * al1m(SZ_SAB);
constexpr size_t WS_SCM = WS_SBB + 2 * al1m(SZ_SBB);
constexpr size_t WS_H = WS_SCM + 2 * al1m(SZ_SCM);
constexpr size_t WS_P = WS_H + al1m((size_t)MPAD * DM * 2);
constexpr size_t WS_GATE = WS_P + al1m((size_t)MPAD * NPROJ * 2);
constexpr size_t WS_DIFF = WS_GATE + al1m((size_t)MPAD * 64 * 4);
constexpr size_t WS_ABR = WS_DIFF + al1m((size_t)MPAD * 1024 * 2);
constexpr size_t SZ_ABR1 = (size_t)MPAD * 1024 * 2;
constexpr size_t WS_Z = WS_ABR + al1m(3 * SZ_ABR1);
constexpr size_t WS_KCP = WS_Z + al1m(SZ_ABR1);
constexpr size_t WS_VCTP = WS_KCP + al1m(65536);
constexpr size_t WS_KCS = WS_VCTP + al1m(65536);
constexpr size_t WS_VCTS = WS_KCS + al1m(1048576);
constexpr size_t WS_VTSEL = WS_VCTS + al1m(1048576);
constexpr size_t WS_VTWIN = WS_VTSEL + al1m(4194304);
constexpr size_t WS_SSME = WS_VTWIN + al1m(4194304);
constexpr size_t WS_MERGED = WS_SSME + al1m(2097152);
constexpr size_t WS_OUTB = WS_MERGED + al1m((size_t)MPAD * DM * 2);
constexpr size_t WS_Y0 = WS_OUTB + al1m((size_t)MPAD * DM * 4);
constexpr size_t WS_BRP = WS_Y0 + al1m((size_t)MPAD * DM * 4);
constexpr size_t WS_SOACC = WS_BRP + al1m((size_t)3 * 32 * DM * 4);
constexpr size_t WS_SBB16 = WS_SOACC + al1m(128 * 768 * 4);
constexpr size_t SZ_SBB16 = 64 * 2 * 64 * 16 * 2;
constexpr size_t WS_KTSEL = WS_SBB16 + 2 * al1m(SZ_SBB16);
constexpr size_t WS_KTWIN = WS_KTSEL + al1m(4194304);
constexpr size_t WS_END = WS_KTWIN + al1m(4194304);

constexpr int CW_BAR = 4096;

constexpr int NWAVES = 8, NT = 512;
constexpr int LDS_BYTES = 147456;
constexpr int LDS_MISC = 143360;

__device__ __forceinline__ float bf2f(unsigned b) { return __uint_as_float(b << 16); }
__device__ __forceinline__ unsigned pk2(float lo, float hi) { f32x2 v = {lo, hi}; bf16x2_t b = __builtin_convertvector(v, bf16x2_t); return __builtin_bit_cast(unsigned, b); }
__device__ __forceinline__ unsigned f2bf(float f) { return pk2(f, 0.f) & 0xffffu; }
__device__ __forceinline__ float wave_sum(float v) {
#pragma unroll
    for (int o = 1; o < 64; o <<= 1) v += __shfl_xor(v, o);
    return v;
}
__device__ __forceinline__ float wave_max(float v) {
#pragma unroll
    for (int o = 1; o < 64; o <<= 1) v = fmaxf(v, __shfl_xor(v, o));
    return v;
}
__device__ __forceinline__ float sigmoidf_(float x) { return __builtin_amdgcn_rcpf(1.f + __expf(-x)); }
__device__ __forceinline__ float siluf_(float x) { return x * sigmoidf_(x); }
__device__ __forceinline__ float gelu_tanh(float y) { const float a = 1.5957691216f * (y + 0.044715f * y * y * y); return y * sigmoidf_(a); }
#define LDS_WAIT() asm volatile("s_waitcnt lgkmcnt(0)" ::: "memory")
#define VM_WAIT() asm volatile("s_waitcnt vmcnt(0)" ::: "memory")

#define XB_TMO      128
#define XB_XCNT(j)  (256  + 64 * (j))
#define XB_XSUB(j)  (1280 + 64 * (j))
#define XB_XGEN(j)  (2304 + 64 * (j))
#define XB_TOP      3328
#define XB_TOPGEN   3392
#define XCD_BAR_WORDS 3456
#define XB_SPIN_CAP (1u << 23)
__device__ __forceinline__ unsigned xb_ld(unsigned* p)              { return __hip_atomic_load(p, __ATOMIC_RELAXED, __HIP_MEMORY_SCOPE_AGENT); }
__device__ __forceinline__ unsigned xb_add(unsigned* p, unsigned v) { return __hip_atomic_fetch_add(p, v, __ATOMIC_RELAXED, __HIP_MEMORY_SCOPE_AGENT); }
__device__ __forceinline__ unsigned xb_xcc_id() { return (unsigned)__builtin_amdgcn_s_getreg((3 << 11) | 20) & 0xFu; }
#define XB_SPIN(cond, bar) do { unsigned _sp = 0; while (cond) { __builtin_amdgcn_s_sleep(1); \
    if ((++_sp & 255u) == 0u) { if (xb_ld(&(bar)[XB_TMO])) break; if (_sp > XB_SPIN_CAP) { atomicAdd(&(bar)[XB_TMO], 1u); break; } } } } while (0)
struct XcdBarrier { unsigned* bar; unsigned x; volatile LAS unsigned* st; };
__device__ __forceinline__ XcdBarrier xcd_barrier_post(unsigned* bar, volatile LAS unsigned* st) {
    XcdBarrier b; b.bar = bar; b.x = xb_xcc_id(); b.st = st;
    if (threadIdx.x == 0) (void)xb_add(&bar[XB_XCNT(b.x)], 1u);
    return b;
}
__device__ __forceinline__ void xcd_barrier_complete(unsigned* bar, unsigned x, unsigned& nloc, unsigned& nx) {
    const unsigned G = gridDim.x * gridDim.y * gridDim.z;
    unsigned sum, cnt, mine, sp = 0u;
    for (;;) {
        sum = 0u; cnt = 0u; mine = 0u;
#pragma unroll
        for (unsigned j = 0; j < 16; ++j) { const unsigned c = xb_ld(&bar[XB_XCNT(j)]); sum += c; cnt += (c > 0u) ? 1u : 0u; mine = (j == x) ? c : mine; }
        if (sum == G) break;
        __builtin_amdgcn_s_sleep(1);
        if ((++sp & 255u) == 0u) { if (xb_ld(&bar[XB_TMO])) break; if (sp > XB_SPIN_CAP) { atomicAdd(&bar[XB_TMO], 1u); break; } }
    }
    nloc = mine > 0u ? mine : 1u; nx = cnt > 0u ? cnt : 1u;
}
__device__ __forceinline__ void xcd_barrier(const XcdBarrier& b) {
    asm volatile("s_waitcnt vmcnt(0)" ::: "memory");
    __syncthreads();
    if (threadIdx.x == 0) {
        unsigned* bar = b.bar;
        __builtin_amdgcn_s_waitcnt(0);
        unsigned nloc = b.st[0], nx = b.st[1];
        if (nloc == 0u) { xcd_barrier_complete(bar, b.x, nloc, nx); b.st[0] = nloc; b.st[1] = nx; }
        const unsigned old = xb_add(&bar[XB_XSUB(b.x)], 1u);
        const unsigned gen = old / nloc;
        if (old + 1u == (gen + 1u) * nloc) {
            __builtin_amdgcn_fence(__ATOMIC_RELEASE, "agent");
            asm volatile("s_waitcnt vmcnt(0)" ::: "memory");
            const unsigned og = xb_add(&bar[XB_TOP], 1u);
            const unsigned tg = og / nx;
            if (og + 1u == (tg + 1u) * nx) xb_add(&bar[XB_TOPGEN], 1u);
            else XB_SPIN(xb_ld(&bar[XB_TOPGEN]) == tg, bar);
            __builtin_amdgcn_fence(__ATOMIC_ACQUIRE, "agent");
            xb_add(&bar[XB_XGEN(b.x)], 1u);
            asm volatile("s_waitcnt vmcnt(0)" ::: "memory");
        } else {
            XB_SPIN(xb_ld(&bar[XB_XGEN(b.x)]) == gen, bar);
            __builtin_amdgcn_fence(__ATOMIC_ACQUIRE, "agent");
            asm volatile("s_waitcnt vmcnt(0)" ::: "memory");
        }
    }
    __syncthreads();
}
namespace pg8 {
constexpr int BM = 256, BK = 64, HALF = 128, HTB = HALF * BK * 2, STAGE_BYTES = 8 * HTB, NXCD = 8, WGM = 8;
__host__ __device__ __forceinline__ int lds_byte(int r, int c) { const int st = (r >> 4) * 2 + (c >> 5), rr = r & 15, cc = c & 31, ob = rr * 64 + cc * 2; return st * 1024 + (ob ^ (((ob >> 9) & 1) << 5)); }
__host__ __device__ __forceinline__ void stage_rc(int b, int& R, int& C) { const int st = b / 1024, sb = b % 1024, swz = sb ^ (((sb >> 9) & 1) << 5); R = (st >> 1) * 16 + swz / 64; C = (st & 1) * 32 + (swz % 64) / 2; }
__host__ __device__ __forceinline__ int perm32(int rho) { const int n = rho >> 4, i = rho & 15; return 8 * (i >> 2) + 4 * n + (i & 3); }

struct Unit { int pm, pn, z; };
struct Gemm { const bf16_t* A; const bf16_t* Bt; int lda, ldb, K; size_t zA, zB; };

struct TileOrder {
    int nM, nN, nz, ntile, G, c, zin;
    __device__ void init(int nM_, int nN_, int nz_, int zin_, int G_, int c_) { nM = nM_; nN = nN_; nz = nz_; zin = zin_; ntile = nM * nN; G = G_; c = c_; }
    __device__ bool next(int i, Unit& u) const {
        long L; int z;
        if (zin) { z = i % nz; L = (long)(i / nz) * G + c; if (L >= ntile) return false; }
        else { const long LL = (long)i * G + c; if (LL >= (long)ntile * nz) return false; z = (int)(LL / ntile); L = LL % ntile; }
        int wgid = (int)L; { const int q = ntile / NXCD, r = ntile % NXCD, xcd = wgid % NXCD, off = wgid / NXCD; wgid = (xcd < r ? xcd * (q + 1) : r * (q + 1) + (xcd - r) * q) + off; }
        const int nig = WGM * nN, gid = wgid / nig, fm = gid * WGM, gsz = (nM - fm) < WGM ? (nM - fm) : WGM;
        u.pm = fm + ((wgid % nig) % gsz); u.pn = (wgid % nig) / gsz; u.z = z; return true;
    }
};

template <class Epi, class Sched>
__device__ __forceinline__ void gemm_phase(LAS unsigned char* lds, const Gemm g, const Sched& S, const Epi& E) {
    int tid = threadIdx.x; asm volatile("" : "+v"(tid));
    const int wid = __builtin_amdgcn_readfirstlane(tid >> 6), lane = tid & 63, wr = wid >> 2, wc = wid & 3, fr = lane & 15, fq = lane >> 4;
    const int K = g.K, nt = K / BK;
    unsigned voffA[2], voffB[2];
#pragma unroll
    for (int i = 0; i < 2; ++i) { int R, C; stage_rc(tid * 16 + i * 8192, R, C); const int Rb = (R & ~31) + perm32(R & 31);
        voffA[i] = (unsigned)(R * g.lda + C) * 2u; voffB[i] = (unsigned)(Rb * g.ldb + C) * 2u; }
    const size_t kstep = (size_t)(BK * 2);
    const size_t hstepA = (size_t)HALF * g.lda * 2, hstepB = (size_t)HALF * g.ldb * 2;
    const unsigned ldsw = (unsigned)wid * 1024u;
    const int aoff = lds_byte(wr * 64 + fr, fq * 8), boff = lds_byte(wc * 32 + fr, fq * 8);
#define PG8_SA(b, h) (((b) * 2 + (h)) * HTB)
#define PG8_SB(b, h) ((4 + (b) * 2 + (h)) * HTB)
#define PG8_STAGE(bufoff, gbase, voff) do { _Pragma("unroll") for (int _i = 0; _i < 2; ++_i) \
        __builtin_amdgcn_global_load_lds((const unsigned*)((const char*)(gbase) + (voff)[_i]), (LAS unsigned*)(lds + (bufoff) + ldsw + _i * 8192), 16, 0, 0); } while (0)
#define PG8_LDA(dst, b, h) do { _Pragma("unroll") for (int m = 0; m < 4; ++m) _Pragma("unroll") for (int k = 0; k < 2; ++k) dst[m][k] = *(const LAS bf16x8*)(lds + PG8_SA(b, h) + aoff + m * 2048 + k * 1024); } while (0)
#define PG8_LDB(dst, b, h) do { _Pragma("unroll") for (int n = 0; n < 2; ++n) _Pragma("unroll") for (int k = 0; k < 2; ++k) dst[n][k] = *(const LAS bf16x8*)(lds + PG8_SB(b, h) + boff + n * 2048 + k * 1024); } while (0)
#define PG8_MMA(ai, bj, At, Bt) do { __builtin_amdgcn_s_setprio(1); _Pragma("unroll") for (int m = 0; m < 4; ++m) _Pragma("unroll") for (int n = 0; n < 2; ++n) _Pragma("unroll") for (int k = 0; k < 2; ++k) \
        acc[ai][bj][m][n] = __builtin_amdgcn_mfma_f32_16x16x32_bf16(Bt[n][k], At[m][k], acc[ai][bj][m][n], 0, 0, 0); __builtin_amdgcn_s_setprio(0); } while (0)
#define PG8_WAIT_V(n) asm volatile("s_waitcnt vmcnt(" #n ")" ::: "memory")
#define PG8_WAIT_L(n) asm volatile("s_waitcnt lgkmcnt(" #n ")" ::: "memory")
#define PG8_BAR __builtin_amdgcn_s_barrier()
#define PG8_SCHED __builtin_amdgcn_sched_barrier(0)
#define PG8_UA(u) ((const char*)(g.A + (size_t)(u).z * g.zA) + (size_t)(u).pm * (2 * hstepA))
#define PG8_UB(u) ((const char*)(g.Bt + (size_t)(u).z * g.zB) + (size_t)(u).pn * (2 * hstepB))
    Unit cur, nxt; int ui = 0;
    if (!S.next(0, cur)) return;
    f32x4 acc[2][2][4][2];
#pragma unroll
    for (int a = 0; a < 2; ++a)
#pragma unroll
        for (int b = 0; b < 2; ++b)
#pragma unroll
            for (int m = 0; m < 4; ++m)
#pragma unroll
                for (int n = 0; n < 2; ++n) acc[a][b][m][n] = (f32x4){0.f, 0.f, 0.f, 0.f};
    bf16x8 At[4][2], B0[2][2], B1[2][2];
    const char* cA = PG8_UA(cur); const char* cB = PG8_UB(cur);
    PG8_STAGE(PG8_SB(0, 0), cB, voffB); PG8_STAGE(PG8_SB(0, 1), cB + hstepB, voffB); PG8_STAGE(PG8_SA(0, 0), cA, voffA); PG8_STAGE(PG8_SA(0, 1), cA + hstepA, voffA);
    if (wr == 1) PG8_BAR;
    PG8_WAIT_V(2); PG8_BAR;
    PG8_STAGE(PG8_SB(1, 0), cB + kstep, voffB); PG8_STAGE(PG8_SA(1, 0), cA + kstep, voffA); PG8_STAGE(PG8_SB(1, 1), cB + hstepB + kstep, voffB);
    PG8_WAIT_V(6); PG8_BAR;
    for (;;) {
        const bool has_next = S.next(ui + 1, nxt);
        const char* nA = has_next ? PG8_UA(nxt) : cA; const char* nB = has_next ? PG8_UB(nxt) : cB;
#pragma unroll 1
        for (int t = 0; t < nt; t += 2) {
            const bool last = (t == nt - 2);
            const char* a1 = cA + (size_t)(t + 1) * kstep;
            const char* a2 = last ? nA : cA + (size_t)(t + 2) * kstep; const char* b2 = last ? nB : cB + (size_t)(t + 2) * kstep;
            const char* a3 = a2 + kstep; const char* b3 = b2 + kstep;
            PG8_LDB(B0, 0, 0); PG8_LDB(B1, 0, 1); PG8_SCHED; PG8_LDA(At, 0, 0); PG8_STAGE(PG8_SA(1, 1), a1 + hstepA, voffA);
            PG8_WAIT_V(8); PG8_WAIT_L(0); PG8_BAR; PG8_MMA(0, 0, At, B0); PG8_MMA(0, 1, At, B1); PG8_BAR; PG8_SCHED;
            PG8_LDA(At, 0, 1); PG8_STAGE(PG8_SB(0, 0), b2, voffB); PG8_STAGE(PG8_SB(0, 1), b2 + hstepB, voffB); PG8_STAGE(PG8_SA(0, 0), a2, voffA);
            PG8_WAIT_V(8); PG8_WAIT_L(0); PG8_BAR; PG8_MMA(1, 0, At, B0); PG8_MMA(1, 1, At, B1); PG8_BAR; PG8_SCHED;
            PG8_LDB(B0, 1, 0); PG8_LDB(B1, 1, 1); PG8_SCHED; PG8_LDA(At, 1, 0); PG8_STAGE(PG8_SA(0, 1), a2 + hstepA, voffA);
            PG8_WAIT_V(8); PG8_WAIT_L(0); PG8_BAR; PG8_MMA(0, 0, At, B0); PG8_MMA(0, 1, At, B1); PG8_BAR; PG8_SCHED;
            PG8_LDA(At, 1, 1); PG8_STAGE(PG8_SB(1, 0), b3, voffB); PG8_STAGE(PG8_SB(1, 1), b3 + hstepB, voffB); PG8_STAGE(PG8_SA(1, 0), a3, voffA);
            PG8_WAIT_V(8); PG8_WAIT_L(0); PG8_BAR; PG8_MMA(1, 0, At, B0); PG8_MMA(1, 1, At, B1); PG8_BAR; PG8_SCHED;
        }
        if (wr == 0) PG8_BAR;
        const bool keep = E(acc, cur, wr, wc, fr, fq);
        if (!has_next) break;
        if (!keep) {
#pragma unroll
            for (int a = 0; a < 2; ++a)
#pragma unroll
                for (int b = 0; b < 2; ++b)
#pragma unroll
                    for (int m = 0; m < 4; ++m)
#pragma unroll
                        for (int n = 0; n < 2; ++n) acc[a][b][m][n] = (f32x4){0.f, 0.f, 0.f, 0.f};
        }
        cur = nxt; cA = nA; cB = nB; ++ui;
        if (wr == 1) PG8_BAR;
    }
    PG8_WAIT_V(0);
    PG8_BAR;
#undef PG8_SA
#undef PG8_SB
#undef PG8_STAGE
#undef PG8_LDA
#undef PG8_LDB
#undef PG8_MMA
#undef PG8_WAIT_V
#undef PG8_WAIT_L
#undef PG8_BAR
#undef PG8_SCHED
#undef PG8_UA
#undef PG8_UB
}
}
#define EPI_ARGS f32x4 (&acc)[2][2][4][2], const pg8::Unit& u, int wr, int wc, int fr, int fq
#define EPI_FOR_ROWS _Pragma("unroll") for (int ai = 0; ai < 2; ++ai) _Pragma("unroll") for (int m = 0; m < 4; ++m)
#define EPI_ROW (u.pm * 256 + ai * 128 + wr * 64 + m * 16 + fr)
#define EPI_FOR_COLS _Pragma("unroll") for (int bj = 0; bj < 2; ++bj)
#define EPI_COL (u.pn * 256 + bj * 128 + wc * 32 + 8 * fq)

__device__ __forceinline__ u32x4 pack8(const f32x4& a, const f32x4& b) { u32x4 w; w.x = pk2(a[0], a[1]); w.y = pk2(a[2], a[3]); w.z = pk2(b[0], b[1]); w.w = pk2(b[2], b[3]); return w; }
__device__ __forceinline__ void unpack8(const u32x4& w, float (&f)[8]) {
    f[0] = bf2f(w.x & 0xffffu); f[1] = __uint_as_float(w.x & 0xffff0000u); f[2] = bf2f(w.y & 0xffffu); f[3] = __uint_as_float(w.y & 0xffff0000u);
    f[4] = bf2f(w.z & 0xffffu); f[5] = __uint_as_float(w.z & 0xffff0000u); f[6] = bf2f(w.w & 0xffffu); f[7] = __uint_as_float(w.w & 0xffff0000u);
}

__device__ __forceinline__ u32x2 pack4(const f32x4& v) { u32x2 w; w.x = pk2(v[0], v[1]); w.y = pk2(v[2], v[3]); return w; }
__device__ __forceinline__ f32x4 unpack4(const u32x2& x) { return (f32x4){bf2f(x.x & 0xffffu), __uint_as_float(x.x & 0xffff0000u), bf2f(x.y & 0xffffu), __uint_as_float(x.y & 0xffff0000u)}; }

struct EpiProj {
    bf16_t* P; float* gate; float* out; int layer;
    __device__ __forceinline__ bool operator()(EPI_ARGS) const {
        const int pn = u.pn;
        int mode;
        if (pn < 4) mode = 0; else if (pn < 8) mode = 1; else if (pn < 12) mode = 5; else if (pn < 16) mode = 3; else if (pn < 18) mode = 0;
        else if (pn < 22) mode = 1; else if (pn < 26) mode = 0; else if (pn < 30) mode = 1; else if (pn < 54) mode = 2; else mode = 4;
        if (mode == 0) {
            EPI_FOR_ROWS { bf16_t* rp = P + (size_t)EPI_ROW * NPROJ; EPI_FOR_COLS { *(u32x4*)(rp + EPI_COL) = pack8(acc[ai][bj][m][0], acc[ai][bj][m][1]); } }
        } else if (mode == 5) {
            EPI_FOR_ROWS { bf16_t* rp = P + (size_t)EPI_ROW * NPROJ; EPI_FOR_COLS { *(u32x4*)(rp + EPI_COL) = pack8(acc[ai][bj][m][0] * SM_SCALE_L2E, acc[ai][bj][m][1] * SM_SCALE_L2E); } }
        } else if (mode == 1) {
            EPI_FOR_ROWS { bf16_t* rp = P + (size_t)EPI_ROW * NPROJ; EPI_FOR_COLS { f32x4 a = acc[ai][bj][m][0], b = acc[ai][bj][m][1];
#pragma unroll
                for (int j = 0; j < 4; ++j) { a[j] = siluf_(a[j]); b[j] = siluf_(b[j]); }
                *(u32x4*)(rp + EPI_COL) = pack8(a, b); } }
        } else if (mode == 2) {
            EPI_FOR_ROWS { bf16_t* rp = P + (size_t)EPI_ROW * NPROJ; EPI_FOR_COLS { f32x4 a = acc[ai][bj][m][0], b = acc[ai][bj][m][1];
#pragma unroll
                for (int j = 0; j < 4; ++j) { a[j] = sigmoidf_(a[j]); b[j] = sigmoidf_(b[j]); }
                *(u32x4*)(rp + EPI_COL) = pack8(a, b); } }
        } else if (mode == 3) {
            EPI_FOR_ROWS { const int row = EPI_ROW; bf16_t* rp = P + (size_t)row * NPROJ;
                float* op = nullptr;
                if (row < MPT) op = out + O_KVP + ((size_t)layer * MPT + row) * 1024;
                else if (row < MROWS) op = out + O_KVS + ((size_t)layer * 32 + (row - MPT)) * 1024;
                EPI_FOR_COLS { const int col = EPI_COL; *(u32x4*)(rp + col) = pack8(acc[ai][bj][m][0], acc[ai][bj][m][1]);
                    if (op) { *(f32x4*)(op + col - C_CK) = acc[ai][bj][m][0]; *(f32x4*)(op + col - C_CK + 4) = acc[ai][bj][m][1]; } } }
        } else {
            EPI_FOR_ROWS { float* gp = gate + (size_t)EPI_ROW * 64; EPI_FOR_COLS { const int c = EPI_COL - C_AG; if (c < 48) { f32x4 a = acc[ai][bj][m][0], b = acc[ai][bj][m][1];
#pragma unroll
                for (int j = 0; j < 4; ++j) { a[j] = sigmoidf_(a[j]); b[j] = sigmoidf_(b[j]); }
                *(f32x4*)(gp + c) = a; *(f32x4*)(gp + c + 4) = b; } } }
        }
        return false;
    }
};

struct EpiPool {
    bf16_t* apool; const bf16_t* P; const float* pscale;
    __device__ __forceinline__ bool operator()(EPI_ARGS) const {
        asm volatile("" ::: "memory");
#pragma unroll
        for (int ai = 0; ai < 2; ++ai) {
            u32x4 zw[4][2];
#pragma unroll
            for (int m = 0; m < 4; ++m) EPI_FOR_COLS { const int col = u.z * 256 + bj * 128 + wc * 32 + 8 * fq; zw[m][bj] = *(const u32x4*)(P + (size_t)EPI_ROW * NPROJ + C_PZ + col); }
            __builtin_amdgcn_sched_barrier(0);
#pragma unroll
            for (int m = 0; m < 4; ++m) EPI_FOR_COLS { const int col = u.z * 256 + bj * 128 + wc * 32 + 8 * fq; float zf[8]; unpack8(zw[m][bj], zf);
                const f32x4 s0 = *(const f32x4*)(pscale + col), s1 = *(const f32x4*)(pscale + col + 4);
                f32x4 a = acc[ai][bj][m][0], b = acc[ai][bj][m][1];
#pragma unroll
                for (int j = 0; j < 4; ++j) { a[j] = a[j] * s0[j] * zf[j]; b[j] = b[j] * s1[j] * zf[4 + j]; }
                *(u32x4*)(apool + (size_t)EPI_ROW * 1024 + col) = pack8(a, b); }
            __builtin_amdgcn_sched_barrier(0);
        }
        return false;
    }
};

struct EpiGlu {
    bf16_t* assm; const bf16_t* P; const bf16_t* Z;
    __device__ __forceinline__ bool operator()(EPI_ARGS) const {
#pragma unroll
        for (int ai = 0; ai < 2; ++ai) {
            u32x4 zw[4][2], sw[4][2];
#pragma unroll
            for (int m = 0; m < 4; ++m) EPI_FOR_COLS { const int row = EPI_ROW, col = EPI_COL; zw[m][bj] = *(const u32x4*)(Z + (size_t)row * 1024 + col); sw[m][bj] = *(const u32x4*)(P + (size_t)row * NPROJ + C_SZ + col); }
            __builtin_amdgcn_sched_barrier(0);
#pragma unroll
            for (int m = 0; m < 4; ++m) EPI_FOR_COLS { float zf[8], sf[8]; unpack8(zw[m][bj], zf); unpack8(sw[m][bj], sf);
                f32x4 a = acc[ai][bj][m][0], b = acc[ai][bj][m][1];
#pragma unroll
                for (int j = 0; j < 4; ++j) { a[j] = zf[j] * sigmoidf_(a[j]) * sf[j]; b[j] = zf[4 + j] * sigmoidf_(b[j]) * sf[4 + j]; }
                *(u32x4*)(assm + (size_t)EPI_ROW * 1024 + EPI_COL) = pack8(a, b); }
            __builtin_amdgcn_sched_barrier(0);
        }
        return false;
    }
};

struct EpiBranch {
    bf16_t* merged; const bf16_t* P;
    __device__ __forceinline__ bool operator()(EPI_ARGS) const {
        const int z = u.z;
#pragma unroll
        for (int ai = 0; ai < 2; ++ai) {
            u32x4 gzw[4][2], gnw[4][2];
#pragma unroll
            for (int m = 0; m < 4; ++m) EPI_FOR_COLS { const bf16_t* gp = P + (size_t)EPI_ROW * NPROJ + C_MG + EPI_COL; gzw[m][bj] = *(const u32x4*)(gp + z * 2048); gnw[m][bj] = *(const u32x4*)(gp + (z < 2 ? z + 1 : 2) * 2048); }
            __builtin_amdgcn_sched_barrier(0);
#pragma unroll
            for (int m = 0; m < 4; ++m) EPI_FOR_COLS { float gz[8], gn[8]; unpack8(gzw[m][bj], gz); unpack8(gnw[m][bj], gn);
                f32x4& a = acc[ai][bj][m][0]; f32x4& b = acc[ai][bj][m][1];
                if (z < 2) {
#pragma unroll
                    for (int j = 0; j < 4; ++j) { a[j] *= fmaxf(gz[j], 1e-30f) * __builtin_amdgcn_rcpf(fmaxf(gn[j], 1e-30f)); b[j] *= fmaxf(gz[4 + j], 1e-30f) * __builtin_amdgcn_rcpf(fmaxf(gn[4 + j], 1e-30f)); }
                } else {
                    f32x4 a2, b2;
#pragma unroll
                    for (int j = 0; j < 4; ++j) { a2[j] = a[j] * fmaxf(gz[j], 1e-30f); b2[j] = b[j] * fmaxf(gz[4 + j], 1e-30f); }
                    *(u32x4*)(merged + (size_t)EPI_ROW * DM + EPI_COL) = pack8(a2, b2);
                } }
            __builtin_amdgcn_sched_barrier(0);
        }
        return z < 2;
    }
};

struct EpiOut {
    bf16_t* outb;
    __device__ __forceinline__ bool operator()(EPI_ARGS) const {
        EPI_FOR_ROWS { bf16_t* rp = outb + (size_t)EPI_ROW * DM; EPI_FOR_COLS { *(u32x4*)(rp + EPI_COL) = pack8(acc[ai][bj][m][0], acc[ai][bj][m][1]); } }
        return false;
    }
};
struct Frame {
    LAS unsigned char* lds;
    int tid, lane, wave, G, bid, gw, ngw;
    float* out; unsigned char* ws;
};
#define FIN(i) ((const float*)(const GAS float*)(((const float* const __attribute__((address_space(4)))*)__builtin_amdgcn_kernarg_segment_ptr())[i]))
#define IN_XP 0
#define IN_XS 1
#define IN_CACHE 2
#define IN_PT 3
#define IN_SWIN 4
#define IN_SPOOL 5
#define IN_SSSM 6
#define IN_GPRE 7
#define IN_GPOST 8
#define IN_WIN 9
#define IN_WPOOL 10
#define IN_PSCALE 11
#define IN_PE 12
#define IN_WPHI 13
#define IN_LRE 14
#define IN_LIM 15
#define IN_LSTEP 16
#define IN_BRE 17
#define IN_BIM 18
#define IN_CRE 19
#define IN_CIM 20
#define IN_DSKIP 21
#define IN_WGLU 22
#define IN_WBRP 23
#define IN_WBRN 24
#define IN_WBRS 25
#define IN_WOUT 26

template <class MAP>
__device__ __forceinline__ void transpose_item(const float* W, int ldw, int K, bf16_t* WT, int k0, int nd0, LAS float* scr, int lane, const MAP& map) {
    const int nq = 4 * (lane & 15), ns = map(nd0 + nq), kr = lane >> 4;
    f32x4 v[16];
#pragma unroll
    for (int i = 0; i < 16; ++i) v[i] = ns >= 0 ? *(const f32x4*)(W + (size_t)(k0 + 4 * i + kr) * ldw + ns) : (f32x4){0.f, 0.f, 0.f, 0.f};
#pragma unroll
    for (int i = 0; i < 16; ++i) { LAS float* d = scr + (4 * i + kr) * 65 + nq; d[0] = v[i].x; d[1] = v[i].y; d[2] = v[i].z; d[3] = v[i].w; }
    LDS_WAIT(); asm volatile("" ::: "memory");
    const int c = lane & 7;
#pragma unroll
    for (int j = 0; j < 8; ++j) { const int n = (lane >> 3) + 8 * j; const LAS float* s = scr + (8 * c) * 65 + n;
        u32x4 o; o.x = pk2(s[0 * 65], s[1 * 65]); o.y = pk2(s[2 * 65], s[3 * 65]); o.z = pk2(s[4 * 65], s[5 * 65]); o.w = pk2(s[6 * 65], s[7 * 65]);
        *(u32x4*)(WT + (size_t)(nd0 + n) * K + k0 + 8 * c) = o; }
    LDS_WAIT(); asm volatile("" ::: "memory");
}
struct MapId { __device__ __forceinline__ int operator()(int n) const { return n; } };
struct MapWin { __device__ __forceinline__ int operator()(int n) const { return n < C_AZ ? n : (n < C_AG ? n + 48 : (n < C_AG + 48 ? n - C_AG + 4608 : -1)); } };

__device__ __forceinline__ double exp_d(double x) {
    const double r = x * (1.0 / 64.0); double t = 1.0, s = 1.0;
#pragma unroll
    for (int k = 1; k <= 14; ++k) { t *= r / (double)k; s += t; }
#pragma unroll
    for (int k = 0; k < 6; ++k) s *= s;
    return s;
}
__device__ __forceinline__ void sincos_d(double x, double& sn, double& cs) {
    const double k = rint(x * 0.63661977236758134308);
    double r = fma(-k, 1.57079632679489655800e+00, x); r = fma(-k, 6.12323399573676603587e-17, r);
    const double r2 = r * r;
    double sp = 1.0, cp = 1.0, ts = 1.0, tc = 1.0;
#pragma unroll
    for (int i = 1; i <= 9; ++i) { ts *= -r2 / (double)((2 * i) * (2 * i + 1)); sp += ts; tc *= -r2 / (double)((2 * i - 1) * (2 * i)); cp += tc; }
    sp *= r;
    const int q = ((int)k) & 3;
    sn = (q == 0) ? sp : (q == 1) ? cp : (q == 2) ? -sp : -cp;
    cs = (q == 0) ? cp : (q == 1) ? -sp : (q == 2) ? -cp : sp;
}

__device__ __forceinline__ void rms_row_to_bf16(const float* xrow, const float* g, bf16_t* orow, int lane) {
    const f32x4* xr = (const f32x4*)xrow + lane; const f32x4* gr = (const f32x4*)g + lane;
    f32x4 v[8]; float s = 0.f;
#pragma unroll
    for (int j = 0; j < 8; ++j) { v[j] = xr[64 * j]; s += (v[j].x * v[j].x + v[j].y * v[j].y) + (v[j].z * v[j].z + v[j].w * v[j].w); }
    const float rstd = 1.f / sqrtf(wave_sum(s) * (1.f / DM) + EPS);
    u32x2* o8 = (u32x2*)orow + lane;
#pragma unroll
    for (int j = 0; j < 8; ++j) { const f32x4 gg = gr[64 * j]; u32x2 w; w.x = pk2(v[j].x * rstd * gg.x, v[j].y * rstd * gg.y); w.y = pk2(v[j].z * rstd * gg.z, v[j].w * rstd * gg.w); o8[64 * j] = w; }
}
__device__ __forceinline__ const float* x_row_l0(const Frame& F, int m) {
    const GAS float* s0 = (const GAS float*)FIN(IN_XP); const GAS float* s1 = (const GAS float*)FIN(IN_XS);
    asm volatile("" : "+s"(s0), "+s"(s1));
    return (const float*)(m < MPT ? s0 + (size_t)m * DM : s1 + (size_t)(m - MPT) * DM); }

__device__ __forceinline__ void phase_prologue(Frame& F) {
    LAS float* scr = (LAS float*)(F.lds + F.wave * 16640);
    const int lane = F.lane;
    constexpr int I_WIN = 32 * (NPROJ / 64), I_GLU = 16 * 16, I_BR = 16 * 32, I_OUT = 32 * 32, I_POOL = 4 * 4, I_PHI = 1;
    constexpr int PER_L = I_WIN + I_GLU + 3 * I_BR + I_OUT + 4 * I_POOL + 128 * I_PHI;
    for (int it = F.gw; it < 2 * PER_L; it += F.ngw) {
        const int l = it / PER_L; int r = it % PER_L;
        if (r < I_WIN) { const int kb = r / (NPROJ / 64), nb = r % (NPROJ / 64);
            transpose_item(FIN(IN_WIN) + (size_t)l * DM * DIN, DIN, DM, (bf16_t*)(F.ws + WS_WIN + l * al1m(SZ_WIN)), 64 * kb, 64 * nb, scr, lane, MapWin()); continue; } r -= I_WIN;
        if (r < I_GLU) { const int kb = r / 16, nb = r % 16;
            transpose_item(FIN(IN_WGLU) + (size_t)l * 1024 * 1024, 1024, 1024, (bf16_t*)(F.ws + WS_WGLU + l * al1m(SZ_WGLU)), 64 * kb, 64 * nb, scr, lane, MapId()); continue; } r -= I_GLU;
        if (r < 3 * I_BR) { const int z = r / I_BR, rr = r % I_BR, kb = rr / 32, nb = rr % 32;
            const float* src = FIN(IN_WBRP + z) + (size_t)l * 1024 * 2048;
            transpose_item(src, 2048, 1024, (bf16_t*)(F.ws + WS_WBR + l * al1m(SZ_WBR)) + (size_t)z * 2048 * 1024, 64 * kb, 64 * nb, scr, lane, MapId()); continue; } r -= 3 * I_BR;
        if (r < I_OUT) { const int kb = r / 32, nb = r % 32;
            transpose_item(FIN(IN_WOUT) + (size_t)l * 2048 * 2048, 2048, 2048, (bf16_t*)(F.ws + WS_WOUT + l * al1m(SZ_WOUT)), 64 * kb, 64 * nb, scr, lane, MapId()); continue; } r -= I_OUT;
        if (r < 4 * I_POOL) { const int z = r / I_POOL, rr = r % I_POOL, kb = rr / 4, nb = rr % 4;
            transpose_item(FIN(IN_WPOOL) + ((size_t)l * 4 + z) * 65536, 256, 256, (bf16_t*)(F.ws + WS_WPOOL + l * al1m(SZ_WPOOL)) + (size_t)z * 65536, 64 * kb, 64 * nb, scr, lane, MapId()); continue; } r -= 4 * I_POOL;
        {
            transpose_item(FIN(IN_WPHI) + ((size_t)l * 128 + r) * 4096, 64, 64, (bf16_t*)(F.ws + WS_WPHI + l * al1m(SZ_WPHI)) + (size_t)r * 4096, 0, 0, scr, lane, MapId()); }
    }
    for (int it = F.gw; it < 64; it += F.ngw) {
        const int l = it >> 5, j = (it >> 4) & 1, part = it & 15;
        const float* pe = FIN(IN_PE) + ((size_t)(l * 2 + j) * 64 + part * 4) * 64;
        const float* wp = FIN(IN_WPHI) + ((size_t)(l * 2 + j) * 64 + part * 4) * 4096;
        float s = 0.f;
#pragma unroll 16
        for (int i = 0; i < 256; ++i) s += pe[i] * wp[(size_t)i * 64 + lane];
        ((float*)(F.ws + WS_PEBP + l * al1m(SZ_PEBP)))[(j * 16 + part) * 64 + lane] = s;
    }
    for (int it = F.gw * 64 + lane; it < 2 * 4096; it += F.ngw * 64) {
        const int l = it >> 12, g = (it >> 6) & 63, n = it & 63;
        const double dt = exp_d((double)FIN(IN_LSTEP)[l * 64 + g]);
        const double lr = (double)FIN(IN_LRE)[(l * 64 + g) * 64 + n], li = (double)FIN(IN_LIM)[(l * 64 + g) * 64 + n];
        const double mag = exp_d(lr * dt); double sn, cs; sincos_d(li * dt, sn, cs);
        const double ar = mag * cs, ai = mag * sn, den = lr * lr + li * li;
        const double cr = ((ar - 1.0) * lr + ai * li) / den, ci = (ai * lr - (ar - 1.0) * li) / den;
        double pr = ar, pi = ai;
#pragma unroll
        for (int k = 0; k < 7; ++k) { const double t = pr * pr - pi * pi; pi = 2.0 * pr * pi; pr = t; }
        float* ab = (float*)(F.ws + WS_SAB + l * al1m(SZ_SAB)) + (g * 64 + n) * 4;
        ab[0] = (float)ar; ab[1] = (float)ai; ab[2] = (float)pr; ab[3] = (float)pi;
        float* bb = (float*)(F.ws + WS_SBB + l * al1m(SZ_SBB)) + (size_t)g * 16 * 128;
        const float* bre = FIN(IN_BRE) + ((size_t)(l * 64 + g) * 64 + n) * 16; const float* bim = FIN(IN_BIM) + ((size_t)(l * 64 + g) * 64 + n) * 16;
        unsigned* bb16 = (unsigned*)(F.ws + WS_SBB16 + l * al1m(SZ_SBB16));
        for (int c = 0; c < 16; c += 2) { const double br0 = bre[c], bi0 = bim[c], br1 = bre[c + 1], bi1 = bim[c + 1];
            const float r0 = (float)(cr * br0 - ci * bi0), i0 = (float)(cr * bi0 + ci * br0), r1 = (float)(cr * br1 - ci * bi1), i1 = (float)(cr * bi1 + ci * br1);
            bb[c * 128 + n] = r0; bb[c * 128 + 64 + n] = i0; bb[(c + 1) * 128 + n] = r1; bb[(c + 1) * 128 + 64 + n] = i1;
            bb16[(((g * 2 + 0) * 64 + n) * 16 + c) >> 1] = pk2(r0, r1); bb16[(((g * 2 + 1) * 64 + n) * 16 + c) >> 1] = pk2(i0, i1); }
        bf16_t* cm = (bf16_t*)(F.ws + WS_SCM + l * al1m(SZ_SCM)) + (size_t)g * 16 * 128;
        const float* cre = FIN(IN_CRE) + (size_t)(l * 64 + g) * 16 * 64; const float* cim = FIN(IN_CIM) + (size_t)(l * 64 + g) * 16 * 64;
        for (int c = 0; c < 16; ++c) *(unsigned*)(cm + c * 128 + 2 * n) = pk2(cre[c * 64 + n], -cim[c * 64 + n]);
    }
    bf16_t* H = (bf16_t*)(F.ws + WS_H);
    for (int m = F.gw; m < MROWS; m += F.ngw) rms_row_to_bf16(x_row_l0(F, m), FIN(IN_GPRE), H + (size_t)m * DM, lane);
}

__device__ __forceinline__ void phase_norm(Frame& F, int l) {
    const int lane = F.lane;
    const bf16_t* outb = (const bf16_t*)(F.ws + WS_OUTB);
    float* y0 = (float*)(F.ws + WS_Y0);
    bf16_t* H = (bf16_t*)(F.ws + WS_H);
    for (int r = F.bid; r < MROWS - MPT; r += F.G) {
        const int m = MPT + r, c0 = F.wave * 256 + 4 * lane;
        LAS float* red = (LAS float*)F.lds;
        const float* xrow = l == 0 ? FIN(IN_XS) + (size_t)r * DM : y0 + (size_t)m * DM;
        float* yrow = l == 0 ? y0 + (size_t)m * DM : F.out + O_YS + (size_t)r * DM;
        const f32x4 o = unpack4(*(const u32x2*)(outb + (size_t)m * DM + c0)), x = *(const f32x4*)(xrow + c0), g = *(const f32x4*)(FIN(IN_GPOST) + l * DM + c0);
        float s = wave_sum(o.x * o.x + o.y * o.y + o.z * o.z + o.w * o.w);
        __syncthreads();
        if (lane == 0) red[F.wave] = s;
        __syncthreads();
        s = 0.f;
#pragma unroll
        for (int w2 = 0; w2 < NWAVES; ++w2) s += red[w2];
        const float rstd = 1.f / sqrtf(s * (1.f / DM) + EPS);
        const f32x4 y = x + o * rstd * g;
        *(f32x4*)(yrow + c0) = y;
        if (l == 0) {
            float s2 = wave_sum(y.x * y.x + y.y * y.y + y.z * y.z + y.w * y.w);
            if (lane == 0) red[8 + F.wave] = s2;
            __syncthreads();
            s2 = 0.f;
#pragma unroll
            for (int w2 = 0; w2 < NWAVES; ++w2) s2 += red[8 + w2];
            const float rstd2 = 1.f / sqrtf(s2 * (1.f / DM) + EPS);
            const f32x4 g2 = *(const f32x4*)(FIN(IN_GPRE) + DM + c0);
            *(u32x2*)(H + (size_t)m * DM + c0) = pack4(y * rstd2 * g2);
        }
    }
    for (int m = F.gw; m < MPT; m += F.ngw) {
        const float* xrow = l == 0 ? x_row_l0(F, m) : y0 + (size_t)m * DM;
        float* yrow = l == 0 ? y0 + (size_t)m * DM : (m < MPT ? F.out + O_YP + (size_t)m * DM : F.out + O_YS + (size_t)(m - MPT) * DM);
        const float* gp = FIN(IN_GPOST) + l * DM;
        float v[4][8]; float s = 0.f;
#pragma unroll
        for (int j = 0; j < 4; ++j) { const u32x4 w = *(const u32x4*)(outb + (size_t)m * DM + 8 * (lane + 64 * j)); unpack8(w, v[j]);
#pragma unroll
            for (int e = 0; e < 8; ++e) s += v[j][e] * v[j][e]; }
        const float rstd = 1.f / sqrtf(wave_sum(s) * (1.f / DM) + EPS);
        float s2 = 0.f;
#pragma unroll
        for (int j = 0; j < 4; ++j) { const int c0 = 8 * (lane + 64 * j);
            const f32x4 g0 = *(const f32x4*)(gp + c0), g1 = *(const f32x4*)(gp + c0 + 4), x0 = *(const f32x4*)(xrow + c0), x1 = *(const f32x4*)(xrow + c0 + 4);
            f32x4 y0v, y1v;
#pragma unroll
            for (int e = 0; e < 4; ++e) { y0v[e] = x0[e] + v[j][e] * rstd * g0[e]; y1v[e] = x1[e] + v[j][4 + e] * rstd * g1[e]; v[j][e] = y0v[e]; v[j][4 + e] = y1v[e]; s2 += y0v[e] * y0v[e] + y1v[e] * y1v[e]; }
            *(f32x4*)(yrow + c0) = y0v; *(f32x4*)(yrow + c0 + 4) = y1v; }
        if (l == 0) {
            const float rstd2 = 1.f / sqrtf(wave_sum(s2) * (1.f / DM) + EPS);
            const float* g2 = FIN(IN_GPRE) + DM;
#pragma unroll
            for (int j = 0; j < 4; ++j) { const int c0 = 8 * (lane + 64 * j); const f32x4 g0 = *(const f32x4*)(g2 + c0), g1 = *(const f32x4*)(g2 + c0 + 4);
                f32x4 a, bq;
#pragma unroll
                for (int e = 0; e < 4; ++e) { a[e] = v[j][e] * rstd2 * g0[e]; bq[e] = v[j][4 + e] * rstd2 * g1[e]; }
                *(u32x4*)(H + (size_t)m * DM + c0) = pack8(a, bq); }
        }
    }
}
template <int KP>
__device__ __forceinline__ void skinny_stage(LAS unsigned char* lds, const bf16_t* A, int lda, int tid) {
    constexpr int CH = KP / 8;
#pragma unroll 8
    for (int i = tid; i < 32 * CH; i += NT) { const int r = i / CH, c = i % CH; *(LAS u32x4*)(lds + r * (KP * 2 + 16) + c * 16) = *(const u32x4*)(A + (size_t)r * lda + 8 * c); }
    __syncthreads();
}
template <int KP>
__device__ __forceinline__ void skinny_tile(const LAS unsigned char* lds, const bf16_t* Bt, int ldb, int n0, int kbeg, int klen, int lane, f32x4& d0, f32x4& d1) {
    const int rw = lane & 15, q = lane >> 4;
    const bf16_t* wrow = Bt + (size_t)(n0 + rw) * ldb + 32 * q;
    const LAS unsigned char* a0 = lds + rw * (KP * 2 + 16) + (kbeg + 32 * q) * 2;
    const LAS unsigned char* a1 = a0 + 16 * (KP * 2 + 16);
    d0 = (f32x4){0.f, 0.f, 0.f, 0.f}; d1 = d0;
#pragma unroll 4
    for (int k0 = 0; k0 < klen; k0 += 128) {
        bf16x8 w[4];
#pragma unroll
        for (int s = 0; s < 4; ++s) w[s] = *(const bf16x8*)(wrow + k0 + 8 * s);
#pragma unroll
        for (int s = 0; s < 4; ++s) { const bf16x8 b0 = *(const LAS bf16x8*)(a0 + k0 * 2 + 16 * s), b1 = *(const LAS bf16x8*)(a1 + k0 * 2 + 16 * s);
            d0 = __builtin_amdgcn_mfma_f32_16x16x32_bf16(w[s], b0, d0, 0, 0, 0); d1 = __builtin_amdgcn_mfma_f32_16x16x32_bf16(w[s], b1, d1, 0, 0, 0); }
    }
}

__device__ __forceinline__ void skinny_proj_epi(Frame& F, int l, int n0, const f32x4 (&d)[2]) {
    bf16_t* P = (bf16_t*)(F.ws + WS_P); float* gate = (float*)(F.ws + WS_GATE);
    const int n = n0 + 4 * (F.lane >> 4), pn = n >> 8;
    int mode; if (pn < 4) mode = 0; else if (pn < 8) mode = 1; else if (pn < 12) mode = 5; else if (pn < 16) mode = 3; else if (pn < 18) mode = 0;
    else if (pn < 22) mode = 1; else if (pn < 26) mode = 0; else if (pn < 30) mode = 1; else if (pn < 54) mode = 2; else mode = 4;
#pragma unroll
    for (int tt = 0; tt < 2; ++tt) { const int t = 16 * tt + (F.lane & 15), row = MPT + t; f32x4 v = d[tt];
        if (mode == 4) { const int c = n - C_AG; if (c < 48) {
#pragma unroll
            for (int j = 0; j < 4; ++j) v[j] = sigmoidf_(v[j]);
            *(f32x4*)(gate + (size_t)row * 64 + c) = v; } }
        else {
            if (mode == 3) *(f32x4*)(F.out + O_KVS + ((size_t)l * 32 + t) * 1024 + n - C_CK) = v;
            if (mode == 5) v = v * SM_SCALE_L2E;
            if (mode == 1) {
#pragma unroll
                for (int j = 0; j < 4; ++j) v[j] = siluf_(v[j]); }
            if (mode == 2) {
#pragma unroll
                for (int j = 0; j < 4; ++j) v[j] = sigmoidf_(v[j]); }
            *(u32x2*)(P + (size_t)row * NPROJ + n) = pack4(v);
        } }
}
__device__ __forceinline__ void skinny_proj(Frame& F, int l) {
    constexpr int NTASK = NPROJ / 128;
    const bf16_t* W = (const bf16_t*)(F.ws + WS_WIN + l * al1m(SZ_WIN));
    const int ntile = (MPT / 256) * (NPROJ / 256), nlight = (ntile % F.G) ? F.G - (ntile % F.G) : F.G, first = F.G - nlight;
    if (F.bid >= first) {
        bool staged = false;
        const int nit = first ? 2 : (NTASK + nlight - 1) / nlight;
        for (int it = 0; it < nit; ++it) { const int task = (F.bid - first) + it * nlight;
            if (task >= NTASK) break;
            if (!staged) { skinny_stage<DM>(F.lds, (const bf16_t*)(F.ws + WS_H) + (size_t)MPT * DM, DM, F.tid); staged = true; }
            const int n0 = task * 128 + F.wave * 16; f32x4 d[2];
            skinny_tile<DM>(F.lds, W, DM, n0, 0, DM, F.lane, d[0], d[1]);
            skinny_proj_epi(F, l, n0, d); }
    } else {
        for (int qt = first - 1 - F.bid; qt < (NTASK - 2 * nlight) * 4; qt += first) {
            __syncthreads();
            skinny_stage<DM>(F.lds, (const bf16_t*)(F.ws + WS_H) + (size_t)MPT * DM, DM, F.tid);
            const int tile = F.wave & 1, kq = F.wave >> 1, n0 = 2 * nlight * 128 + qt * 32 + tile * 16; f32x4 d[2];
            skinny_tile<DM>(F.lds, W + kq * 512, DM, n0, kq * 512, 512, F.lane, d[0], d[1]);
            __syncthreads();
            LAS f32x4* red = (LAS f32x4*)F.lds;
            red[(F.wave * 2 + 0) * 64 + F.lane] = d[0]; red[(F.wave * 2 + 1) * 64 + F.lane] = d[1];
            __syncthreads();
            if (kq == 0) {
#pragma unroll
                for (int tt = 0; tt < 2; ++tt)
#pragma unroll
                    for (int k2 = 1; k2 < 4; ++k2) d[tt] += red[((2 * k2 + tile) * 2 + tt) * 64 + F.lane];
                skinny_proj_epi(F, l, n0, d); }
        }
    }
    __syncthreads();
}
__device__ __forceinline__ void skinny_pool(Frame& F, int l) {
    const bf16_t* P = (const bf16_t*)(F.ws + WS_P); bf16_t* apool = (bf16_t*)(F.ws + WS_ABR);
    const bf16_t* W = (const bf16_t*)(F.ws + WS_WPOOL + l * al1m(SZ_WPOOL)); const float* pscale = FIN(IN_PSCALE) + l * 1024;
    bool staged = false;
    for (int task = F.G - 1 - F.bid; task < 8; task += F.G) {
        if (!staged) { skinny_stage<1024>(F.lds, (const bf16_t*)(F.ws + WS_DIFF) + (size_t)MPT * 1024, 1024, F.tid); staged = true; }
        const int z = task >> 1, n0 = (task & 1) * 128 + F.wave * 16; f32x4 d[2];
        skinny_tile<1024>(F.lds, W + (size_t)z * 65536, 256, n0, z * 256, 256, F.lane, d[0], d[1]);
        const int col = z * 256 + n0 + 4 * (F.lane >> 4);
        const f32x4 ps = *(const f32x4*)(pscale + col);
#pragma unroll
        for (int tt = 0; tt < 2; ++tt) { const int row = MPT + 16 * tt + (F.lane & 15);
            const f32x4 zf = unpack4(*(const u32x2*)(P + (size_t)row * NPROJ + C_PZ + col));
            *(u32x2*)(apool + (size_t)row * 1024 + col) = pack4(d[tt] * ps * zf); }
    }
    __syncthreads();
}
__device__ __forceinline__ void skinny_glu(Frame& F, int l) {
    const bf16_t* P = (const bf16_t*)(F.ws + WS_P); const bf16_t* Z = (const bf16_t*)(F.ws + WS_Z); bf16_t* assm = (bf16_t*)(F.ws + WS_ABR + 2 * SZ_ABR1);
    const bf16_t* W = (const bf16_t*)(F.ws + WS_WGLU + l * al1m(SZ_WGLU));
    bool staged = false;
    for (int task = F.G - 17 - F.bid; task < 8; task += F.G) {
        if (task < 0) continue;
        if (!staged) { skinny_stage<1024>(F.lds, Z + (size_t)MPT * 1024, 1024, F.tid); staged = true; }
        const int n0 = task * 128 + F.wave * 16; f32x4 d[2];
        skinny_tile<1024>(F.lds, W, 1024, n0, 0, 1024, F.lane, d[0], d[1]);
        const int col = n0 + 4 * (F.lane >> 4);
#pragma unroll
        for (int tt = 0; tt < 2; ++tt) { const int row = MPT + 16 * tt + (F.lane & 15);
            const f32x4 zf = unpack4(*(const u32x2*)(Z + (size_t)row * 1024 + col)), sf = unpack4(*(const u32x2*)(P + (size_t)row * NPROJ + C_SZ + col));
            f32x4 v = d[tt];
#pragma unroll
            for (int j = 0; j < 4; ++j) v[j] = zf[j] * sigmoidf_(v[j]) * sf[j];
            *(u32x2*)(assm + (size_t)row * 1024 + col) = pack4(v); }
    }
    __syncthreads();
}
__device__ __forceinline__ void skinny_stage_att(Frame& F) {
    const bf16_t* P = (const bf16_t*)(F.ws + WS_P); const float* so = (const float*)(F.ws + WS_SOACC); const float* gate = (const float*)(F.ws + WS_GATE);
#pragma unroll 2
    for (int i = F.tid; i < 32 * 128; i += NT) { const int r = i >> 7, c = i & 127, head = c >> 3, d0 = (c & 7) * 8, row = MPT + r;
        const int unit = (r >> 2) * 16 + (head >> 2) * 4 + (r & 3);
        const float* sp = so + (size_t)unit * 768 + (head & 3) * 64 + d0; const float* gt = gate + (size_t)row * 64 + head * 3;
        const float g0 = gt[0], g1 = gt[1], g2 = gt[2];
        float zf[8]; unpack8(*(const u32x4*)(P + (size_t)row * NPROJ + C_AZ + head * 64 + d0), zf);
        f32x4 o[2];
#pragma unroll
        for (int h = 0; h < 2; ++h) { const f32x4 a = *(const f32x4*)(sp + 4 * h), b = *(const f32x4*)(sp + 256 + 4 * h), w = *(const f32x4*)(sp + 512 + 4 * h);
#pragma unroll
            for (int j = 0; j < 4; ++j) o[h][j] = (g0 * a[j] + g1 * b[j] + g2 * w[j]) * zf[4 * h + j]; }
        *(LAS u32x4*)(F.lds + r * (1024 * 2 + 16) + c * 16) = pack8(o[0], o[1]); }
    __syncthreads();
}
__device__ __forceinline__ void skinny_branch(Frame& F, int l) {
    const bf16_t* P = (const bf16_t*)(F.ws + WS_P); float* brp = (float*)(F.ws + WS_BRP);
    const bf16_t* W = (const bf16_t*)(F.ws + WS_WBR + l * al1m(SZ_WBR));
    for (int task = F.G - 1 - F.bid; task < 192; task += F.G) {
        const int z = task >> 6, tile = F.wave & 1, kq = F.wave >> 1, n0 = (task & 63) * 32 + tile * 16; f32x4 d[2];
        __syncthreads();
        if (z == 1) skinny_stage_att(F);
        else skinny_stage<1024>(F.lds, (const bf16_t*)(F.ws + WS_ABR) + (size_t)z * MPAD * 1024 + (size_t)MPT * 1024, 1024, F.tid);
        skinny_tile<1024>(F.lds, W + (size_t)z * 2048 * 1024 + kq * 256, 1024, n0, kq * 256, 256, F.lane, d[0], d[1]);
        __syncthreads();
        LAS f32x4* red = (LAS f32x4*)F.lds;
        red[(F.wave * 2 + 0) * 64 + F.lane] = d[0]; red[(F.wave * 2 + 1) * 64 + F.lane] = d[1];
        __syncthreads();
        if (kq == 0) { const int col = n0 + 4 * (F.lane >> 4);
#pragma unroll
            for (int tt = 0; tt < 2; ++tt) { const int t = 16 * tt + (F.lane & 15), row = MPT + t; f32x4 a = d[tt];
#pragma unroll
                for (int k2 = 1; k2 < 4; ++k2) a += red[((2 * k2 + tile) * 2 + tt) * 64 + F.lane];
                const f32x4 gm = unpack4(*(const u32x2*)(P + (size_t)row * NPROJ + C_MG + z * 2048 + col));
                *(f32x4*)(brp + ((size_t)z * 32 + t) * DM + col) = a * gm; } }
    }
    __syncthreads();
}
__device__ __forceinline__ void skinny_out(Frame& F, int l) {
    const float* brp = (const float*)(F.ws + WS_BRP); bf16_t* outb = (bf16_t*)(F.ws + WS_OUTB);
    const bf16_t* W = (const bf16_t*)(F.ws + WS_WOUT + l * al1m(SZ_WOUT));
    bool staged = false;
    for (int task = F.G - 1 - F.bid; task < 64; task += F.G) {
        if (!staged) {
#pragma unroll 4
            for (int i = F.tid; i < 32 * (DM / 4); i += NT) { const int r = i / (DM / 4), c = i % (DM / 4);
                const f32x4 s = *(const f32x4*)(brp + (size_t)r * DM + 4 * c) + *(const f32x4*)(brp + (size_t)(32 + r) * DM + 4 * c) + *(const f32x4*)(brp + (size_t)(64 + r) * DM + 4 * c);
                *(LAS u32x2*)(F.lds + r * (DM * 2 + 16) + c * 8) = pack4(s); }
            __syncthreads(); staged = true; }
        const int tile = F.wave & 1, kq = F.wave >> 1, n0 = task * 32 + tile * 16; f32x4 d[2];
        skinny_tile<DM>(F.lds, W + kq * 512, DM, n0, kq * 512, 512, F.lane, d[0], d[1]);
        __syncthreads();
        LAS f32x4* red = (LAS f32x4*)F.lds;
        red[(F.wave * 2 + 0) * 64 + F.lane] = d[0]; red[(F.wave * 2 + 1) * 64 + F.lane] = d[1];
        staged = false;
        __syncthreads();
        if (kq == 0) {
#pragma unroll
            for (int tt = 0; tt < 2; ++tt) { f32x4 a = d[tt];
#pragma unroll
                for (int k2 = 1; k2 < 4; ++k2) a += red[((2 * k2 + tile) * 2 + tt) * 64 + F.lane];
                *(u32x2*)(outb + (size_t)(MPT + 16 * tt + (F.lane & 15)) * DM + n0 + 4 * (F.lane >> 4)) = pack4(a); } }
        __syncthreads();
    }
    __syncthreads();
}
__device__ __forceinline__ int keypos(int key) { return (key & ~12) | ((key & 4) << 1) | ((key & 8) >> 1); }

template <int W>
__device__ __forceinline__ void pool_diff_load(const bf16_t* P, const float* spool, int m, int c0, f32x4 (&v)[W]) {
    if (m < MPT) {
        const int s = m & (SEQ - 1);
#pragma unroll
        for (int j = 0; j < W; ++j) v[j] = (j <= s) ? unpack4(*(const u32x2*)(P + (size_t)(m - j) * NPROJ + C_PU + c0)) : (f32x4){0.f, 0.f, 0.f, 0.f};
    } else {
        const int b = (m - MPT) >> 2, i = (m - MPT) & 3;
#pragma unroll
        for (int j = 0; j < W; ++j) { const int idx = 15 + i - j;
            v[j] = (idx >= 15) ? unpack4(*(const u32x2*)(P + (size_t)(MPT + b * 4 + idx - 15) * NPROJ + C_PU + c0)) : *(const f32x4*)(spool + ((size_t)b * 15 + idx) * 1024 + c0); }
    }
}
template <int W>
__device__ __forceinline__ void pool_diff_store(bf16_t* D, int m, int c0, const f32x4 (&v)[W]) {
    int cnt = W; if (m < MPT) { const int s = m & (SEQ - 1); cnt = (s + 1 < W) ? s + 1 : W; }
    f32x4 sum = v[0];
#pragma unroll
    for (int j = 1; j < W; ++j) sum += v[j];
    *(u32x2*)(D + (size_t)m * 1024 + c0) = pack4(sum * (1.f / (float)cnt) - v[0]);
}
__device__ __forceinline__ void s2_pool_diff(Frame& F, int l) {
    const bf16_t* P = (const bf16_t*)(F.ws + WS_P); bf16_t* D = (bf16_t*)(F.ws + WS_DIFF);
    const float* spool = FIN(IN_SPOOL) + (size_t)l * SB * 15 * 1024;
    const int c0 = 4 * F.lane;
    for (int m = F.gw; m < MROWS; m += F.ngw) {
        f32x4 v2[2], v4[4], v8[8], v16[16];
        pool_diff_load<2>(P, spool, m, c0, v2); pool_diff_load<4>(P, spool, m, 256 + c0, v4); pool_diff_load<8>(P, spool, m, 512 + c0, v8); pool_diff_load<16>(P, spool, m, 768 + c0, v16);
        pool_diff_store<2>(D, m, c0, v2); pool_diff_store<4>(D, m, 256 + c0, v4); pool_diff_store<8>(D, m, 512 + c0, v8); pool_diff_store<16>(D, m, 768 + c0, v16);
    }
}

__device__ __forceinline__ void store8f(float* dst, const u32x4& x) { float f[8]; unpack8(x, f); *(f32x4*)dst = (f32x4){f[0], f[1], f[2], f[3]}; *(f32x4*)(dst + 4) = (f32x4){f[4], f[5], f[6], f[7]}; }

__device__ __forceinline__ void s2_state_outputs(Frame& F, int l) {
    const bf16_t* P = (const bf16_t*)(F.ws + WS_P);
    const int gt = F.gw * 64 + F.lane, ngt = F.ngw * 64;
    for (int it = gt; it < PB * 15 * 128; it += ngt) { const int c0 = (it & 127) * 8, r = (it >> 7) % 15, b = (it >> 7) / 15;
        store8f(F.out + O_POOLP + (((size_t)l * PB + b) * 15 + r) * 1024 + c0, *(const u32x4*)(P + (size_t)(b * SEQ + SEQ - 15 + r) * NPROJ + C_PU + c0)); }
    for (int it = gt; it < SB * 15 * 128; it += ngt) { const int c0 = (it & 127) * 8, r = (it >> 7) % 15, b = (it >> 7) / 15, e = 4 + r;
        float* dst = F.out + O_POOLS + (((size_t)l * SB + b) * 15 + r) * 1024 + c0;
        if (e < 15) { const float* sp = FIN(IN_SPOOL) + (((size_t)l * SB + b) * 15 + e) * 1024 + c0; *(f32x4*)dst = *(const f32x4*)sp; *(f32x4*)(dst + 4) = *(const f32x4*)(sp + 4); }
        else store8f(dst, *(const u32x4*)(P + (size_t)(MPT + b * 4 + e - 15) * NPROJ + C_PU + c0)); }
    for (int it = gt; it < PB * 512 * 64; it += ngt) { const int c0 = (it & 63) * 8, r = (it >> 6) & 511, b = it >> 15;
        store8f(F.out + O_WINP + (((size_t)l * PB + b) * 512 + r) * 512 + c0, *(const u32x4*)(P + (size_t)(b * SEQ + SEQ - 512 + r) * NPROJ + C_WK + c0)); }
    for (int it = gt; it < SB * 512 * 64; it += ngt) { const int c0 = (it & 63) * 8, r = (it >> 6) & 511, b = it >> 15;
        float* dst = F.out + O_WINS + (((size_t)l * SB + b) * 512 + r) * 512 + c0;
        if (r < 508) { const float* sp = FIN(IN_SWIN) + (((size_t)l * SB + b) * 512 + r + 4) * 512 + c0; *(f32x4*)dst = *(const f32x4*)sp; *(f32x4*)(dst + 4) = *(const f32x4*)(sp + 4); }
        else store8f(dst, *(const u32x4*)(P + (size_t)(MPT + b * 4 + r - 508) * NPROJ + C_WK + c0)); }
}

__device__ __forceinline__ void s2_vt_images(Frame& F) {
    const bf16_t* P = (const bf16_t*)(F.ws + WS_P);
    for (int it = F.gw; it < 2 * PB * 4 * 64; it += F.ngw) {
        const int which = it >> 9, b = (it >> 8) & 1, kvh = (it >> 6) & 3, blk = it & 63;
        const bf16_t* src = P + (size_t)(b * SEQ + blk * 64 + F.lane) * NPROJ + (which ? C_WK : C_SK) + kvh * 64;
        bf16_t* img = (bf16_t*)(F.ws + (which ? WS_KTWIN : WS_KTSEL)) + (size_t)((b * 4 + kvh) * 64 + blk) * 4096 + F.lane * 8;
        u32x4 v[8];
#pragma unroll
        for (int j = 0; j < 8; ++j) v[j] = *(const u32x4*)(src + 8 * j);
#pragma unroll
        for (int j = 0; j < 8; ++j) *(u32x4*)(img + j * 512) = v[j];
    }
    for (int it = F.gw; it < 2 * PB * 4 * 64; it += F.ngw) {
        const int which = it >> 9, b = (it >> 8) & 1, kvh = (it >> 6) & 3, blk = it & 63;
        const bf16_t* src = P + (size_t)(b * SEQ + blk * 64 + F.lane) * NPROJ + (which ? C_WV : C_SV) + kvh * 64;
        const int pos = keypos(F.lane);
        bf16_t* img = (bf16_t*)(F.ws + (which ? WS_VTWIN : WS_VTSEL)) + (size_t)((b * 4 + kvh) * 64 + blk) * 4096 + (pos >> 3) * 512 + (pos & 7);
        u32x4 v[8];
#pragma unroll
        for (int j = 0; j < 8; ++j) v[j] = *(const u32x4*)(src + 8 * j);
#pragma unroll
        for (int j = 0; j < 8; ++j) {
            img[(8 * j + 0) * 8] = (bf16_t)(v[j].x & 0xffffu); img[(8 * j + 1) * 8] = (bf16_t)(v[j].x >> 16);
            img[(8 * j + 2) * 8] = (bf16_t)(v[j].y & 0xffffu); img[(8 * j + 3) * 8] = (bf16_t)(v[j].y >> 16);
            img[(8 * j + 4) * 8] = (bf16_t)(v[j].z & 0xffffu); img[(8 * j + 5) * 8] = (bf16_t)(v[j].z >> 16);
            img[(8 * j + 6) * 8] = (bf16_t)(v[j].w & 0xffffu); img[(8 * j + 7) * 8] = (bf16_t)(v[j].w >> 16); }
    }
}

template <bool SAMPLE>
__device__ __forceinline__ void compress_unit(Frame& F, int l, int unit) {
    const int lane = F.lane, w = F.wave, col = lane & 15, q = lane >> 4, nl = col >> 2, k = col & 3;
    const int b = SAMPLE ? unit >> 5 : unit >> 3, n0 = SAMPLE ? (unit & 31) * 8 : (unit & 7) * 8;
    const bf16_t* wphi = (const bf16_t*)(F.ws + WS_WPHI + l * al1m(SZ_WPHI));
    const bf16_t* P = (const bf16_t*)(F.ws + WS_P);
    const float* cache = FIN(IN_CACHE); const int* pt = (const int*)FIN(IN_PT);
    f32x4 acc[2][2][4];
#pragma unroll
    for (int j = 0; j < 2; ++j)
#pragma unroll
        for (int nt = 0; nt < 2; ++nt)
#pragma unroll
            for (int et = 0; et < 4; ++et) acc[j][nt][et] = (f32x4){0.f, 0.f, 0.f, 0.f};
    size_t xoff[2];
#pragma unroll
    for (int nt = 0; nt < 2; ++nt) { const int blk = n0 + 4 * nt + nl;
        if (SAMPLE) { const int page = pt[b * 128 + (blk >> 1)]; xoff[nt] = ((((size_t)l * NPOOL + page) * 128 + (blk & 1) * 64) * 4) * 256 + k * 64 + 8 * q; }
        else xoff[nt] = (size_t)(b * SEQ + blk * 64) * NPROJ + C_CK + k * 64 + 8 * q; }
    bf16x8 ra[2][2][4];
    f32x4 rx[2][2][2][2];
#define CMP_LOAD(J, LPOS) do { _Pragma("unroll") for (int dc = 0; dc < 2; ++dc) { \
        _Pragma("unroll") for (int et = 0; et < 4; ++et) ra[J][dc][et] = *(const bf16x8*)(wphi + ((size_t)((J) * 64 + (LPOS)) * 64 + 16 * et + col) * 64 + 32 * dc + 8 * q); \
        _Pragma("unroll") for (int nt = 0; nt < 2; ++nt) { \
            if (SAMPLE) { const float* s_ = cache + xoff[nt] + ((size_t)(LPOS) * 4 + (J)) * 256 + 32 * dc; rx[J][dc][nt][0] = __builtin_nontemporal_load((const f32x4*)s_); rx[J][dc][nt][1] = __builtin_nontemporal_load((const f32x4*)(s_ + 4)); } \
            else rx[J][dc][nt][0] = __builtin_bit_cast(f32x4, *(const bf16x8*)(P + xoff[nt] + (size_t)(LPOS) * NPROJ + (J) * 256 + 32 * dc)); } } } while (0)
#define CMP_MMA(J) do { _Pragma("unroll") for (int dc = 0; dc < 2; ++dc) _Pragma("unroll") for (int nt = 0; nt < 2; ++nt) { \
        const bf16x8 bx_ = SAMPLE ? __builtin_bit_cast(bf16x8, pack8(rx[J][dc][nt][0], rx[J][dc][nt][1])) : __builtin_bit_cast(bf16x8, rx[J][dc][nt][0]); \
        _Pragma("unroll") for (int et = 0; et < 4; ++et) acc[J][nt][et] = __builtin_amdgcn_mfma_f32_16x16x32_bf16(ra[J][dc][et], bx_, acc[J][nt][et], 0, 0, 0); } } while (0)
    CMP_LOAD(0, w * 8);
#pragma unroll 1
    for (int li = 0; li < 8; ++li) { const int lpos = w * 8 + li;
        CMP_LOAD(1, lpos); __builtin_amdgcn_sched_barrier(0);
        CMP_MMA(0); __builtin_amdgcn_sched_barrier(0);
        if (li < 7) CMP_LOAD(0, lpos + 1);
        __builtin_amdgcn_sched_barrier(0);
        CMP_MMA(1); __builtin_amdgcn_sched_barrier(0);
    }
#undef CMP_LOAD
#undef CMP_MMA
    LAS float* red = (LAS float*)F.lds;
#pragma unroll
    for (int j = 0; j < 2; ++j)
#pragma unroll
        for (int nt = 0; nt < 2; ++nt)
#pragma unroll
            for (int et = 0; et < 4; ++et)
#pragma unroll
                for (int i = 0; i < 4; ++i) red[(w * 64 + ((j * 2 + nt) * 4 + et) * 4 + i) * 64 + lane] = acc[j][nt][et][i];
    __syncthreads();
    const LAS float* pb = (const LAS float*)(F.lds + 131072);
    bf16_t* kc = (bf16_t*)(F.ws + (SAMPLE ? WS_KCS : WS_KCP)); bf16_t* vct = (bf16_t*)(F.ws + (SAMPLE ? WS_VCTS : WS_VCTP));
    constexpr int NBLK = SAMPLE ? 256 : 64;
    for (int o = F.tid; o < 4096; o += NT) { const int r = o >> 6, ln = o & 63;
        float s = 0.f;
#pragma unroll
        for (int ww = 0; ww < 8; ++ww) s += red[(ww * 64 + r) * 64 + ln];
        const int j = r >> 5, nt = (r >> 4) & 1, et = (r >> 2) & 3, i = r & 3, e = 16 * et + 4 * (ln >> 4) + i, cc = ln & 15, blk = n0 + 4 * nt + (cc >> 2), kk = cc & 3;
        s += pb[j * 64 + e];
        if (j == 0) kc[((size_t)(b * 4 + kk) * NBLK + blk) * 64 + e] = (bf16_t)f2bf(s);
        else vct[(((size_t)(b * 4 + kk) * (NBLK / 64) + (blk >> 6)) * 64 + e) * 64 + keypos(blk & 63)] = (bf16_t)f2bf(s);
    }
    __syncthreads();
}

__device__ __forceinline__ void compress_prompt_piece(Frame& F, int l, int piece) {
    const int lane = F.lane, w = F.wave, col = lane & 15, q = lane >> 4, nl = col >> 2, k = col & 3;
    const int ntile = piece >> 3, j = (piece >> 2) & 1, et = piece & 3, b = ntile >> 4, n0 = (ntile & 15) * 4;
    const bf16_t* wphi = (const bf16_t*)(F.ws + WS_WPHI + l * al1m(SZ_WPHI)) + ((size_t)(j * 64) * 64 + 16 * et + col) * 64 + 8 * q;
    const bf16_t* xp = (const bf16_t*)(F.ws + WS_P) + (size_t)(b * SEQ + (n0 + nl) * 64) * NPROJ + C_CK + j * 256 + k * 64 + 8 * q;
    bf16x8 a[16], x[16];
#pragma unroll
    for (int li = 0; li < 8; ++li)
#pragma unroll
        for (int dc = 0; dc < 2; ++dc) { const int lpos = w * 8 + li;
            a[li * 2 + dc] = *(const bf16x8*)(wphi + (size_t)lpos * 4096 + 32 * dc); x[li * 2 + dc] = *(const bf16x8*)(xp + (size_t)lpos * NPROJ + 32 * dc); }
    f32x4 acc = {0.f, 0.f, 0.f, 0.f};
#pragma unroll
    for (int i = 0; i < 16; ++i) acc = __builtin_amdgcn_mfma_f32_16x16x32_bf16(a[i], x[i], acc, 0, 0, 0);
    LAS float* red = (LAS float*)F.lds;
    __syncthreads();
#pragma unroll
    for (int i = 0; i < 4; ++i) red[(w * 4 + i) * 64 + lane] = acc[i];
    __syncthreads();
    if (F.tid < 256) { const int i = F.tid >> 6, ln = F.tid & 63; float s = 0.f;
#pragma unroll
        for (int ww = 0; ww < 8; ++ww) s += red[(ww * 4 + i) * 64 + ln];
        const int e = 16 * et + 4 * (ln >> 4) + i, cc = ln & 15, blk = n0 + (cc >> 2), kk = cc & 3;
        s += ((const LAS float*)(F.lds + 131072))[j * 64 + e];
        if (j == 0) ((bf16_t*)(F.ws + WS_KCP))[(size_t)(b * 4 + kk) * 4096 + (e >> 3) * 512 + blk * 8 + (e & 7)] = (bf16_t)f2bf(s);
        else { const int pos = keypos(blk); ((bf16_t*)(F.ws + WS_VCTP))[(size_t)(b * 4 + kk) * 4096 + (pos >> 3) * 512 + e * 8 + (pos & 7)] = (bf16_t)f2bf(s); } }
    __syncthreads();
}

__device__ __forceinline__ void s2_compress(Frame& F, int l) {
    if (F.tid < 128) { const float* pp = (const float*)(F.ws + WS_PEBP + l * al1m(SZ_PEBP)); float s = 0.f;
#pragma unroll
        for (int p = 0; p < 16; ++p) s += pp[((F.tid >> 6) * 16 + p) * 64 + (F.tid & 63)];
        ((LAS float*)(F.lds + 131072))[F.tid] = s; }
    __syncthreads();
    for (int u = F.bid; u < 256; u += F.G) compress_unit<true>(F, l, u);
    for (int u = F.bid; u < 256; u += F.G) compress_prompt_piece(F, l, u);
}

#ifndef NSA_SGB
#define NSA_SGB 1
#endif
#define MFMA32(a, b, c) __builtin_amdgcn_mfma_f32_32x32x16_bf16((a), (b), (c), 0, 0, 0)
constexpr float NEG_BIG = -1e30f;
constexpr int AL_K = 0, AL_V = 8192, AL_SLOT = 16384  , AL_MASK = 4 * AL_SLOT  , AL_UNION = AL_MASK + 512,
              AL_TOT = 66560  , AL_IMP = AL_TOT  ;
__device__ __forceinline__ void dma16(const void* src, LAS unsigned char* dst) { __builtin_amdgcn_global_load_lds((const unsigned*)src, (LAS unsigned*)dst, 16, 0, 0); }
__device__ __forceinline__ void tile_dma(const bf16_t* kimg, const bf16_t* vimg, LAS unsigned char* slot, int w, int lane) {
    dma16(kimg + (unsigned)w * 512u + 8u * (unsigned)lane, slot + AL_K + w * 1024);
    dma16(vimg + (unsigned)w * 512u + 8u * (unsigned)lane, slot + AL_V + w * 1024);
}

template <int CTRL> __device__ __forceinline__ float quad_xor(float x) { return __int_as_float(__builtin_amdgcn_update_dpp(0, __float_as_int(x), CTRL, 0xF, 0xF, false)); }
struct FlashState { f32x16 o[2]; float m, l; };
__device__ __forceinline__ void flash_reset(FlashState& S) {
#pragma unroll
    for (int i = 0; i < 16; ++i) { S.o[0][i] = 0.f; S.o[1][i] = 0.f; }
    S.m = 0.f; S.l = 0.f;
}
__device__ __forceinline__ void flash_scores(const LAS unsigned char* kbuf, const bf16x8 (&qf)[4], int r, int h, float init, f32x16& s0, f32x16& s1) {
    bf16x8 kf[8];
#pragma unroll
    for (int ks = 0; ks < 4; ++ks) { kf[2 * ks] = *(const LAS bf16x8*)(kbuf + (2 * ks + h) * 1024 + r * 16); kf[2 * ks + 1] = *(const LAS bf16x8*)(kbuf + (2 * ks + h) * 1024 + (32 + r) * 16); }
    __builtin_amdgcn_sched_barrier(0);
#pragma unroll
    for (int i = 0; i < 16; ++i) { s0[i] = init; s1[i] = init; }
#pragma unroll
    for (int ks = 0; ks < 4; ++ks) { s0 = MFMA32(kf[2 * ks], qf[ks], s0); s1 = MFMA32(kf[2 * ks + 1], qf[ks], s1); }
}
__device__ __forceinline__ bf16x8 pack_p(const f32x16& p, int s) {
    u32x4 w; w.x = pk2(p[8 * s], p[8 * s + 1]); w.y = pk2(p[8 * s + 2], p[8 * s + 3]); w.z = pk2(p[8 * s + 4], p[8 * s + 5]); w.w = pk2(p[8 * s + 6], p[8 * s + 7]);
    return __builtin_bit_cast(bf16x8, w);
}
__device__ __forceinline__ void flash_vload(const LAS unsigned char* vbuf, int r, int h, bf16x8 (&vf)[8]) {
#pragma unroll
    for (int sub = 0; sub < 2; ++sub)
#pragma unroll
        for (int s = 0; s < 2; ++s)
#pragma unroll
            for (int dt = 0; dt < 2; ++dt) vf[(sub * 2 + s) * 2 + dt] = *(const LAS bf16x8*)(vbuf + (4 * sub + 2 * s + h) * 1024 + (32 * dt + r) * 16);
    __builtin_amdgcn_sched_barrier(0);
}
__device__ __forceinline__ void flash_pv(const bf16x8 (&vf)[8], const f32x16& p0, const f32x16& p1, f32x16 (&o)[2]) {
#pragma unroll
    for (int sub = 0; sub < 2; ++sub)
#pragma unroll
        for (int s = 0; s < 2; ++s) {
            const bf16x8 pb = pack_p(sub ? p1 : p0, s);
#pragma unroll
            for (int dt = 0; dt < 2; ++dt) o[dt] = MFMA32(vf[(sub * 2 + s) * 2 + dt], pb, o[dt]);
        }
}
__device__ __forceinline__ float xhalf_max(float x) {
    const auto r = __builtin_amdgcn_permlane32_swap(__float_as_uint(x), __float_as_uint(x), false, false);
    return fmaxf(__uint_as_float(r[0]), __uint_as_float(r[1]));
}
__device__ __forceinline__ void flash_mask(f32x16& s0, f32x16& s1, int lo, int hi, int h) {
#pragma unroll
    for (int i = 0; i < 16; ++i) { const int key = (i & 3) + 8 * (i >> 2) + 4 * h;
        s0[i] = (key >= lo && key <= hi) ? s0[i] : -INFINITY; s1[i] = (key + 32 >= lo && key + 32 <= hi) ? s1[i] : -INFINITY; }
}
__device__ __forceinline__ float flash_rowmax(const f32x16& s0, const f32x16& s1) {
    float mx = -INFINITY;
#pragma unroll
    for (int i = 0; i < 16; ++i) asm("v_max3_f32 %0, %1, %2, %3" : "=v"(mx) : "v"(mx), "v"(s0[i]), "v"(s1[i]));
    return xhalf_max(mx);
}
__device__ __forceinline__ void flash_first(FlashState& S, f32x16& s0, f32x16& s1, int lo, int hi, int h, bool masked) {
    if (masked) flash_mask(s0, s1, lo, hi, h);
    S.m = fmaxf(flash_rowmax(s0, s1), NEG_BIG);
    float ls = 0.f;
#pragma unroll
    for (int i = 0; i < 16; ++i) { s0[i] = __builtin_amdgcn_exp2f(s0[i] - S.m); s1[i] = __builtin_amdgcn_exp2f(s1[i] - S.m); ls += s0[i] + s1[i]; }
    S.l = ls;
}
__device__ __forceinline__ void flash_next(FlashState& S, f32x16& s0, f32x16& s1, float mused, int lo, int hi, int h, bool masked, bool first) {
    if (masked) flash_mask(s0, s1, lo, hi, h);
    const float corr = S.m - mused;
    if (__ballot(corr != 0.f) != 0ull) {
#pragma unroll
        for (int i = 0; i < 16; ++i) { s0[i] -= corr; s1[i] -= corr; } }
    const float mx = flash_rowmax(s0, s1);
    if (__ballot(mx > SM_THR || (first && mx < -SM_THR)) != 0ull) {
        const float d = (mx > NEG_BIG) ? (first ? mx : fmaxf(mx, 0.f)) : 0.f, alpha = __builtin_amdgcn_exp2f(-d);
        S.m += d; S.l *= alpha;
#pragma unroll
        for (int i = 0; i < 16; ++i) { S.o[0][i] *= alpha; S.o[1][i] *= alpha; s0[i] -= d; s1[i] -= d; }
    }
    float ls = 0.f;
#pragma unroll
    for (int i = 0; i < 16; ++i) { s0[i] = __builtin_amdgcn_exp2f(s0[i]); s1[i] = __builtin_amdgcn_exp2f(s1[i]); ls += s0[i] + s1[i]; }
    S.l += ls;
}

__device__ __forceinline__ void flash_kload(const LAS unsigned char* kbuf, int r, int h, bf16x8 (&kf)[8]) {
#pragma unroll
    for (int ks = 0; ks < 4; ++ks) { kf[2 * ks] = *(const LAS bf16x8*)(kbuf + (2 * ks + h) * 1024 + r * 16); kf[2 * ks + 1] = *(const LAS bf16x8*)(kbuf + (2 * ks + h) * 1024 + (32 + r) * 16); }
    __builtin_amdgcn_sched_barrier(0);
}
struct TileCtl { bool en, masked; int lo, hi; };
__device__ __forceinline__ void flash_pair(FlashState& S, const LAS unsigned char* ka, const LAS unsigned char* va, const LAS unsigned char* kb2, const LAS unsigned char* vb2,
                                           const bf16x8 (&qf)[4], const TileCtl& A, const TileCtl& B, bool first, int r, int h) {
    bf16x8 kf[8]; f32x16 a0, a1, b0, b1;
    flash_kload(ka, r, h, kf);
    { const float init = A.en ? -S.m : -INFINITY;
#pragma unroll
        for (int i = 0; i < 16; ++i) { a0[i] = init; a1[i] = init; }
#pragma unroll
        for (int ks = 0; ks < 4; ++ks) { a0 = MFMA32(kf[2 * ks], qf[ks], a0); a1 = MFMA32(kf[2 * ks + 1], qf[ks], a1); } }
    if (A.masked) flash_mask(a0, a1, A.lo, A.hi, h);
    { const float mx = flash_rowmax(a0, a1);
        if (__ballot(mx > SM_THR || (first && mx < -SM_THR)) != 0ull) { const float d = (mx > NEG_BIG) ? (first ? mx : fmaxf(mx, 0.f)) : 0.f, alpha = __builtin_amdgcn_exp2f(-d); S.m += d; S.l *= alpha;
#pragma unroll
            for (int i = 0; i < 16; ++i) { S.o[0][i] *= alpha; S.o[1][i] *= alpha; a0[i] -= d; a1[i] -= d; } } }
    flash_kload(kb2, r, h, kf);
    { const float init = B.en ? -S.m : -INFINITY;
#pragma unroll
        for (int i = 0; i < 16; ++i) { b0[i] = init; b1[i] = init; } }
    __builtin_amdgcn_sched_barrier(0);
#pragma unroll
    for (int k = 0; k < 8; ++k) {
        if (k & 1) b1 = MFMA32(kf[k], qf[k >> 1], b1); else b0 = MFMA32(kf[k], qf[k >> 1], b0);
#pragma unroll
        for (int e = 0; e < 4; ++e) { const int idx = 4 * k + e;
            if (idx < 16) { float t = __builtin_amdgcn_exp2f(a0[idx]); asm volatile("" : "+v"(t)); a0[idx] = t; }
            else { float t = __builtin_amdgcn_exp2f(a1[idx - 16]); asm volatile("" : "+v"(t)); a1[idx - 16] = t; } }
        __builtin_amdgcn_sched_barrier(0);
    }
    bf16x8 pa[4]; float ls = 0.f;
#pragma unroll
    for (int i = 0; i < 16; ++i) ls += a0[i] + a1[i];
    pa[0] = pack_p(a0, 0); pa[1] = pack_p(a0, 1); pa[2] = pack_p(a1, 0); pa[3] = pack_p(a1, 1);
    S.l += ls;
    __builtin_amdgcn_sched_barrier(0);
    if (B.masked) flash_mask(b0, b1, B.lo, B.hi, h);
    float alphaB = 1.f;
    { const float mx = flash_rowmax(b0, b1);
        if (__ballot(mx > SM_THR) != 0ull) { const float d = (mx > NEG_BIG) ? fmaxf(mx, 0.f) : 0.f; alphaB = __builtin_amdgcn_exp2f(-d); S.m += d; S.l *= alphaB;
#pragma unroll
            for (int i = 0; i < 16; ++i) { b0[i] -= d; b1[i] -= d; } } }
    { bf16x8 vf[8]; flash_vload(va, r, h, vf);
#pragma unroll
        for (int k = 0; k < 8; ++k) {
            S.o[k & 1] = MFMA32(vf[k], pa[k >> 1], S.o[k & 1]);
#pragma unroll
            for (int e = 0; e < 4; ++e) { const int idx = 4 * k + e;
                if (idx < 16) { float t = __builtin_amdgcn_exp2f(b0[idx]); asm volatile("" : "+v"(t)); b0[idx] = t; }
                else { float t = __builtin_amdgcn_exp2f(b1[idx - 16]); asm volatile("" : "+v"(t)); b1[idx - 16] = t; } }
            __builtin_amdgcn_sched_barrier(0);
        }
    }
    __builtin_amdgcn_sched_barrier(0);
    if (__ballot(alphaB != 1.f) != 0ull) {
#pragma unroll
        for (int i = 0; i < 16; ++i) { S.o[0][i] *= alphaB; S.o[1][i] *= alphaB; } }
    { bf16x8 vf[8]; flash_vload(vb2, r, h, vf);
        bf16x8 pb[4]; pb[0] = pack_p(b0, 0); pb[1] = pack_p(b0, 1); pb[2] = pack_p(b1, 0); pb[3] = pack_p(b1, 1);
        float l0 = 0.f, l1 = 0.f;
        __builtin_amdgcn_sched_barrier(0);
#pragma unroll
        for (int k = 0; k < 8; ++k) {
            S.o[k & 1] = MFMA32(vf[k], pb[k >> 1], S.o[k & 1]);
#pragma unroll
            for (int e = 0; e < 2; ++e) { const int idx = 2 * k + e; l0 += b0[idx]; l1 += b1[idx]; }
            asm volatile("" : "+v"(l0), "+v"(l1));
            __builtin_amdgcn_sched_barrier(0);
        }
        S.l += l0 + l1; }
}

__device__ __forceinline__ void nsa_prompt_unit(Frame& F, int l, int b, int kvh, int c) {
    int tid = threadIdx.x; asm volatile("" : "+v"(tid));
    const int lane = tid & 63, w = F.wave, r = lane & 31, h = lane >> 5, qi = r >> 2, g = r & 3, qloc = 8 * w + qi;
    const int tok = b * SEQ + 64 * c + qloc, head = kvh * 4 + g;
    const bf16_t* P = (const bf16_t*)(F.ws + WS_P);
    LAS unsigned char* kbuf = F.lds + AL_K; LAS unsigned char* vbuf = F.lds + AL_V;
    LAS float* imp = (LAS float*)(F.lds + AL_IMP); LAS unsigned* msk = (LAS unsigned*)(F.lds + AL_MASK); LAS unsigned* uni = (LAS unsigned*)(F.lds + AL_UNION);
    __syncthreads();
    tile_dma((const bf16_t*)(F.ws + WS_KCP) + (size_t)(b * 4 + kvh) * 4096, (const bf16_t*)(F.ws + WS_VCTP) + (size_t)(b * 4 + kvh) * 4096, F.lds, w, lane);
    bf16x8 qf[4];
#pragma unroll
    for (int ks = 0; ks < 4; ++ks) qf[ks] = *(const bf16x8*)(P + (size_t)tok * NPROJ + C_Q + head * 64 + 16 * ks + 8 * h);
    const float* gt = (const float*)(F.ws + WS_GATE) + (size_t)tok * 64 + head * 3;
    const float g_cmp = gt[0], g_sel = gt[1], g_win = gt[2];
    LAS f32x4* ltot = (LAS f32x4*)(F.lds + AL_TOT) + tid;
    FlashState S;
    {
        if (tid < 128) msk[tid] = 0u; if (tid < 2) uni[tid] = 0u;
        __syncthreads();
        flash_reset(S);
        f32x16 s0, s1; flash_scores(kbuf, qf, r, h, 0.f, s0, s1);
        const int nvalid = c + (qloc == 63 ? 1 : 0);
        bf16x8 vf[8]; flash_vload(vbuf, r, h, vf);
        flash_first(S, s0, s1, 0, nvalid - 1, h, true);
        const float lt = S.l + __shfl_xor(S.l, 32), inv = lt > 0.f ? 1.f / lt : 0.f;
#pragma unroll
        for (int i = 0; i < 16; ++i) { s0[i] *= inv; s1[i] *= inv; }
#pragma unroll
        for (int i = 0; i < 16; ++i) { float a = s0[i]; a += quad_xor<0xB1>(a); a += quad_xor<0x4E>(a); float bq = s1[i]; bq += quad_xor<0xB1>(bq); bq += quad_xor<0x4E>(bq);
            if (g == 0) { const int key = (i & 3) + 8 * (i >> 2) + 4 * h; imp[qloc * 65 + key] = a; imp[qloc * 65 + key + 32] = bq; } }
        flash_pv(vf, s0, s1, S.o);
    }
    __syncthreads();
    {
        const int n = lane; const bool cand = (n >= 1) && (n <= c - 2);
        const unsigned long long forced = 1ull | (1ull << c) | (c >= 1 ? (1ull << (c - 1)) : 0ull);
        unsigned long long um = 0ull;
#pragma unroll 1
        for (int qq = 0; qq < 8; ++qq) { const int q = w * 8 + qq;
            const unsigned kb_ = cand ? ((__float_as_uint(imp[q * 65 + n]) & ~63u) | (unsigned)(63 - n)) : 0u;
            int rank = 0;
            for (int j = 1; j <= c - 2; ++j) { const unsigned sj = __builtin_amdgcn_readlane(kb_, j); rank += (sj > kb_) ? 1 : 0; }
            const unsigned long long m = __ballot(cand && rank < 13) | forced;
            if (lane == 0) { msk[q * 2] = (unsigned)m; msk[q * 2 + 1] = (unsigned)(m >> 32); }
            um |= m; }
        if (lane == 0) { atomicOr((unsigned*)uni, (unsigned)um); atomicOr((unsigned*)(uni + 1), (unsigned)(um >> 32)); }
    }
    __syncthreads();
    const unsigned mlo = msk[qloc * 2], mhi = msk[qloc * 2 + 1], ulo = uni[0], uhi = uni[1];
#pragma unroll
    for (int i4 = 0; i4 < 8; ++i4) { const f32x16& o = S.o[i4 >> 2]; const int i = 4 * (i4 & 3); ltot[i4 * 512] = (f32x4){g_cmp * o[i], g_cmp * o[i + 1], g_cmp * o[i + 2], g_cmp * o[i + 3]}; }
#define NSA_POP(REM_) ((REM_) ? (t_ = sel ? __builtin_ctzll(REM_) : 63 - __builtin_clzll(REM_), (REM_) &= ~(1ull << t_), t_) : -1)
#define NSA_EN(N_) (sel ? ((((N_) < 32 ? mlo >> (N_) : mhi >> ((N_) - 32)) & 1u) != 0u) : true)
#define NSA_LOHI(N_) const int n_ = (N_), lo_ = (!sel && n_ == c - 8) ? qloc + 1 : 0, hi_ = (n_ == c) ? qloc : 63; const bool mk_ = (n_ == c) || (!sel && n_ == c - 8)
#define NSA_PV(SLOT_, S0_, S1_) do { bf16x8 vf[8]; flash_vload(vbuf + (SLOT_), r, h, vf); flash_pv(vf, S0_, S1_, S.o); } while (0)
#pragma unroll 1
    for (int pass = 0; pass < 2; ++pass) {
        const bool sel = pass == 0;
        flash_reset(S);
        const bf16_t* kb = (const bf16_t*)(F.ws + (sel ? WS_KTSEL : WS_KTWIN)) + (size_t)(b * 4 + kvh) * 64 * 4096;
        const bf16_t* vt = (const bf16_t*)(F.ws + (sel ? WS_VTSEL : WS_VTWIN)) + (size_t)(b * 4 + kvh) * 64 * 4096;
        unsigned long long rem;
        if (sel) rem = ((unsigned long long)uhi << 32) | ulo;
        else { const int lo = c >= 8 ? c - 8 : 0; rem = (c == 63 ? ~0ull : ((1ull << (c + 1)) - 1ull)) & ~((1ull << lo) - 1ull); }
        int t_;
        int tA = NSA_POP(rem), tB = NSA_POP(rem);
        int pr = 0; bool first = true;
        __syncthreads();
        tile_dma(kb + (size_t)tA * 4096, vt + (size_t)tA * 4096, F.lds, w, lane);
        if (tB >= 0) tile_dma(kb + (size_t)tB * 4096, vt + (size_t)tB * 4096, F.lds + AL_SLOT, w, lane);
        for (;;) {
            const int sa = pr, sb = pr + AL_SLOT;
            __syncthreads();
            const int nA = NSA_POP(rem), nB = NSA_POP(rem);
            if (nA >= 0) tile_dma(kb + (size_t)nA * 4096, vt + (size_t)nA * 4096, F.lds + (pr ^ (2 * AL_SLOT)), w, lane);
            if (nB >= 0) tile_dma(kb + (size_t)nB * 4096, vt + (size_t)nB * 4096, F.lds + (pr ^ (2 * AL_SLOT)) + AL_SLOT, w, lane);
            const bool enA = first || NSA_EN(tA), enB = tB >= 0 ? NSA_EN(tB) : false;
            if (__ballot(enA || enB) != 0ull) {
                TileCtl A, B;
                A.en = enA; A.masked = (tA == c) || (!sel && tA == c - 8); A.lo = (!sel && tA == c - 8) ? qloc + 1 : 0; A.hi = (tA == c) ? qloc : 63;
                B.en = enB; B.masked = (tB == c) || (!sel && tB == c - 8); B.lo = (!sel && tB == c - 8) ? qloc + 1 : 0; B.hi = (tB == c) ? qloc : 63;
                const int sbb = tB >= 0 ? sb : sa;
                flash_pair(S, kbuf + sa, vbuf + sa, kbuf + sbb, vbuf + sbb, qf, A, B, first, r, h);
            }
            first = false;
            if (nA < 0) break;
            tA = nA; tB = nB; pr ^= 2 * AL_SLOT;
        }
        const float lt = S.l + __shfl_xor(S.l, 32), sc = (sel ? g_sel : g_win) / lt;
#pragma unroll
        for (int i4 = 0; i4 < 8; ++i4) { const f32x16& o = S.o[i4 >> 2]; const int i = 4 * (i4 & 3); ltot[i4 * 512] += (f32x4){sc * o[i], sc * o[i + 1], sc * o[i + 2], sc * o[i + 3]}; }
    }
#undef NSA_PV
#undef NSA_LOHI
#undef NSA_EN
#undef NSA_POP
    bf16_t* ao = (bf16_t*)(F.ws + WS_ABR + SZ_ABR1) + (size_t)tok * 1024 + head * 64;
    const bf16_t* az = P + (size_t)tok * NPROJ + C_AZ + head * 64;
#pragma unroll
    for (int i4 = 0; i4 < 8; ++i4) { const int d = 32 * (i4 >> 2) + 8 * (i4 & 3) + 4 * h;
        const f32x4 t = ltot[i4 * 512]; const f32x4 zz = unpack4(*(const u32x2*)(az + d));
        *(u32x2*)(ao + d) = pack4(t * zz); }
}

constexpr int SL_Q = 0  , SL_SC = 1024  , SL_IMP = SL_SC + 4 * 1040 * 4  , SL_RED = SL_IMP + 264 * 4  ,
              SL_LIST = SL_RED + 128  , SL_KOFF = SL_LIST + 64  , SL_PART = SL_KOFF + 1040 * 4  , SL_OACC = SL_PART + 32768  , SL_PT = SL_OACC + 3072  ;
constexpr int KOFF_INVALID = -2147483647;

__device__ __forceinline__ void block_softmax4(LAS float* sc, int count, LAS float* red, int tid) {
    const int gh = tid >> 7, t = tid & 127, wv = tid >> 6;
    LAS float* row = sc + gh * 1040;
    float mx = -INFINITY;
    for (int i = t; i < count; i += 128) mx = fmaxf(mx, row[i]);
    mx = wave_max(mx);
    if ((tid & 63) == 0) red[wv] = mx;
    __syncthreads();
    mx = fmaxf(red[2 * gh], red[2 * gh + 1]);
    float sm = 0.f;
    for (int i = t; i < count; i += 128) { const float p = __expf(row[i] - mx); row[i] = p; sm += p; }
    sm = wave_sum(sm);
    if ((tid & 63) == 0) red[8 + wv] = sm;
    __syncthreads();
    const float inv = 1.f / (red[8 + 2 * gh] + red[8 + 2 * gh + 1]);
    for (int i = t; i < count; i += 128) row[i] *= inv;
    __syncthreads();
}
__device__ __forceinline__ void sample_scores(const float* base, const bf16_t* Pnew, int pcol, int count, const LAS int* koff, const LAS float* qv, LAS float* sc, int tid) {
#pragma unroll 1
    for (int idx = tid; idx < count; idx += NT) {
        const int ko = koff[idx];
        float d0 = -INFINITY, d1 = -INFINITY, d2 = -INFINITY, d3 = -INFINITY;
        if (ko != KOFF_INVALID) {
            f32x4 kx[16];
            if (ko >= 0) {
#pragma unroll
                for (int j = 0; j < 16; ++j) kx[j] = *(const f32x4*)(base + (size_t)ko + 4 * j); }
            else {
#pragma unroll
                for (int j = 0; j < 16; ++j) kx[j] = unpack4(*(const u32x2*)(Pnew + (size_t)(-1 - ko) * NPROJ + pcol + 4 * j)); }
            d0 = d1 = d2 = d3 = 0.f;
#pragma unroll
            for (int j4 = 0; j4 < 4; ++j4) {
#pragma unroll
                for (int jj = 0; jj < 4; ++jj) { const int j = 4 * j4 + jj; const f32x4 kq = kx[j];
                    const f32x4 q0 = *(const LAS f32x4*)(qv + 4 * j), q1 = *(const LAS f32x4*)(qv + 64 + 4 * j), q2 = *(const LAS f32x4*)(qv + 128 + 4 * j), q3 = *(const LAS f32x4*)(qv + 192 + 4 * j);
                    d0 += kq.x * q0.x + kq.y * q0.y + kq.z * q0.z + kq.w * q0.w; d1 += kq.x * q1.x + kq.y * q1.y + kq.z * q1.z + kq.w * q1.w;
                    d2 += kq.x * q2.x + kq.y * q2.y + kq.z * q2.z + kq.w * q2.w; d3 += kq.x * q3.x + kq.y * q3.y + kq.z * q3.z + kq.w * q3.w; }
                __builtin_amdgcn_sched_barrier(0);
            }
            d0 *= 0.125f; d1 *= 0.125f; d2 *= 0.125f; d3 *= 0.125f;
        }
        sc[idx] = d0; sc[1040 + idx] = d1; sc[2080 + idx] = d2; sc[3120 + idx] = d3;
    }
}
__device__ __forceinline__ void sample_pv(const float* base, const bf16_t* Pnew, int pcol, int count, const LAS int* koff, const LAS float* sc, LAS float* part, LAS float* oacc, int tid) {
    const int dq = tid & 15, ks = tid >> 4, per = (count + 31) >> 5, i0 = ks * per, i1 = (i0 + per < count) ? i0 + per : count;
    f32x4 a0 = {0.f, 0.f, 0.f, 0.f}, a1 = a0, a2 = a0, a3 = a0;
#pragma unroll 8
    for (int idx = i0; idx < i1; ++idx) { const int ko = koff[idx];
        f32x4 v = {0.f, 0.f, 0.f, 0.f};
        if (ko >= 0) v = *(const f32x4*)(base + (size_t)ko + 256 + 4 * dq);
        else if (ko != KOFF_INVALID) { const u32x2 x = *(const u32x2*)(Pnew + (size_t)(-1 - ko) * NPROJ + pcol + 256 + 4 * dq); v = (f32x4){bf2f(x.x & 0xffffu), __uint_as_float(x.x & 0xffff0000u), bf2f(x.y & 0xffffu), __uint_as_float(x.y & 0xffff0000u)}; }
        a0 += sc[idx] * v; a1 += sc[1040 + idx] * v; a2 += sc[2080 + idx] * v; a3 += sc[3120 + idx] * v; }
    *(LAS f32x4*)(part + ks * 256 + 4 * dq) = a0; *(LAS f32x4*)(part + ks * 256 + 64 + 4 * dq) = a1; *(LAS f32x4*)(part + ks * 256 + 128 + 4 * dq) = a2; *(LAS f32x4*)(part + ks * 256 + 192 + 4 * dq) = a3;
    __syncthreads();
    if (tid < 256) { float t = 0.f;
#pragma unroll 8
        for (int k = 0; k < 32; ++k) t += part[k * 256 + tid];
        oacc[tid] = t; }
    __syncthreads();
}

__device__ __forceinline__ void nsa_sample_unit(Frame& F, int l, int unit, int part_id) {
    const int tid = F.tid, qi = unit & 3, kvh = (unit >> 2) & 3, b = unit >> 4, row = MPT + b * 4 + qi;
    const bf16_t* P = (const bf16_t*)(F.ws + WS_P); const int* pt = (const int*)FIN(IN_PT);
    LAS float* qv = (LAS float*)(F.lds + SL_Q); LAS float* sc = (LAS float*)(F.lds + SL_SC); LAS float* imp = (LAS float*)(F.lds + SL_IMP); LAS float* red = (LAS float*)(F.lds + SL_RED);
    LAS int* list = (LAS int*)(F.lds + SL_LIST); LAS int* koff = (LAS int*)(F.lds + SL_KOFF); LAS float* part = (LAS float*)(F.lds + SL_PART); LAS float* oacc = (LAS float*)(F.lds + SL_OACC);
    LAS int* ptl = (LAS int*)(F.lds + SL_PT);
    __syncthreads();
    if (part_id == 0 && tid >= 256 && tid < 384) ptl[tid - 256] = pt[b * 128 + tid - 256];
    if (tid < 256) qv[tid] = bf2f(P[(size_t)row * NPROJ + C_Q + kvh * 256 + tid]) * (1.f / SM_SCALE_L2E);
    __syncthreads();
    float* soacc = (float*)(F.ws + WS_SOACC) + (size_t)unit * 768;
    if (part_id == 0) {
    {
        const int n = tid & 255, gp = tid >> 8;
        const bf16_t* kr = (const bf16_t*)(F.ws + WS_KCS) + ((size_t)(b * 4 + kvh) * 256 + n) * 64;
        float d0 = 0.f, d1 = 0.f;
#pragma unroll
        for (int j = 0; j < 8; ++j) { const u32x4 x = *(const u32x4*)(kr + 8 * j); float kf[8]; unpack8(x, kf);
#pragma unroll
            for (int e = 0; e < 8; ++e) { d0 += kf[e] * qv[(2 * gp) * 64 + 8 * j + e]; d1 += kf[e] * qv[(2 * gp + 1) * 64 + 8 * j + e]; } }
        sc[(2 * gp) * 1040 + n] = d0 * 0.125f; sc[(2 * gp + 1) * 1040 + n] = d1 * 0.125f;
    }
    __syncthreads();
    block_softmax4(sc, 256, red, tid);
    if (tid < 257) { float v; if (tid == 0 || tid >= 255) v = 1e4f; else v = sc[tid] + sc[1040 + tid] + sc[2080 + tid] + sc[3120 + tid]; imp[tid] = v; }
    {
        const int half = tid >> 8, gd = tid & 255, gh = gd >> 6, d = gd & 63;
        const bf16_t* vt = (const bf16_t*)(F.ws + WS_VCTS) + (size_t)(b * 4 + kvh) * 4 * 4096;
        float a = 0.f;
        for (int tl = 2 * half; tl < 2 * half + 2; ++tl) {
            const bf16_t* vr = vt + (size_t)tl * 4096 + d * 64;
#pragma unroll
            for (int j = 0; j < 8; ++j) { const u32x4 x = *(const u32x4*)(vr + 8 * j); float vf[8]; unpack8(x, vf);
#pragma unroll
                for (int e = 0; e < 8; ++e) a += sc[gh * 1040 + tl * 64 + keypos(8 * j + e)] * vf[e]; } }
        part[half * 256 + gd] = a;
    }
    __syncthreads();
    if (tid < 256) oacc[tid] = part[tid] + part[256 + tid];
    if (tid < 257) { const float si = imp[tid]; int rk = 0;
        for (int j = 0; j < 257; ++j) { const float sj = imp[j]; rk += (sj > si || (sj == si && j < tid)) ? 1 : 0; }
        if (rk < 16) list[rk] = tid; }
    __syncthreads();
    for (int idx = tid; idx < 1024; idx += NT) { const int blk = list[idx >> 6], kk = idx & 63; int ko;
        if (blk < 256) { const int page = ptl[blk >> 1]; ko = (int)(((((size_t)l * NPOOL + page) * 128 + (blk & 1) * 64 + kk) * 4 + 2) * 256 + kvh * 64); }
        else ko = (kk <= qi) ? -1 - (MPT + b * 4 + kk) : KOFF_INVALID;
        koff[idx] = ko; }
    __syncthreads();
    sample_scores(FIN(IN_CACHE), P, C_SK + kvh * 64, 1024, koff, qv, sc, tid);
    __syncthreads();
    block_softmax4(sc, 1024, red, tid);
    sample_pv(FIN(IN_CACHE), P, C_SK + kvh * 64, 1024, koff, sc, part, oacc + 256, tid);
    soacc[tid] = oacc[tid];
    } else {
    for (int idx = tid; idx < 516; idx += NT) { int ko;
        if (idx < 512) ko = (idx > qi) ? (int)((((size_t)(l * SB + b) * 512 + idx) * 2) * 256 + kvh * 64) : KOFF_INVALID;
        else ko = (idx - 512 <= qi) ? -1 - (MPT + b * 4 + idx - 512) : KOFF_INVALID;
        koff[idx] = ko; }
    __syncthreads();
    sample_scores(FIN(IN_SWIN), P, C_WK + kvh * 64, 516, koff, qv, sc, tid);
    __syncthreads();
    block_softmax4(sc, 516, red, tid);
    sample_pv(FIN(IN_SWIN), P, C_WK + kvh * 64, 516, koff, sc, part, oacc + 512, tid);
    if (tid < 256) soacc[512 + tid] = oacc[512 + tid];
    }
    __syncthreads();
}

struct SsmPow { float r[4], i[4]; };
__device__ __forceinline__ void ssm_pows(float ar, float ai, SsmPow& p) {
    p.r[0] = ar; p.i[0] = ai;
    p.r[1] = ar * ar - ai * ai; p.i[1] = 2.f * ar * ai;
    p.r[2] = p.r[1] * ar - p.i[1] * ai; p.i[2] = p.r[1] * ai + p.i[1] * ar;
    p.r[3] = p.r[1] * p.r[1] - p.i[1] * p.i[1]; p.i[3] = 2.f * p.r[1] * p.i[1];
}
struct SsmUnit { SsmPow pw[2]; bf16x8 bfr[4]; float alr[2], ali[2]; };
__device__ __forceinline__ void ssm_unit_load(const Frame& F, int l, int g, int lane, SsmUnit& U) {
    const int n32 = lane & 31, h = lane >> 5;
    const float* sab = (const float*)(F.ws + WS_SAB + l * al1m(SZ_SAB)) + (size_t)g * 64 * 4;
    const bf16_t* bb16 = (const bf16_t*)(F.ws + WS_SBB16 + l * al1m(SZ_SBB16)) + (size_t)g * 2 * 64 * 16;
#pragma unroll
    for (int s = 0; s < 2; ++s) { const f32x4 ab = *(const f32x4*)(sab + (n32 + 32 * s) * 4); ssm_pows(ab.x, ab.y, U.pw[s]); U.alr[s] = ab.z; U.ali[s] = ab.w;
        U.bfr[2 * s] = *(const bf16x8*)(bb16 + (size_t)(n32 + 32 * s) * 16 + 8 * h); U.bfr[2 * s + 1] = *(const bf16x8*)(bb16 + (size_t)(64 + n32 + 32 * s) * 16 + 8 * h); }
}
template <bool FIX>
__device__ __forceinline__ void ssm_block32(const bf16x8& au, const SsmUnit& U, float (&Hr)[2], float (&Hi)[2], float (&H1r)[2], float (&H1i)[2], f32x16 (&Dr)[2], f32x16 (&Di)[2], int h) {
    f32x16 z;
#pragma unroll
    for (int i = 0; i < 16; ++i) z[i] = 0.f;
#pragma unroll
    for (int s = 0; s < 2; ++s) { Dr[s] = MFMA32(au, U.bfr[2 * s], z); Di[s] = MFMA32(au, U.bfr[2 * s + 1], z); }
#pragma unroll
    for (int s = 0; s < 2; ++s) {
        const float ar = U.pw[s].r[0], ai = U.pw[s].i[0], a4r = U.pw[s].r[3], a4i = U.pw[s].i[3];
#pragma unroll
        for (int j = 0; j < 4; ++j)
#pragma unroll
            for (int e = 1; e < 4; ++e) { const int i = 4 * j + e;
                const float nr = ar * Dr[s][i - 1] - ai * Di[s][i - 1] + Dr[s][i], ni = ar * Di[s][i - 1] + ai * Dr[s][i - 1] + Di[s][i]; Dr[s][i] = nr; Di[s][i] = ni; }
        float hr = Hr[s], hi = Hi[s];
#pragma unroll
        for (int j = 0; j < 4; ++j) {
            const float ownr = Dr[s][4 * j + 3], owni = Di[s][4 * j + 3], othr = __shfl_xor(ownr, 32), othi = __shfl_xor(owni, 32);
            const float evr = h ? othr : ownr, evi = h ? othi : owni, odr = h ? ownr : othr, odi = h ? owni : othi;
            const float inr0 = hr, ini0 = hi;
            float t = a4r * hr - a4i * hi + evr; hi = a4r * hi + a4i * hr + evi; hr = t;
            if (j == 0) { H1r[s] = hr; H1i[s] = hi; }
            const float inr1 = hr, ini1 = hi;
            t = a4r * hr - a4i * hi + odr; hi = a4r * hi + a4i * hr + odi; hr = t;
            if (FIX) { const float inr = h ? inr1 : inr0, ini = h ? ini1 : ini0;
#pragma unroll
                for (int e = 0; e < 4; ++e) { const int i = 4 * j + e; Dr[s][i] += U.pw[s].r[e] * inr - U.pw[s].i[e] * ini; Di[s][i] += U.pw[s].r[e] * ini + U.pw[s].i[e] * inr; } }
        }
        Hr[s] = hr; Hi[s] = hi;
    }
}
__device__ __forceinline__ bf16x8 ssm_load_au(const bf16_t* P, int m0, int ntok, int g, int lane) {
    const int t = lane & 31, h = lane >> 5;
    if (t < ntok) return *(const bf16x8*)(P + (size_t)(m0 + t) * NPROJ + C_SU + g * 16 + 8 * h);
    return (bf16x8){0, 0, 0, 0, 0, 0, 0, 0};
}
__device__ __forceinline__ void s2_ssm_pass1(Frame& F, int l) {
    const bf16_t* P = (const bf16_t*)(F.ws + WS_P); f32x2* E = (f32x2*)(F.ws + WS_SSME);
    const int lane = F.lane, n32 = lane & 31, h = lane >> 5;
    for (int u = F.gw; u < PB * 64 * SSM_NCH; u += F.ngw) {
        const int b = u >> 11, g = (u >> 5) & 63, ch = u & 31, m0 = b * SEQ + ch * SSM_L;
        SsmUnit U; ssm_unit_load(F, l, g, lane, U);
        float Hr[2] = {0.f, 0.f}, Hi[2] = {0.f, 0.f}, H1r[2], H1i[2];
        bf16x8 au = ssm_load_au(P, m0, 32, g, lane);
#pragma unroll 1
        for (int blk = 0; blk < SSM_L / 32; ++blk) {
            const bf16x8 an = ssm_load_au(P, m0 + 32 * ((blk + 1) & 3), 32, g, lane);
            f32x16 Dr[2], Di[2];
            ssm_block32<false>(au, U, Hr, Hi, H1r, H1i, Dr, Di, h);
            au = an;
        }
        if (h == 0) { f32x2* e = E + ((size_t)(b * 64 + g) * SSM_NCH + ch) * 64; e[n32] = (f32x2){Hr[0], Hi[0]}; e[32 + n32] = (f32x2){Hr[1], Hi[1]}; }
    }
}
__device__ __forceinline__ void s3_ssm_pass2(Frame& F, int l) {
    const bf16_t* P = (const bf16_t*)(F.ws + WS_P); const f32x2* E = (const f32x2*)(F.ws + WS_SSME); bf16_t* Z = (bf16_t*)(F.ws + WS_Z);
    LAS unsigned char* himg = F.lds + 65536 + F.wave * 8960;
    const int lane = F.lane, n32 = lane & 31, h = lane >> 5, tk = lane & 15, cq = lane >> 4;
    for (int u = F.gw; u < PB * 64 * SSM_NCH + SB * 64; u += F.ngw) {
        const bool smp = u >= PB * 64 * SSM_NCH;
        int b, g, ch, m0, nblk, ntok;
        if (!smp) { b = u >> 11; g = (u >> 5) & 63; ch = (u & 31) ^ (b & 1 ? 31 : 0); m0 = b * SEQ + ch * SSM_L; nblk = SSM_L / 32; ntok = 32; }
        else { const int su = u - PB * 64 * SSM_NCH; b = su >> 6; g = su & 63; ch = 0; m0 = MPT + b * 4; nblk = 1; ntok = 4; }
        SsmUnit U; ssm_unit_load(F, l, g, lane, U);
        bf16x8 cmf[4];
        { const bf16_t* cm = (const bf16_t*)(F.ws + WS_SCM + l * al1m(SZ_SCM)) + (size_t)(g * 16 + tk) * 128 + 8 * cq;
#pragma unroll
            for (int ks = 0; ks < 4; ++ks) cmf[ks] = *(const bf16x8*)(cm + 32 * ks); }
        const f32x4 ds = *(const f32x4*)(FIN(IN_DSKIP) + l * 1024 + g * 16 + 4 * cq);
        float Hr[2] = {0.f, 0.f}, Hi[2] = {0.f, 0.f}, H1r[2] = {0.f, 0.f}, H1i[2] = {0.f, 0.f};
        if (!smp) { const f32x2* e = E + (size_t)(b * 64 + g) * SSM_NCH * 64;
            for (int j0 = 0; j0 < ch; j0 += 8) {
                f32x2 ev[8][2];
#pragma unroll
                for (int jj = 0; jj < 8; ++jj)
#pragma unroll
                    for (int s = 0; s < 2; ++s) ev[jj][s] = (j0 + jj < ch) ? e[(size_t)(j0 + jj) * 64 + n32 + 32 * s] : (f32x2){0.f, 0.f};
#pragma unroll
                for (int jj = 0; jj < 8; ++jj) if (j0 + jj < ch) {
#pragma unroll
                    for (int s = 0; s < 2; ++s) { const float nr = U.alr[s] * Hr[s] - U.ali[s] * Hi[s] + ev[jj][s].x, ni = U.alr[s] * Hi[s] + U.ali[s] * Hr[s] + ev[jj][s].y; Hr[s] = nr; Hi[s] = ni; } } } }
        else { const float* h0 = FIN(IN_SSSM) + ((size_t)(l * SB + b) * 2 * 64 + g) * 64 + n32;
#pragma unroll
            for (int s = 0; s < 2; ++s) { Hr[s] = h0[32 * s]; Hi[s] = h0[64 * 64 + 32 * s]; } }
        bf16x8 au = ssm_load_au(P, m0, ntok, g, lane);
#pragma unroll 1
        for (int blk = 0; blk < nblk; ++blk) {
            const bf16x8 an = ssm_load_au(P, m0 + 32 * ((blk + 1) & 3), ntok, g, lane);
            u32x2 uw[2];
#pragma unroll
            for (int tt = 0; tt < 2; ++tt) uw[tt] = (16 * tt + tk < ntok) ? *(const u32x2*)(P + (size_t)(m0 + 32 * blk + 16 * tt + tk) * NPROJ + C_SU + g * 16 + 4 * cq) : (u32x2){0u, 0u};
            f32x16 Dr[2], Di[2];
            ssm_block32<true>(au, U, Hr, Hi, H1r, H1i, Dr, Di, h);
            au = an;
#pragma unroll
            for (int i = 0; i < 16; ++i) { const int tl = (i & 3) + 8 * (i >> 2) + 4 * h;
                *(LAS unsigned*)(himg + tl * 272 + 4 * n32) = pk2(Dr[0][i], Di[0][i]); *(LAS unsigned*)(himg + tl * 272 + 4 * (32 + n32)) = pk2(Dr[1][i], Di[1][i]); }
            LDS_WAIT(); asm volatile("" ::: "memory");
#pragma unroll
            for (int tt = 0; tt < 2; ++tt) {
                f32x4 y = {0.f, 0.f, 0.f, 0.f};
#pragma unroll
                for (int ks = 0; ks < 4; ++ks) { const bf16x8 hf = *(const LAS bf16x8*)(himg + (16 * tt + tk) * 272 + (32 * ks + 8 * cq) * 2); y = __builtin_amdgcn_mfma_f32_16x16x32_bf16(cmf[ks], hf, y, 0, 0, 0); }
                const int t = 32 * blk + 16 * tt + tk;
                if (16 * tt + tk < ntok) { const f32x4 uu = unpack4(uw[tt]);
                    u32x2 o; o.x = pk2(gelu_tanh(y.x + ds.x * uu.x), gelu_tanh(y.y + ds.y * uu.y)); o.y = pk2(gelu_tanh(y.z + ds.z * uu.z), gelu_tanh(y.w + ds.w * uu.w));
                    *(u32x2*)(Z + (size_t)(m0 + t) * 1024 + g * 16 + 4 * cq) = o; }
            }
            LDS_WAIT(); asm volatile("" ::: "memory");
        }
        if (h == 0) {
            if (smp) { float* o = F.out + O_SSMS + ((size_t)(l * SB + b) * 2 * 64 + g) * 64 + n32;
#pragma unroll
                for (int s = 0; s < 2; ++s) { o[32 * s] = H1r[s]; o[64 * 64 + 32 * s] = H1i[s]; } }
            else if (ch == SSM_NCH - 1) { float* o = F.out + O_SSMP + ((size_t)(l * PB + b) * 2 * 64 + g) * 64 + n32;
#pragma unroll
                for (int s = 0; s < 2; ++s) { o[32 * s] = Hr[s]; o[64 * 64 + 32 * s] = Hi[s]; } }
        }
    }
}
struct Args { const float* in[27]; float* out; unsigned char* ws; int ph_lo, ph_hi; };
constexpr int N_PHASES = 15;

__global__ void __launch_bounds__(NT, 2) fwd_kernel(Args args) {
    extern __shared__ __attribute__((aligned(16))) unsigned char lds_raw[];
    Frame F;
    F.lds = (LAS unsigned char*)lds_raw;
    F.tid = threadIdx.x; F.lane = F.tid & 63; F.wave = __builtin_amdgcn_readfirstlane(F.tid >> 6);
    F.G = gridDim.x; F.bid = blockIdx.x; F.gw = F.bid * NWAVES + F.wave; F.ngw = F.G * NWAVES;
    F.out = args.out; F.ws = args.ws;
    volatile LAS unsigned* misc = (volatile LAS unsigned*)(F.lds + LDS_MISC);
    if (F.tid < 64) misc[F.tid] = 0u;
    __syncthreads();
    const int lo = args.ph_lo, hi = args.ph_hi;
#if MK_PER_PHASE
#define GRID_BAR() do { } while (0)
#else
    XcdBarrier bar = xcd_barrier_post((unsigned*)(F.ws + WS_CTL) + CW_BAR, misc + 8);
#define GRID_BAR() xcd_barrier(bar)
#endif
#ifdef ONLYPH
#define IN(k) ((((k)==0?0:(((k)-1)%7)+1))==ONLYPH && lo <= (k) && (k) < hi)
#else
#define IN(k) (lo <= (k) && (k) < hi)
#endif
#define BOTH(k) (IN(k) && IN((k) + 1))
#ifndef PROBE_PH
#define PROBE_PH -1
#endif
#define REPS(k) _Pragma("unroll 1") for (int rep_ = 0; rep_ < ((PROBE_PH) == (k) ? 2 : 1); ++rep_)
#define PHASE_BEGIN() do { int t_ = threadIdx.x; asm volatile("" : "+v"(t_)); F.tid = t_; F.lane = t_ & 63; F.wave = __builtin_amdgcn_readfirstlane(t_ >> 6); \
    F.gw = F.bid * NWAVES + F.wave; GAS unsigned char* w_ = (GAS unsigned char*)args.ws; asm volatile("" : "+s"(w_)); F.ws = (unsigned char*)w_; \
    GAS float* o_ = (GAS float*)args.out; asm volatile("" : "+s"(o_)); F.out = (float*)o_; } while (0)
    if (IN(0)) { PHASE_BEGIN(); REPS(0) phase_prologue(F); if (BOTH(0)) GRID_BAR(); }
    for (int l = 0; l < 2; ++l) {
        const int p0 = 1 + 7 * l;
        if (IN(p0)) {
            PHASE_BEGIN();
            pg8::Gemm g{(const bf16_t*)(F.ws + WS_H), (const bf16_t*)(F.ws + WS_WIN + l * al1m(SZ_WIN)), DM, DM, DM, 0, 0};
            pg8::TileOrder S; S.init(MPT / 256, NPROJ / 256, 1, 0, F.G, F.bid);
            EpiProj E{(bf16_t*)(F.ws + WS_P), (float*)(F.ws + WS_GATE), F.out, l};
            REPS(1) pg8::gemm_phase(F.lds, g, S, E);
            skinny_proj(F, l);
            if (BOTH(p0)) GRID_BAR();
        }
        if (IN(p0 + 1)) {
            PHASE_BEGIN();
            REPS(2) {
#ifndef SK_A
            REPS(21) s2_compress(F, l);
#endif
            __syncthreads();
#ifndef SK_B
            PHASE_BEGIN();
            REPS(22) s2_ssm_pass1(F, l);
#endif
#ifndef SK_C
            PHASE_BEGIN();
            REPS(23) s2_pool_diff(F, l);
#endif
#ifndef SK_D
            PHASE_BEGIN();
            REPS(24) s2_state_outputs(F, l);
#endif
#ifndef SK_E
            PHASE_BEGIN();
            REPS(25) s2_vt_images(F);
#endif
            }
            if (BOTH(p0 + 1)) GRID_BAR();
        }
        if (IN(p0 + 2)) {
            PHASE_BEGIN();
            REPS(33) s3_ssm_pass2(F, l);
            __syncthreads();
            if (BOTH(p0 + 2)) GRID_BAR();
        }
        if (IN(p0 + 3)) {
            PHASE_BEGIN();
            REPS(3) {
#ifndef SK_F
            REPS(31) for (int p = F.bid; p < 256; p += F.G) { const int bk = p >> 5, j = p & 31;
#pragma unroll 1
                for (int k2 = 0; k2 < 2; ++k2) nsa_prompt_unit(F, l, bk >> 2, bk & 3, k2 ? j : 63 - j); }
#endif
#ifndef SK_G
            PHASE_BEGIN();
            for (int uu = F.bid; uu < (((PROBE_PH) == 35 || (PROBE_PH) == 36) ? 2048 : (PROBE_PH) == 32 ? 512 : 256); uu += F.G) { const int u = uu & 255, part = (u >> 3) & 1;
                if (uu >= 256 && (PROBE_PH) != 32 && (PROBE_PH) != 35 + part) continue;
                nsa_sample_unit(F, l, (u & 7) | ((u >> 4) << 3), part); }
#endif
            __syncthreads();
            PHASE_BEGIN();
            REPS(4) {
            const int hi = (F.bid >> 3) & 1, idx = (F.bid >> 4) * 8 + (F.bid & 7);
            const int n1 = (F.G >> 4) * 8 + ((F.G & 15) > 8 ? (F.G & 15) - 8 : 0), n0 = F.G - n1;
            if (hi || n1 == 0) {
                pg8::Gemm g{(const bf16_t*)(F.ws + WS_Z), (const bf16_t*)(F.ws + WS_WGLU + l * al1m(SZ_WGLU)), 1024, 1024, 1024, 0, 0};
                pg8::TileOrder S; if (n1) S.init(MPT / 256, 4, 1, 0, n1, idx); else S.init(MPT / 256, 4, 1, 0, F.G, F.bid);
                EpiGlu E{(bf16_t*)(F.ws + WS_ABR + 2 * SZ_ABR1), (const bf16_t*)(F.ws + WS_P), (const bf16_t*)(F.ws + WS_Z)};
                pg8::gemm_phase(F.lds, g, S, E);
            }
            if (!hi) {
                pg8::Gemm g{(const bf16_t*)(F.ws + WS_DIFF), (const bf16_t*)(F.ws + WS_WPOOL + l * al1m(SZ_WPOOL)), 1024, 256, 256, 256, 65536};
                pg8::TileOrder S; S.init(MPT / 256, 1, 4, 0, n0, idx);
                EpiPool E{(bf16_t*)(F.ws + WS_ABR), (const bf16_t*)(F.ws + WS_P), FIN(IN_PSCALE) + l * 1024};
                pg8::gemm_phase(F.lds, g, S, E);
            }
            skinny_glu(F, l); skinny_pool(F, l);
            }
            }
            if (BOTH(p0 + 3)) GRID_BAR();
        }
        if (IN(p0 + 4)) {
            PHASE_BEGIN();
            pg8::Gemm g{(const bf16_t*)(F.ws + WS_ABR), (const bf16_t*)(F.ws + WS_WBR + l * al1m(SZ_WBR)), 1024, 1024, 1024, (size_t)MPAD * 1024, (size_t)2048 * 1024};
            pg8::TileOrder S; S.init(MPT / 256, 8, 3, 1, F.G, F.bid);
            EpiBranch E{(bf16_t*)(F.ws + WS_MERGED), (const bf16_t*)(F.ws + WS_P)};
            REPS(5) { pg8::gemm_phase(F.lds, g, S, E); skinny_branch(F, l); }
            if (BOTH(p0 + 4)) GRID_BAR();
        }
        if (IN(p0 + 5)) {
            PHASE_BEGIN();
            pg8::Gemm g{(const bf16_t*)(F.ws + WS_MERGED), (const bf16_t*)(F.ws + WS_WOUT + l * al1m(SZ_WOUT)), DM, DM, DM, 0, 0};
            pg8::TileOrder S; S.init(MPT / 256, 8, 1, 0, F.G, F.bid);
            EpiOut E{(bf16_t*)(F.ws + WS_OUTB)};
            REPS(6) { pg8::gemm_phase(F.lds, g, S, E); skinny_out(F, l); }
            if (BOTH(p0 + 5)) GRID_BAR();
        }
        if (IN(p0 + 6)) {
            PHASE_BEGIN();
            REPS(7) phase_norm(F, l);
            if (BOTH(p0 + 6)) GRID_BAR();
        }
    }
#undef IN
#undef BOTH
}

extern "C" void kernel_launch(void* const* d_in, const int* in_sizes, int n_in, void* d_out, int out_size, void* d_ws, size_t ws_size, hipStream_t stream) {
    static int grid = 0;
    if (grid == 0) {
        if (n_in != 27 || out_size != (int)O_TOTAL || ws_size < WS_END) { fprintf(stderr, "kernel_launch: unexpected problem shape (n_in %d, out %d, ws %zu < %zu)\n", n_in, out_size, ws_size, (size_t)WS_END); grid = -1; return; }
        int dev = 0, cus = 0, per_cu = 0;
        if (hipGetDevice(&dev) != hipSuccess || hipDeviceGetAttribute(&cus, hipDeviceAttributeMultiprocessorCount, dev) != hipSuccess) { grid = -1; return; }
        if (hipFuncSetAttribute((const void*)fwd_kernel, hipFuncAttributeMaxDynamicSharedMemorySize, LDS_BYTES) != hipSuccess) { fprintf(stderr, "kernel_launch: hipFuncSetAttribute failed\n"); grid = -1; return; }
        if (hipOccupancyMaxActiveBlocksPerMultiprocessor(&per_cu, (const void*)fwd_kernel, NT, LDS_BYTES) != hipSuccess || per_cu < 1)
            fprintf(stderr, "kernel_launch: note: occupancy query reports %d workgroups per CU\n", per_cu);
        (void)hipGetLastError();
        grid = cus;
    }
    if (grid < 0) return;
    if (hipMemsetAsync((char*)d_ws + WS_CTL, 0, CTL_ZERO_BYTES, stream) != hipSuccess) return;
    Args a{};
    for (int i = 0; i < 27; ++i) a.in[i] = (const float*)d_in[i];
    a.out = (float*)d_out; a.ws = (unsigned char*)d_ws;
#if MK_PER_PHASE
    for (int k = 0; k < N_PHASES; ++k) { a.ph_lo = k; a.ph_hi = k + 1; hipLaunchKernelGGL(fwd_kernel, dim3(grid), dim3(NT), LDS_BYTES, stream, a); }
#else
    a.ph_lo = 0; a.ph_hi = N_PHASES;
    hipLaunchKernelGGL(fwd_kernel, dim3(grid), dim3(NT), LDS_BYTES, stream, a);
#endif
    const hipError_t le = hipPeekAtLastError();
    if (le != hipSuccess) fprintf(stderr, "kernel_launch: launch failed: %s\n", hipGetErrorName(le));
}
```

```cpp
#define MK_PER_PHASE 0
#include <hip/hip_runtime.h>
#include <cstdio>
#include <cstdint>

#ifndef MK_PER_PHASE
#define MK_PER_PHASE 0
#endif

#define LAS __attribute__((address_space(3)))
#define GAS __attribute__((address_space(1)))
typedef unsigned short bf16_t;
typedef short bf16x8 __attribute__((ext_vector_type(8)));
typedef float f32x4 __attribute__((ext_vector_type(4)));
typedef float f32x2 __attribute__((ext_vector_type(2)));
typedef float f32x16 __attribute__((ext_vector_type(16)));
typedef unsigned u32x4 __attribute__((ext_vector_type(4)));
typedef unsigned u32x2 __attribute__((ext_vector_type(2)));
typedef __bf16 bf16x2_t __attribute__((ext_vector_type(2)));

constexpr int DM = 2048, SEQ = 4096, PB = 2, SB = 8, SQ = 4, PAST = 16384;
constexpr int MPT = PB * SEQ;
constexpr int MROWS = MPT + SB * SQ;
constexpr int MPAD = 8448;
constexpr int DIN = 13872, NPROJ = 14080;
constexpr int C_PU = 0, C_PZ = 1024, C_Q = 2048, C_CK = 3072, C_CV = 3328, C_SK = 3584, C_SV = 3840, C_WK = 4096, C_WV = 4352,
              C_AZ = 4608, C_SU = 5632, C_SZ = 6656, C_MG = 7680, C_AG = 13824;
constexpr int NPOOL = 1280;
constexpr int SSM_L = 128, SSM_NCH = SEQ / SSM_L;
constexpr float EPS = 1e-6f;
constexpr float SM_SCALE_L2E = 0.125f * 1.44269504088896f;
constexpr float SM_THR = 8.f;

constexpr size_t O_YP = 0, O_YS = 16777216, O_KVP = 16842752, O_KVS = 33619968, O_WINP = 33685504, O_WINS = 34734080,
                 O_POOLP = 38928384, O_POOLS = 38989824, O_SSMP = 39235584, O_SSMS = 39268352, O_TOTAL = 39399424;

constexpr size_t al1m(size_t x) { return (x + 1048575) & ~(size_t)1048575; }
constexpr size_t SZ_WIN = (size_t)NPROJ * DM * 2, SZ_WPOOL = 4 * 256 * 256 * 2, SZ_WGLU = 1024 * 1024 * 2, SZ_WBR = (size_t)3 * 2048 * 1024 * 2,
                 SZ_WOUT = (size_t)2048 * 2048 * 2, SZ_WPHI = 2 * 64 * 64 * 64 * 2, SZ_PEBP = 2 * 16 * 64 * 4, SZ_SAB = 64 * 64 * 4 * 4,
                 SZ_SBB = 64 * 16 * 2 * 64 * 4, SZ_SCM = 64 * 16 * 128 * 2;
constexpr size_t WS_CTL = 0, CTL_BYTES = 1048576, CTL_ZERO_BYTES = 32768;
constexpr size_t WS_WIN = CTL_BYTES;
constexpr size_t WS_WPOOL = WS_WIN + 2 * al1m(SZ_WIN);
constexpr size_t WS_WGLU = WS_WPOOL + 2 * al1m(SZ_WPOOL);
constexpr size_t WS_WBR = WS_WGLU + 2 * al1m(SZ_WGLU);
constexpr size_t WS_WOUT = WS_WBR + 2 * al1m(SZ_WBR);
constexpr size_t WS_WPHI = WS_WOUT + 2 * al1m(SZ_WOUT);
constexpr size_t WS_PEBP = WS_WPHI + 2 * al1m(SZ_WPHI);
constexpr size_t WS_SAB = WS_PEBP + 2 * al1m(SZ_PEBP);
constexpr size_t WS_SBB = WS_SAB + 2 * al1m(SZ_SAB);
constexpr size_t WS_SCM = WS_SBB + 2 * al1m(SZ_SBB);
constexpr size_t WS_H = WS_SCM + 2 * al1m(SZ_SCM);
constexpr size_t WS_P = WS_H + al1m((size_t)MPAD * DM * 2);
constexpr size_t WS_GATE = WS_P + al1m((size_t)MPAD * NPROJ * 2);
constexpr size_t WS_DIFF = WS_GATE + al1m((size_t)MPAD * 64 * 4);
constexpr size_t WS_ABR = WS_DIFF + al1m((size_t)MPAD * 1024 * 2);
constexpr size_t SZ_ABR1 = (size_t)MPAD * 1024 * 2;
constexpr size_t WS_Z = WS_ABR + al1m(3 * SZ_ABR1);
constexpr size_t WS_KCP = WS_Z + al1m(SZ_ABR1);
constexpr size_t WS_VCTP = WS_KCP + al1m(65536);
constexpr size_t WS_KCS = WS_VCTP + al1m(65536);
constexpr size_t WS_VCTS = WS_KCS + al1m(1048576);
constexpr size_t WS_VTSEL = WS_VCTS + al1m(1048576);
constexpr size_t WS_VTWIN = WS_VTSEL + al1m(4194304);
constexpr size_t WS_SSME = WS_VTWIN + al1m(4194304);
constexpr size_t WS_MERGED = WS_SSME + al1m(2097152);
constexpr size_t WS_OUTB = WS_MERGED + al1m((size_t)MPAD * DM * 2);
constexpr size_t WS_Y0 = WS_OUTB + al1m((size_t)MPAD * DM * 4);
constexpr size_t WS_BRP = WS_Y0 + al1m((size_t)MPAD * DM * 4);
constexpr size_t WS_SOACC = WS_BRP + al1m((size_t)3 * 32 * DM * 4);
constexpr size_t WS_SBB16 = WS_SOACC + al1m(128 * 768 * 4);
constexpr size_t SZ_SBB16 = 64 * 2 * 64 * 16 * 2;
constexpr size_t WS_KTSEL = WS_SBB16 + 2 * al1m(SZ_SBB16);
constexpr size_t WS_KTWIN = WS_KTSEL + al1m(4194304);
constexpr size_t WS_END = WS_KTWIN + al1m(4194304);

constexpr int CW_BAR = 4096;

constexpr int NWAVES = 8, NT = 512;
constexpr int LDS_BYTES = 147456;
constexpr int LDS_MISC = 143360;

__device__ __forceinline__ float bf2f(unsigned b) { return __uint_as_float(b << 16); }
__device__ __forceinline__ unsigned pk2(float lo, float hi) { f32x2 v = {lo, hi}; bf16x2_t b = __builtin_convertvector(v, bf16x2_t); return __builtin_bit_cast(unsigned, b); }
__device__ __forceinline__ unsigned f2bf(float f) { return pk2(f, 0.f) & 0xffffu; }
__device__ __forceinline__ float wave_sum(float v) {
#pragma unroll
    for (int o = 1; o < 64; o <<= 1) v += __shfl_xor(v, o);
    return v;
}
__device__ __forceinline__ float wave_max(float v) {
#pragma unroll
    for (int o = 1; o < 64; o <<= 1) v = fmaxf(v, __shfl_xor(v, o));
    return v;
}
__device__ __forceinline__ float sigmoidf_(float x) { return __builtin_amdgcn_rcpf(1.f + __expf(-x)); }
__device__ __forceinline__ float siluf_(float x) { return x * sigmoidf_(x); }
__device__ __forceinline__ float gelu_tanh(float y) { const float a = 1.5957691216f * (y + 0.044715f * y * y * y); return y * sigmoidf_(a); }
#define LDS_WAIT() asm volatile("s_waitcnt lgkmcnt(0)" ::: "memory")
#define VM_WAIT() asm volatile("s_waitcnt vmcnt(0)" ::: "memory")

#define XB_TMO      128
#define XB_XCNT(j)  (256  + 64 * (j))
#define XB_XSUB(j)  (1280 + 64 * (j))
#define XB_XGEN(j)  (2304 + 64 * (j))
#define XB_TOP      3328
#define XB_TOPGEN   3392
#define XCD_BAR_WORDS 3456
#define XB_SPIN_CAP (1u << 23)
__device__ __forceinline__ unsigned xb_ld(unsigned* p)              { return __hip_atomic_load(p, __ATOMIC_RELAXED, __HIP_MEMORY_SCOPE_AGENT); }
__device__ __forceinline__ unsigned xb_add(unsigned* p, unsigned v) { return __hip_atomic_fetch_add(p, v, __ATOMIC_RELAXED, __HIP_MEMORY_SCOPE_AGENT); }
__device__ __forceinline__ unsigned xb_xcc_id() { return (unsigned)__builtin_amdgcn_s_getreg((3 << 11) | 20) & 0xFu; }
#define XB_SPIN(cond, bar) do { unsigned _sp = 0; while (cond) { __builtin_amdgcn_s_sleep(1); \
    if ((++_sp & 255u) == 0u) { if (xb_ld(&(bar)[XB_TMO])) break; if (_sp > XB_SPIN_CAP) { atomicAdd(&(bar)[XB_TMO], 1u); break; } } } } while (0)
struct XcdBarrier { unsigned* bar; unsigned x; volatile LAS unsigned* st; };
__device__ __forceinline__ XcdBarrier xcd_barrier_post(unsigned* bar, volatile LAS unsigned* st) {
    XcdBarrier b; b.bar = bar; b.x = xb_xcc_id(); b.st = st;
    if (threadIdx.x == 0) (void)xb_add(&bar[XB_XCNT(b.x)], 1u);
    return b;
}
__device__ __forceinline__ void xcd_barrier_complete(unsigned* bar, unsigned x, unsigned& nloc, unsigned& nx) {
    const unsigned G = gridDim.x * gridDim.y * gridDim.z;
    unsigned sum, cnt, mine, sp = 0u;
    for (;;) {
        sum = 0u; cnt = 0u; mine = 0u;
#pragma unroll
        for (unsigned j = 0; j < 16; ++j) { const unsigned c = xb_ld(&bar[XB_XCNT(j)]); sum += c; cnt += (c > 0u) ? 1u : 0u; mine = (j == x) ? c : mine; }
        if (sum == G) break;
        __builtin_amdgcn_s_sleep(1);
        if ((++sp & 255u) == 0u) { if (xb_ld(&bar[XB_TMO])) break; if (sp > XB_SPIN_CAP) { atomicAdd(&bar[XB_TMO], 1u); break; } }
    }
    nloc = mine > 0u ? mine : 1u; nx = cnt > 0u ? cnt : 1u;
}
__device__ __forceinline__ void xcd_barrier(const XcdBarrier& b) {
    asm volatile("s_waitcnt vmcnt(0)" ::: "memory");
    __syncthreads();
    if (threadIdx.x == 0) {
        unsigned* bar = b.bar;
        __builtin_amdgcn_s_waitcnt(0);
        unsigned nloc = b.st[0], nx = b.st[1];
        if (nloc == 0u) { xcd_barrier_complete(bar, b.x, nloc, nx); b.st[0] = nloc; b.st[1] = nx; }
        const unsigned old = xb_add(&bar[XB_XSUB(b.x)], 1u);
        const unsigned gen = old / nloc;
        if (old + 1u == (gen + 1u) * nloc) {
            __builtin_amdgcn_fence(__ATOMIC_RELEASE, "agent");
            asm volatile("s_waitcnt vmcnt(0)" ::: "memory");
            const unsigned og = xb_add(&bar[XB_TOP], 1u);
            const unsigned tg = og / nx;
            if (og + 1u == (tg + 1u) * nx) xb_add(&bar[XB_TOPGEN], 1u);
            else XB_SPIN(xb_ld(&bar[XB_TOPGEN]) == tg, bar);
            __builtin_amdgcn_fence(__ATOMIC_ACQUIRE, "agent");
            xb_add(&bar[XB_XGEN(b.x)], 1u);
            asm volatile("s_waitcnt vmcnt(0)" ::: "memory");
        } else {
            XB_SPIN(xb_ld(&bar[XB_XGEN(b.x)]) == gen, bar);
            __builtin_amdgcn_fence(__ATOMIC_ACQUIRE, "agent");
            asm volatile("s_waitcnt vmcnt(0)" ::: "memory");
        }
    }
    __syncthreads();
}
namespace pg8 {
constexpr int BM = 256, BK = 64, HALF = 128, HTB = HALF * BK * 2, STAGE_BYTES = 8 * HTB, NXCD = 8, WGM = 8;
__host__ __device__ __forceinline__ int lds_byte(int r, int c) { const int st = (r >> 4) * 2 + (c >> 5), rr = r & 15, cc = c & 31, ob = rr * 64 + cc * 2; return st * 1024 + (ob ^ (((ob >> 9) & 1) << 5)); }
__host__ __device__ __forceinline__ void stage_rc(int b, int& R, int& C) { const int st = b / 1024, sb = b % 1024, swz = sb ^ (((sb >> 9) & 1) << 5); R = (st >> 1) * 16 + swz / 64; C = (st & 1) * 32 + (swz % 64) / 2; }
__host__ __device__ __forceinline__ int perm32(int rho) { const int n = rho >> 4, i = rho & 15; return 8 * (i >> 2) + 4 * n + (i & 3); }

struct Unit { int pm, pn, z; };
struct Gemm { const bf16_t* A; const bf16_t* Bt; int lda, ldb, K; size_t zA, zB; };

struct TileOrder {
    int nM, nN, nz, ntile, G, c, zin;
    __device__ void init(int nM_, int nN_, int nz_, int zin_, int G_, int c_) { nM = nM_; nN = nN_; nz = nz_; zin = zin_; ntile = nM * nN; G = G_; c = c_; }
    __device__ bool next(int i, Unit& u) const {
        long L; int z;
        if (zin) { z = i % nz; L = (long)(i / nz) * G + c; if (L >= ntile) return false; }
        else { const long LL = (long)i * G + c; if (LL >= (long)ntile * nz) return false; z = (int)(LL / ntile); L = LL % ntile; }
        int wgid = (int)L; { const int q = ntile / NXCD, r = ntile % NXCD, xcd = wgid % NXCD, off = wgid / NXCD; wgid = (xcd < r ? xcd * (q + 1) : r * (q + 1) + (xcd - r) * q) + off; }
        const int nig = WGM * nN, gid = wgid / nig, fm = gid * WGM, gsz = (nM - fm) < WGM ? (nM - fm) : WGM;
        u.pm = fm + ((wgid % nig) % gsz); u.pn = (wgid % nig) / gsz; u.z = z; return true;
    }
};

template <class Epi, class Sched>
__device__ __forceinline__ void gemm_phase(LAS unsigned char* lds, const Gemm g, const Sched& S, const Epi& E) {
    int tid = threadIdx.x; asm volatile("" : "+v"(tid));
    const int wid = __builtin_amdgcn_readfirstlane(tid >> 6), lane = tid & 63, wr = wid >> 2, wc = wid & 3, fr = lane & 15, fq = lane >> 4;
    const int K = g.K, nt = K / BK;
    unsigned voffA[2], voffB[2];
#pragma unroll
    for (int i = 0; i < 2; ++i) { int R, C; stage_rc(tid * 16 + i * 8192, R, C); const int Rb = (R & ~31) + perm32(R & 31);
        voffA[i] = (unsigned)(R * g.lda + C) * 2u; voffB[i] = (unsigned)(Rb * g.ldb + C) * 2u; }
    const size_t kstep = (size_t)(BK * 2);
    const size_t hstepA = (size_t)HALF * g.lda * 2, hstepB = (size_t)HALF * g.ldb * 2;
    const unsigned ldsw = (unsigned)wid * 1024u;
    const int aoff = lds_byte(wr * 64 + fr, fq * 8), boff = lds_byte(wc * 32 + fr, fq * 8);
#define PG8_SA(b, h) (((b) * 2 + (h)) * HTB)
#define PG8_SB(b, h) ((4 + (b) * 2 + (h)) * HTB)
#define PG8_STAGE(bufoff, gbase, voff) do { _Pragma("unroll") for (int _i = 0; _i < 2; ++_i) \
        __builtin_amdgcn_global_load_lds((const unsigned*)((const char*)(gbase) + (voff)[_i]), (LAS unsigned*)(lds + (bufoff) + ldsw + _i * 8192), 16, 0, 0); } while (0)
#define PG8_LDA(dst, b, h) do { _Pragma("unroll") for (int m = 0; m < 4; ++m) _Pragma("unroll") for (int k = 0; k < 2; ++k) dst[m][k] = *(const LAS bf16x8*)(lds + PG8_SA(b, h) + aoff + m * 2048 + k * 1024); } while (0)
#define PG8_LDB(dst, b, h) do { _Pragma("unroll") for (int n = 0; n < 2; ++n) _Pragma("unroll") for (int k = 0; k < 2; ++k) dst[n][k] = *(const LAS bf16x8*)(lds + PG8_SB(b, h) + boff + n * 2048 + k * 1024); } while (0)
#define PG8_MMA(ai, bj, At, Bt) do { __builtin_amdgcn_s_setprio(1); _Pragma("unroll") for (int m = 0; m < 4; ++m) _Pragma("unroll") for (int n = 0; n < 2; ++n) _Pragma("unroll") for (int k = 0; k < 2; ++k) \
        acc[ai][bj][m][n] = __builtin_amdgcn_mfma_f32_16x16x32_bf16(Bt[n][k], At[m][k], acc[ai][bj][m][n], 0, 0, 0); __builtin_amdgcn_s_setprio(0); } while (0)
#define PG8_WAIT_V(n) asm volatile("s_waitcnt vmcnt(" #n ")" ::: "memory")
#define PG8_WAIT_L(n) asm volatile("s_waitcnt lgkmcnt(" #n ")" ::: "memory")
#define PG8_BAR __builtin_amdgcn_s_barrier()
#define PG8_SCHED __builtin_amdgcn_sched_barrier(0)
#define PG8_UA(u) ((const char*)(g.A + (size_t)(u).z * g.zA) + (size_t)(u).pm * (2 * hstepA))
#define PG8_UB(u) ((const char*)(g.Bt + (size_t)(u).z * g.zB) + (size_t)(u).pn * (2 * hstepB))
    Unit cur, nxt; int ui = 0;
    if (!S.next(0, cur)) return;
    f32x4 acc[2][2][4][2];
#pragma unroll
    for (int a = 0; a < 2; ++a)
#pragma unroll
        for (int b = 0; b < 2; ++b)
#pragma unroll
            for (int m = 0; m < 4; ++m)
#pragma unroll
                for (int n = 0; n < 2; ++n) acc[a][b][m][n] = (f32x4){0.f, 0.f, 0.f, 0.f};
    bf16x8 At[4][2], B0[2][2], B1[2][2];
    const char* cA = PG8_UA(cur); const char* cB = PG8_UB(cur);
    PG8_STAGE(PG8_SB(0, 0), cB, voffB); PG8_STAGE(PG8_SB(0, 1), cB + hstepB, voffB); PG8_STAGE(PG8_SA(0, 0), cA, voffA); PG8_STAGE(PG8_SA(0, 1), cA + hstepA, voffA);
    if (wr == 1) PG8_BAR;
    PG8_WAIT_V(2); PG8_BAR;
    PG8_STAGE(PG8_SB(1, 0), cB + kstep, voffB); PG8_STAGE(PG8_SA(1, 0), cA + kstep, voffA); PG8_STAGE(PG8_SB(1, 1), cB + hstepB + kstep, voffB);
    PG8_WAIT_V(6); PG8_BAR;
    for (;;) {
        const bool has_next = S.next(ui + 1, nxt);
        const char* nA = has_next ? PG8_UA(nxt) : cA; const char* nB = has_next ? PG8_UB(nxt) : cB;
#pragma unroll 1
        for (int t = 0; t < nt; t += 2) {
            const bool last = (t == nt - 2);
            const char* a1 = cA + (size_t)(t + 1) * kstep;
            const char* a2 = last ? nA : cA + (size_t)(t + 2) * kstep; const char* b2 = last ? nB : cB + (size_t)(t + 2) * kstep;
            const char* a3 = a2 + kstep; const char* b3 = b2 + kstep;
            PG8_LDB(B0, 0, 0); PG8_LDB(B1, 0, 1); PG8_SCHED; PG8_LDA(At, 0, 0); PG8_STAGE(PG8_SA(1, 1), a1 + hstepA, voffA);
            PG8_WAIT_V(8); PG8_WAIT_L(0); PG8_BAR; PG8_MMA(0, 0, At, B0); PG8_MMA(0, 1, At, B1); PG8_BAR; PG8_SCHED;
            PG8_LDA(At, 0, 1); PG8_STAGE(PG8_SB(0, 0), b2, voffB); PG8_STAGE(PG8_SB(0, 1), b2 + hstepB, voffB); PG8_STAGE(PG8_SA(0, 0), a2, voffA);
            PG8_WAIT_V(8); PG8_WAIT_L(0); PG8_BAR; PG8_MMA(1, 0, At, B0); PG8_MMA(1, 1, At, B1); PG8_BAR; PG8_SCHED;
            PG8_LDB(B0, 1, 0); PG8_LDB(B1, 1, 1); PG8_SCHED; PG8_LDA(At, 1, 0); PG8_STAGE(PG8_SA(0, 1), a2 + hstepA, voffA);
            PG8_WAIT_V(8); PG8_WAIT_L(0); PG8_BAR; PG8_MMA(0, 0, At, B0); PG8_MMA(0, 1, At, B1); PG8_BAR; PG8_SCHED;
            PG8_LDA(At, 1, 1); PG8_STAGE(PG8_SB(1, 0), b3, voffB); PG8_STAGE(PG8_SB(1, 1), b3 + hstepB, voffB); PG8_STAGE(PG8_SA(1, 0), a3, voffA);
            PG8_WAIT_V(8); PG8_WAIT_L(0); PG8_BAR; PG8_MMA(1, 0, At, B0); PG8_MMA(1, 1, At, B1); PG8_BAR; PG8_SCHED;
        }
        if (wr == 0) PG8_BAR;
        const bool keep = E(acc, cur, wr, wc, fr, fq);
        if (!has_next) break;
        if (!keep) {
#pragma unroll
            for (int a = 0; a < 2; ++a)
#pragma unroll
                for (int b = 0; b < 2; ++b)
#pragma unroll
                    for (int m = 0; m < 4; ++m)
#pragma unroll
                        for (int n = 0; n < 2; ++n) acc[a][b][m][n] = (f32x4){0.f, 0.f, 0.f, 0.f};
        }
        cur = nxt; cA = nA; cB = nB; ++ui;
        if (wr == 1) PG8_BAR;
    }
    PG8_WAIT_V(0);
    PG8_BAR;
#undef PG8_SA
#undef PG8_SB
#undef PG8_STAGE
#undef PG8_LDA
#undef PG8_LDB
#undef PG8_MMA
#undef PG8_WAIT_V
#undef PG8_WAIT_L
#undef PG8_BAR
#undef PG8_SCHED
#undef PG8_UA
#undef PG8_UB
}
}
#define EPI_ARGS f32x4 (&acc)[2][2][4][2], const pg8::Unit& u, int wr, int wc, int fr, int fq
#define EPI_FOR_ROWS _Pragma("unroll") for (int ai = 0; ai < 2; ++ai) _Pragma("unroll") for (int m = 0; m < 4; ++m)
#define EPI_ROW (u.pm * 256 + ai * 128 + wr * 64 + m * 16 + fr)
#define EPI_FOR_COLS _Pragma("unroll") for (int bj = 0; bj < 2; ++bj)
#define EPI_COL (u.pn * 256 + bj * 128 + wc * 32 + 8 * fq)

__device__ __forceinline__ u32x4 pack8(const f32x4& a, const f32x4& b) { u32x4 w; w.x = pk2(a[0], a[1]); w.y = pk2(a[2], a[3]); w.z = pk2(b[0], b[1]); w.w = pk2(b[2], b[3]); return w; }
__device__ __forceinline__ void unpack8(const u32x4& w, float (&f)[8]) {
    f[0] = bf2f(w.x & 0xffffu); f[1] = __uint_as_float(w.x & 0xffff0000u); f[2] = bf2f(w.y & 0xffffu); f[3] = __uint_as_float(w.y & 0xffff0000u);
    f[4] = bf2f(w.z & 0xffffu); f[5] = __uint_as_float(w.z & 0xffff0000u); f[6] = bf2f(w.w & 0xffffu); f[7] = __uint_as_float(w.w & 0xffff0000u);
}

__device__ __forceinline__ u32x2 pack4(const f32x4& v) { u32x2 w; w.x = pk2(v[0], v[1]); w.y = pk2(v[2], v[3]); return w; }
__device__ __forceinline__ f32x4 unpack4(const u32x2& x) { return (f32x4){bf2f(x.x & 0xffffu), __uint_as_float(x.x & 0xffff0000u), bf2f(x.y & 0xffffu), __uint_as_float(x.y & 0xffff0000u)}; }

struct EpiProj {
    bf16_t* P; float* gate; float* out; int layer;
    __device__ __forceinline__ bool operator()(EPI_ARGS) const {
        const int pn = u.pn;
        int mode;
        if (pn < 4) mode = 0; else if (pn < 8) mode = 1; else if (pn < 12) mode = 5; else if (pn < 16) mode = 3; else if (pn < 18) mode = 0;
        else if (pn < 22) mode = 1; else if (pn < 26) mode = 0; else if (pn < 30) mode = 1; else if (pn < 54) mode = 2; else mode = 4;
        if (mode == 0) {
            EPI_FOR_ROWS { bf16_t* rp = P + (size_t)EPI_ROW * NPROJ; EPI_FOR_COLS { *(u32x4*)(rp + EPI_COL) = pack8(acc[ai][bj][m][0], acc[ai][bj][m][1]); } }
        } else if (mode == 5) {
            EPI_FOR_ROWS { bf16_t* rp = P + (size_t)EPI_ROW * NPROJ; EPI_FOR_COLS { *(u32x4*)(rp + EPI_COL) = pack8(acc[ai][bj][m][0] * SM_SCALE_L2E, acc[ai][bj][m][1] * SM_SCALE_L2E); } }
        } else if (mode == 1) {
            EPI_FOR_ROWS { bf16_t* rp = P + (size_t)EPI_ROW * NPROJ; EPI_FOR_COLS { f32x4 a = acc[ai][bj][m][0], b = acc[ai][bj][m][1];
#pragma unroll
                for (int j = 0; j < 4; ++j) { a[j] = siluf_(a[j]); b[j] = siluf_(b[j]); }
                *(u32x4*)(rp + EPI_COL) = pack8(a, b); } }
        } else if (mode == 2) {
            EPI_FOR_ROWS { bf16_t* rp = P + (size_t)EPI_ROW * NPROJ; EPI_FOR_COLS { f32x4 a = acc[ai][bj][m][0], b = acc[ai][bj][m][1];
#pragma unroll
                for (int j = 0; j < 4; ++j) { a[j] = sigmoidf_(a[j]); b[j] = sigmoidf_(b[j]); }
                *(u32x4*)(rp + EPI_COL) = pack8(a, b); } }
        } else if (mode == 3) {
            EPI_FOR_ROWS { const int row = EPI_ROW; bf16_t* rp = P + (size_t)row * NPROJ;
                float* op = nullptr;
                if (row < MPT) op = out + O_KVP + ((size_t)layer * MPT + row) * 1024;
                else if (row < MROWS) op = out + O_KVS + ((size_t)layer * 32 + (row - MPT)) * 1024;
                EPI_FOR_COLS { const int col = EPI_COL; *(u32x4*)(rp + col) = pack8(acc[ai][bj][m][0], acc[ai][bj][m][1]);
                    if (op) { *(f32x4*)(op + col - C_CK) = acc[ai][bj][m][0]; *(f32x4*)(op + col - C_CK + 4) = acc[ai][bj][m][1]; } } }
        } else {
            EPI_FOR_ROWS { float* gp = gate + (size_t)EPI_ROW * 64; EPI_FOR_COLS { const int c = EPI_COL - C_AG; if (c < 48) { f32x4 a = acc[ai][bj][m][0], b = acc[ai][bj][m][1];
#pragma unroll
                for (int j = 0; j < 4; ++j) { a[j] = sigmoidf_(a[j]); b[j] = sigmoidf_(b[j]); }
                *(f32x4*)(gp + c) = a; *(f32x4*)(gp + c + 4) = b; } } }
        }
        return false;
    }
};

struct EpiPool {
    bf16_t* apool; const bf16_t* P; const float* pscale;
    __device__ __forceinline__ bool operator()(EPI_ARGS) const {
        asm volatile("" ::: "memory");
#pragma unroll
        for (int ai = 0; ai < 2; ++ai) {
            u32x4 zw[4][2];
#pragma unroll
            for (int m = 0; m < 4; ++m) EPI_FOR_COLS { const int col = u.z * 256 + bj * 128 + wc * 32 + 8 * fq; zw[m][bj] = *(const u32x4*)(P + (size_t)EPI_ROW * NPROJ + C_PZ + col); }
            __builtin_amdgcn_sched_barrier(0);
#pragma unroll
            for (int m = 0; m < 4; ++m) EPI_FOR_COLS { const int col = u.z * 256 + bj * 128 + wc * 32 + 8 * fq; float zf[8]; unpack8(zw[m][bj], zf);
                const f32x4 s0 = *(const f32x4*)(pscale + col), s1 = *(const f32x4*)(pscale + col + 4);
                f32x4 a = acc[ai][bj][m][0], b = acc[ai][bj][m][1];
#pragma unroll
                for (int j = 0; j < 4; ++j) { a[j] = a[j] * s0[j] * zf[j]; b[j] = b[j] * s1[j] * zf[4 + j]; }
                *(u32x4*)(apool + (size_t)EPI_ROW * 1024 + col) = pack8(a, b); }
            __builtin_amdgcn_sched_barrier(0);
        }
        return false;
    }
};

struct EpiGlu {
    bf16_t* assm; const bf16_t* P; const bf16_t* Z;
    __device__ __forceinline__ bool operator()(EPI_ARGS) const {
#pragma unroll
        for (int ai = 0; ai < 2; ++ai) {
            u32x4 zw[4][2], sw[4][2];
#pragma unroll
            for (int m = 0; m < 4; ++m) EPI_FOR_COLS { const int row = EPI_ROW, col = EPI_COL; zw[m][bj] = *(const u32x4*)(Z + (size_t)row * 1024 + col); sw[m][bj] = *(const u32x4*)(P + (size_t)row * NPROJ + C_SZ + col); }
            __builtin_amdgcn_sched_barrier(0);
#pragma unroll
            for (int m = 0; m < 4; ++m) EPI_FOR_COLS { float zf[8], sf[8]; unpack8(zw[m][bj], zf); unpack8(sw[m][bj], sf);
                f32x4 a = acc[ai][bj][m][0], b = acc[ai][bj][m][1];
#pragma unroll
                for (int j = 0; j < 4; ++j) { a[j] = zf[j] * sigmoidf_(a[j]) * sf[j]; b[j] = zf[4 + j] * sigmoidf_(b[j]) * sf[4 + j]; }
                *(u32x4*)(assm + (size_t)EPI_ROW * 1024 + EPI_COL) = pack8(a, b); }
            __builtin_amdgcn_sched_barrier(0);
        }
        return false;
    }
};

struct EpiBranch {
    bf16_t* merged; const bf16_t* P;
    __device__ __forceinline__ bool operator()(EPI_ARGS) const {
        const int z = u.z;
#pragma unroll
        for (int ai = 0; ai < 2; ++ai) {
            u32x4 gzw[4][2], gnw[4][2];
#pragma unroll
            for (int m = 0; m < 4; ++m) EPI_FOR_COLS { const bf16_t* gp = P + (size_t)EPI_ROW * NPROJ + C_MG + EPI_COL; gzw[m][bj] = *(const u32x4*)(gp + z * 2048); gnw[m][bj] = *(const u32x4*)(gp + (z < 2 ? z + 1 : 2) * 2048); }
            __builtin_amdgcn_sched_barrier(0);
#pragma unroll
            for (int m = 0; m < 4; ++m) EPI_FOR_COLS { float gz[8], gn[8]; unpack8(gzw[m][bj], gz); unpack8(gnw[m][bj], gn);
                f32x4& a = acc[ai][bj][m][0]; f32x4& b = acc[ai][bj][m][1];
                if (z < 2) {
#pragma unroll
                    for (int j = 0; j < 4; ++j) { a[j] *= fmaxf(gz[j], 1e-30f) * __builtin_amdgcn_rcpf(fmaxf(gn[j], 1e-30f)); b[j] *= fmaxf(gz[4 + j], 1e-30f) * __builtin_amdgcn_rcpf(fmaxf(gn[4 + j], 1e-30f)); }
                } else {
                    f32x4 a2, b2;
#pragma unroll
                    for (int j = 0; j < 4; ++j) { a2[j] = a[j] * fmaxf(gz[j], 1e-30f); b2[j] = b[j] * fmaxf(gz[4 + j], 1e-30f); }
                    *(u32x4*)(merged + (size_t)EPI_ROW * DM + EPI_COL) = pack8(a2, b2);
                } }
            __builtin_amdgcn_sched_barrier(0);
        }
        return z < 2;
    }
};

struct EpiOut {
    bf16_t* outb;
    __device__ __forceinline__ bool operator()(EPI_ARGS) const {
        EPI_FOR_ROWS { bf16_t* rp = outb + (size_t)EPI_ROW * DM; EPI_FOR_COLS { *(u32x4*)(rp + EPI_COL) = pack8(acc[ai][bj][m][0], acc[ai][bj][m][1]); } }
        return false;
    }
};
struct Frame {
    LAS unsigned char* lds;
    int tid, lane, wave, G, bid, gw, ngw;
    float* out; unsigned char* ws;
};
#define FIN(i) ((const float*)(const GAS float*)(((const float* const __attribute__((address_space(4)))*)__builtin_amdgcn_kernarg_segment_ptr())[i]))
#define IN_XP 0
#define IN_XS 1
#define IN_CACHE 2
#define IN_PT 3
#define IN_SWIN 4
#define IN_SPOOL 5
#define IN_SSSM 6
#define IN_GPRE 7
#define IN_GPOST 8
#define IN_WIN 9
#define IN_WPOOL 10
#define IN_PSCALE 11
#define IN_PE 12
#define IN_WPHI 13
#define IN_LRE 14
#define IN_LIM 15
#define IN_LSTEP 16
#define IN_BRE 17
#define IN_BIM 18
#define IN_CRE 19
#define IN_CIM 20
#define IN_DSKIP 21
#define IN_WGLU 22
#define IN_WBRP 23
#define IN_WBRN 24
#define IN_WBRS 25
#define IN_WOUT 26

template <class MAP>
__device__ __forceinline__ void transpose_item(const float* W, int ldw, int K, bf16_t* WT, int k0, int nd0, LAS float* scr, int lane, const MAP& map) {
    const int nq = 4 * (lane & 15), ns = map(nd0 + nq), kr = lane >> 4;
    f32x4 v[16];
#pragma unroll
    for (int i = 0; i < 16; ++i) v[i] = ns >= 0 ? *(const f32x4*)(W + (size_t)(k0 + 4 * i + kr) * ldw + ns) : (f32x4){0.f, 0.f, 0.f, 0.f};
#pragma unroll
    for (int i = 0; i < 16; ++i) { LAS float* d = scr + (4 * i + kr) * 65 + nq; d[0] = v[i].x; d[1] = v[i].y; d[2] = v[i].z; d[3] = v[i].w; }
    LDS_WAIT(); asm volatile("" ::: "memory");
    const int c = lane & 7;
#pragma unroll
    for (int j = 0; j < 8; ++j) { const int n = (lane >> 3) + 8 * j; const LAS float* s = scr + (8 * c) * 65 + n;
        u32x4 o; o.x = pk2(s[0 * 65], s[1 * 65]); o.y = pk2(s[2 * 65], s[3 * 65]); o.z = pk2(s[4 * 65], s[5 * 65]); o.w = pk2(s[6 * 65], s[7 * 65]);
        *(u32x4*)(WT + (size_t)(nd0 + n) * K + k0 + 8 * c) = o; }
    LDS_WAIT(); asm volatile("" ::: "memory");
}
struct MapId { __device__ __forceinline__ int operator()(int n) const { return n; } };
struct MapWin { __device__ __forceinline__ int operator()(int n) const { return n < C_AZ ? n : (n < C_AG ? n + 48 : (n < C_AG + 48 ? n - C_AG + 4608 : -1)); } };

__device__ __forceinline__ double exp_d(double x) {
    const double r = x * (1.0 / 64.0); double t = 1.0, s = 1.0;
#pragma unroll
    for (int k = 1; k <= 14; ++k) { t *= r / (double)k; s += t; }
#pragma unroll
    for (int k = 0; k < 6; ++k) s *= s;
    return s;
}
__device__ __forceinline__ void sincos_d(double x, double& sn, double& cs) {
    const double k = rint(x * 0.63661977236758134308);
    double r = fma(-k, 1.57079632679489655800e+00, x); r = fma(-k, 6.12323399573676603587e-17, r);
    const double r2 = r * r;
    double sp = 1.0, cp = 1.0, ts = 1.0, tc = 1.0;
#pragma unroll
    for (int i = 1; i <= 9; ++i) { ts *= -r2 / (double)((2 * i) * (2 * i + 1)); sp += ts; tc *= -r2 / (double)((2 * i - 1) * (2 * i)); cp += tc; }
    sp *= r;
    const int q = ((int)k) & 3;
    sn = (q == 0) ? sp : (q == 1) ? cp : (q == 2) ? -sp : -cp;
    cs = (q == 0) ? cp : (q == 1) ? -sp : (q == 2) ? -cp : sp;
}

__device__ __forceinline__ void rms_row_to_bf16(const float* xrow, const float* g, bf16_t* orow, int lane) {
    const f32x4* xr = (const f32x4*)xrow + lane; const f32x4* gr = (const f32x4*)g + lane;
    f32x4 v[8]; float s = 0.f;
#pragma unroll
    for (int j = 0; j < 8; ++j) { v[j] = xr[64 * j]; s += (v[j].x * v[j].x + v[j].y * v[j].y) + (v[j].z * v[j].z + v[j].w * v[j].w); }
    const float rstd = 1.f / sqrtf(wave_sum(s) * (1.f / DM) + EPS);
    u32x2* o8 = (u32x2*)orow + lane;
#pragma unroll
    for (int j = 0; j < 8; ++j) { const f32x4 gg = gr[64 * j]; u32x2 w; w.x = pk2(v[j].x * rstd * gg.x, v[j].y * rstd * gg.y); w.y = pk2(v[j].z * rstd * gg.z, v[j].w * rstd * gg.w); o8[64 * j] = w; }
}
__device__ __forceinline__ const float* x_row_l0(const Frame& F, int m) {
    const GAS float* s0 = (const GAS float*)FIN(IN_XP); const GAS float* s1 = (const GAS float*)FIN(IN_XS);
    asm volatile("" : "+s"(s0), "+s"(s1));
    return (const float*)(m < MPT ? s0 + (size_t)m * DM : s1 + (size_t)(m - MPT) * DM); }

__device__ __forceinline__ void phase_prologue(Frame& F) {
    LAS float* scr = (LAS float*)(F.lds + F.wave * 16640);
    const int lane = F.lane;
    constexpr int I_WIN = 32 * (NPROJ / 64), I_GLU = 16 * 16, I_BR = 16 * 32, I_OUT = 32 * 32, I_POOL = 4 * 4, I_PHI = 1;
    constexpr int PER_L = I_WIN + I_GLU + 3 * I_BR + I_OUT + 4 * I_POOL + 128 * I_PHI;
    for (int it = F.gw; it < 2 * PER_L; it += F.ngw) {
        const int l = it / PER_L; int r = it % PER_L;
        if (r < I_WIN) { const int kb = r / (NPROJ / 64), nb = r % (NPROJ / 64);
            transpose_item(FIN(IN_WIN) + (size_t)l * DM * DIN, DIN, DM, (bf16_t*)(F.ws + WS_WIN + l * al1m(SZ_WIN)), 64 * kb, 64 * nb, scr, lane, MapWin()); continue; } r -= I_WIN;
        if (r < I_GLU) { const int kb = r / 16, nb = r % 16;
            transpose_item(FIN(IN_WGLU) + (size_t)l * 1024 * 1024, 1024, 1024, (bf16_t*)(F.ws + WS_WGLU + l * al1m(SZ_WGLU)), 64 * kb, 64 * nb, scr, lane, MapId()); continue; } r -= I_GLU;
        if (r < 3 * I_BR) { const int z = r / I_BR, rr = r % I_BR, kb = rr / 32, nb = rr % 32;
            const float* src = FIN(IN_WBRP + z) + (size_t)l * 1024 * 2048;
            transpose_item(src, 2048, 1024, (bf16_t*)(F.ws + WS_WBR + l * al1m(SZ_WBR)) + (size_t)z * 2048 * 1024, 64 * kb, 64 * nb, scr, lane, MapId()); continue; } r -= 3 * I_BR;
        if (r < I_OUT) { const int kb = r / 32, nb = r % 32;
            transpose_item(FIN(IN_WOUT) + (size_t)l * 2048 * 2048, 2048, 2048, (bf16_t*)(F.ws + WS_WOUT + l * al1m(SZ_WOUT)), 64 * kb, 64 * nb, scr, lane, MapId()); continue; } r -= I_OUT;
        if (r < 4 * I_POOL) { const int z = r / I_POOL, rr = r % I_POOL, kb = rr / 4, nb = rr % 4;
            transpose_item(FIN(IN_WPOOL) + ((size_t)l * 4 + z) * 65536, 256, 256, (bf16_t*)(F.ws + WS_WPOOL + l * al1m(SZ_WPOOL)) + (size_t)z * 65536, 64 * kb, 64 * nb, scr, lane, MapId()); continue; } r -= 4 * I_POOL;
        {
            transpose_item(FIN(IN_WPHI) + ((size_t)l * 128 + r) * 4096, 64, 64, (bf16_t*)(F.ws + WS_WPHI + l * al1m(SZ_WPHI)) + (size_t)r * 4096, 0, 0, scr, lane, MapId()); }
    }
    for (int it = F.gw; it < 64; it += F.ngw) {
        const int l = it >> 5, j = (it >> 4) & 1, part = it & 15;
        const float* pe = FIN(IN_PE) + ((size_t)(l * 2 + j) * 64 + part * 4) * 64;
        const float* wp = FIN(IN_WPHI) + ((size_t)(l * 2 + j) * 64 + part * 4) * 4096;
        float s = 0.f;
#pragma unroll 16
        for (int i = 0; i < 256; ++i) s += pe[i] * wp[(size_t)i * 64 + lane];
        ((float*)(F.ws + WS_PEBP + l * al1m(SZ_PEBP)))[(j * 16 + part) * 64 + lane] = s;
    }
    for (int it = F.gw * 64 + lane; it < 2 * 4096; it += F.ngw * 64) {
        const int l = it >> 12, g = (it >> 6) & 63, n = it & 63;
        const double dt = exp_d((double)FIN(IN_LSTEP)[l * 64 + g]);
        const double lr = (double)FIN(IN_LRE)[(l * 64 + g) * 64 + n], li = (double)FIN(IN_LIM)[(l * 64 + g) * 64 + n];
        const double mag = exp_d(lr * dt); double sn, cs; sincos_d(li * dt, sn, cs);
        const double ar = mag * cs, ai = mag * sn, den = lr * lr + li * li;
        const double cr = ((ar - 1.0) * lr + ai * li) / den, ci = (ai * lr - (ar - 1.0) * li) / den;
        double pr = ar, pi = ai;
#pragma unroll
        for (int k = 0; k < 7; ++k) { const double t = pr * pr - pi * pi; pi = 2.0 * pr * pi; pr = t; }
        float* ab = (float*)(F.ws + WS_SAB + l * al1m(SZ_SAB)) + (g * 64 + n) * 4;
        ab[0] = (float)ar; ab[1] = (float)ai; ab[2] = (float)pr; ab[3] = (float)pi;
        float* bb = (float*)(F.ws + WS_SBB + l * al1m(SZ_SBB)) + (size_t)g * 16 * 128;
        const float* bre = FIN(IN_BRE) + ((size_t)(l * 64 + g) * 64 + n) * 16; const float* bim = FIN(IN_BIM) + ((size_t)(l * 64 + g) * 64 + n) * 16;
        unsigned* bb16 = (unsigned*)(F.ws + WS_SBB16 + l * al1m(SZ_SBB16));
        for (int c = 0; c < 16; c += 2) { const double br0 = bre[c], bi0 = bim[c], br1 = bre[c + 1], bi1 = bim[c + 1];
            const float r0 = (float)(cr * br0 - ci * bi0), i0 = (float)(cr * bi0 + ci * br0), r1 = (float)(cr * br1 - ci * bi1), i1 = (float)(cr * bi1 + ci * br1);
            bb[c * 128 + n] = r0; bb[c * 128 + 64 + n] = i0; bb[(c + 1) * 128 + n] = r1; bb[(c + 1) * 128 + 64 + n] = i1;
            bb16[(((g * 2 + 0) * 64 + n) * 16 + c) >> 1] = pk2(r0, r1); bb16[(((g * 2 + 1) * 64 + n) * 16 + c) >> 1] = pk2(i0, i1); }
        bf16_t* cm = (bf16_t*)(F.ws + WS_SCM + l * al1m(SZ_SCM)) + (size_t)g * 16 * 128;
        const float* cre = FIN(IN_CRE) + (size_t)(l * 64 + g) * 16 * 64; const float* cim = FIN(IN_CIM) + (size_t)(l * 64 + g) * 16 * 64;
        for (int c = 0; c < 16; ++c) *(unsigned*)(cm + c * 128 + 2 * n) = pk2(cre[c * 64 + n], -cim[c * 64 + n]);
    }
    bf16_t* H = (bf16_t*)(F.ws + WS_H);
    for (int m = F.gw; m < MROWS; m += F.ngw) rms_row_to_bf16(x_row_l0(F, m), FIN(IN_GPRE), H + (size_t)m * DM, lane);
}

__device__ __forceinline__ void phase_norm(Frame& F, int l) {
    const int lane = F.lane;
    const bf16_t* outb = (const bf16_t*)(F.ws + WS_OUTB);
    float* y0 = (float*)(F.ws + WS_Y0);
    bf16_t* H = (bf16_t*)(F.ws + WS_H);
    for (int r = F.bid; r < MROWS - MPT; r += F.G) {
        const int m = MPT + r, c0 = F.wave * 256 + 4 * lane;
        LAS float* red = (LAS float*)F.lds;
        const float* xrow = l == 0 ? FIN(IN_XS) + (size_t)r * DM : y0 + (size_t)m * DM;
        float* yrow = l == 0 ? y0 + (size_t)m * DM : F.out + O_YS + (size_t)r * DM;
        const f32x4 o = unpack4(*(const u32x2*)(outb + (size_t)m * DM + c0)), x = *(const f32x4*)(xrow + c0), g = *(const f32x4*)(FIN(IN_GPOST) + l * DM + c0);
        float s = wave_sum(o.x * o.x + o.y * o.y + o.z * o.z + o.w * o.w);
        __syncthreads();
        if (lane == 0) red[F.wave] = s;
        __syncthreads();
        s = 0.f;
#pragma unroll
        for (int w2 = 0; w2 < NWAVES; ++w2) s += red[w2];
        const float rstd = 1.f / sqrtf(s * (1.f / DM) + EPS);
        const f32x4 y = x + o * rstd * g;
        *(f32x4*)(yrow + c0) = y;
        if (l == 0) {
            float s2 = wave_sum(y.x * y.x + y.y * y.y + y.z * y.z + y.w * y.w);
            if (lane == 0) red[8 + F.wave] = s2;
            __syncthreads();
            s2 = 0.f;
#pragma unroll
            for (int w2 = 0; w2 < NWAVES; ++w2) s2 += red[8 + w2];
            const float rstd2 = 1.f / sqrtf(s2 * (1.f / DM) + EPS);
            const f32x4 g2 = *(const f32x4*)(FIN(IN_GPRE) + DM + c0);
            *(u32x2*)(H + (size_t)m * DM + c0) = pack4(y * rstd2 * g2);
        }
    }
    for (int m = F.gw; m < MPT; m += F.ngw) {
        const float* xrow = l == 0 ? x_row_l0(F, m) : y0 + (size_t)m * DM;
        float* yrow = l == 0 ? y0 + (size_t)m * DM : (m < MPT ? F.out + O_YP + (size_t)m * DM : F.out + O_YS + (size_t)(m - MPT) * DM);
        const float* gp = FIN(IN_GPOST) + l * DM;
        float v[4][8]; float s = 0.f;
#pragma unroll
        for (int j = 0; j < 4; ++j) { const u32x4 w = *(const u32x4*)(outb + (size_t)m * DM + 8 * (lane + 64 * j)); unpack8(w, v[j]);
#pragma unroll
            for (int e = 0; e < 8; ++e) s += v[j][e] * v[j][e]; }
        const float rstd = 1.f / sqrtf(wave_sum(s) * (1.f / DM) + EPS);
        float s2 = 0.f;
#pragma unroll
        for (int j = 0; j < 4; ++j) { const int c0 = 8 * (lane + 64 * j);
            const f32x4 g0 = *(const f32x4*)(gp + c0), g1 = *(const f32x4*)(gp + c0 + 4), x0 = *(const f32x4*)(xrow + c0), x1 = *(const f32x4*)(xrow + c0 + 4);
            f32x4 y0v, y1v;
#pragma unroll
            for (int e = 0; e < 4; ++e) { y0v[e] = x0[e] + v[j][e] * rstd * g0[e]; y1v[e] = x1[e] + v[j][4 + e] * rstd * g1[e]; v[j][e] = y0v[e]; v[j][4 + e] = y1v[e]; s2 += y0v[e] * y0v[e] + y1v[e] * y1v[e]; }
            *(f32x4*)(yrow + c0) = y0v; *(f32x4*)(yrow + c0 + 4) = y1v; }
        if (l == 0) {
            const float rstd2 = 1.f / sqrtf(wave_sum(s2) * (1.f / DM) + EPS);
            const float* g2 = FIN(IN_GPRE) + DM;
#pragma unroll
            for (int j = 0; j < 4; ++j) { const int c0 = 8 * (lane + 64 * j); const f32x4 g0 = *(const f32x4*)(g2 + c0), g1 = *(const f32x4*)(g2 + c0 + 4);
                f32x4 a, bq;
#pragma unroll
                for (int e = 0; e < 4; ++e) { a[e] = v[j][e] * rstd2 * g0[e]; bq[e] = v[j][4 + e] * rstd2 * g1[e]; }
                *(u32x4*)(H + (size_t)m * DM + c0) = pack8(a, bq); }
        }
    }
}
template <int KP>
__device__ __forceinline__ void skinny_stage(LAS unsigned char* lds, const bf16_t* A, int lda, int tid) {
    constexpr int CH = KP / 8;
#pragma unroll 8
    for (int i = tid; i < 32 * CH; i += NT) { const int r = i / CH, c = i % CH; *(LAS u32x4*)(lds + r * (KP * 2 + 16) + c * 16) = *(const u32x4*)(A + (size_t)r * lda + 8 * c); }
    __syncthreads();
}
template <int KP>
__device__ __forceinline__ void skinny_tile(const LAS unsigned char* lds, const bf16_t* Bt, int ldb, int n0, int kbeg, int klen, int lane, f32x4& d0, f32x4& d1) {
    const int rw = lane & 15, q = lane >> 4;
    const bf16_t* wrow = Bt + (size_t)(n0 + rw) * ldb + 32 * q;
    const LAS unsigned char* a0 = lds + rw * (KP * 2 + 16) + (kbeg + 32 * q) * 2;
    const LAS unsigned char* a1 = a0 + 16 * (KP * 2 + 16);
    d0 = (f32x4){0.f, 0.f, 0.f, 0.f}; d1 = d0;
#pragma unroll 4
    for (int k0 = 0; k0 < klen; k0 += 128) {
        bf16x8 w[4];
#pragma unroll
        for (int s = 0; s < 4; ++s) w[s] = *(const bf16x8*)(wrow + k0 + 8 * s);
#pragma unroll
        for (int s = 0; s < 4; ++s) { const bf16x8 b0 = *(const LAS bf16x8*)(a0 + k0 * 2 + 16 * s), b1 = *(const LAS bf16x8*)(a1 + k0 * 2 + 16 * s);
            d0 = __builtin_amdgcn_mfma_f32_16x16x32_bf16(w[s], b0, d0, 0, 0, 0); d1 = __builtin_amdgcn_mfma_f32_16x16x32_bf16(w[s], b1, d1, 0, 0, 0); }
    }
}

__device__ __forceinline__ void skinny_proj_epi(Frame& F, int l, int n0, const f32x4 (&d)[2]) {
    bf16_t* P = (bf16_t*)(F.ws + WS_P); float* gate = (float*)(F.ws + WS_GATE);
    const int n = n0 + 4 * (F.lane >> 4), pn = n >> 8;
    int mode; if (pn < 4) mode = 0; else if (pn < 8) mode = 1; else if (pn < 12) mode = 5; else if (pn < 16) mode = 3; else if (pn < 18) mode = 0;
    else if (pn < 22) mode = 1; else if (pn < 26) mode = 0; else if (pn < 30) mode = 1; else if (pn < 54) mode = 2; else mode = 4;
#pragma unroll
    for (int tt = 0; tt < 2; ++tt) { const int t = 16 * tt + (F.lane & 15), row = MPT + t; f32x4 v = d[tt];
        if (mode == 4) { const int c = n - C_AG; if (c < 48) {
#pragma unroll
            for (int j = 0; j < 4; ++j) v[j] = sigmoidf_(v[j]);
            *(f32x4*)(gate + (size_t)row * 64 + c) = v; } }
        else {
            if (mode == 3) *(f32x4*)(F.out + O_KVS + ((size_t)l * 32 + t) * 1024 + n - C_CK) = v;
            if (mode == 5) v = v * SM_SCALE_L2E;
            if (mode == 1) {
#pragma unroll
                for (int j = 0; j < 4; ++j) v[j] = siluf_(v[j]); }
            if (mode == 2) {
#pragma unroll
                for (int j = 0; j < 4; ++j) v[j] = sigmoidf_(v[j]); }
            *(u32x2*)(P + (size_t)row * NPROJ + n) = pack4(v);
        } }
}
__device__ __forceinline__ void skinny_proj(Frame& F, int l) {
    constexpr int NTASK = NPROJ / 128;
    const bf16_t* W = (const bf16_t*)(F.ws + WS_WIN + l * al1m(SZ_WIN));
    const int ntile = (MPT / 256) * (NPROJ / 256), nlight = (ntile % F.G) ? F.G - (ntile % F.G) : F.G, first = F.G - nlight;
    if (F.bid >= first) {
        bool staged = false;
        const int nit = first ? 2 : (NTASK + nlight - 1) / nlight;
        for (int it = 0; it < nit; ++it) { const int task = (F.bid - first) + it * nlight;
            if (task >= NTASK) break;
            if (!staged) { skinny_stage<DM>(F.lds, (const bf16_t*)(F.ws + WS_H) + (size_t)MPT * DM, DM, F.tid); staged = true; }
            const int n0 = task * 128 + F.wave * 16; f32x4 d[2];
            skinny_tile<DM>(F.lds, W, DM, n0, 0, DM, F.lane, d[0], d[1]);
            skinny_proj_epi(F, l, n0, d); }
    } else {
        for (int qt = first - 1 - F.bid; qt < (NTASK - 2 * nlight) * 4; qt += first) {
            __syncthreads();
            skinny_stage<DM>(F.lds, (const bf16_t*)(F.ws + WS_H) + (size_t)MPT * DM, DM, F.tid);
            const int tile = F.wave & 1, kq = F.wave >> 1, n0 = 2 * nlight * 128 + qt * 32 + tile * 16; f32x4 d[2];
            skinny_tile<DM>(F.lds, W + kq * 512, DM, n0, kq * 512, 512, F.lane, d[0], d[1]);
            __syncthreads();
            LAS f32x4* red = (LAS f32x4*)F.lds;
            red[(F.wave * 2 + 0) * 64 + F.lane] = d[0]; red[(F.wave * 2 + 1) * 64 + F.lane] = d[1];
            __syncthreads();
            if (kq == 0) {
#pragma unroll
                for (int tt = 0; tt < 2; ++tt)
#pragma unroll
                    for (int k2 = 1; k2 < 4; ++k2) d[tt] += red[((2 * k2 + tile) * 2 + tt) * 64 + F.lane];
                skinny_proj_epi(F, l, n0, d); }
        }
    }
    __syncthreads();
}
__device__ __forceinline__ void skinny_pool(Frame& F, int l) {
    const bf16_t* P = (const bf16_t*)(F.ws + WS_P); bf16_t* apool = (bf16_t*)(F.ws + WS_ABR);
    const bf16_t* W = (const bf16_t*)(F.ws + WS_WPOOL + l * al1m(SZ_WPOOL)); const float* pscale = FIN(IN_PSCALE) + l * 1024;
    bool staged = false;
    for (int task = F.G - 1 - F.bid; task < 8; task += F.G) {
        if (!staged) { skinny_stage<1024>(F.lds, (const bf16_t*)(F.ws + WS_DIFF) + (size_t)MPT * 1024, 1024, F.tid); staged = true; }
        const int z = task >> 1, n0 = (task & 1) * 128 + F.wave * 16; f32x4 d[2];
        skinny_tile<1024>(F.lds, W + (size_t)z * 65536, 256, n0, z * 256, 256, F.lane, d[0], d[1]);
        const int col = z * 256 + n0 + 4 * (F.lane >> 4);
        const f32x4 ps = *(const f32x4*)(pscale + col);
#pragma unroll
        for (int tt = 0; tt < 2; ++tt) { const int row = MPT + 16 * tt + (F.lane & 15);
            const f32x4 zf = unpack4(*(const u32x2*)(P + (size_t)row * NPROJ + C_PZ + col));
            *(u32x2*)(apool + (size_t)row * 1024 + col) = pack4(d[tt] * ps * zf); }
    }
    __syncthreads();
}
__device__ __forceinline__ void skinny_glu(Frame& F, int l) {
    const bf16_t* P = (const bf16_t*)(F.ws + WS_P); const bf16_t* Z = (const bf16_t*)(F.ws + WS_Z); bf16_t* assm = (bf16_t*)(F.ws + WS_ABR + 2 * SZ_ABR1);
    const bf16_t* W = (const bf16_t*)(F.ws + WS_WGLU + l * al1m(SZ_WGLU));
    bool staged = false;
    for (int task = F.G - 17 - F.bid; task < 8; task += F.G) {
        if (task < 0) continue;
        if (!staged) { skinny_stage<1024>(F.lds, Z + (size_t)MPT * 1024, 1024, F.tid); staged = true; }
        const int n0 = task * 128 + F.wave * 16; f32x4 d[2];
        skinny_tile<1024>(F.lds, W, 1024, n0, 0, 1024, F.lane, d[0], d[1]);
        const int col = n0 + 4 * (F.lane >> 4);
#pragma unroll
        for (int tt = 0; tt < 2; ++tt) { const int row = MPT + 16 * tt + (F.lane & 15);
            const f32x4 zf = unpack4(*(const u32x2*)(Z + (size_t)row * 1024 + col)), sf = unpack4(*(const u32x2*)(P + (size_t)row * NPROJ + C_SZ + col));
            f32x4 v = d[tt];
#pragma unroll
            for (int j = 0; j < 4; ++j) v[j] = zf[j] * sigmoidf_(v[j]) * sf[j];
            *(u32x2*)(assm + (size_t)row * 1024 + col) = pack4(v); }
    }
    __syncthreads();
}
__device__ __forceinline__ void skinny_stage_att(Frame& F) {
    const bf16_t* P = (const bf16_t*)(F.ws + WS_P); const float* so = (const float*)(F.ws + WS_SOACC); const float* gate = (const float*)(F.ws + WS_GATE);
#pragma unroll 2
    for (int i = F.tid; i < 32 * 128; i += NT) { const int r = i >> 7, c = i & 127, head = c >> 3, d0 = (c & 7) * 8, row = MPT + r;
        const int unit = (r >> 2) * 16 + (head >> 2) * 4 + (r & 3);
        const float* sp = so + (size_t)unit * 768 + (head & 3) * 64 + d0; const float* gt = gate + (size_t)row * 64 + head * 3;
        const float g0 = gt[0], g1 = gt[1], g2 = gt[2];
        float zf[8]; unpack8(*(const u32x4*)(P + (size_t)row * NPROJ + C_AZ + head * 64 + d0), zf);
        f32x4 o[2];
#pragma unroll
        for (int h = 0; h < 2; ++h) { const f32x4 a = *(const f32x4*)(sp + 4 * h), b = *(const f32x4*)(sp + 256 + 4 * h), w = *(const f32x4*)(sp + 512 + 4 * h);
#pragma unroll
            for (int j = 0; j < 4; ++j) o[h][j] = (g0 * a[j] + g1 * b[j] + g2 * w[j]) * zf[4 * h + j]; }
        *(LAS u32x4*)(F.lds + r * (1024 * 2 + 16) + c * 16) = pack8(o[0], o[1]); }
    __syncthreads();
}
__device__ __forceinline__ void skinny_branch(Frame& F, int l) {
    const bf16_t* P = (const bf16_t*)(F.ws + WS_P); bf16_t* brp = (bf16_t*)(F.ws + WS_BRP);
    const bf16_t* W = (const bf16_t*)(F.ws + WS_WBR + l * al1m(SZ_WBR));
    for (int task = F.G - 1 - F.bid; task < 192; task += F.G) {
        const int z = task >> 6, tile = F.wave & 1, kq = F.wave >> 1, n0 = (task & 63) * 32 + tile * 16; f32x4 d[2];
        __syncthreads();
        if (z == 1) skinny_stage_att(F);
        else skinny_stage<1024>(F.lds, (const bf16_t*)(F.ws + WS_ABR) + (size_t)z * MPAD * 1024 + (size_t)MPT * 1024, 1024, F.tid);
        skinny_tile<1024>(F.lds, W + (size_t)z * 2048 * 1024 + kq * 256, 1024, n0, kq * 256, 256, F.lane, d[0], d[1]);
        __syncthreads();
        LAS f32x4* red = (LAS f32x4*)F.lds;
        red[(F.wave * 2 + 0) * 64 + F.lane] = d[0]; red[(F.wave * 2 + 1) * 64 + F.lane] = d[1];
        __syncthreads();
        if (kq == 0) { const int col = n0 + 4 * (F.lane >> 4);
#pragma unroll
            for (int tt = 0; tt < 2; ++tt) { const int t = 16 * tt + (F.lane & 15), row = MPT + t; f32x4 a = d[tt];
#pragma unroll
                for (int k2 = 1; k2 < 4; ++k2) a += red[((2 * k2 + tile) * 2 + tt) * 64 + F.lane];
                const f32x4 gm = unpack4(*(const u32x2*)(P + (size_t)row * NPROJ + C_MG + z * 2048 + col));
                *(u32x2*)(brp + ((size_t)z * 32 + t) * DM + col) = pack4(a * gm); } }
    }
    __syncthreads();
}
__device__ __forceinline__ void skinny_out(Frame& F, int l) {
    const bf16_t* brp = (const bf16_t*)(F.ws + WS_BRP); bf16_t* outb = (bf16_t*)(F.ws + WS_OUTB);
    const bf16_t* W = (const bf16_t*)(F.ws + WS_WOUT + l * al1m(SZ_WOUT));
    bool staged = false;
    for (int task = F.G - 1 - F.bid; task < 64; task += F.G) {
        if (!staged) {
#pragma unroll 4
            for (int i = F.tid; i < 32 * (DM / 8); i += NT) { const int r = i / (DM / 8), c = i % (DM / 8);
                float p0[8], p1[8], p2[8];
                unpack8(*(const u32x4*)(brp + (size_t)r * DM + 8 * c), p0); unpack8(*(const u32x4*)(brp + (size_t)(32 + r) * DM + 8 * c), p1); unpack8(*(const u32x4*)(brp + (size_t)(64 + r) * DM + 8 * c), p2);
                f32x4 s0, s1;
#pragma unroll
                for (int j = 0; j < 4; ++j) { s0[j] = p0[j] + p1[j] + p2[j]; s1[j] = p0[4 + j] + p1[4 + j] + p2[4 + j]; }
                *(LAS u32x4*)(F.lds + r * (DM * 2 + 16) + c * 16) = pack8(s0, s1); }
            __syncthreads(); staged = true; }
        const int tile = F.wave & 1, kq = F.wave >> 1, n0 = task * 32 + tile * 16; f32x4 d[2];
        skinny_tile<DM>(F.lds, W + kq * 512, DM, n0, kq * 512, 512, F.lane, d[0], d[1]);
        __syncthreads();
        LAS f32x4* red = (LAS f32x4*)F.lds;
        red[(F.wave * 2 + 0) * 64 + F.lane] = d[0]; red[(F.wave * 2 + 1) * 64 + F.lane] = d[1];
        staged = false;
        __syncthreads();
        if (kq == 0) {
#pragma unroll
            for (int tt = 0; tt < 2; ++tt) { f32x4 a = d[tt];
#pragma unroll
                for (int k2 = 1; k2 < 4; ++k2) a += red[((2 * k2 + tile) * 2 + tt) * 64 + F.lane];
                *(u32x2*)(outb + (size_t)(MPT + 16 * tt + (F.lane & 15)) * DM + n0 + 4 * (F.lane >> 4)) = pack4(a); } }
        __syncthreads();
    }
    __syncthreads();
}
__device__ __forceinline__ int keypos(int key) { return (key & ~12) | ((key & 4) << 1) | ((key & 8) >> 1); }

template <int W>
__device__ __forceinline__ void pool_diff_load(const bf16_t* P, const float* spool, int m, int c0, f32x4 (&v)[W]) {
    if (m < MPT) {
        const int s = m & (SEQ - 1);
#pragma unroll
        for (int j = 0; j < W; ++j) v[j] = (j <= s) ? unpack4(*(const u32x2*)(P + (size_t)(m - j) * NPROJ + C_PU + c0)) : (f32x4){0.f, 0.f, 0.f, 0.f};
    } else {
        const int b = (m - MPT) >> 2, i = (m - MPT) & 3;
#pragma unroll
        for (int j = 0; j < W; ++j) { const int idx = 15 + i - j;
            v[j] = (idx >= 15) ? unpack4(*(const u32x2*)(P + (size_t)(MPT + b * 4 + idx - 15) * NPROJ + C_PU + c0)) : *(const f32x4*)(spool + ((size_t)b * 15 + idx) * 1024 + c0); }
    }
}
template <int W>
__device__ __forceinline__ void pool_diff_store(bf16_t* D, int m, int c0, const f32x4 (&v)[W]) {
    int cnt = W; if (m < MPT) { const int s = m & (SEQ - 1); cnt = (s + 1 < W) ? s + 1 : W; }
    f32x4 sum = v[0];
#pragma unroll
    for (int j = 1; j < W; ++j) sum += v[j];
    *(u32x2*)(D + (size_t)m * 1024 + c0) = pack4(sum * (1.f / (float)cnt) - v[0]);
}
__device__ __forceinline__ void s2_pool_diff(Frame& F, int l) {
    const bf16_t* P = (const bf16_t*)(F.ws + WS_P); bf16_t* D = (bf16_t*)(F.ws + WS_DIFF);
    const float* spool = FIN(IN_SPOOL) + (size_t)l * SB * 15 * 1024;
    const int c0 = 4 * F.lane;
    for (int m = F.gw; m < MROWS; m += F.ngw) {
        f32x4 v2[2], v4[4], v8[8], v16[16];
        pool_diff_load<2>(P, spool, m, c0, v2); pool_diff_load<4>(P, spool, m, 256 + c0, v4); pool_diff_load<8>(P, spool, m, 512 + c0, v8); pool_diff_load<16>(P, spool, m, 768 + c0, v16);
        pool_diff_store<2>(D, m, c0, v2); pool_diff_store<4>(D, m, 256 + c0, v4); pool_diff_store<8>(D, m, 512 + c0, v8); pool_diff_store<16>(D, m, 768 + c0, v16);
    }
}

__device__ __forceinline__ void store8f(float* dst, const u32x4& x) { float f[8]; unpack8(x, f); *(f32x4*)dst = (f32x4){f[0], f[1], f[2], f[3]}; *(f32x4*)(dst + 4) = (f32x4){f[4], f[5], f[6], f[7]}; }

__device__ __forceinline__ void s2_state_outputs(Frame& F, int l) {
    const bf16_t* P = (const bf16_t*)(F.ws + WS_P);
    const int gt = F.gw * 64 + F.lane, ngt = F.ngw * 64;
    for (int it = gt; it < PB * 15 * 128; it += ngt) { const int c0 = (it & 127) * 8, r = (it >> 7) % 15, b = (it >> 7) / 15;
        store8f(F.out + O_POOLP + (((size_t)l * PB + b) * 15 + r) * 1024 + c0, *(const u32x4*)(P + (size_t)(b * SEQ + SEQ - 15 + r) * NPROJ + C_PU + c0)); }
    for (int it = gt; it < SB * 15 * 128; it += ngt) { const int c0 = (it & 127) * 8, r = (it >> 7) % 15, b = (it >> 7) / 15, e = 4 + r;
        float* dst = F.out + O_POOLS + (((size_t)l * SB + b) * 15 + r) * 1024 + c0;
        if (e < 15) { const float* sp = FIN(IN_SPOOL) + (((size_t)l * SB + b) * 15 + e) * 1024 + c0; *(f32x4*)dst = *(const f32x4*)sp; *(f32x4*)(dst + 4) = *(const f32x4*)(sp + 4); }
        else store8f(dst, *(const u32x4*)(P + (size_t)(MPT + b * 4 + e - 15) * NPROJ + C_PU + c0)); }
    for (int it = gt; it < PB * 512 * 64; it += ngt) { const int c0 = (it & 63) * 8, r = (it >> 6) & 511, b = it >> 15;
        store8f(F.out + O_WINP + (((size_t)l * PB + b) * 512 + r) * 512 + c0, *(const u32x4*)(P + (size_t)(b * SEQ + SEQ - 512 + r) * NPROJ + C_WK + c0)); }
    for (int it = gt; it < SB * 512 * 64; it += ngt) { const int c0 = (it & 63) * 8, r = (it >> 6) & 511, b = it >> 15;
        float* dst = F.out + O_WINS + (((size_t)l * SB + b) * 512 + r) * 512 + c0;
        if (r < 508) { const float* sp = FIN(IN_SWIN) + (((size_t)l * SB + b) * 512 + r + 4) * 512 + c0; *(f32x4*)dst = *(const f32x4*)sp; *(f32x4*)(dst + 4) = *(const f32x4*)(sp + 4); }
        else store8f(dst, *(const u32x4*)(P + (size_t)(MPT + b * 4 + r - 508) * NPROJ + C_WK + c0)); }
}

__device__ __forceinline__ void s2_vt_images(Frame& F) {
    const bf16_t* P = (const bf16_t*)(F.ws + WS_P);
    for (int it = F.gw; it < 2 * PB * 4 * 64; it += F.ngw) {
        const int which = it >> 9, b = (it >> 8) & 1, kvh = (it >> 6) & 3, blk = it & 63;
        const bf16_t* src = P + (size_t)(b * SEQ + blk * 64 + F.lane) * NPROJ + (which ? C_WK : C_SK) + kvh * 64;
        bf16_t* img = (bf16_t*)(F.ws + (which ? WS_KTWIN : WS_KTSEL)) + (size_t)((b * 4 + kvh) * 64 + blk) * 4096 + F.lane * 8;
        u32x4 v[8];
#pragma unroll
        for (int j = 0; j < 8; ++j) v[j] = *(const u32x4*)(src + 8 * j);
#pragma unroll
        for (int j = 0; j < 8; ++j) *(u32x4*)(img + j * 512) = v[j];
    }
    for (int it = F.gw; it < 2 * PB * 4 * 64; it += F.ngw) {
        const int which = it >> 9, b = (it >> 8) & 1, kvh = (it >> 6) & 3, blk = it & 63;
        const bf16_t* src = P + (size_t)(b * SEQ + blk * 64 + F.lane) * NPROJ + (which ? C_WV : C_SV) + kvh * 64;
        const int pos = keypos(F.lane);
        bf16_t* img = (bf16_t*)(F.ws + (which ? WS_VTWIN : WS_VTSEL)) + (size_t)((b * 4 + kvh) * 64 + blk) * 4096 + (pos >> 3) * 512 + (pos & 7);
        u32x4 v[8];
#pragma unroll
        for (int j = 0; j < 8; ++j) v[j] = *(const u32x4*)(src + 8 * j);
#pragma unroll
        for (int j = 0; j < 8; ++j) {
            img[(8 * j + 0) * 8] = (bf16_t)(v[j].x & 0xffffu); img[(8 * j + 1) * 8] = (bf16_t)(v[j].x >> 16);
            img[(8 * j + 2) * 8] = (bf16_t)(v[j].y & 0xffffu); img[(8 * j + 3) * 8] = (bf16_t)(v[j].y >> 16);
            img[(8 * j + 4) * 8] = (bf16_t)(v[j].z & 0xffffu); img[(8 * j + 5) * 8] = (bf16_t)(v[j].z >> 16);
            img[(8 * j + 6) * 8] = (bf16_t)(v[j].w & 0xffffu); img[(8 * j + 7) * 8] = (bf16_t)(v[j].w >> 16); }
    }
}

template <bool SAMPLE>
__device__ __forceinline__ void compress_unit(Frame& F, int l, int unit) {
    const int lane = F.lane, w = F.wave, col = lane & 15, q = lane >> 4, nl = col >> 2, k = col & 3;
    const int b = SAMPLE ? unit >> 5 : unit >> 3, n0 = SAMPLE ? (unit & 31) * 8 : (unit & 7) * 8;
    const bf16_t* wphi = (const bf16_t*)(F.ws + WS_WPHI + l * al1m(SZ_WPHI));
    const bf16_t* P = (const bf16_t*)(F.ws + WS_P);
    const float* cache = FIN(IN_CACHE); const int* pt = (const int*)FIN(IN_PT);
    f32x4 acc[2][2][4];
#pragma unroll
    for (int j = 0; j < 2; ++j)
#pragma unroll
        for (int nt = 0; nt < 2; ++nt)
#pragma unroll
            for (int et = 0; et < 4; ++et) acc[j][nt][et] = (f32x4){0.f, 0.f, 0.f, 0.f};
    size_t xoff[2];
#pragma unroll
    for (int nt = 0; nt < 2; ++nt) { const int blk = n0 + 4 * nt + nl;
        if (SAMPLE) { const int page = pt[b * 128 + (blk >> 1)]; xoff[nt] = ((((size_t)l * NPOOL + page) * 128 + (blk & 1) * 64) * 4) * 256 + k * 64 + 8 * q; }
        else xoff[nt] = (size_t)(b * SEQ + blk * 64) * NPROJ + C_CK + k * 64 + 8 * q; }
    bf16x8 ra[2][2][4];
    f32x4 rx[2][2][2][2];
#define CMP_LOAD(J, LPOS) do { _Pragma("unroll") for (int dc = 0; dc < 2; ++dc) { \
        _Pragma("unroll") for (int et = 0; et < 4; ++et) ra[J][dc][et] = *(const bf16x8*)(wphi + ((size_t)((J) * 64 + (LPOS)) * 64 + 16 * et + col) * 64 + 32 * dc + 8 * q); \
        _Pragma("unroll") for (int nt = 0; nt < 2; ++nt) { \
            if (SAMPLE) { const float* s_ = cache + xoff[nt] + ((size_t)(LPOS) * 4 + (J)) * 256 + 32 * dc; rx[J][dc][nt][0] = __builtin_nontemporal_load((const f32x4*)s_); rx[J][dc][nt][1] = __builtin_nontemporal_load((const f32x4*)(s_ + 4)); } \
            else rx[J][dc][nt][0] = __builtin_bit_cast(f32x4, *(const bf16x8*)(P + xoff[nt] + (size_t)(LPOS) * NPROJ + (J) * 256 + 32 * dc)); } } } while (0)
#define CMP_MMA(J) do { _Pragma("unroll") for (int dc = 0; dc < 2; ++dc) _Pragma("unroll") for (int nt = 0; nt < 2; ++nt) { \
        const bf16x8 bx_ = SAMPLE ? __builtin_bit_cast(bf16x8, pack8(rx[J][dc][nt][0], rx[J][dc][nt][1])) : __builtin_bit_cast(bf16x8, rx[J][dc][nt][0]); \
        _Pragma("unroll") for (int et = 0; et < 4; ++et) acc[J][nt][et] = __builtin_amdgcn_mfma_f32_16x16x32_bf16(ra[J][dc][et], bx_, acc[J][nt][et], 0, 0, 0); } } while (0)
    CMP_LOAD(0, w * 8);
#pragma unroll 1
    for (int li = 0; li < 8; ++li) { const int lpos = w * 8 + li;
        CMP_LOAD(1, lpos); __builtin_amdgcn_sched_barrier(0);
        CMP_MMA(0); __builtin_amdgcn_sched_barrier(0);
        if (li < 7) CMP_LOAD(0, lpos + 1);
        __builtin_amdgcn_sched_barrier(0);
        CMP_MMA(1); __builtin_amdgcn_sched_barrier(0);
    }
#undef CMP_LOAD
#undef CMP_MMA
    LAS float* red = (LAS float*)F.lds;
#pragma unroll
    for (int j = 0; j < 2; ++j)
#pragma unroll
        for (int nt = 0; nt < 2; ++nt)
#pragma unroll
            for (int et = 0; et < 4; ++et)
#pragma unroll
                for (int i = 0; i < 4; ++i) red[(w * 64 + ((j * 2 + nt) * 4 + et) * 4 + i) * 64 + lane] = acc[j][nt][et][i];
    __syncthreads();
    const LAS float* pb = (const LAS float*)(F.lds + 131072);
    bf16_t* kc = (bf16_t*)(F.ws + (SAMPLE ? WS_KCS : WS_KCP)); bf16_t* vct = (bf16_t*)(F.ws + (SAMPLE ? WS_VCTS : WS_VCTP));
    constexpr int NBLK = SAMPLE ? 256 : 64;
    for (int o = F.tid; o < 4096; o += NT) { const int r = o >> 6, ln = o & 63;
        float s = 0.f;
#pragma unroll
        for (int ww = 0; ww < 8; ++ww) s += red[(ww * 64 + r) * 64 + ln];
        const int j = r >> 5, nt = (r >> 4) & 1, et = (r >> 2) & 3, i = r & 3, e = 16 * et + 4 * (ln >> 4) + i, cc = ln & 15, blk = n0 + 4 * nt + (cc >> 2), kk = cc & 3;
        s += pb[j * 64 + e];
        if (j == 0) kc[((size_t)(b * 4 + kk) * NBLK + blk) * 64 + e] = (bf16_t)f2bf(s);
        else vct[(((size_t)(b * 4 + kk) * (NBLK / 64) + (blk >> 6)) * 64 + e) * 64 + keypos(blk & 63)] = (bf16_t)f2bf(s);
    }
    __syncthreads();
}

__device__ __forceinline__ void compress_prompt_piece(Frame& F, int l, int piece) {
    const int lane = F.lane, w = F.wave, col = lane & 15, q = lane >> 4, nl = col >> 2, k = col & 3;
    const int ntile = piece >> 3, j = (piece >> 2) & 1, et = piece & 3, b = ntile >> 4, n0 = (ntile & 15) * 4;
    const bf16_t* wphi = (const bf16_t*)(F.ws + WS_WPHI + l * al1m(SZ_WPHI)) + ((size_t)(j * 64) * 64 + 16 * et + col) * 64 + 8 * q;
    const bf16_t* xp = (const bf16_t*)(F.ws + WS_P) + (size_t)(b * SEQ + (n0 + nl) * 64) * NPROJ + C_CK + j * 256 + k * 64 + 8 * q;
    bf16x8 a[16], x[16];
#pragma unroll
    for (int li = 0; li < 8; ++li)
#pragma unroll
        for (int dc = 0; dc < 2; ++dc) { const int lpos = w * 8 + li;
            a[li * 2 + dc] = *(const bf16x8*)(wphi + (size_t)lpos * 4096 + 32 * dc); x[li * 2 + dc] = *(const bf16x8*)(xp + (size_t)lpos * NPROJ + 32 * dc); }
    f32x4 acc = {0.f, 0.f, 0.f, 0.f};
#pragma unroll
    for (int i = 0; i < 16; ++i) acc = __builtin_amdgcn_mfma_f32_16x16x32_bf16(a[i], x[i], acc, 0, 0, 0);
    LAS float* red = (LAS float*)F.lds;
    __syncthreads();
#pragma unroll
    for (int i = 0; i < 4; ++i) red[(w * 4 + i) * 64 + lane] = acc[i];
    __syncthreads();
    if (F.tid < 256) { const int i = F.tid >> 6, ln = F.tid & 63; float s = 0.f;
#pragma unroll
        for (int ww = 0; ww < 8; ++ww) s += red[(ww * 4 + i) * 64 + ln];
        const int e = 16 * et + 4 * (ln >> 4) + i, cc = ln & 15, blk = n0 + (cc >> 2), kk = cc & 3;
        s += ((const LAS float*)(F.lds + 131072))[j * 64 + e];
        if (j == 0) ((bf16_t*)(F.ws + WS_KCP))[(size_t)(b * 4 + kk) * 4096 + (e >> 3) * 512 + blk * 8 + (e & 7)] = (bf16_t)f2bf(s);
        else { const int pos = keypos(blk); ((bf16_t*)(F.ws + WS_VCTP))[(size_t)(b * 4 + kk) * 4096 + (pos >> 3) * 512 + e * 8 + (pos & 7)] = (bf16_t)f2bf(s); } }
    __syncthreads();
}

__device__ __forceinline__ void s2_compress(Frame& F, int l) {
    if (F.tid < 128) { const float* pp = (const float*)(F.ws + WS_PEBP + l * al1m(SZ_PEBP)); float s = 0.f;
#pragma unroll
        for (int p = 0; p < 16; ++p) s += pp[((F.tid >> 6) * 16 + p) * 64 + (F.tid & 63)];
        ((LAS float*)(F.lds + 131072))[F.tid] = s; }
    __syncthreads();
    for (int u = F.bid; u < 256; u += F.G) compress_unit<true>(F, l, u);
    for (int u = F.bid; u < 256; u += F.G) compress_prompt_piece(F, l, u);
}

#ifndef NSA_SGB
#define NSA_SGB 1
#endif
#define MFMA32(a, b, c) __builtin_amdgcn_mfma_f32_32x32x16_bf16((a), (b), (c), 0, 0, 0)
constexpr float NEG_BIG = -1e30f;
constexpr int AL_K = 0, AL_V = 8192, AL_SLOT = 16384  , AL_MASK = 4 * AL_SLOT  , AL_UNION = AL_MASK + 512,
              AL_TOT = 66560  , AL_IMP = AL_TOT  ;
__device__ __forceinline__ void dma16(const void* src, LAS unsigned char* dst) { __builtin_amdgcn_global_load_lds((const unsigned*)src, (LAS unsigned*)dst, 16, 0, 0); }
__device__ __forceinline__ void tile_dma(const bf16_t* kimg, const bf16_t* vimg, LAS unsigned char* slot, int w, int lane) {
    dma16(kimg + (unsigned)w * 512u + 8u * (unsigned)lane, slot + AL_K + w * 1024);
    dma16(vimg + (unsigned)w * 512u + 8u * (unsigned)lane, slot + AL_V + w * 1024);
}

template <int CTRL> __device__ __forceinline__ float quad_xor(float x) { return __int_as_float(__builtin_amdgcn_update_dpp(0, __float_as_int(x), CTRL, 0xF, 0xF, false)); }
struct FlashState { f32x16 o[2]; float m, l; };
__device__ __forceinline__ void flash_reset(FlashState& S) {
#pragma unroll
    for (int i = 0; i < 16; ++i) { S.o[0][i] = 0.f; S.o[1][i] = 0.f; }
    S.m = 0.f; S.l = 0.f;
}
__device__ __forceinline__ void flash_scores(const LAS unsigned char* kbuf, const bf16x8 (&qf)[4], int r, int h, float init, f32x16& s0, f32x16& s1) {
    bf16x8 kf[8];
#pragma unroll
    for (int ks = 0; ks < 4; ++ks) { kf[2 * ks] = *(const LAS bf16x8*)(kbuf + (2 * ks + h) * 1024 + r * 16); kf[2 * ks + 1] = *(const LAS bf16x8*)(kbuf + (2 * ks + h) * 1024 + (32 + r) * 16); }
    __builtin_amdgcn_sched_barrier(0);
#pragma unroll
    for (int i = 0; i < 16; ++i) { s0[i] = init; s1[i] = init; }
#pragma unroll
    for (int ks = 0; ks < 4; ++ks) { s0 = MFMA32(kf[2 * ks], qf[ks], s0); s1 = MFMA32(kf[2 * ks + 1], qf[ks], s1); }
}
__device__ __forceinline__ bf16x8 pack_p(const f32x16& p, int s) {
    u32x4 w; w.x = pk2(p[8 * s], p[8 * s + 1]); w.y = pk2(p[8 * s + 2], p[8 * s + 3]); w.z = pk2(p[8 * s + 4], p[8 * s + 5]); w.w = pk2(p[8 * s + 6], p[8 * s + 7]);
    return __builtin_bit_cast(bf16x8, w);
}
__device__ __forceinline__ void flash_vload(const LAS unsigned char* vbuf, int r, int h, bf16x8 (&vf)[8]) {
#pragma unroll
    for (int sub = 0; sub < 2; ++sub)
#pragma unroll
        for (int s = 0; s < 2; ++s)
#pragma unroll
            for (int dt = 0; dt < 2; ++dt) vf[(sub * 2 + s) * 2 + dt] = *(const LAS bf16x8*)(vbuf + (4 * sub + 2 * s + h) * 1024 + (32 * dt + r) * 16);
    __builtin_amdgcn_sched_barrier(0);
}
__device__ __forceinline__ void flash_pv(const bf16x8 (&vf)[8], const f32x16& p0, const f32x16& p1, f32x16 (&o)[2]) {
#pragma unroll
    for (int sub = 0; sub < 2; ++sub)
#pragma unroll
        for (int s = 0; s < 2; ++s) {
            const bf16x8 pb = pack_p(sub ? p1 : p0, s);
#pragma unroll
            for (int dt = 0; dt < 2; ++dt) o[dt] = MFMA32(vf[(sub * 2 + s) * 2 + dt], pb, o[dt]);
        }
}
__device__ __forceinline__ float xhalf_max(float x) {
    const auto r = __builtin_amdgcn_permlane32_swap(__float_as_uint(x), __float_as_uint(x), false, false);
    return fmaxf(__uint_as_float(r[0]), __uint_as_float(r[1]));
}
__device__ __forceinline__ void flash_mask(f32x16& s0, f32x16& s1, int lo, int hi, int h) {
#pragma unroll
    for (int i = 0; i < 16; ++i) { const int key = (i & 3) + 8 * (i >> 2) + 4 * h;
        s0[i] = (key >= lo && key <= hi) ? s0[i] : -INFINITY; s1[i] = (key + 32 >= lo && key + 32 <= hi) ? s1[i] : -INFINITY; }
}
__device__ __forceinline__ float flash_rowmax(const f32x16& s0, const f32x16& s1) {
    float mx = -INFINITY;
#pragma unroll
    for (int i = 0; i < 16; ++i) asm("v_max3_f32 %0, %1, %2, %3" : "=v"(mx) : "v"(mx), "v"(s0[i]), "v"(s1[i]));
    return xhalf_max(mx);
}
__device__ __forceinline__ void flash_first(FlashState& S, f32x16& s0, f32x16& s1, int lo, int hi, int h, bool masked) {
    if (masked) flash_mask(s0, s1, lo, hi, h);
    S.m = fmaxf(flash_rowmax(s0, s1), NEG_BIG);
    float ls = 0.f;
#pragma unroll
    for (int i = 0; i < 16; ++i) { s0[i] = __builtin_amdgcn_exp2f(s0[i] - S.m); s1[i] = __builtin_amdgcn_exp2f(s1[i] - S.m); ls += s0[i] + s1[i]; }
    S.l = ls;
}
__device__ __forceinline__ void flash_next(FlashState& S, f32x16& s0, f32x16& s1, float mused, int lo, int hi, int h, bool masked, bool first) {
    if (masked) flash_mask(s0, s1, lo, hi, h);
    const float corr = S.m - mused;
    if (__ballot(corr != 0.f) != 0ull) {
#pragma unroll
        for (int i = 0; i < 16; ++i) { s0[i] -= corr; s1[i] -= corr; } }
    const float mx = flash_rowmax(s0, s1);
    if (__ballot(mx > SM_THR || (first && mx < -SM_THR)) != 0ull) {
        const float d = (mx > NEG_BIG) ? (first ? mx : fmaxf(mx, 0.f)) : 0.f, alpha = __builtin_amdgcn_exp2f(-d);
        S.m += d; S.l *= alpha;
#pragma unroll
        for (int i = 0; i < 16; ++i) { S.o[0][i] *= alpha; S.o[1][i] *= alpha; s0[i] -= d; s1[i] -= d; }
    }
    float ls = 0.f;
#pragma unroll
    for (int i = 0; i < 16; ++i) { s0[i] = __builtin_amdgcn_exp2f(s0[i]); s1[i] = __builtin_amdgcn_exp2f(s1[i]); ls += s0[i] + s1[i]; }
    S.l += ls;
}

__device__ __forceinline__ void flash_kload(const LAS unsigned char* kbuf, int r, int h, bf16x8 (&kf)[8]) {
#pragma unroll
    for (int ks = 0; ks < 4; ++ks) { kf[2 * ks] = *(const LAS bf16x8*)(kbuf + (2 * ks + h) * 1024 + r * 16); kf[2 * ks + 1] = *(const LAS bf16x8*)(kbuf + (2 * ks + h) * 1024 + (32 + r) * 16); }
    __builtin_amdgcn_sched_barrier(0);
}
struct TileCtl { bool en, masked; int lo, hi; };
__device__ __forceinline__ void flash_pair(FlashState& S, const LAS unsigned char* ka, const LAS unsigned char* va, const LAS unsigned char* kb2, const LAS unsigned char* vb2,
                                           const bf16x8 (&qf)[4], const TileCtl& A, const TileCtl& B, bool first, int r, int h) {
    bf16x8 kf[8]; f32x16 a0, a1, b0, b1;
    flash_kload(ka, r, h, kf);
    { const float init = A.en ? -S.m : -INFINITY;
#pragma unroll
        for (int i = 0; i < 16; ++i) { a0[i] = init; a1[i] = init; }
#pragma unroll
        for (int ks = 0; ks < 4; ++ks) { a0 = MFMA32(kf[2 * ks], qf[ks], a0); a1 = MFMA32(kf[2 * ks + 1], qf[ks], a1); } }
    if (A.masked) flash_mask(a0, a1, A.lo, A.hi, h);
    { const float mx = flash_rowmax(a0, a1);
        if (__ballot(mx > SM_THR || (first && mx < -SM_THR)) != 0ull) { const float d = (mx > NEG_BIG) ? (first ? mx : fmaxf(mx, 0.f)) : 0.f, alpha = __builtin_amdgcn_exp2f(-d); S.m += d; S.l *= alpha;
#pragma unroll
            for (int i = 0; i < 16; ++i) { S.o[0][i] *= alpha; S.o[1][i] *= alpha; a0[i] -= d; a1[i] -= d; } } }
    flash_kload(kb2, r, h, kf);
    { const float init = B.en ? -S.m : -INFINITY;
#pragma unroll
        for (int i = 0; i < 16; ++i) { b0[i] = init; b1[i] = init; } }
    __builtin_amdgcn_sched_barrier(0);
#pragma unroll
    for (int k = 0; k < 8; ++k) {
        if (k & 1) b1 = MFMA32(kf[k], qf[k >> 1], b1); else b0 = MFMA32(kf[k], qf[k >> 1], b0);
#pragma unroll
        for (int e = 0; e < 4; ++e) { const int idx = 4 * k + e;
            if (idx < 16) { float t = __builtin_amdgcn_exp2f(a0[idx]); asm volatile("" : "+v"(t)); a0[idx] = t; }
            else { float t = __builtin_amdgcn_exp2f(a1[idx - 16]); asm volatile("" : "+v"(t)); a1[idx - 16] = t; } }
        __builtin_amdgcn_sched_barrier(0);
    }
    bf16x8 pa[4]; float ls = 0.f;
#pragma unroll
    for (int i = 0; i < 16; ++i) ls += a0[i] + a1[i];
    pa[0] = pack_p(a0, 0); pa[1] = pack_p(a0, 1); pa[2] = pack_p(a1, 0); pa[3] = pack_p(a1, 1);
    S.l += ls;
    __builtin_amdgcn_sched_barrier(0);
    if (B.masked) flash_mask(b0, b1, B.lo, B.hi, h);
    float alphaB = 1.f;
    { const float mx = flash_rowmax(b0, b1);
        if (__ballot(mx > SM_THR) != 0ull) { const float d = (mx > NEG_BIG) ? fmaxf(mx, 0.f) : 0.f; alphaB = __builtin_amdgcn_exp2f(-d); S.m += d; S.l *= alphaB;
#pragma unroll
            for (int i = 0; i < 16; ++i) { b0[i] -= d; b1[i] -= d; } } }
    { bf16x8 vf[8]; flash_vload(va, r, h, vf);
#pragma unroll
        for (int k = 0; k < 8; ++k) {
            S.o[k & 1] = MFMA32(vf[k], pa[k >> 1], S.o[k & 1]);
#pragma unroll
            for (int e = 0; e < 4; ++e) { const int idx = 4 * k + e;
                if (idx < 16) { float t = __builtin_amdgcn_exp2f(b0[idx]); asm volatile("" : "+v"(t)); b0[idx] = t; }
                else { float t = __builtin_amdgcn_exp2f(b1[idx - 16]); asm volatile("" : "+v"(t)); b1[idx - 16] = t; } }
            __builtin_amdgcn_sched_barrier(0);
        }
    }
    __builtin_amdgcn_sched_barrier(0);
    if (__ballot(alphaB != 1.f) != 0ull) {
#pragma unroll
        for (int i = 0; i < 16; ++i) { S.o[0][i] *= alphaB; S.o[1][i] *= alphaB; } }
    { bf16x8 vf[8]; flash_vload(vb2, r, h, vf);
        bf16x8 pb[4]; pb[0] = pack_p(b0, 0); pb[1] = pack_p(b0, 1); pb[2] = pack_p(b1, 0); pb[3] = pack_p(b1, 1);
        float l0 = 0.f, l1 = 0.f;
        __builtin_amdgcn_sched_barrier(0);
#pragma unroll
        for (int k = 0; k < 8; ++k) {
            S.o[k & 1] = MFMA32(vf[k], pb[k >> 1], S.o[k & 1]);
#pragma unroll
            for (int e = 0; e < 2; ++e) { const int idx = 2 * k + e; l0 += b0[idx]; l1 += b1[idx]; }
            asm volatile("" : "+v"(l0), "+v"(l1));
            __builtin_amdgcn_sched_barrier(0);
        }
        S.l += l0 + l1; }
}

__device__ __forceinline__ void nsa_prompt_unit(Frame& F, int l, int b, int kvh, int c) {
    int tid = threadIdx.x; asm volatile("" : "+v"(tid));
    const int lane = tid & 63, w = F.wave, r = lane & 31, h = lane >> 5, qi = r >> 2, g = r & 3, qloc = 8 * w + qi;
    const int tok = b * SEQ + 64 * c + qloc, head = kvh * 4 + g;
    const bf16_t* P = (const bf16_t*)(F.ws + WS_P);
    LAS unsigned char* kbuf = F.lds + AL_K; LAS unsigned char* vbuf = F.lds + AL_V;
    LAS float* imp = (LAS float*)(F.lds + AL_IMP); LAS unsigned* msk = (LAS unsigned*)(F.lds + AL_MASK); LAS unsigned* uni = (LAS unsigned*)(F.lds + AL_UNION);
    __syncthreads();
    tile_dma((const bf16_t*)(F.ws + WS_KCP) + (size_t)(b * 4 + kvh) * 4096, (const bf16_t*)(F.ws + WS_VCTP) + (size_t)(b * 4 + kvh) * 4096, F.lds, w, lane);
    bf16x8 qf[4];
#pragma unroll
    for (int ks = 0; ks < 4; ++ks) qf[ks] = *(const bf16x8*)(P + (size_t)tok * NPROJ + C_Q + head * 64 + 16 * ks + 8 * h);
    const float* gt = (const float*)(F.ws + WS_GATE) + (size_t)tok * 64 + head * 3;
    const float g_cmp = gt[0], g_sel = gt[1], g_win = gt[2];
    LAS f32x4* ltot = (LAS f32x4*)(F.lds + AL_TOT) + tid;
    FlashState S;
    {
        if (tid < 128) msk[tid] = 0u; if (tid < 2) uni[tid] = 0u;
        __syncthreads();
        flash_reset(S);
        f32x16 s0, s1; flash_scores(kbuf, qf, r, h, 0.f, s0, s1);
        const int nvalid = c + (qloc == 63 ? 1 : 0);
        bf16x8 vf[8]; flash_vload(vbuf, r, h, vf);
        flash_first(S, s0, s1, 0, nvalid - 1, h, true);
        const float lt = S.l + __shfl_xor(S.l, 32), inv = lt > 0.f ? 1.f / lt : 0.f;
#pragma unroll
        for (int i = 0; i < 16; ++i) { s0[i] *= inv; s1[i] *= inv; }
#pragma unroll
        for (int i = 0; i < 16; ++i) { float a = s0[i]; a += quad_xor<0xB1>(a); a += quad_xor<0x4E>(a); float bq = s1[i]; bq += quad_xor<0xB1>(bq); bq += quad_xor<0x4E>(bq);
            if (g == 0) { const int key = (i & 3) + 8 * (i >> 2) + 4 * h; imp[qloc * 65 + key] = a; imp[qloc * 65 + key + 32] = bq; } }
        flash_pv(vf, s0, s1, S.o);
    }
    __syncthreads();
    {
        const int n = lane; const bool cand = (n >= 1) && (n <= c - 2);
        const unsigned long long forced = 1ull | (1ull << c) | (c >= 1 ? (1ull << (c - 1)) : 0ull);
        unsigned long long um = 0ull;
#pragma unroll 1
        for (int qq = 0; qq < 8; ++qq) { const int q = w * 8 + qq;
            const unsigned kb_ = cand ? ((__float_as_uint(imp[q * 65 + n]) & ~63u) | (unsigned)(63 - n)) : 0u;
            int rank = 0;
            for (int j = 1; j <= c - 2; ++j) { const unsigned sj = __builtin_amdgcn_readlane(kb_, j); rank += (sj > kb_) ? 1 : 0; }
            const unsigned long long m = __ballot(cand && rank < 13) | forced;
            if (lane == 0) { msk[q * 2] = (unsigned)m; msk[q * 2 + 1] = (unsigned)(m >> 32); }
            um |= m; }
        if (lane == 0) { atomicOr((unsigned*)uni, (unsigned)um); atomicOr((unsigned*)(uni + 1), (unsigned)(um >> 32)); }
    }
    __syncthreads();
    const unsigned mlo = msk[qloc * 2], mhi = msk[qloc * 2 + 1], ulo = uni[0], uhi = uni[1];
#pragma unroll
    for (int i4 = 0; i4 < 8; ++i4) { const f32x16& o = S.o[i4 >> 2]; const int i = 4 * (i4 & 3); ltot[i4 * 512] = (f32x4){g_cmp * o[i], g_cmp * o[i + 1], g_cmp * o[i + 2], g_cmp * o[i + 3]}; }
#define NSA_POP(REM_) ((REM_) ? (t_ = sel ? __builtin_ctzll(REM_) : 63 - __builtin_clzll(REM_), (REM_) &= ~(1ull << t_), t_) : -1)
#define NSA_EN(N_) (sel ? ((((N_) < 32 ? mlo >> (N_) : mhi >> ((N_) - 32)) & 1u) != 0u) : true)
#define NSA_LOHI(N_) const int n_ = (N_), lo_ = (!sel && n_ == c - 8) ? qloc + 1 : 0, hi_ = (n_ == c) ? qloc : 63; const bool mk_ = (n_ == c) || (!sel && n_ == c - 8)
#define NSA_PV(SLOT_, S0_, S1_) do { bf16x8 vf[8]; flash_vload(vbuf + (SLOT_), r, h, vf); flash_pv(vf, S0_, S1_, S.o); } while (0)
#pragma unroll 1
    for (int pass = 0; pass < 2; ++pass) {
        const bool sel = pass == 0;
        flash_reset(S);
        const bf16_t* kb = (const bf16_t*)(F.ws + (sel ? WS_KTSEL : WS_KTWIN)) + (size_t)(b * 4 + kvh) * 64 * 4096;
        const bf16_t* vt = (const bf16_t*)(F.ws + (sel ? WS_VTSEL : WS_VTWIN)) + (size_t)(b * 4 + kvh) * 64 * 4096;
        unsigned long long rem;
        if (sel) rem = ((unsigned long long)uhi << 32) | ulo;
        else { const int lo = c >= 8 ? c - 8 : 0; rem = (c == 63 ? ~0ull : ((1ull << (c + 1)) - 1ull)) & ~((1ull << lo) - 1ull); }
        int t_;
        int tA = NSA_POP(rem), tB = NSA_POP(rem);
        int pr = 0; bool first = true;
        __syncthreads();
        tile_dma(kb + (size_t)tA * 4096, vt + (size_t)tA * 4096, F.lds, w, lane);
        if (tB >= 0) tile_dma(kb + (size_t)tB * 4096, vt + (size_t)tB * 4096, F.lds + AL_SLOT, w, lane);
        for (;;) {
            const int sa = pr, sb = pr + AL_SLOT;
            __syncthreads();
            const int nA = NSA_POP(rem), nB = NSA_POP(rem);
            if (nA >= 0) tile_dma(kb + (size_t)nA * 4096, vt + (size_t)nA * 4096, F.lds + (pr ^ (2 * AL_SLOT)), w, lane);
            if (nB >= 0) tile_dma(kb + (size_t)nB * 4096, vt + (size_t)nB * 4096, F.lds + (pr ^ (2 * AL_SLOT)) + AL_SLOT, w, lane);
            const bool enA = first || NSA_EN(tA), enB = tB >= 0 ? NSA_EN(tB) : false;
            if (__ballot(enA || enB) != 0ull) {
                TileCtl A, B;
                A.en = enA; A.masked = (tA == c) || (!sel && tA == c - 8); A.lo = (!sel && tA == c - 8) ? qloc + 1 : 0; A.hi = (tA == c) ? qloc : 63;
                B.en = enB; B.masked = (tB == c) || (!sel && tB == c - 8); B.lo = (!sel && tB == c - 8) ? qloc + 1 : 0; B.hi = (tB == c) ? qloc : 63;
                const int sbb = tB >= 0 ? sb : sa;
                flash_pair(S, kbuf + sa, vbuf + sa, kbuf + sbb, vbuf + sbb, qf, A, B, first, r, h);
            }
            first = false;
            if (nA < 0) break;
            tA = nA; tB = nB; pr ^= 2 * AL_SLOT;
        }
        const float lt = S.l + __shfl_xor(S.l, 32), sc = (sel ? g_sel : g_win) / lt;
#pragma unroll
        for (int i4 = 0; i4 < 8; ++i4) { const f32x16& o = S.o[i4 >> 2]; const int i = 4 * (i4 & 3); ltot[i4 * 512] += (f32x4){sc * o[i], sc * o[i + 1], sc * o[i + 2], sc * o[i + 3]}; }
    }
#undef NSA_PV
#undef NSA_LOHI
#undef NSA_EN
#undef NSA_POP
    bf16_t* ao = (bf16_t*)(F.ws + WS_ABR + SZ_ABR1) + (size_t)tok * 1024 + head * 64;
    const bf16_t* az = P + (size_t)tok * NPROJ + C_AZ + head * 64;
#pragma unroll
    for (int i4 = 0; i4 < 8; ++i4) { const int d = 32 * (i4 >> 2) + 8 * (i4 & 3) + 4 * h;
        const f32x4 t = ltot[i4 * 512]; const f32x4 zz = unpack4(*(const u32x2*)(az + d));
        *(u32x2*)(ao + d) = pack4(t * zz); }
}

constexpr int SL_Q = 0  , SL_SC = 1024  , SL_IMP = SL_SC + 4 * 1040 * 4  , SL_RED = SL_IMP + 264 * 4  ,
              SL_LIST = SL_RED + 128  , SL_KOFF = SL_LIST + 64  , SL_PART = SL_KOFF + 1040 * 4  , SL_OACC = SL_PART + 32768  , SL_PT = SL_OACC + 3072  ;
constexpr int KOFF_INVALID = -2147483647;

__device__ __forceinline__ void block_softmax4(LAS float* sc, int count, LAS float* red, int tid) {
    const int gh = tid >> 7, t = tid & 127, wv = tid >> 6;
    LAS float* row = sc + gh * 1040;
    float mx = -INFINITY;
    for (int i = t; i < count; i += 128) mx = fmaxf(mx, row[i]);
    mx = wave_max(mx);
    if ((tid & 63) == 0) red[wv] = mx;
    __syncthreads();
    mx = fmaxf(red[2 * gh], red[2 * gh + 1]);
    float sm = 0.f;
    for (int i = t; i < count; i += 128) { const float p = __expf(row[i] - mx); row[i] = p; sm += p; }
    sm = wave_sum(sm);
    if ((tid & 63) == 0) red[8 + wv] = sm;
    __syncthreads();
    const float inv = 1.f / (red[8 + 2 * gh] + red[8 + 2 * gh + 1]);
    for (int i = t; i < count; i += 128) row[i] *= inv;
    __syncthreads();
}
__device__ __forceinline__ void sample_scores(const float* base, const bf16_t* Pnew, int pcol, int count, const LAS int* koff, const LAS float* qv, LAS float* sc, int tid) {
#pragma unroll 1
    for (int idx = tid; idx < count; idx += NT) {
        const int ko = koff[idx];
        float d0 = -INFINITY, d1 = -INFINITY, d2 = -INFINITY, d3 = -INFINITY;
        if (ko != KOFF_INVALID) {
            f32x4 kx[16];
            if (ko >= 0) {
#pragma unroll
                for (int j = 0; j < 16; ++j) kx[j] = *(const f32x4*)(base + (size_t)ko + 4 * j); }
            else {
#pragma unroll
                for (int j = 0; j < 16; ++j) kx[j] = unpack4(*(const u32x2*)(Pnew + (size_t)(-1 - ko) * NPROJ + pcol + 4 * j)); }
            d0 = d1 = d2 = d3 = 0.f;
#pragma unroll
            for (int j4 = 0; j4 < 4; ++j4) {
#pragma unroll
                for (int jj = 0; jj < 4; ++jj) { const int j = 4 * j4 + jj; const f32x4 kq = kx[j];
                    const f32x4 q0 = *(const LAS f32x4*)(qv + 4 * j), q1 = *(const LAS f32x4*)(qv + 64 + 4 * j), q2 = *(const LAS f32x4*)(qv + 128 + 4 * j), q3 = *(const LAS f32x4*)(qv + 192 + 4 * j);
                    d0 += kq.x * q0.x + kq.y * q0.y + kq.z * q0.z + kq.w * q0.w; d1 += kq.x * q1.x + kq.y * q1.y + kq.z * q1.z + kq.w * q1.w;
                    d2 += kq.x * q2.x + kq.y * q2.y + kq.z * q2.z + kq.w * q2.w; d3 += kq.x * q3.x + kq.y * q3.y + kq.z * q3.z + kq.w * q3.w; }
                __builtin_amdgcn_sched_barrier(0);
            }
            d0 *= 0.125f; d1 *= 0.125f; d2 *= 0.125f; d3 *= 0.125f;
        }
        sc[idx] = d0; sc[1040 + idx] = d1; sc[2080 + idx] = d2; sc[3120 + idx] = d3;
    }
}
__device__ __forceinline__ void sample_pv(const float* base, const bf16_t* Pnew, int pcol, int count, const LAS int* koff, const LAS float* sc, LAS float* part, LAS float* oacc, int tid) {
    const int dq = tid & 15, ks = tid >> 4, per = (count + 31) >> 5, i0 = ks * per, i1 = (i0 + per < count) ? i0 + per : count;
    f32x4 a0 = {0.f, 0.f, 0.f, 0.f}, a1 = a0, a2 = a0, a3 = a0;
#pragma unroll 8
    for (int idx = i0; idx < i1; ++idx) { const int ko = koff[idx];
        f32x4 v = {0.f, 0.f, 0.f, 0.f};
        if (ko >= 0) v = *(const f32x4*)(base + (size_t)ko + 256 + 4 * dq);
        else if (ko != KOFF_INVALID) { const u32x2 x = *(const u32x2*)(Pnew + (size_t)(-1 - ko) * NPROJ + pcol + 256 + 4 * dq); v = (f32x4){bf2f(x.x & 0xffffu), __uint_as_float(x.x & 0xffff0000u), bf2f(x.y & 0xffffu), __uint_as_float(x.y & 0xffff0000u)}; }
        a0 += sc[idx] * v; a1 += sc[1040 + idx] * v; a2 += sc[2080 + idx] * v; a3 += sc[3120 + idx] * v; }
    *(LAS f32x4*)(part + ks * 256 + 4 * dq) = a0; *(LAS f32x4*)(part + ks * 256 + 64 + 4 * dq) = a1; *(LAS f32x4*)(part + ks * 256 + 128 + 4 * dq) = a2; *(LAS f32x4*)(part + ks * 256 + 192 + 4 * dq) = a3;
    __syncthreads();
    if (tid < 256) { float t = 0.f;
#pragma unroll 8
        for (int k = 0; k < 32; ++k) t += part[k * 256 + tid];
        oacc[tid] = t; }
    __syncthreads();
}

__device__ __forceinline__ void nsa_sample_unit(Frame& F, int l, int unit, int part_id) {
    const int tid = F.tid, qi = unit & 3, kvh = (unit >> 2) & 3, b = unit >> 4, row = MPT + b * 4 + qi;
    const bf16_t* P = (const bf16_t*)(F.ws + WS_P); const int* pt = (const int*)FIN(IN_PT);
    LAS float* qv = (LAS float*)(F.lds + SL_Q); LAS float* sc = (LAS float*)(F.lds + SL_SC); LAS float* imp = (LAS float*)(F.lds + SL_IMP); LAS float* red = (LAS float*)(F.lds + SL_RED);
    LAS int* list = (LAS int*)(F.lds + SL_LIST); LAS int* koff = (LAS int*)(F.lds + SL_KOFF); LAS float* part = (LAS float*)(F.lds + SL_PART); LAS float* oacc = (LAS float*)(F.lds + SL_OACC);
    LAS int* ptl = (LAS int*)(F.lds + SL_PT);
    __syncthreads();
    if (part_id == 0 && tid >= 256 && tid < 384) ptl[tid - 256] = pt[b * 128 + tid - 256];
    if (tid < 256) qv[tid] = bf2f(P[(size_t)row * NPROJ + C_Q + kvh * 256 + tid]) * (1.f / SM_SCALE_L2E);
    __syncthreads();
    float* soacc = (float*)(F.ws + WS_SOACC) + (size_t)unit * 768;
    if (part_id == 0) {
    {
        const int n = tid & 255, gp = tid >> 8;
        const bf16_t* kr = (const bf16_t*)(F.ws + WS_KCS) + ((size_t)(b * 4 + kvh) * 256 + n) * 64;
        float d0 = 0.f, d1 = 0.f;
#pragma unroll
        for (int j = 0; j < 8; ++j) { const u32x4 x = *(const u32x4*)(kr + 8 * j); float kf[8]; unpack8(x, kf);
#pragma unroll
            for (int e = 0; e < 8; ++e) { d0 += kf[e] * qv[(2 * gp) * 64 + 8 * j + e]; d1 += kf[e] * qv[(2 * gp + 1) * 64 + 8 * j + e]; } }
        sc[(2 * gp) * 1040 + n] = d0 * 0.125f; sc[(2 * gp + 1) * 1040 + n] = d1 * 0.125f;
    }
    __syncthreads();
    block_softmax4(sc, 256, red, tid);
    if (tid < 257) { float v; if (tid == 0 || tid >= 255) v = 1e4f; else v = sc[tid] + sc[1040 + tid] + sc[2080 + tid] + sc[3120 + tid]; imp[tid] = v; }
    {
        const int half = tid >> 8, gd = tid & 255, gh = gd >> 6, d = gd & 63;
        const bf16_t* vt = (const bf16_t*)(F.ws + WS_VCTS) + (size_t)(b * 4 + kvh) * 4 * 4096;
        float a = 0.f;
        for (int tl = 2 * half; tl < 2 * half + 2; ++tl) {
            const bf16_t* vr = vt + (size_t)tl * 4096 + d * 64;
#pragma unroll
            for (int j = 0; j < 8; ++j) { const u32x4 x = *(const u32x4*)(vr + 8 * j); float vf[8]; unpack8(x, vf);
#pragma unroll
                for (int e = 0; e < 8; ++e) a += sc[gh * 1040 + tl * 64 + keypos(8 * j + e)] * vf[e]; } }
        part[half * 256 + gd] = a;
    }
    __syncthreads();
    if (tid < 256) oacc[tid] = part[tid] + part[256 + tid];
    if (tid < 257) { const float si = imp[tid]; int rk = 0;
        for (int j = 0; j < 257; ++j) { const float sj = imp[j]; rk += (sj > si || (sj == si && j < tid)) ? 1 : 0; }
        if (rk < 16) list[rk] = tid; }
    __syncthreads();
    for (int idx = tid; idx < 1024; idx += NT) { const int blk = list[idx >> 6], kk = idx & 63; int ko;
        if (blk < 256) { const int page = ptl[blk >> 1]; ko = (int)(((((size_t)l * NPOOL + page) * 128 + (blk & 1) * 64 + kk) * 4 + 2) * 256 + kvh * 64); }
        else ko = (kk <= qi) ? -1 - (MPT + b * 4 + kk) : KOFF_INVALID;
        koff[idx] = ko; }
    __syncthreads();
    sample_scores(FIN(IN_CACHE), P, C_SK + kvh * 64, 1024, koff, qv, sc, tid);
    __syncthreads();
    block_softmax4(sc, 1024, red, tid);
    sample_pv(FIN(IN_CACHE), P, C_SK + kvh * 64, 1024, koff, sc, part, oacc + 256, tid);
    soacc[tid] = oacc[tid];
    } else {
    for (int idx = tid; idx < 516; idx += NT) { int ko;
        if (idx < 512) ko = (idx > qi) ? (int)((((size_t)(l * SB + b) * 512 + idx) * 2) * 256 + kvh * 64) : KOFF_INVALID;
        else ko = (idx - 512 <= qi) ? -1 - (MPT + b * 4 + idx - 512) : KOFF_INVALID;
        koff[idx] = ko; }
    __syncthreads();
    sample_scores(FIN(IN_SWIN), P, C_WK + kvh * 64, 516, koff, qv, sc, tid);
    __syncthreads();
    block_softmax4(sc, 516, red, tid);
    sample_pv(FIN(IN_SWIN), P, C_WK + kvh * 64, 516, koff, sc, part, oacc + 512, tid);
    if (tid < 256) soacc[512 + tid] = oacc[512 + tid];
    }
    __syncthreads();
}

struct SsmPow { float r[4], i[4]; };
__device__ __forceinline__ void ssm_pows(float ar, float ai, SsmPow& p) {
    p.r[0] = ar; p.i[0] = ai;
    p.r[1] = ar * ar - ai * ai; p.i[1] = 2.f * ar * ai;
    p.r[2] = p.r[1] * ar - p.i[1] * ai; p.i[2] = p.r[1] * ai + p.i[1] * ar;
    p.r[3] = p.r[1] * p.r[1] - p.i[1] * p.i[1]; p.i[3] = 2.f * p.r[1] * p.i[1];
}
struct SsmUnit { SsmPow pw[2]; bf16x8 bfr[4]; float alr[2], ali[2]; };
__device__ __forceinline__ void ssm_unit_load(const Frame& F, int l, int g, int lane, SsmUnit& U) {
    const int n32 = lane & 31, h = lane >> 5;
    const float* sab = (const float*)(F.ws + WS_SAB + l * al1m(SZ_SAB)) + (size_t)g * 64 * 4;
    const bf16_t* bb16 = (const bf16_t*)(F.ws + WS_SBB16 + l * al1m(SZ_SBB16)) + (size_t)g * 2 * 64 * 16;
#pragma unroll
    for (int s = 0; s < 2; ++s) { const f32x4 ab = *(const f32x4*)(sab + (n32 + 32 * s) * 4); ssm_pows(ab.x, ab.y, U.pw[s]); U.alr[s] = ab.z; U.ali[s] = ab.w;
        U.bfr[2 * s] = *(const bf16x8*)(bb16 + (size_t)(n32 + 32 * s) * 16 + 8 * h); U.bfr[2 * s + 1] = *(const bf16x8*)(bb16 + (size_t)(64 + n32 + 32 * s) * 16 + 8 * h); }
}
template <bool FIX>
__device__ __forceinline__ void ssm_block32(const bf16x8& au, const SsmUnit& U, float (&Hr)[2], float (&Hi)[2], float (&H1r)[2], float (&H1i)[2], f32x16 (&Dr)[2], f32x16 (&Di)[2], int h) {
    f32x16 z;
#pragma unroll
    for (int i = 0; i < 16; ++i) z[i] = 0.f;
#pragma unroll
    for (int s = 0; s < 2; ++s) { Dr[s] = MFMA32(au, U.bfr[2 * s], z); Di[s] = MFMA32(au, U.bfr[2 * s + 1], z); }
#pragma unroll
    for (int s = 0; s < 2; ++s) {
        const float ar = U.pw[s].r[0], ai = U.pw[s].i[0], a4r = U.pw[s].r[3], a4i = U.pw[s].i[3];
#pragma unroll
        for (int j = 0; j < 4; ++j)
#pragma unroll
            for (int e = 1; e < 4; ++e) { const int i = 4 * j + e;
                const float nr = ar * Dr[s][i - 1] - ai * Di[s][i - 1] + Dr[s][i], ni = ar * Di[s][i - 1] + ai * Dr[s][i - 1] + Di[s][i]; Dr[s][i] = nr; Di[s][i] = ni; }
        float hr = Hr[s], hi = Hi[s];
#pragma unroll
        for (int j = 0; j < 4; ++j) {
            const float ownr = Dr[s][4 * j + 3], owni = Di[s][4 * j + 3], othr = __shfl_xor(ownr, 32), othi = __shfl_xor(owni, 32);
            const float evr = h ? othr : ownr, evi = h ? othi : owni, odr = h ? ownr : othr, odi = h ? owni : othi;
            const float inr0 = hr, ini0 = hi;
            float t = a4r * hr - a4i * hi + evr; hi = a4r * hi + a4i * hr + evi; hr = t;
            if (j == 0) { H1r[s] = hr; H1i[s] = hi; }
            const float inr1 = hr, ini1 = hi;
            t = a4r * hr - a4i * hi + odr; hi = a4r * hi + a4i * hr + odi; hr = t;
            if (FIX) { const float inr = h ? inr1 : inr0, ini = h ? ini1 : ini0;
#pragma unroll
                for (int e = 0; e < 4; ++e) { const int i = 4 * j + e; Dr[s][i] += U.pw[s].r[e] * inr - U.pw[s].i[e] * ini; Di[s][i] += U.pw[s].r[e] * ini + U.pw[s].i[e] * inr; } }
        }
        Hr[s] = hr; Hi[s] = hi;
    }
}
__device__ __forceinline__ bf16x8 ssm_load_au(const bf16_t* P, int m0, int ntok, int g, int lane) {
    const int t = lane & 31, h = lane >> 5;
    if (t < ntok) return *(const bf16x8*)(P + (size_t)(m0 + t) * NPROJ + C_SU + g * 16 + 8 * h);
    return (bf16x8){0, 0, 0, 0, 0, 0, 0, 0};
}
__device__ __forceinline__ void s2_ssm_pass1(Frame& F, int l) {
    const bf16_t* P = (const bf16_t*)(F.ws + WS_P); f32x2* E = (f32x2*)(F.ws + WS_SSME);
    const int lane = F.lane, n32 = lane & 31, h = lane >> 5;
    for (int u = F.gw; u < PB * 64 * SSM_NCH; u += F.ngw) {
        const int b = u >> 11, g = (u >> 5) & 63, ch = u & 31, m0 = b * SEQ + ch * SSM_L;
        SsmUnit U; ssm_unit_load(F, l, g, lane, U);
        float Hr[2] = {0.f, 0.f}, Hi[2] = {0.f, 0.f}, H1r[2], H1i[2];
        bf16x8 au = ssm_load_au(P, m0, 32, g, lane);
#pragma unroll 1
        for (int blk = 0; blk < SSM_L / 32; ++blk) {
            const bf16x8 an = ssm_load_au(P, m0 + 32 * ((blk + 1) & 3), 32, g, lane);
            f32x16 Dr[2], Di[2];
            ssm_block32<false>(au, U, Hr, Hi, H1r, H1i, Dr, Di, h);
            au = an;
        }
        if (h == 0) { f32x2* e = E + ((size_t)(b * 64 + g) * SSM_NCH + ch) * 64; e[n32] = (f32x2){Hr[0], Hi[0]}; e[32 + n32] = (f32x2){Hr[1], Hi[1]}; }
    }
}
__device__ __forceinline__ void s3_ssm_pass2(Frame& F, int l) {
    const bf16_t* P = (const bf16_t*)(F.ws + WS_P); const f32x2* E = (const f32x2*)(F.ws + WS_SSME); bf16_t* Z = (bf16_t*)(F.ws + WS_Z);
    LAS unsigned char* himg = F.lds + 65536 + F.wave * 8960;
    const int lane = F.lane, n32 = lane & 31, h = lane >> 5, tk = lane & 15, cq = lane >> 4;
    for (int u = F.gw; u < PB * 64 * SSM_NCH + SB * 64; u += F.ngw) {
        const bool smp = u >= PB * 64 * SSM_NCH;
        int b, g, ch, m0, nblk, ntok;
        if (!smp) { b = u >> 11; g = (u >> 5) & 63; ch = (u & 31) ^ (b & 1 ? 31 : 0); m0 = b * SEQ + ch * SSM_L; nblk = SSM_L / 32; ntok = 32; }
        else { const int su = u - PB * 64 * SSM_NCH; b = su >> 6; g = su & 63; ch = 0; m0 = MPT + b * 4; nblk = 1; ntok = 4; }
        SsmUnit U; ssm_unit_load(F, l, g, lane, U);
        bf16x8 cmf[4];
        { const bf16_t* cm = (const bf16_t*)(F.ws + WS_SCM + l * al1m(SZ_SCM)) + (size_t)(g * 16 + tk) * 128 + 8 * cq;
#pragma unroll
            for (int ks = 0; ks < 4; ++ks) cmf[ks] = *(const bf16x8*)(cm + 32 * ks); }
        const f32x4 ds = *(const f32x4*)(FIN(IN_DSKIP) + l * 1024 + g * 16 + 4 * cq);
        float Hr[2] = {0.f, 0.f}, Hi[2] = {0.f, 0.f}, H1r[2] = {0.f, 0.f}, H1i[2] = {0.f, 0.f};
        if (!smp) { const f32x2* e = E + (size_t)(b * 64 + g) * SSM_NCH * 64;
            for (int j0 = 0; j0 < ch; j0 += 8) {
                f32x2 ev[8][2];
#pragma unroll
                for (int jj = 0; jj < 8; ++jj)
#pragma unroll
                    for (int s = 0; s < 2; ++s) ev[jj][s] = (j0 + jj < ch) ? e[(size_t)(j0 + jj) * 64 + n32 + 32 * s] : (f32x2){0.f, 0.f};
#pragma unroll
                for (int jj = 0; jj < 8; ++jj) if (j0 + jj < ch) {
#pragma unroll
                    for (int s = 0; s < 2; ++s) { const float nr = U.alr[s] * Hr[s] - U.ali[s] * Hi[s] + ev[jj][s].x, ni = U.alr[s] * Hi[s] + U.ali[s] * Hr[s] + ev[jj][s].y; Hr[s] = nr; Hi[s] = ni; } } } }
        else { const float* h0 = FIN(IN_SSSM) + ((size_t)(l * SB + b) * 2 * 64 + g) * 64 + n32;
#pragma unroll
            for (int s = 0; s < 2; ++s) { Hr[s] = h0[32 * s]; Hi[s] = h0[64 * 64 + 32 * s]; } }
        bf16x8 au = ssm_load_au(P, m0, ntok, g, lane);
#pragma unroll 1
        for (int blk = 0; blk < nblk; ++blk) {
            const bf16x8 an = ssm_load_au(P, m0 + 32 * ((blk + 1) & 3), ntok, g, lane);
            u32x2 uw[2];
#pragma unroll
            for (int tt = 0; tt < 2; ++tt) uw[tt] = (16 * tt + tk < ntok) ? *(const u32x2*)(P + (size_t)(m0 + 32 * blk + 16 * tt + tk) * NPROJ + C_SU + g * 16 + 4 * cq) : (u32x2){0u, 0u};
            f32x16 Dr[2], Di[2];
            ssm_block32<true>(au, U, Hr, Hi, H1r, H1i, Dr, Di, h);
            au = an;
#pragma unroll
            for (int i = 0; i < 16; ++i) { const int tl = (i & 3) + 8 * (i >> 2) + 4 * h;
                *(LAS unsigned*)(himg + tl * 272 + 4 * n32) = pk2(Dr[0][i], Di[0][i]); *(LAS unsigned*)(himg + tl * 272 + 4 * (32 + n32)) = pk2(Dr[1][i], Di[1][i]); }
            LDS_WAIT(); asm volatile("" ::: "memory");
#pragma unroll
            for (int tt = 0; tt < 2; ++tt) {
                f32x4 y = {0.f, 0.f, 0.f, 0.f};
#pragma unroll
                for (int ks = 0; ks < 4; ++ks) { const bf16x8 hf = *(const LAS bf16x8*)(himg + (16 * tt + tk) * 272 + (32 * ks + 8 * cq) * 2); y = __builtin_amdgcn_mfma_f32_16x16x32_bf16(cmf[ks], hf, y, 0, 0, 0); }
                const int t = 32 * blk + 16 * tt + tk;
                if (16 * tt + tk < ntok) { const f32x4 uu = unpack4(uw[tt]);
                    u32x2 o; o.x = pk2(gelu_tanh(y.x + ds.x * uu.x), gelu_tanh(y.y + ds.y * uu.y)); o.y = pk2(gelu_tanh(y.z + ds.z * uu.z), gelu_tanh(y.w + ds.w * uu.w));
                    *(u32x2*)(Z + (size_t)(m0 + t) * 1024 + g * 16 + 4 * cq) = o; }
            }
            LDS_WAIT(); asm volatile("" ::: "memory");
        }
        if (h == 0) {
            if (smp) { float* o = F.out + O_SSMS + ((size_t)(l * SB + b) * 2 * 64 + g) * 64 + n32;
#pragma unroll
                for (int s = 0; s < 2; ++s) { o[32 * s] = H1r[s]; o[64 * 64 + 32 * s] = H1i[s]; } }
            else if (ch == SSM_NCH - 1) { float* o = F.out + O_SSMP + ((size_t)(l * PB + b) * 2 * 64 + g) * 64 + n32;
#pragma unroll
                for (int s = 0; s < 2; ++s) { o[32 * s] = Hr[s]; o[64 * 64 + 32 * s] = Hi[s]; } }
        }
    }
}
struct Args { const float* in[27]; float* out; unsigned char* ws; int ph_lo, ph_hi; };
constexpr int N_PHASES = 15;

__global__ void __launch_bounds__(NT, 2) fwd_kernel(Args args) {
    extern __shared__ __attribute__((aligned(16))) unsigned char lds_raw[];
    Frame F;
    F.lds = (LAS unsigned char*)lds_raw;
    F.tid = threadIdx.x; F.lane = F.tid & 63; F.wave = __builtin_amdgcn_readfirstlane(F.tid >> 6);
    F.G = gridDim.x; F.bid = blockIdx.x; F.gw = F.bid * NWAVES + F.wave; F.ngw = F.G * NWAVES;
    F.out = args.out; F.ws = args.ws;
    volatile LAS unsigned* misc = (volatile LAS unsigned*)(F.lds + LDS_MISC);
    if (F.tid < 64) misc[F.tid] = 0u;
    __syncthreads();
    const int lo = args.ph_lo, hi = args.ph_hi;
#if MK_PER_PHASE
#define GRID_BAR() do { } while (0)
#else
    XcdBarrier bar = xcd_barrier_post((unsigned*)(F.ws + WS_CTL) + CW_BAR, misc + 8);
#define GRID_BAR() xcd_barrier(bar)
#endif
#ifdef ONLYPH
#define IN(k) ((((k)==0?0:(((k)-1)%7)+1))==ONLYPH && lo <= (k) && (k) < hi)
#else
#define IN(k) (lo <= (k) && (k) < hi)
#endif
#define BOTH(k) (IN(k) && IN((k) + 1))
#ifndef PROBE_PH
#define PROBE_PH -1
#endif
#define REPS(k) _Pragma("unroll 1") for (int rep_ = 0; rep_ < ((PROBE_PH) == (k) ? 2 : 1); ++rep_)
#define PHASE_BEGIN() do { int t_ = threadIdx.x; asm volatile("" : "+v"(t_)); F.tid = t_; F.lane = t_ & 63; F.wave = __builtin_amdgcn_readfirstlane(t_ >> 6); \
    F.gw = F.bid * NWAVES + F.wave; GAS unsigned char* w_ = (GAS unsigned char*)args.ws; asm volatile("" : "+s"(w_)); F.ws = (unsigned char*)w_; \
    GAS float* o_ = (GAS float*)args.out; asm volatile("" : "+s"(o_)); F.out = (float*)o_; } while (0)
    if (IN(0)) { PHASE_BEGIN(); REPS(0) phase_prologue(F); if (BOTH(0)) GRID_BAR(); }
    for (int l = 0; l < 2; ++l) {
        const int p0 = 1 + 7 * l;
        if (IN(p0)) {
            PHASE_BEGIN();
            pg8::Gemm g{(const bf16_t*)(F.ws + WS_H), (const bf16_t*)(F.ws + WS_WIN + l * al1m(SZ_WIN)), DM, DM, DM, 0, 0};
            pg8::TileOrder S; S.init(MPT / 256, NPROJ / 256, 1, 0, F.G, F.bid);
            EpiProj E{(bf16_t*)(F.ws + WS_P), (float*)(F.ws + WS_GATE), F.out, l};
            REPS(1) pg8::gemm_phase(F.lds, g, S, E);
            skinny_proj(F, l);
            if (BOTH(p0)) GRID_BAR();
        }
        if (IN(p0 + 1)) {
            PHASE_BEGIN();
            REPS(2) {
#ifndef SK_A
            REPS(21) s2_compress(F, l);
#endif
            __syncthreads();
#ifndef SK_B
            PHASE_BEGIN();
            REPS(22) s2_ssm_pass1(F, l);
#endif
#ifndef SK_C
            PHASE_BEGIN();
            REPS(23) s2_pool_diff(F, l);
#endif
#ifndef SK_D
            PHASE_BEGIN();
            REPS(24) s2_state_outputs(F, l);
#endif
#ifndef SK_E
            PHASE_BEGIN();
            REPS(25) s2_vt_images(F);
#endif
            }
            if (BOTH(p0 + 1)) GRID_BAR();
        }
        if (IN(p0 + 2)) {
            PHASE_BEGIN();
            REPS(33) s3_ssm_pass2(F, l);
            __syncthreads();
            if (BOTH(p0 + 2)) GRID_BAR();
        }
        if (IN(p0 + 3)) {
            PHASE_BEGIN();
            REPS(3) {
#ifndef SK_F
            REPS(31) for (int p = F.bid; p < 256; p += F.G) { const int bk = p >> 5, j = p & 31;
#pragma unroll 1
                for (int k2 = 0; k2 < 2; ++k2) nsa_prompt_unit(F, l, bk >> 2, bk & 3, k2 ? j : 63 - j); }
#endif
#ifndef SK_G
            PHASE_BEGIN();
            for (int uu = F.bid; uu < (((PROBE_PH) == 35 || (PROBE_PH) == 36) ? 2048 : (PROBE_PH) == 32 ? 512 : 256); uu += F.G) { const int u = uu & 255, part = (u >> 3) & 1;
                if (uu >= 256 && (PROBE_PH) != 32 && (PROBE_PH) != 35 + part) continue;
                nsa_sample_unit(F, l, (u & 7) | ((u >> 4) << 3), part); }
#endif
            __syncthreads();
            PHASE_BEGIN();
            REPS(4) {
            const int hi = (F.bid >> 3) & 1, idx = (F.bid >> 4) * 8 + (F.bid & 7);
            const int n1 = (F.G >> 4) * 8 + ((F.G & 15) > 8 ? (F.G & 15) - 8 : 0), n0 = F.G - n1;
            if (hi || n1 == 0) {
                pg8::Gemm g{(const bf16_t*)(F.ws + WS_Z), (const bf16_t*)(F.ws + WS_WGLU + l * al1m(SZ_WGLU)), 1024, 1024, 1024, 0, 0};
                pg8::TileOrder S; if (n1) S.init(MPT / 256, 4, 1, 0, n1, idx); else S.init(MPT / 256, 4, 1, 0, F.G, F.bid);
                EpiGlu E{(bf16_t*)(F.ws + WS_ABR + 2 * SZ_ABR1), (const bf16_t*)(F.ws + WS_P), (const bf16_t*)(F.ws + WS_Z)};
                pg8::gemm_phase(F.lds, g, S, E);
            }
            if (!hi) {
                pg8::Gemm g{(const bf16_t*)(F.ws + WS_DIFF), (const bf16_t*)(F.ws + WS_WPOOL + l * al1m(SZ_WPOOL)), 1024, 256, 256, 256, 65536};
                pg8::TileOrder S; S.init(MPT / 256, 1, 4, 0, n0, idx);
                EpiPool E{(bf16_t*)(F.ws + WS_ABR), (const bf16_t*)(F.ws + WS_P), FIN(IN_PSCALE) + l * 1024};
                pg8::gemm_phase(F.lds, g, S, E);
            }
            skinny_glu(F, l); skinny_pool(F, l);
            }
            }
            if (BOTH(p0 + 3)) GRID_BAR();
        }
        if (IN(p0 + 4)) {
            PHASE_BEGIN();
            pg8::Gemm g{(const bf16_t*)(F.ws + WS_ABR), (const bf16_t*)(F.ws + WS_WBR + l * al1m(SZ_WBR)), 1024, 1024, 1024, (size_t)MPAD * 1024, (size_t)2048 * 1024};
            pg8::TileOrder S; S.init(MPT / 256, 8, 3, 1, F.G, F.bid);
            EpiBranch E{(bf16_t*)(F.ws + WS_MERGED), (const bf16_t*)(F.ws + WS_P)};
            REPS(5) { pg8::gemm_phase(F.lds, g, S, E); skinny_branch(F, l); }
            if (BOTH(p0 + 4)) GRID_BAR();
        }
        if (IN(p0 + 5)) {
            PHASE_BEGIN();
            pg8::Gemm g{(const bf16_t*)(F.ws + WS_MERGED), (const bf16_t*)(F.ws + WS_WOUT + l * al1m(SZ_WOUT)), DM, DM, DM, 0, 0};
            pg8::TileOrder S; S.init(MPT / 256, 8, 1, 0, F.G, F.bid);
            EpiOut E{(bf16_t*)(F.ws + WS_OUTB)};
            REPS(6) { pg8::gemm_phase(F.lds, g, S, E); skinny_out(F, l); }
            if (BOTH(p0 + 5)) GRID_BAR();
        }
        if (IN(p0 + 6)) {
            PHASE_BEGIN();
            REPS(7) phase_norm(F, l);
            if (BOTH(p0 + 6)) GRID_BAR();
        }
    }
#undef IN
#undef BOTH
}

extern "C" void kernel_launch(void* const* d_in, const int* in_sizes, int n_in, void* d_out, int out_size, void* d_ws, size_t ws_size, hipStream_t stream) {
    static int grid = 0;
    if (grid == 0) {
        if (n_in != 27 || out_size != (int)O_TOTAL || ws_size < WS_END) { fprintf(stderr, "kernel_launch: unexpected problem shape (n_in %d, out %d, ws %zu < %zu)\n", n_in, out_size, ws_size, (size_t)WS_END); grid = -1; return; }
        int dev = 0, cus = 0, per_cu = 0;
        if (hipGetDevice(&dev) != hipSuccess || hipDeviceGetAttribute(&cus, hipDeviceAttributeMultiprocessorCount, dev) != hipSuccess) { grid = -1; return; }
        if (hipFuncSetAttribute((const void*)fwd_kernel, hipFuncAttributeMaxDynamicSharedMemorySize, LDS_BYTES) != hipSuccess) { fprintf(stderr, "kernel_launch: hipFuncSetAttribute failed\n"); grid = -1; return; }
        if (hipOccupancyMaxActiveBlocksPerMultiprocessor(&per_cu, (const void*)fwd_kernel, NT, LDS_BYTES) != hipSuccess || per_cu < 1)
            fprintf(stderr, "kernel_launch: note: occupancy query reports %d workgroups per CU\n", per_cu);
        (void)hipGetLastError();
        grid = cus;
    }
    if (grid < 0) return;
    if (hipMemsetAsync((char*)d_ws + WS_CTL, 0, CTL_ZERO_BYTES, stream) != hipSuccess) return;
    Args a{};
    for (int i = 0; i < 27; ++i) a.in[i] = (const float*)d_in[i];
    a.out = (float*)d_out; a.ws = (unsigned char*)d_ws;
#if MK_PER_PHASE
    for (int k = 0; k < N_PHASES; ++k) { a.ph_lo = k; a.ph_hi = k + 1; hipLaunchKernelGGL(fwd_kernel, dim3(grid), dim3(NT), LDS_BYTES, stream, a); }
#else
    a.ph_lo = 0; a.ph_hi = N_PHASES;
    hipLaunchKernelGGL(fwd_kernel, dim3(grid), dim3(NT), LDS_BYTES, stream, a);
#endif
    const hipError_t le = hipPeekAtLastError();
    if (le != hipSuccess) fprintf(stderr, "kernel_launch: launch failed: %s\n", hipGetErrorName(le));
}
```
